# Optimizing an MI355X kernel written in HIP

```python
import math
import jax
import jax.numpy as jnp
from jax import lax
import numpy as np

D_MODEL = 2048
BATCH = 1
SEQ = 8192
DEPTH = 2

MIX_W = 512
N_BRANCH = 4
HEAD_DIM = 64
NORM_EPS = 1e-6

RWKV_HEADS = MIX_W // HEAD_DIM
RWKV_W_LORA = 32
RWKV_A_LORA = 32
RWKV_G_LORA = 96
RWKV_DECAY_SCALE = 0.6065306597126334
RWKV_LN_EPS = 64e-5

RET_HEADS = 8
RET_HD = MIX_W // RET_HEADS
RET_CHUNK = 128
ROPE_BASE = 10000.0

LRU_BLOCKS = 8
LRU_BD = MIX_W // LRU_BLOCKS
CONV_W = 4
LRU_C = 8.0

GLA_HEADS = 4
GLA_DK = (MIX_W // 2) // GLA_HEADS
GLA_DV = MIX_W // GLA_HEADS
GLA_LORA = 16
GLA_GATE_NORM = 16.0
GLA_CHUNK = 64

N_GROUPS = 4
EXP_PER_GROUP = 8
N_EXPERTS = N_GROUPS * EXP_PER_GROUP
TOP_K = 2
D_EXPERT = 1024
MOE_BLOCK = 128

A_COLS = 3 * MIX_W + RWKV_W_LORA + RWKV_A_LORA + RWKV_G_LORA
B_COLS = 4 * MIX_W
C_COLS = 2 * MIX_W
D_COLS = 2 * (MIX_W // 2) + MIX_W + GLA_LORA + MIX_W
GATE_COLS = N_BRANCH * D_MODEL
IN_COLS = A_COLS + B_COLS + C_COLS + D_COLS + GATE_COLS

kernel_name = 'hybrid_rwkv7_retnet_rglru_gla_hmoe'


def rmsnorm(x, g):
    xf = x.astype(jnp.float32)
    y = xf * lax.rsqrt(jnp.mean(xf * xf, -1, keepdims=True) + NORM_EPS)
    return (y * g.astype(jnp.float32)).astype(x.dtype)


def head_rmsnorm(y, g):
    h, d = y.shape[-2], y.shape[-1]
    y = y * lax.rsqrt(jnp.mean(y * y, -1, keepdims=True) + NORM_EPS)
    return y * g.astype(jnp.float32).reshape(h, d)


def head_layernorm(y, g, b, eps):
    h, d = y.shape[-2], y.shape[-1]
    mean = jnp.mean(y, -1, keepdims=True)
    yc = y - mean
    yn = yc * lax.rsqrt(jnp.mean(yc * yc, -1, keepdims=True) + eps)
    return yn * g.astype(jnp.float32).reshape(h, d) + b.astype(jnp.float32).reshape(h, d)


def rotary(x, positions):
    d = x.shape[-1]
    inv = 1.0 / (ROPE_BASE ** (jnp.arange(0, d, 2, dtype=jnp.float32) / d))
    ang = positions.astype(jnp.float32)[..., None] * inv
    cos = jnp.cos(ang)[:, :, None, :]
    sin = jnp.sin(ang)[:, :, None, :]
    x1, x2 = x[..., : d // 2], x[..., d // 2:]
    return jnp.concatenate([x1 * cos - x2 * sin, x2 * cos + x1 * sin], -1)


def rwkv7_branch(cols, mu, w0, w_up, a0, a_up, g_up, k_k, k_a, r_k, ln_g, ln_b):
    f32 = jnp.float32
    B_, S_, _ = cols.shape
    H, N = RWKV_HEADS, HEAD_DIM
    prev = jnp.pad(cols, ((0, 0), (1, 0), (0, 0)))[:, :S_]
    z = cols + (prev - cols) * mu
    o1 = 3 * MIX_W + RWKV_W_LORA
    r, k, v, wl, al, gl = jnp.split(z, [MIX_W, 2 * MIX_W, 3 * MIX_W, o1, o1 + RWKV_A_LORA], axis=-1)
    w = jnp.exp(-RWKV_DECAY_SCALE * jax.nn.sigmoid((w0 + jnp.tanh(wl) @ w_up).astype(f32)))
    a = jax.nn.sigmoid((a0 + al @ a_up).astype(f32))
    g = (jax.nn.sigmoid(gl) @ g_up).astype(f32)
    r = r.astype(f32)
    k = k.astype(f32)
    v = v.astype(f32)
    kk = (k * k_k.astype(f32)).reshape(B_, S_, H, N)
    kk = kk / jnp.maximum(jnp.sqrt(jnp.sum(kk * kk, -1, keepdims=True)), 1e-12)
    k = k * (1.0 + (a - 1.0) * k_a.astype(f32))

    def to_steps(t):
        return t.reshape(B_, S_, H, N).transpose(1, 0, 2, 3)

    xs = (to_steps(r), to_steps(w), to_steps(k), to_steps(v), kk.transpose(1, 0, 2, 3), to_steps(a))

    def step(state, inp):
        r_t, w_t, k_t, v_t, kk_t, a_t = inp
        sa = jnp.einsum('bhvk,bhk->bhv', state, -kk_t)
        state = (state * w_t[:, :, None, :]
                 + sa[..., None] * (kk_t * a_t)[:, :, None, :]
                 + v_t[..., None] * k_t[:, :, None, :])
        return state, jnp.einsum('bhvk,bhk->bhv', state, r_t)

    _, y = lax.scan(step, jnp.zeros((B_, H, N, N), f32), xs)
    y = y.transpose(1, 0, 2, 3)
    y = head_layernorm(y, ln_g, ln_b, RWKV_LN_EPS)
    r4, k4, v4 = r.reshape(B_, S_, H, N), k.reshape(B_, S_, H, N), v.reshape(B_, S_, H, N)
    bonus = jnp.sum(r4 * k4 * r_k.astype(f32), -1, keepdims=True) * v4
    y = (y + bonus).reshape(B_, S_, MIX_W) * g
    return y.astype(cols.dtype)


def retention_branch(cols, positions, norm_g):
    f32 = jnp.float32
    B_, S_, _ = cols.shape
    H, d, C = RET_HEADS, RET_HD, RET_CHUNK
    N = S_ // C
    q, k, v, gt = jnp.split(cols, 4, axis=-1)

    def hs(t):
        return t.reshape(B_, S_, H, d).astype(f32)

    q = rotary(hs(q), positions)
    k = rotary(hs(k), positions) * (d ** -0.5)
    v = hs(v)
    log_g = jnp.log(1.0 - jnp.exp(jnp.linspace(math.log(1.0 / 32), math.log(1.0 / 512), H, dtype=f32)))
    idx = jnp.arange(C, dtype=f32)
    diff = idx[:, None] - idx[None, :]
    decay = jnp.where(diff >= 0, jnp.exp(log_g[:, None, None] * jnp.maximum(diff, 0.0)[None]), 0.0)
    qc = q.reshape(B_, N, C, H, d)
    kc = k.reshape(B_, N, C, H, d)
    vc = v.reshape(B_, N, C, H, d)
    scores = jnp.einsum('bnihd,bnjhd->bnhij', qc, kc) * decay
    intra = jnp.einsum('bnhij,bnjhe->bnihe', scores, vc)
    zeta = jnp.exp(log_g[:, None] * (C - 1 - idx)[None])
    kv = jnp.einsum('bnjhd,hj,bnjhe->nbhde', kc, zeta, vc)
    chunk_decay = jnp.exp(log_g * C)[None, :, None, None]

    def step(state, kv_n):
        return state * chunk_decay + kv_n, state

    _, prev = lax.scan(step, jnp.zeros((B_, H, d, d), f32), kv)
    xi = jnp.exp(log_g[:, None] * (idx + 1)[None])
    cross = jnp.einsum('bnihd,nbhde,hi->bnihe', qc, prev, xi)
    o = (intra + cross).reshape(B_, S_, H, d)
    o = head_rmsnorm(o, norm_g).reshape(B_, S_, MIX_W)
    return (o * jax.nn.silu(gt.astype(f32))).astype(cols.dtype)


def rglru_branch(cols, positions, conv_w, conv_b, w_a, b_a, w_x, b_x, lam):
    f32 = jnp.float32
    B_, S_, _ = cols.shape
    G, BD = LRU_BLOCKS, LRU_BD
    xb, gb = jnp.split(cols, 2, axis=-1)
    xc = lax.conv_general_dilated(xb, conv_w[:, None, :].astype(xb.dtype), window_strides=(1,),
                                  padding=[(CONV_W - 1, 0)], dimension_numbers=('NWC', 'WIO', 'NWC'),
                                  feature_group_count=MIX_W) + conv_b
    xh = xc.reshape(B_, S_, G, BD).astype(f32)
    r = jax.nn.sigmoid(jnp.einsum('bsgi,gij->bsgj', xh, w_a.astype(f32)) + b_a.astype(f32).reshape(G, BD))
    i = jax.nn.sigmoid(jnp.einsum('bsgi,gij->bsgj', xh, w_x.astype(f32)) + b_x.astype(f32).reshape(G, BD))
    log_a = -LRU_C * r * jax.nn.softplus(-lam.astype(f32).reshape(G, BD))
    reset = (positions == 0)[:, :, None, None]
    a = jnp.where(reset, 0.0, jnp.exp(log_a))
    mult = jnp.where(reset, 1.0, jnp.sqrt(-jnp.expm1(2.0 * log_a)))
    b = mult * i * xh

    def combine(lhs, rhs):
        a1, b1 = lhs
        a2, b2 = rhs
        return a1 * a2, a2 * b1 + b2

    _, hseq = lax.associative_scan(combine, (a, b), axis=1)
    y = hseq.reshape(B_, S_, MIX_W) * jax.nn.gelu(gb.astype(f32))
    return y.astype(cols.dtype)


def gla_branch(cols, alpha_up, alpha_b, norm_g):
    f32 = jnp.float32
    B_, S_, _ = cols.shape
    H, dk, dv, C = GLA_HEADS, GLA_DK, GLA_DV, GLA_CHUNK
    N = S_ // C
    hk = MIX_W // 2
    q, k, v, al, gt = jnp.split(cols, [hk, 2 * hk, 2 * hk + MIX_W, 2 * hk + MIX_W + GLA_LORA], axis=-1)
    log_a = jax.nn.log_sigmoid((al @ alpha_up + alpha_b).astype(f32)) / GLA_GATE_NORM

    def chunks(t, dd):
        return t.reshape(B_, N, C, H, dd).astype(f32)

    qc = chunks(q, dk) * (dk ** -0.5)
    kc = chunks(k, dk)
    vc = chunks(v, dv)
    bcum = jnp.cumsum(chunks(log_a, dk), axis=2)
    blast = bcum[:, :, -1:]
    q_e = qc * jnp.exp(bcum)
    k_e = kc * jnp.exp(-bcum)
    causal = jnp.tril(jnp.ones((C, C), dtype=bool))
    scores = jnp.where(causal, jnp.einsum('bnihd,bnjhd->bnhij', q_e, k_e), 0.0)
    intra = jnp.einsum('bnhij,bnjhe->bnihe', scores, vc)
    kv = jnp.einsum('bnjhd,bnjhe->nbhde', kc * jnp.exp(blast - bcum), vc)
    dec = jnp.exp(blast[:, :, 0]).transpose(1, 0, 2, 3)

    def step(state, inp):
        kv_n, d_n = inp
        return state * d_n[..., None] + kv_n, state

    _, prev = lax.scan(step, jnp.zeros((B_, H, dk, dv), f32), (kv, dec))
    cross = jnp.einsum('bnihd,nbhde->bnihe', q_e, prev)
    o = (intra + cross).reshape(B_, S_, H, dv)
    o = head_rmsnorm(o, norm_g).reshape(B_, S_, MIX_W)
    return (o * jax.nn.silu(gt.astype(f32))).astype(cols.dtype)


def hier_moe(xn, wg_r, bg_r, we_r, be_r, w_gate, w_up, w_down):
    f32 = jnp.float32
    B_, S_, D = xn.shape
    T = B_ * S_
    xf = xn.reshape(T, D)
    pg = jax.nn.softmax((xf @ wg_r).astype(f32) + bg_r.astype(f32), -1)
    pg_top, g_idx = lax.top_k(pg, 1)
    le = ((xf @ we_r).astype(f32) + be_r.astype(f32)).reshape(T, N_GROUPS, EXP_PER_GROUP)
    sel = jnp.broadcast_to(g_idx[:, :, None], (T, 1, EXP_PER_GROUP))
    le_sel = jnp.take_along_axis(le, sel, axis=1)[:, 0]
    pe_top, e_idx = lax.top_k(jax.nn.softmax(le_sel, -1), TOP_K)
    pe_top = pe_top / jnp.sum(pe_top, -1, keepdims=True)
    gate = (pg_top * pe_top).reshape(-1)
    expert_id = (g_idx * EXP_PER_GROUP + e_idx).reshape(-1).astype(jnp.int32)
    token_id = jnp.repeat(jnp.arange(T, dtype=jnp.int32), TOP_K)
    order = jnp.argsort(expert_id)
    se, st, sg = expert_id[order], token_id[order], gate[order]
    counts = jnp.zeros((N_EXPERTS,), jnp.int32).at[expert_id].add(1)
    starts = jnp.cumsum(counts) - counts
    padded = (counts + MOE_BLOCK - 1) // MOE_BLOCK * MOE_BLOCK
    pad_ends = jnp.cumsum(padded)
    pad_starts = pad_ends - padded
    dest = pad_starts[se] + (jnp.arange(T * TOP_K, dtype=jnp.int32) - starts[se])
    n_blocks = (T * TOP_K + MOE_BLOCK - 1) // MOE_BLOCK + N_EXPERTS
    n_rows = n_blocks * MOE_BLOCK
    row_tok = jnp.full((n_rows,), T, jnp.int32).at[dest].set(st)
    row_gate = jnp.zeros((n_rows,), f32).at[dest].set(sg)
    block_start = jnp.arange(n_blocks, dtype=jnp.int32) * MOE_BLOCK
    block_exp = jnp.minimum(jnp.sum(block_start[:, None] >= pad_ends[None, :], axis=1), N_EXPERTS - 1)
    x_pad = jnp.concatenate([xf, jnp.zeros((1, D), xf.dtype)], 0)
    xb = x_pad[row_tok].reshape(n_blocks, MOE_BLOCK, D)

    def expert_block(args):
        xblk, e = args
        hmid = jax.nn.silu(xblk @ w_gate[e]) * (xblk @ w_up[e])
        return hmid @ w_down[e]

    yb = lax.map(expert_block, (xb, block_exp)).reshape(n_rows, D)
    out = jnp.zeros((T + 1, D), f32).at[row_tok].add(yb.astype(f32) * row_gate[:, None])
    return out[:T].reshape(B_, S_, D).astype(xn.dtype)


def setup_inputs(seed: int = 0) -> dict:
    key = jax.random.key(seed)
    keys = jax.random.split(key, 48)
    f32 = jnp.float32
    L = DEPTH

    def nrm(i, shape, scale):
        return jax.random.normal(keys[i], shape, f32) * scale

    def gain(i, shape):
        return 1.0 + 0.05 * jax.random.normal(keys[i], shape, f32)

    u = jax.random.uniform(keys[27], (L, MIX_W), f32, 0.9, 0.999)
    a_lru = u ** (1.0 / LRU_C)
    return {
        'x': nrm(0, (BATCH, SEQ, D_MODEL), 1.0),
        'positions': jnp.broadcast_to(jnp.arange(SEQ, dtype=jnp.int32)[None], (BATCH, SEQ)),
        'norm_mix_g': gain(1, (L, D_MODEL)),
        'w_in': nrm(2, (L, D_MODEL, IN_COLS), D_MODEL ** -0.5),
        'rwkv_mu': jax.random.uniform(keys[3], (L, A_COLS), f32, 0.2, 0.8),
        'rwkv_w0': nrm(4, (L, MIX_W), 0.5),
        'rwkv_w_up': nrm(5, (L, RWKV_W_LORA, MIX_W), 0.1),
        'rwkv_a0': nrm(6, (L, MIX_W), 0.5),
        'rwkv_a_up': nrm(7, (L, RWKV_A_LORA, MIX_W), 0.1),
        'rwkv_g_up': nrm(8, (L, RWKV_G_LORA, MIX_W), RWKV_G_LORA ** -0.5),
        'rwkv_k_k': 0.85 + nrm(9, (L, MIX_W), 0.05),
        'rwkv_k_a': gain(10, (L, MIX_W)),
        'rwkv_r_k': nrm(11, (L, RWKV_HEADS, HEAD_DIM), 0.1),
        'rwkv_ln_g': gain(12, (L, MIX_W)),
        'rwkv_ln_b': nrm(13, (L, MIX_W), 0.01),
        'rwkv_w_o': nrm(14, (L, MIX_W, D_MODEL), MIX_W ** -0.5),
        'ret_norm_g': gain(15, (L, MIX_W)),
        'ret_w_o': nrm(16, (L, MIX_W, D_MODEL), MIX_W ** -0.5),
        'lru_conv_w': nrm(17, (L, CONV_W, MIX_W), CONV_W ** -0.5),
        'lru_conv_b': nrm(18, (L, MIX_W), 0.01),
        'lru_w_a': nrm(19, (L, LRU_BLOCKS, LRU_BD, LRU_BD), LRU_BD ** -0.5),
        'lru_b_a': nrm(20, (L, MIX_W), 0.01),
        'lru_w_x': nrm(21, (L, LRU_BLOCKS, LRU_BD, LRU_BD), LRU_BD ** -0.5),
        'lru_b_x': nrm(22, (L, MIX_W), 0.01),
        'lru_lambda': jnp.log(a_lru) - jnp.log1p(-a_lru),
        'lru_w_o': nrm(23, (L, MIX_W, D_MODEL), MIX_W ** -0.5),
        'gla_alpha_up': nrm(24, (L, GLA_LORA, MIX_W // 2), GLA_LORA ** -0.5),
        'gla_alpha_b': nrm(25, (L, MIX_W // 2), 0.1),
        'gla_norm_g': gain(26, (L, MIX_W)),
        'gla_w_o': nrm(28, (L, MIX_W, D_MODEL), MIX_W ** -0.5),
        'w_out': nrm(29, (L, D_MODEL, D_MODEL), D_MODEL ** -0.5),
        'norm_ffn_g': gain(30, (L, D_MODEL)),
        'router_group_w': nrm(31, (L, D_MODEL, N_GROUPS), D_MODEL ** -0.5),
        'router_group_b': nrm(32, (L, N_GROUPS), 0.01),
        'router_expert_w': nrm(33, (L, D_MODEL, N_EXPERTS), D_MODEL ** -0.5),
        'router_expert_b': nrm(34, (L, N_EXPERTS), 0.01),
        'moe_w_gate': nrm(35, (L, N_EXPERTS, D_MODEL, D_EXPERT), D_MODEL ** -0.5),
        'moe_w_up': nrm(36, (L, N_EXPERTS, D_MODEL, D_EXPERT), D_MODEL ** -0.5),
        'moe_w_down': nrm(37, (L, N_EXPERTS, D_EXPERT, D_MODEL), D_EXPERT ** -0.5),
        'final_norm_g': gain(38, (D_MODEL,)),
    }


def reference(x, positions, norm_mix_g, w_in, rwkv_mu, rwkv_w0, rwkv_w_up, rwkv_a0, rwkv_a_up,
              rwkv_g_up, rwkv_k_k, rwkv_k_a, rwkv_r_k, rwkv_ln_g, rwkv_ln_b, rwkv_w_o,
              ret_norm_g, ret_w_o, lru_conv_w, lru_conv_b, lru_w_a, lru_b_a, lru_w_x, lru_b_x,
              lru_lambda, lru_w_o, gla_alpha_up, gla_alpha_b, gla_norm_g, gla_w_o, w_out,
              norm_ffn_g, router_group_w, router_group_b, router_expert_w, router_expert_b,
              moe_w_gate, moe_w_up, moe_w_down, final_norm_g):
    B_, S_, _ = x.shape
    splits = [A_COLS, A_COLS + B_COLS, A_COLS + B_COLS + C_COLS, A_COLS + B_COLS + C_COLS + D_COLS]
    h = x
    for l in range(DEPTH):
        xn = rmsnorm(h, norm_mix_g[l])
        proj = xn @ w_in[l]
        a_cols, b_cols, c_cols, d_cols, gate_cols = jnp.split(proj, splits, axis=-1)
        y_a = rwkv7_branch(a_cols, rwkv_mu[l], rwkv_w0[l], rwkv_w_up[l], rwkv_a0[l], rwkv_a_up[l],
                           rwkv_g_up[l], rwkv_k_k[l], rwkv_k_a[l], rwkv_r_k[l], rwkv_ln_g[l], rwkv_ln_b[l])
        y_b = retention_branch(b_cols, positions, ret_norm_g[l])
        y_c = rglru_branch(c_cols, positions, lru_conv_w[l], lru_conv_b[l], lru_w_a[l], lru_b_a[l],
                           lru_w_x[l], lru_b_x[l], lru_lambda[l])
        y_d = gla_branch(d_cols, gla_alpha_up[l], gla_alpha_b[l], gla_norm_g[l])
        gates = jax.nn.sigmoid(gate_cols.astype(jnp.float32)).reshape(B_, S_, N_BRANCH, D_MODEL)
        merged = (gates[:, :, 0] * (y_a @ rwkv_w_o[l]).astype(jnp.float32)
                  + gates[:, :, 1] * (y_b @ ret_w_o[l]).astype(jnp.float32)
                  + gates[:, :, 2] * (y_c @ lru_w_o[l]).astype(jnp.float32)
                  + gates[:, :, 3] * (y_d @ gla_w_o[l]).astype(jnp.float32))
        h = h + (merged.astype(h.dtype) @ w_out[l])
        hn = rmsnorm(h, norm_ffn_g[l])
        h = h + hier_moe(hn, router_group_w[l], router_group_b[l], router_expert_w[l],
                         router_expert_b[l], moe_w_gate[l], moe_w_up[l], moe_w_down[l])
    return rmsnorm(h, final_norm_g)
```

```cpp
#include <hip/hip_runtime.h>
#include <stdint.h>

typedef unsigned short u16;
typedef __attribute__((ext_vector_type(8))) short bf16x8;
typedef __attribute__((ext_vector_type(4))) float f32x4;

constexpr int T_ = 8192, DM = 2048, NL = 2, MIXW = 512;
constexpr int IN_COLS = 14512, PC = 14592;
constexpr int OFF_A = 0, OFF_B = 1696, OFF_C = 3744, OFF_D = 4768, OFF_G = 6320;
constexpr int NEXP = 32, DEXP = 1024;
constexpr int MAXROWS = 24576, MAXRT = 96;

__device__ __forceinline__ u16 f2bf(float f) { unsigned u = __float_as_uint(f); u += 0x7fffu + ((u >> 16) & 1u); return (u16)(u >> 16); }
__device__ __forceinline__ float bf2f(u16 h) { return __uint_as_float(((unsigned)h) << 16); }
__device__ __forceinline__ float sigmoidf_(float x) { return 1.f / (1.f + __expf(-x)); }
__device__ __forceinline__ float wave_sum(float v) {
#pragma unroll
  for (int o = 32; o > 0; o >>= 1) v += __shfl_xor(v, o, 64);
  return v;
}

__global__ __launch_bounds__(256) void k_transpose(const float* __restrict__ src, u16* __restrict__ dst, int K, int N, long sstride, long dstride, int mode) {
  __shared__ float tile[64][65];
  const int b = blockIdx.z; src += (long)b * sstride; dst += (long)b * dstride;
  const int n0 = blockIdx.x * 64, k0 = blockIdx.y * 64, tx = threadIdx.x & 63, ty = threadIdx.x >> 6;
  for (int r = 0; r < 16; ++r) { int k = k0 + ty + 4 * r, n = n0 + tx; tile[ty + 4 * r][tx] = (n < N) ? src[(long)k * N + n] : 0.f; }
  __syncthreads();
  for (int r = 0; r < 16; ++r) {
    int n = n0 + ty + 4 * r, k = k0 + tx;
    int row = (mode == 0) ? n : ((n >> 7) * 256 + (mode == 2 ? 128 : 0) + (n & 127));
    dst[(long)row * K + k] = f2bf(tile[tx][ty + 4 * r]);
  }
}

struct NormArgs {
  const float* x; float* h; const float* g; u16* xn; float* out; const float* ybuf;
  const float* wg; const float* bg; const float* we; const float* be; int* tok_e; float* tok_g;
};
template <int MODE>
__global__ __launch_bounds__(256) void k_norm(NormArgs a) {
  const int row = blockIdx.x * 4 + (threadIdx.x >> 6), lane = threadIdx.x & 63;
  float v[32];
  const float* src = (MODE == 0) ? a.x : a.h;
#pragma unroll
  for (int i = 0; i < 8; ++i) {
    f32x4 t = *(const f32x4*)(src + (long)row * DM + i * 256 + lane * 4);
    if (MODE == 1 || MODE == 2) {
      f32x4 y0 = *(const f32x4*)(a.ybuf + (long)(2 * row) * DM + i * 256 + lane * 4);
      f32x4 y1 = *(const f32x4*)(a.ybuf + (long)(2 * row + 1) * DM + i * 256 + lane * 4);
      t = t + y0 + y1;
    }
    if (MODE != 3 && MODE != 2) *(f32x4*)(a.h + (long)row * DM + i * 256 + lane * 4) = t;
    v[i * 4 + 0] = t[0]; v[i * 4 + 1] = t[1]; v[i * 4 + 2] = t[2]; v[i * 4 + 3] = t[3];
  }
  float ss = 0.f;
#pragma unroll
  for (int i = 0; i < 32; ++i) ss += v[i] * v[i];
  ss = wave_sum(ss);
  const float rs = rsqrtf(ss * (1.f / DM) + 1e-6f);
#pragma unroll
  for (int i = 0; i < 8; ++i) {
    f32x4 g = *(const f32x4*)(a.g + i * 256 + lane * 4);
#pragma unroll
    for (int j = 0; j < 4; ++j) v[i * 4 + j] = v[i * 4 + j] * rs * g[j];
    if (MODE == 2) {
      f32x4 o = {v[i * 4], v[i * 4 + 1], v[i * 4 + 2], v[i * 4 + 3]};
      *(f32x4*)(a.out + (long)row * DM + i * 256 + lane * 4) = o;
    } else {
      uint2 pk;
      pk.x = (unsigned)f2bf(v[i * 4]) | ((unsigned)f2bf(v[i * 4 + 1]) << 16);
      pk.y = (unsigned)f2bf(v[i * 4 + 2]) | ((unsigned)f2bf(v[i * 4 + 3]) << 16);
      *(uint2*)(a.xn + (long)row * DM + i * 256 + lane * 4) = pk;
    }
  }
  if (MODE == 3) {
    float p[36];
#pragma unroll
    for (int c = 0; c < 36; ++c) p[c] = 0.f;
#pragma unroll
    for (int i = 0; i < 8; ++i) {
#pragma unroll
      for (int j = 0; j < 4; ++j) {
        const int e = i * 256 + lane * 4 + j;
        const float xv = v[i * 4 + j];
        f32x4 wg = *(const f32x4*)(a.wg + (long)e * 4);
#pragma unroll
        for (int c = 0; c < 4; ++c) p[c] += xv * wg[c];
#pragma unroll
        for (int q = 0; q < 8; ++q) {
          f32x4 we = *(const f32x4*)(a.we + (long)e * 32 + q * 4);
#pragma unroll
          for (int c = 0; c < 4; ++c) p[4 + q * 4 + c] += xv * we[c];
        }
      }
    }
#pragma unroll
    for (int c = 0; c < 36; ++c) p[c] = wave_sum(p[c]);
    if (lane == 0) {
      float lg[4];
#pragma unroll
      for (int c = 0; c < 4; ++c) lg[c] = p[c] + a.bg[c];
      int gi = 0; float gm = lg[0];
#pragma unroll
      for (int c = 1; c < 4; ++c) if (lg[c] > gm) { gm = lg[c]; gi = c; }
      float gs = 0.f;
#pragma unroll
      for (int c = 0; c < 4; ++c) gs += __expf(lg[c] - gm);
      const float pg = 1.f / gs;
      float le[8];
#pragma unroll
      for (int j = 0; j < 8; ++j) {
        float l0 = p[4 + j] + a.be[j], l1 = p[12 + j] + a.be[8 + j], l2 = p[20 + j] + a.be[16 + j], l3 = p[28 + j] + a.be[24 + j];
        le[j] = gi == 0 ? l0 : (gi == 1 ? l1 : (gi == 2 ? l2 : l3));
      }
      int i1 = 0; float m1 = le[0];
#pragma unroll
      for (int j = 1; j < 8; ++j) if (le[j] > m1) { m1 = le[j]; i1 = j; }
      int i2 = -1; float m2 = -3.0e38f;
#pragma unroll
      for (int j = 0; j < 8; ++j) if (j != i1 && le[j] > m2) { m2 = le[j]; i2 = j; }
      const float w1 = 1.f / (1.f + __expf(m2 - m1)), w2 = 1.f - w1;
      a.tok_e[2 * row] = gi * 8 + i1; a.tok_e[2 * row + 1] = gi * 8 + i2;
      a.tok_g[2 * row] = pg * w1; a.tok_g[2 * row + 1] = pg * w2;
    }
  }
}

constexpr int BKK = 64, HALF = 128, HT = HALF * BKK, SHM_B = 8 * HT * 2;
__device__ __forceinline__ int lds_byte(int r, int c) {
  int st = (r >> 4) * 2 + (c >> 5), rr = r & 15, cc = c & 31, ob = rr * 64 + cc * 2;
  return st * 1024 + (ob ^ (((ob >> 9) & 1) << 5));
}
__device__ __forceinline__ void stage_rc(int b, int& R, int& C) {
  int st = b / 1024, sb = b % 1024, swz = sb ^ (((sb >> 9) & 1) << 5);
  R = (st >> 1) * 16 + swz / 64; C = (st & 1) * 32 + (swz % 64) / 2;
}

template <class Epi>
__device__ __forceinline__ void gemm256(const u16* __restrict__ A, int lda, const u16* __restrict__ Bt, int ldb, int K, u16* shm, const Epi& epi) {
#define SA(b, h) (shm + ((b) * 2 + (h)) * HT)
#define SB(b, h) (shm + (4 + (b) * 2 + (h)) * HT)
#define STAGE_X(TT, P, BASE, LD, br, kt) do { const u16* _g = (BASE) + (long)(br) * (LD) + (long)(kt) * BKK; \
    _Pragma("unroll") for (int _i = 0; _i < 2; ++_i) { int _b = (TT) * 16 + _i * 8192; int _r, _c; stage_rc(_b, _r, _c); \
      __builtin_amdgcn_global_load_lds((const unsigned*)(_g + (long)_r * (LD) + _c), (unsigned*)((char*)(P) + _b), 16, 0, 0); } } while (0)
#define STAGE_A(P, br, kt) STAGE_X(tid0, P, A, lda, br, kt)
#define STAGE_B(P, br, kt) STAGE_X(tid0, P, Bt, ldb, br, kt)
#define LDA(dst, b, h) _Pragma("unroll") for (int m = 0; m < 4; ++m) _Pragma("unroll") for (int k = 0; k < 2; ++k) \
    dst[m][k] = *reinterpret_cast<const bf16x8*>((char*)SA(b, h) + lds_byte(wr * 64 + m * 16 + fr, k * 32 + fq * 8))
#define LDB(dst, b, h) _Pragma("unroll") for (int n = 0; n < 2; ++n) _Pragma("unroll") for (int k = 0; k < 2; ++k) \
    dst[n][k] = *reinterpret_cast<const bf16x8*>((char*)SB(b, h) + lds_byte(wc * 32 + n * 16 + fr, k * 32 + fq * 8))
#define MMA(ai, bj, At, Bx) do { __builtin_amdgcn_s_setprio(1); \
    _Pragma("unroll") for (int m = 0; m < 4; ++m) _Pragma("unroll") for (int n = 0; n < 2; ++n) _Pragma("unroll") for (int k = 0; k < 2; ++k) \
      acc[ai][bj][m][n] = __builtin_amdgcn_mfma_f32_16x16x32_bf16(At[m][k], Bx[n][k], acc[ai][bj][m][n], 0, 0, 0); \
    __builtin_amdgcn_s_setprio(0); } while (0)
#define WAIT_V(n) asm volatile("s_waitcnt vmcnt(" #n ")" ::: "memory")
#define WAIT_L(n) asm volatile("s_waitcnt lgkmcnt(" #n ")" ::: "memory")
#define BAR __builtin_amdgcn_s_barrier()
#define SCHED __builtin_amdgcn_sched_barrier(0)
  int tid0 = threadIdx.x; asm volatile("" : "+v"(tid0));
  int wid = tid0 >> 6, lane = tid0 & 63, wr = wid >> 2, wc = wid & 3, fr = lane & 15, fq = lane >> 4;
  f32x4 acc[2][2][4][2] = {};
  bf16x8 At[4][2], B0[2][2], B1[2][2];
  const int nt = K / BKK;
  STAGE_B(SB(0, 0), 0, 0); STAGE_A(SA(0, 0), 0, 0);
  STAGE_B(SB(0, 1), HALF, 0); STAGE_A(SA(0, 1), HALF, 0);
  if (wr == 1) BAR;
  WAIT_V(4); BAR;
  STAGE_B(SB(1, 0), 0, 1); STAGE_A(SA(1, 0), 0, 1); STAGE_B(SB(1, 1), HALF, 1);
  WAIT_V(6); BAR;
  for (int t = 0; t < nt - 2; t += 2) {
    LDB(B0, 0, 0); SCHED; LDA(At, 0, 0); STAGE_A(SA(1, 1), HALF, t + 1);
    WAIT_L(8); BAR; WAIT_L(0); MMA(0, 0, At, B0); BAR; SCHED;
    LDB(B1, 0, 1); STAGE_B(SB(0, 0), 0, t + 2);
    BAR; WAIT_L(0); MMA(0, 1, At, B1); BAR;
    LDA(At, 0, 1); STAGE_A(SA(0, 0), 0, t + 2);
    BAR; WAIT_L(0); MMA(1, 0, At, B0); BAR; SCHED;
    STAGE_B(SB(0, 1), HALF, t + 2);
    WAIT_V(6); BAR; MMA(1, 1, At, B1); BAR;
    LDB(B0, 1, 0); SCHED; LDA(At, 1, 0); STAGE_A(SA(0, 1), HALF, t + 2);
    WAIT_L(8); BAR; WAIT_L(0); MMA(0, 0, At, B0); BAR; SCHED;
    LDB(B1, 1, 1); STAGE_B(SB(1, 0), 0, t + 3);
    BAR; WAIT_L(0); MMA(0, 1, At, B1); BAR;
    LDA(At, 1, 1); STAGE_A(SA(1, 0), 0, t + 3);
    BAR; WAIT_L(0); MMA(1, 0, At, B0); BAR; SCHED;
    STAGE_B(SB(1, 1), HALF, t + 3);
    WAIT_V(6); BAR; MMA(1, 1, At, B1); BAR;
  }
  int tz = threadIdx.x; asm volatile("" : "+v"(tz)); wid = tz >> 6; lane = tz & 63; wr = wid >> 2; wc = wid & 3; fr = lane & 15; fq = lane >> 4;
  { LDB(B0, 0, 0); WAIT_V(0); LDA(At, 0, 0); STAGE_X(tz, SA(1, 1), A, lda, HALF, nt - 1);
    BAR; WAIT_L(0); MMA(0, 0, At, B0); BAR;
    LDB(B1, 0, 1); BAR; WAIT_L(0); MMA(0, 1, At, B1); BAR;
    LDA(At, 0, 1); WAIT_V(4); BAR; WAIT_L(0); MMA(1, 0, At, B0); MMA(1, 1, At, B1); BAR; }
  { LDB(B0, 1, 0); LDA(At, 1, 0); WAIT_V(2); BAR; WAIT_L(0); MMA(0, 0, At, B0); BAR;
    LDB(B1, 1, 1); WAIT_V(0); BAR; WAIT_L(0); MMA(0, 1, At, B1); BAR;
    LDA(At, 1, 1); BAR; WAIT_L(0); MMA(1, 0, At, B0); MMA(1, 1, At, B1); BAR; }
  if (wr == 0) BAR;
  epi(acc, wr, wc, fr, fq);
  __syncthreads();
#undef SA
#undef SB
}

#define UNR _Pragma("unroll")
#define EPI_LOOP UNR for (int ai = 0; ai < 2; ++ai) UNR for (int bj = 0; bj < 2; ++bj) UNR for (int m = 0; m < 4; ++m) UNR for (int n = 0; n < 2; ++n) UNR for (int j = 0; j < 4; ++j)
#define EPI_ROW (ai * HALF + wr * 64 + m * 16 + fq * 4 + j)
#define EPI_COL (bj * HALF + wc * 32 + n * 16 + fr)

struct EpiProj {
  u16* proj; int brow, bcol;
  __device__ __forceinline__ void operator()(const f32x4 (&acc)[2][2][4][2], int wr, int wc, int fr, int fq) const {
    EPI_LOOP { int row = brow + EPI_ROW, col = bcol + EPI_COL; float v = acc[ai][bj][m][n][j]; if (col >= OFF_G) v = sigmoidf_(v); proj[(long)row * PC + col] = f2bf(v); }
  }
};
struct EpiMerge {
  const u16* proj; float* mbuf; u16* merged; int kb, brow, bcol;
  __device__ __forceinline__ void operator()(const f32x4 (&acc)[2][2][4][2], int wr, int wc, int fr, int fq) const {
    EPI_LOOP { int row = brow + EPI_ROW, col = bcol + EPI_COL; long idx = (long)row * DM + col;
      float g = bf2f(proj[(long)row * PC + OFF_G + kb * DM + col]); float v = g * acc[ai][bj][m][n][j];
      if (kb > 0) v += mbuf[idx];
      if (kb < 3) mbuf[idx] = v; else merged[idx] = f2bf(v); }
  }
};
struct EpiResid {
  float* h; int brow, bcol;
  __device__ __forceinline__ void operator()(const f32x4 (&acc)[2][2][4][2], int wr, int wc, int fr, int fq) const {
    EPI_LOOP { int row = brow + EPI_ROW, col = bcol + EPI_COL; long idx = (long)row * DM + col; h[idx] += acc[ai][bj][m][n][j]; }
  }
};
struct EpiGateUp {
  u16* hmid; int brow, ct;
  __device__ __forceinline__ void operator()(const f32x4 (&acc)[2][2][4][2], int wr, int wc, int fr, int fq) const {
    u16* base = hmid + (long)(brow + wr * 64 + fq * 4) * DEXP + ct * 128 + wc * 32 + fr;
    UNR for (int ai = 0; ai < 2; ++ai) UNR for (int m = 0; m < 4; ++m) {
      UNR for (int n = 0; n < 2; ++n) UNR for (int j = 0; j < 4; ++j) {
        float g = acc[ai][0][m][n][j], u = acc[ai][1][m][n][j];
        base[(long)(ai * HALF + m * 16 + j) * DEXP + n * 16] = f2bf(g * sigmoidf_(g) * u); }
      asm volatile("" ::: "memory"); }
  }
};
struct EpiDown {
  float* ybuf; const int* row_slot; const float* row_gate; int brow, bcol;
  __device__ __forceinline__ void operator()(const f32x4 (&acc)[2][2][4][2], int wr, int wc, int fr, int fq) const {
    UNR for (int ai = 0; ai < 2; ++ai) UNR for (int m = 0; m < 4; ++m) UNR for (int j = 0; j < 4; ++j) {
      int row = brow + ai * HALF + wr * 64 + m * 16 + fq * 4 + j; int slot = row_slot[row]; float gt = row_gate[row];
      if (slot >= 0) UNR for (int bj = 0; bj < 2; ++bj) UNR for (int n = 0; n < 2; ++n) { int col = bcol + EPI_COL; ybuf[(long)slot * DM + col] = gt * acc[ai][bj][m][n][j]; } }
  }
};

struct GemmArgs {
  const u16* A; const u16* Bt; u16* proj; float* mbuf; u16* merged; float* h; u16* hmid; float* ybuf;
  const int* row_slot; const float* row_gate; const int* tile_exp; const int* nrt; int kb; int pad;
};
__device__ __forceinline__ void unit_map(int b, int round, int& pm, int& pn) {
  int xcd = b & 7, i = b >> 3, pr = xcd >> 1, pc = xcd & 1, lr = i & 7, lc = i >> 3;
  pm = pr * 8 + lr; pn = round * 8 + pc * 4 + lc;
}
template <int MODE>
__global__ __launch_bounds__(512, 2) void k_gemm(GemmArgs a) {
  extern __shared__ __attribute__((aligned(16))) u16 shm[];
  if (MODE == 0) {
    for (int round = 0; round < (PC / 256 + 7) / 8; ++round) {
      int pm, pn; unit_map(blockIdx.x, round, pm, pn);
      if (pn >= PC / 256) continue;
      EpiProj e{a.proj, pm * 256, pn * 256};
      gemm256(a.A + (long)pm * 256 * DM, DM, a.Bt + (long)pn * 256 * DM, DM, DM, shm, e);
    }
  } else if (MODE == 1) {
    int pm, pn; unit_map(blockIdx.x, 0, pm, pn);
    EpiMerge e{a.proj, a.mbuf, a.merged, a.kb, pm * 256, pn * 256};
    gemm256(a.A + (long)pm * 256 * DM + a.kb * MIXW, DM, a.Bt + ((long)a.kb * DM + pn * 256) * MIXW, MIXW, MIXW, shm, e);
  } else if (MODE == 2) {
    int pm, pn; unit_map(blockIdx.x, 0, pm, pn);
    EpiResid e{a.h, pm * 256, pn * 256};
    gemm256(a.A + (long)pm * 256 * DM, DM, a.Bt + (long)pn * 256 * DM, DM, DM, shm, e);
  } else if (MODE == 3) {
    const int nu = a.nrt[0] * 8;
    for (int u = blockIdx.x; u < nu; u += gridDim.x) {
      int rt = u >> 3, ct = u & 7, ex = a.tile_exp[rt];
      EpiGateUp e{a.hmid, rt * 256, ct};
      gemm256(a.A + (long)rt * 256 * DM, DM, a.Bt + ((long)ex * 2048 + ct * 256) * DM, DM, DM, shm, e);
    }
  } else {
    const int nu = a.nrt[0] * 8;
    for (int u = blockIdx.x; u < nu; u += gridDim.x) {
      int rt = u >> 3, ct = u & 7, ex = a.tile_exp[rt];
      EpiDown e{a.ybuf, a.row_slot, a.row_gate, rt * 256, ct * 256};
      gemm256(a.A + (long)rt * 256 * DEXP, DEXP, a.Bt + ((long)ex * DM + ct * 256) * DEXP, DEXP, DEXP, shm, e);
    }
  }
}

struct RwkvP { const float *mu, *w0, *w_up, *a0, *a_up, *g_up, *k_k, *k_a, *r_k, *ln_g, *ln_b; };
__global__ __launch_bounds__(512) void k_rwkv_prep(const u16* __restrict__ proj, RwkvP p, float* R, float* W, float* Kp, float* V, float* KK, float* AB, float* G, float* BS) {
  __shared__ float z[1696]; __shared__ float tw[32]; __shared__ float sg[96];
  const int t = blockIdx.x, c = threadIdx.x;
  for (int i = c; i < 1696; i += 512) {
    float cur = bf2f(proj[(long)t * PC + i]); float prev = t > 0 ? bf2f(proj[(long)(t - 1) * PC + i]) : 0.f;
    z[i] = cur + (prev - cur) * p.mu[i];
  }
  __syncthreads();
  if (c < 32) tw[c] = tanhf(z[1536 + c]);
  if (c >= 64 && c < 160) sg[c - 64] = sigmoidf_(z[1600 + c - 64]);
  __syncthreads();
  float wv = p.w0[c], av = p.a0[c], gv = 0.f;
  for (int j = 0; j < 32; ++j) { wv += tw[j] * p.w_up[j * 512 + c]; av += z[1568 + j] * p.a_up[j * 512 + c]; }
  for (int j = 0; j < 96; ++j) gv += sg[j] * p.g_up[j * 512 + c];
  const float w = __expf(-0.6065306597126334f * sigmoidf_(wv)), av2 = sigmoidf_(av);
  const float r = z[c], k = z[512 + c], v = z[1024 + c];
  float kk = k * p.k_k[c]; float ss = wave_sum(kk * kk); kk = kk / fmaxf(sqrtf(ss), 1e-12f);
  const float kp = k * (1.f + (av2 - 1.f) * p.k_a[c]);
  const float bs = wave_sum(r * kp * p.r_k[c]);
  const long o = (long)t * 512 + c;
  R[o] = r; W[o] = w; Kp[o] = kp; V[o] = v; KK[o] = kk; AB[o] = kk * av2; G[o] = gv;
  if ((c & 63) == 0) BS[t * 8 + (c >> 6)] = bs;
}
__global__ __launch_bounds__(64) void k_rwkv_scan(const float* R, const float* W, const float* Kp, const float* V, const float* KK, const float* AB, const float* G, const float* BS,
                                                  const float* ln_g, const float* ln_b, u16* ycat) {
  __shared__ float sR[16][64], sW[16][64], sK[16][64], sKK[16][64], sAB[16][64];
  const int h = blockIdx.x, l = threadIdx.x, c = h * 64 + l;
  float S[64];
#pragma unroll
  for (int k = 0; k < 64; ++k) S[k] = 0.f;
  const float lg = ln_g[c], lb = ln_b[c];
  for (int t0 = 0; t0 < T_; t0 += 16) {
    __syncthreads();
    for (int i = 0; i < 16; ++i) { long o = (long)(t0 + i) * 512 + c; sR[i][l] = R[o]; sW[i][l] = W[o]; sK[i][l] = Kp[o]; sKK[i][l] = KK[o]; sAB[i][l] = AB[o]; }
    __syncthreads();
#pragma unroll 1
    for (int i = 0; i < 16; ++i) {
      const long o = (long)(t0 + i) * 512 + c;
      const float vt = V[o];
      float sa = 0.f;
#pragma unroll
      for (int k = 0; k < 64; ++k) sa -= S[k] * sKK[i][k];
#pragma unroll
      for (int k = 0; k < 64; ++k) S[k] = S[k] * sW[i][k] + sa * sAB[i][k] + vt * sK[i][k];
      float y = 0.f;
#pragma unroll
      for (int k = 0; k < 64; ++k) y += S[k] * sR[i][k];
      const float mean = wave_sum(y) * (1.f / 64.f); const float d = y - mean; const float var = wave_sum(d * d) * (1.f / 64.f);
      const float yn = d * rsqrtf(var + 64e-5f) * lg + lb;
      ycat[(long)(t0 + i) * DM + c] = f2bf((yn + BS[(t0 + i) * 8 + h] * vt) * G[o]);
    }
  }
}

__global__ __launch_bounds__(512) void k_ret_prep(const u16* __restrict__ proj, const int* __restrict__ pos, float* Q, float* Kr) {
  const int t = blockIdx.x, c = threadIdx.x, h = c >> 6, d = c & 63, j = d & 31;
  const float inv = exp2f(-(float)j * (13.287712379549449f / 32.f));
  const float ang = (float)pos[t] * inv; float sn, cs; sincosf(ang, &sn, &cs);
  const u16* row = proj + (long)t * PC + OFF_B;
  const float q1 = bf2f(row[h * 64 + j]), q2 = bf2f(row[h * 64 + 32 + j]);
  const float k1 = bf2f(row[512 + h * 64 + j]), k2 = bf2f(row[512 + h * 64 + 32 + j]);
  float qo, ko;
  if (d < 32) { qo = q1 * cs - q2 * sn; ko = k1 * cs - k2 * sn; } else { qo = q2 * cs + q1 * sn; ko = k2 * cs + k1 * sn; }
  Q[(long)t * 512 + c] = qo; Kr[(long)t * 512 + c] = ko * 0.125f;
}
__global__ __launch_bounds__(64) void k_ret_scan(const u16* __restrict__ proj, const float* Q, const float* Kr, const float* norm_g, u16* ycat) {
  __shared__ float sQ[16][64], sK[16][64];
  const int h = blockIdx.x, l = threadIdx.x, c = h * 64 + l;
  const float gdec = 1.f - exp2f(-(5.f + 4.f * (float)h / 7.f));
  float S[64];
#pragma unroll
  for (int k = 0; k < 64; ++k) S[k] = 0.f;
  const float ng = norm_g[c];
  for (int t0 = 0; t0 < T_; t0 += 16) {
    __syncthreads();
    for (int i = 0; i < 16; ++i) { long o = (long)(t0 + i) * 512 + c; sQ[i][l] = Q[o]; sK[i][l] = Kr[o]; }
    __syncthreads();
#pragma unroll 1
    for (int i = 0; i < 16; ++i) {
      const u16* row = proj + (long)(t0 + i) * PC + OFF_B;
      const float vt = bf2f(row[1024 + c]), gt = bf2f(row[1536 + c]);
      float o = 0.f;
#pragma unroll
      for (int d = 0; d < 64; ++d) { S[d] = gdec * S[d] + sK[i][d] * vt; o += sQ[i][d] * S[d]; }
      const float ms = wave_sum(o * o) * (1.f / 64.f);
      const float on = o * rsqrtf(ms + 1e-6f) * ng;
      ycat[(long)(t0 + i) * DM + 512 + c] = f2bf(on * gt * sigmoidf_(gt));
    }
  }
}

__global__ __launch_bounds__(256) void k_gla_prep(const u16* __restrict__ proj, const float* alpha_up, const float* alpha_b, float* GA) {
  const int t = blockIdx.x, c = threadIdx.x;
  const u16* row = proj + (long)t * PC + OFF_D + 1024;
  float x = alpha_b[c];
  for (int j = 0; j < 16; ++j) x += bf2f(row[j]) * alpha_up[j * 256 + c];
  const float ls = x >= 0.f ? -log1pf(__expf(-x)) : x - log1pf(__expf(x));
  GA[(long)t * 256 + c] = __expf(ls * (1.f / 16.f));
}
__global__ __launch_bounds__(128) void k_gla_scan(const u16* __restrict__ proj, const float* GA, const float* norm_g, u16* ycat) {
  __shared__ float sQ[16][64], sK[16][64], sA[16][64]; __shared__ float red[2];
  const int h = blockIdx.x, e = threadIdx.x, c = h * 128 + e;
  float S[64];
#pragma unroll
  for (int k = 0; k < 64; ++k) S[k] = 0.f;
  const float ng = norm_g[c];
  for (int t0 = 0; t0 < T_; t0 += 16) {
    __syncthreads();
    for (int i = e; i < 16 * 64; i += 128) { int ti = i >> 6, d = i & 63; const u16* row = proj + (long)(t0 + ti) * PC + OFF_D;
      sQ[ti][d] = bf2f(row[h * 64 + d]) * 0.125f; sK[ti][d] = bf2f(row[256 + h * 64 + d]); sA[ti][d] = GA[(long)(t0 + ti) * 256 + h * 64 + d]; }
    __syncthreads();
#pragma unroll 1
    for (int i = 0; i < 16; ++i) {
      const u16* row = proj + (long)(t0 + i) * PC + OFF_D;
      const float vt = bf2f(row[512 + c]), gt = bf2f(row[1040 + c]);
      float o = 0.f;
#pragma unroll
      for (int d = 0; d < 64; ++d) { S[d] = sA[i][d] * S[d] + sK[i][d] * vt; o += sQ[i][d] * S[d]; }
      const float part = wave_sum(o * o);
      if ((e & 63) == 0) red[e >> 6] = part;
      __syncthreads();
      const float ms = (red[0] + red[1]) * (1.f / 128.f);
      __syncthreads();
      const float on = o * rsqrtf(ms + 1e-6f) * ng;
      ycat[(long)(t0 + i) * DM + 1536 + c] = f2bf(on * gt * sigmoidf_(gt));
    }
  }
}

struct LruP { const float *conv_w, *conv_b, *w_a, *b_a, *w_x, *b_x, *lam; };
__global__ __launch_bounds__(512) void k_lru_prep(const u16* __restrict__ proj, const int* __restrict__ pos, LruP p, float* LA, float* LB) {
  __shared__ float sx[512];
  const int t = blockIdx.x, c = threadIdx.x;
  float xc = p.conv_b[c];
  for (int j = 0; j < 4; ++j) { int tt = t - 3 + j; if (tt >= 0) xc += p.conv_w[j * 512 + c] * bf2f(proj[(long)tt * PC + OFF_C + c]); }
  sx[c] = xc;
  __syncthreads();
  const int g = c >> 6, jj = c & 63;
  float ra = p.b_a[c], ix = p.b_x[c];
  for (int i = 0; i < 64; ++i) { float xv = sx[g * 64 + i]; ra += xv * p.w_a[(g * 64 + i) * 64 + jj]; ix += xv * p.w_x[(g * 64 + i) * 64 + jj]; }
  const float r = sigmoidf_(ra), ig = sigmoidf_(ix);
  const float lam = p.lam[c];
  const float sp = (-lam) > 20.f ? (-lam) : log1pf(__expf(-lam));
  const float log_a = -8.f * r * sp;
  const bool reset = pos[t] == 0;
  const float av = reset ? 0.f : __expf(log_a);
  const float mult = reset ? 1.f : sqrtf(-expm1f(2.f * log_a));
  LA[(long)t * 512 + c] = av; LB[(long)t * 512 + c] = mult * ig * xc;
}
__device__ __forceinline__ float gelu_tanh(float x) {
  const float u = 0.7978845608028654f * (x + 0.044715f * x * x * x);
  return 0.5f * x * (1.f + tanhf(u));
}
__global__ __launch_bounds__(64) void k_lru_scan(const u16* __restrict__ proj, const float* LA, const float* LB, u16* ycat) {
  const int c = blockIdx.x * 64 + threadIdx.x;
  float hs = 0.f;
  for (int t0 = 0; t0 < T_; t0 += 8) {
    float la[8], lb[8], gb[8];
#pragma unroll
    for (int i = 0; i < 8; ++i) { la[i] = LA[(long)(t0 + i) * 512 + c]; lb[i] = LB[(long)(t0 + i) * 512 + c]; gb[i] = bf2f(proj[(long)(t0 + i) * PC + OFF_C + 512 + c]); }
#pragma unroll
    for (int i = 0; i < 8; ++i) { hs = la[i] * hs + lb[i]; ycat[(long)(t0 + i) * DM + 1024 + c] = f2bf(hs * gelu_tanh(gb[i])); }
  }
}

__global__ __launch_bounds__(1024) void k_moe_route(const int* __restrict__ tok_e, const float* __restrict__ tok_g, int* row_tok, int* row_slot, float* row_gate, int* tile_exp, int* nrt) {
  __shared__ int cnt[32], pstart[32], fill[32];
  const int tid = threadIdx.x;
  if (tid < 32) { cnt[tid] = 0; fill[tid] = 0; }
  __syncthreads();
  for (int i = tid; i < 2 * T_; i += 1024) atomicAdd(&cnt[tok_e[i]], 1);
  __syncthreads();
  if (tid == 0) {
    int acc = 0, rt = 0;
    for (int e = 0; e < 32; ++e) { pstart[e] = acc; int nt = (cnt[e] + 255) / 256; for (int j = 0; j < nt; ++j) tile_exp[rt++] = e; acc += nt * 256; }
    nrt[0] = rt;
  }
  for (int i = tid; i < MAXROWS; i += 1024) { row_tok[i] = -1; row_slot[i] = -1; row_gate[i] = 0.f; }
  __syncthreads();
  for (int i = tid; i < 2 * T_; i += 1024) {
    int e = tok_e[i]; int pos = atomicAdd(&fill[e], 1); int dest = pstart[e] + pos;
    row_tok[dest] = i >> 1; row_slot[dest] = i; row_gate[dest] = tok_g[i];
  }
}
__global__ __launch_bounds__(256) void k_gather(const u16* __restrict__ hn, const int* __restrict__ row_tok, const int* __restrict__ nrt, u16* xg) {
  const int row = blockIdx.x * 4 + (threadIdx.x >> 6), lane = threadIdx.x & 63;
  if (row >= nrt[0] * 256) return;
  const int tok = row_tok[row];
#pragma unroll
  for (int i = 0; i < 4; ++i) {
    uint4 v = make_uint4(0, 0, 0, 0);
    if (tok >= 0) v = *(const uint4*)(hn + (long)tok * DM + i * 512 + lane * 8);
    *(uint4*)(xg + (long)row * DM + i * 512 + lane * 8) = v;
  }
}

static inline size_t al256(size_t x) { return (x + 255) & ~(size_t)255; }

extern "C" void kernel_launch(void* const* d_in, const int* in_sizes, int n_in, void* d_out, int out_size, void* d_ws, size_t ws_size, hipStream_t stream) {
  (void)in_sizes; (void)n_in; (void)out_size; (void)ws_size;
  const float* x = (const float*)d_in[0]; const int* pos = (const int*)d_in[1];
#define FIN(i) ((const float*)d_in[i])
  char* ws = (char*)d_ws; size_t off = 0;
  auto take = [&](size_t bytes) { char* p = ws + off; off += al256(bytes); return p; };
  take(65536);
  u16* Wt_in = (u16*)take((size_t)NL * PC * DM * 2);
  u16* Wt_o = (u16*)take((size_t)NL * 4 * DM * MIXW * 2);
  u16* Wt_out = (u16*)take((size_t)NL * DM * DM * 2);
  u16* Wgu = (u16*)take((size_t)NL * NEXP * 2048 * DM * 2);
  u16* Wdn = (u16*)take((size_t)NL * NEXP * DM * DEXP * 2);
  float* h = (float*)take((size_t)T_ * DM * 4);
  u16* xn = (u16*)take((size_t)T_ * DM * 2);
  u16* proj = (u16*)take((size_t)T_ * PC * 2);
  u16* ycat = (u16*)take((size_t)T_ * DM * 2);
  float* mbuf = (float*)take((size_t)T_ * DM * 4);
  u16* merged = (u16*)take((size_t)T_ * DM * 2);
  int* tok_e = (int*)take((size_t)2 * T_ * 4); float* tok_g = (float*)take((size_t)2 * T_ * 4);
  int* row_tok = (int*)take((size_t)MAXROWS * 4); int* row_slot = (int*)take((size_t)MAXROWS * 4); float* row_gate = (float*)take((size_t)MAXROWS * 4);
  int* tile_exp = (int*)take(1024); int* nrt = (int*)take(256);
  char* moe0 = ws + off;
  u16* xg = (u16*)take((size_t)MAXROWS * DM * 2);
  u16* hmid = (u16*)take((size_t)MAXROWS * DEXP * 2);
  float* ybuf = (float*)take((size_t)2 * T_ * DM * 4);
  float* sc = (float*)moe0; const size_t SA = (size_t)T_ * 512;
  float *sR = sc, *sW = sc + SA, *sKp = sc + 2 * SA, *sV = sc + 3 * SA, *sKK = sc + 4 * SA, *sAB = sc + 5 * SA, *sG = sc + 6 * SA, *sBS = sc + 7 * SA;
  float *sQ = sc + 8 * SA, *sKr = sc + 9 * SA, *sGA = sc + 10 * SA, *sLA = sc + 11 * SA, *sLB = sc + 12 * SA;

  static bool attr = false;
  if (!attr) {
    (void)hipFuncSetAttribute((const void*)k_gemm<0>, hipFuncAttributeMaxDynamicSharedMemorySize, SHM_B);
    (void)hipFuncSetAttribute((const void*)k_gemm<1>, hipFuncAttributeMaxDynamicSharedMemorySize, SHM_B);
    (void)hipFuncSetAttribute((const void*)k_gemm<2>, hipFuncAttributeMaxDynamicSharedMemorySize, SHM_B);
    (void)hipFuncSetAttribute((const void*)k_gemm<3>, hipFuncAttributeMaxDynamicSharedMemorySize, SHM_B);
    (void)hipFuncSetAttribute((const void*)k_gemm<4>, hipFuncAttributeMaxDynamicSharedMemorySize, SHM_B);
    attr = true;
  }
  k_transpose<<<dim3(PC / 64, DM / 64, NL), 256, 0, stream>>>(FIN(3), Wt_in, DM, IN_COLS, (long)DM * IN_COLS, (long)PC * DM, 0);
  const int woi[4] = {15, 17, 25, 29};
  for (int k = 0; k < 4; ++k)
    for (int l = 0; l < NL; ++l)
      k_transpose<<<dim3(DM / 64, MIXW / 64, 1), 256, 0, stream>>>(FIN(woi[k]) + (long)l * MIXW * DM, Wt_o + ((long)l * 4 + k) * DM * MIXW, MIXW, DM, 0, 0, 0);
  k_transpose<<<dim3(DM / 64, DM / 64, NL), 256, 0, stream>>>(FIN(30), Wt_out, DM, DM, (long)DM * DM, (long)DM * DM, 0);
  k_transpose<<<dim3(DEXP / 64, DM / 64, NL * NEXP), 256, 0, stream>>>(FIN(36), Wgu, DM, DEXP, (long)DM * DEXP, (long)2048 * DM, 1);
  k_transpose<<<dim3(DEXP / 64, DM / 64, NL * NEXP), 256, 0, stream>>>(FIN(37), Wgu, DM, DEXP, (long)DM * DEXP, (long)2048 * DM, 2);
  k_transpose<<<dim3(DM / 64, DEXP / 64, NL * NEXP), 256, 0, stream>>>(FIN(38), Wdn, DEXP, DM, (long)DEXP * DM, (long)DM * DEXP, 0);

  for (int l = 0; l < NL; ++l) {
    NormArgs na{}; na.x = x; na.h = h; na.g = FIN(2) + (long)l * DM; na.xn = xn; na.out = (float*)d_out; na.ybuf = ybuf;
    if (l == 0) k_norm<0><<<T_ / 4, 256, 0, stream>>>(na); else k_norm<1><<<T_ / 4, 256, 0, stream>>>(na);
    GemmArgs ga{}; ga.proj = proj; ga.mbuf = mbuf; ga.merged = merged; ga.h = h; ga.hmid = hmid; ga.ybuf = ybuf; ga.row_slot = row_slot; ga.row_gate = row_gate; ga.tile_exp = tile_exp; ga.nrt = nrt;
    ga.A = xn; ga.Bt = Wt_in + (long)l * PC * DM;
    k_gemm<0><<<256, 512, SHM_B, stream>>>(ga);
    RwkvP rp{FIN(4) + l * 1696, FIN(5) + l * 512, FIN(6) + l * 32 * 512, FIN(7) + l * 512, FIN(8) + l * 32 * 512, FIN(9) + l * 96 * 512, FIN(10) + l * 512, FIN(11) + l * 512, FIN(12) + l * 512, FIN(13) + l * 512, FIN(14) + l * 512};
    k_rwkv_prep<<<T_, 512, 0, stream>>>(proj, rp, sR, sW, sKp, sV, sKK, sAB, sG, sBS);
    k_rwkv_scan<<<8, 64, 0, stream>>>(sR, sW, sKp, sV, sKK, sAB, sG, sBS, rp.ln_g, rp.ln_b, ycat);
    k_ret_prep<<<T_, 512, 0, stream>>>(proj, pos, sQ, sKr);
    k_ret_scan<<<8, 64, 0, stream>>>(proj, sQ, sKr, FIN(16) + l * 512, ycat);
    LruP lp{FIN(18) + l * 4 * 512, FIN(19) + l * 512, FIN(20) + l * 8 * 64 * 64, FIN(21) + l * 512, FIN(22) + l * 8 * 64 * 64, FIN(23) + l * 512, FIN(24) + l * 512};
    k_lru_prep<<<T_, 512, 0, stream>>>(proj, pos, lp, sLA, sLB);
    k_lru_scan<<<8, 64, 0, stream>>>(proj, sLA, sLB, ycat);
    k_gla_prep<<<T_, 256, 0, stream>>>(proj, FIN(26) + l * 16 * 256, FIN(27) + l * 256, sGA);
    k_gla_scan<<<4, 128, 0, stream>>>(proj, sGA, FIN(28) + l * 512, ycat);
    ga.A = ycat; ga.Bt = Wt_o + (long)l * 4 * DM * MIXW;
    for (int kb = 0; kb < 4; ++kb) { ga.kb = kb; k_gemm<1><<<256, 512, SHM_B, stream>>>(ga); }
    ga.kb = 0; ga.A = merged; ga.Bt = Wt_out + (long)l * DM * DM;
    k_gemm<2><<<256, 512, SHM_B, stream>>>(ga);
    NormArgs nf{}; nf.h = h; nf.g = FIN(31) + (long)l * DM; nf.xn = xn; nf.wg = FIN(32) + (long)l * DM * 4; nf.bg = FIN(33) + l * 4; nf.we = FIN(34) + (long)l * DM * 32; nf.be = FIN(35) + l * 32;
    nf.tok_e = tok_e; nf.tok_g = tok_g;
    k_norm<3><<<T_ / 4, 256, 0, stream>>>(nf);
    k_moe_route<<<1, 1024, 0, stream>>>(tok_e, tok_g, row_tok, row_slot, row_gate, tile_exp, nrt);
    k_gather<<<MAXROWS / 4, 256, 0, stream>>>(xn, row_tok, nrt, xg);
    ga.A = xg; ga.Bt = Wgu + (long)l * NEXP * 2048 * DM;
    k_gemm<3><<<256, 512, SHM_B, stream>>>(ga);
    ga.A = hmid; ga.Bt = Wdn + (long)l * NEXP * DM * DEXP;
    k_gemm<4><<<256, 512, SHM_B, stream>>>(ga);
  }
  NormArgs nz{}; nz.h = h; nz.g = FIN(39); nz.out = (float*)d_out; nz.ybuf = ybuf;
  k_norm<2><<<T_ / 4, 256, 0, stream>>>(nz);
}
```

```cpp
#ifndef RWKV_CHUNKED_FLAG
#define RWKV_CHUNKED_FLAG true
#endif
#include <hip/hip_runtime.h>
#include <stdint.h>

typedef unsigned short u16;
typedef __attribute__((ext_vector_type(8))) short bf16x8;
typedef __attribute__((ext_vector_type(4))) float f32x4;

constexpr int T_ = 8192, DM = 2048, NL = 2, MIXW = 512;
constexpr int IN_COLS = 14512, PC = 14592;
constexpr int OFF_A = 0, OFF_B = 1696, OFF_C = 3744, OFF_D = 4768, OFF_G = 6320;
constexpr int NEXP = 32, DEXP = 1024;
constexpr int MAXROWS = 24576, MAXRT = 96;

__device__ __forceinline__ u16 f2bf(float f) { unsigned u = __float_as_uint(f); u += 0x7fffu + ((u >> 16) & 1u); return (u16)(u >> 16); }
__device__ __forceinline__ float bf2f(u16 h) { return __uint_as_float(((unsigned)h) << 16); }
__device__ __forceinline__ float sigmoidf_(float x) { return 1.f / (1.f + __expf(-x)); }
__device__ __forceinline__ float wave_sum(float v) {
#pragma unroll
  for (int o = 32; o > 0; o >>= 1) v += __shfl_xor(v, o, 64);
  return v;
}

__global__ __launch_bounds__(256) void k_transpose(const float* __restrict__ src, u16* __restrict__ dst, int K, int N, long sstride, long dstride, int mode) {
  __shared__ float tile[64][65];
  const int b = blockIdx.z; src += (long)b * sstride; dst += (long)b * dstride;
  const int n0 = blockIdx.x * 64, k0 = blockIdx.y * 64, tx = threadIdx.x & 63, ty = threadIdx.x >> 6;
  for (int r = 0; r < 16; ++r) { int k = k0 + ty + 4 * r, n = n0 + tx; tile[ty + 4 * r][tx] = (n < N) ? src[(long)k * N + n] : 0.f; }
  __syncthreads();
  for (int r = 0; r < 16; ++r) {
    int n = n0 + ty + 4 * r, k = k0 + tx;
    int row = (mode == 0) ? n : ((n >> 7) * 256 + (mode == 2 ? 128 : 0) + (n & 127));
    dst[(long)row * K + k] = f2bf(tile[tx][ty + 4 * r]);
  }
}

struct NormArgs {
  const float* x; float* h; const float* g; u16* xn; float* out; const float* ybuf;
  const float* wg; const float* bg; const float* we; const float* be; int* tok_e; float* tok_g;
};
template <int MODE>
__global__ __launch_bounds__(256) void k_norm(NormArgs a) {
  const int row = blockIdx.x * 4 + (threadIdx.x >> 6), lane = threadIdx.x & 63;
  float v[32];
  const float* src = (MODE == 0) ? a.x : a.h;
#pragma unroll
  for (int i = 0; i < 8; ++i) {
    f32x4 t = *(const f32x4*)(src + (long)row * DM + i * 256 + lane * 4);
    if (MODE == 1 || MODE == 2) {
      f32x4 y0 = *(const f32x4*)(a.ybuf + (long)(2 * row) * DM + i * 256 + lane * 4);
      f32x4 y1 = *(const f32x4*)(a.ybuf + (long)(2 * row + 1) * DM + i * 256 + lane * 4);
      t = t + y0 + y1;
    }
    if (MODE != 3 && MODE != 2) *(f32x4*)(a.h + (long)row * DM + i * 256 + lane * 4) = t;
    v[i * 4 + 0] = t[0]; v[i * 4 + 1] = t[1]; v[i * 4 + 2] = t[2]; v[i * 4 + 3] = t[3];
  }
  float ss = 0.f;
#pragma unroll
  for (int i = 0; i < 32; ++i) ss += v[i] * v[i];
  ss = wave_sum(ss);
  const float rs = rsqrtf(ss * (1.f / DM) + 1e-6f);
#pragma unroll
  for (int i = 0; i < 8; ++i) {
    f32x4 g = *(const f32x4*)(a.g + i * 256 + lane * 4);
#pragma unroll
    for (int j = 0; j < 4; ++j) v[i * 4 + j] = v[i * 4 + j] * rs * g[j];
    if (MODE == 2) {
      f32x4 o = {v[i * 4], v[i * 4 + 1], v[i * 4 + 2], v[i * 4 + 3]};
      *(f32x4*)(a.out + (long)row * DM + i * 256 + lane * 4) = o;
    } else {
      uint2 pk;
      pk.x = (unsigned)f2bf(v[i * 4]) | ((unsigned)f2bf(v[i * 4 + 1]) << 16);
      pk.y = (unsigned)f2bf(v[i * 4 + 2]) | ((unsigned)f2bf(v[i * 4 + 3]) << 16);
      *(uint2*)(a.xn + (long)row * DM + i * 256 + lane * 4) = pk;
    }
  }
  if (MODE == 3) {
    float p[36];
#pragma unroll
    for (int c = 0; c < 36; ++c) p[c] = 0.f;
#pragma unroll
    for (int i = 0; i < 8; ++i) {
#pragma unroll
      for (int j = 0; j < 4; ++j) {
        const int e = i * 256 + lane * 4 + j;
        const float xv = v[i * 4 + j];
        f32x4 wg = *(const f32x4*)(a.wg + (long)e * 4);
#pragma unroll
        for (int c = 0; c < 4; ++c) p[c] += xv * wg[c];
#pragma unroll
        for (int q = 0; q < 8; ++q) {
          f32x4 we = *(const f32x4*)(a.we + (long)e * 32 + q * 4);
#pragma unroll
          for (int c = 0; c < 4; ++c) p[4 + q * 4 + c] += xv * we[c];
        }
      }
    }
#pragma unroll
    for (int c = 0; c < 36; ++c) p[c] = wave_sum(p[c]);
    if (lane == 0) {
      float lg[4];
#pragma unroll
      for (int c = 0; c < 4; ++c) lg[c] = p[c] + a.bg[c];
      int gi = 0; float gm = lg[0];
#pragma unroll
      for (int c = 1; c < 4; ++c) if (lg[c] > gm) { gm = lg[c]; gi = c; }
      float gs = 0.f;
#pragma unroll
      for (int c = 0; c < 4; ++c) gs += __expf(lg[c] - gm);
      const float pg = 1.f / gs;
      float le[8];
#pragma unroll
      for (int j = 0; j < 8; ++j) {
        float l0 = p[4 + j] + a.be[j], l1 = p[12 + j] + a.be[8 + j], l2 = p[20 + j] + a.be[16 + j], l3 = p[28 + j] + a.be[24 + j];
        le[j] = gi == 0 ? l0 : (gi == 1 ? l1 : (gi == 2 ? l2 : l3));
      }
      int i1 = 0; float m1 = le[0];
#pragma unroll
      for (int j = 1; j < 8; ++j) if (le[j] > m1) { m1 = le[j]; i1 = j; }
      int i2 = -1; float m2 = -3.0e38f;
#pragma unroll
      for (int j = 0; j < 8; ++j) if (j != i1 && le[j] > m2) { m2 = le[j]; i2 = j; }
      const float w1 = 1.f / (1.f + __expf(m2 - m1)), w2 = 1.f - w1;
      a.tok_e[2 * row] = gi * 8 + i1; a.tok_e[2 * row + 1] = gi * 8 + i2;
      a.tok_g[2 * row] = pg * w1; a.tok_g[2 * row + 1] = pg * w2;
    }
  }
}

constexpr int BKK = 64, HALF = 128, HT = HALF * BKK, SHM_B = 8 * HT * 2;
__device__ __forceinline__ int lds_byte(int r, int c) {
  int st = (r >> 4) * 2 + (c >> 5), rr = r & 15, cc = c & 31, ob = rr * 64 + cc * 2;
  return st * 1024 + (ob ^ (((ob >> 9) & 1) << 5));
}
__device__ __forceinline__ void stage_rc(int b, int& R, int& C) {
  int st = b / 1024, sb = b % 1024, swz = sb ^ (((sb >> 9) & 1) << 5);
  R = (st >> 1) * 16 + swz / 64; C = (st & 1) * 32 + (swz % 64) / 2;
}

template <class Epi>
__device__ __forceinline__ void gemm256(const u16* __restrict__ A, int lda, const u16* __restrict__ Bt, int ldb, int K, u16* shm, const Epi& epi) {
#define SA(b, h) (shm + ((b) * 2 + (h)) * HT)
#define SB(b, h) (shm + (4 + (b) * 2 + (h)) * HT)
#define STAGE_X(TT, P, BASE, LD, br, kt) do { const u16* _g = (BASE) + (long)(br) * (LD) + (long)(kt) * BKK; \
    _Pragma("unroll") for (int _i = 0; _i < 2; ++_i) { int _b = (TT) * 16 + _i * 8192; int _r, _c; stage_rc(_b, _r, _c); \
      __builtin_amdgcn_global_load_lds((const unsigned*)(_g + (long)_r * (LD) + _c), (unsigned*)((char*)(P) + _b), 16, 0, 0); } } while (0)
#define STAGE_A(P, br, kt) STAGE_X(tid0, P, A, lda, br, kt)
#define STAGE_B(P, br, kt) STAGE_X(tid0, P, Bt, ldb, br, kt)
#define LDA(dst, b, h) _Pragma("unroll") for (int m = 0; m < 4; ++m) _Pragma("unroll") for (int k = 0; k < 2; ++k) \
    dst[m][k] = *reinterpret_cast<const bf16x8*>((char*)SA(b, h) + lds_byte(wr * 64 + m * 16 + fr, k * 32 + fq * 8))
#define LDB(dst, b, h) _Pragma("unroll") for (int n = 0; n < 2; ++n) _Pragma("unroll") for (int k = 0; k < 2; ++k) \
    dst[n][k] = *reinterpret_cast<const bf16x8*>((char*)SB(b, h) + lds_byte(wc * 32 + n * 16 + fr, k * 32 + fq * 8))
#define MMA(ai, bj, At, Bx) do { __builtin_amdgcn_s_setprio(1); \
    _Pragma("unroll") for (int m = 0; m < 4; ++m) _Pragma("unroll") for (int n = 0; n < 2; ++n) _Pragma("unroll") for (int k = 0; k < 2; ++k) \
      acc[ai][bj][m][n] = __builtin_amdgcn_mfma_f32_16x16x32_bf16(At[m][k], Bx[n][k], acc[ai][bj][m][n], 0, 0, 0); \
    __builtin_amdgcn_s_setprio(0); } while (0)
#define WAIT_V(n) asm volatile("s_waitcnt vmcnt(" #n ")" ::: "memory")
#define WAIT_L(n) asm volatile("s_waitcnt lgkmcnt(" #n ")" ::: "memory")
#define BAR __builtin_amdgcn_s_barrier()
#define SCHED __builtin_amdgcn_sched_barrier(0)
  int tid0 = threadIdx.x; asm volatile("" : "+v"(tid0));
  int wid = tid0 >> 6, lane = tid0 & 63, wr = wid >> 2, wc = wid & 3, fr = lane & 15, fq = lane >> 4;
  f32x4 acc[2][2][4][2] = {};
  bf16x8 At[4][2], B0[2][2], B1[2][2];
  const int nt = K / BKK;
  STAGE_B(SB(0, 0), 0, 0); STAGE_A(SA(0, 0), 0, 0);
  STAGE_B(SB(0, 1), HALF, 0); STAGE_A(SA(0, 1), HALF, 0);
  if (wr == 1) BAR;
  WAIT_V(4); BAR;
  STAGE_B(SB(1, 0), 0, 1); STAGE_A(SA(1, 0), 0, 1); STAGE_B(SB(1, 1), HALF, 1);
  WAIT_V(6); BAR;
  for (int t = 0; t < nt - 2; t += 2) {
    LDB(B0, 0, 0); SCHED; LDA(At, 0, 0); STAGE_A(SA(1, 1), HALF, t + 1);
    WAIT_L(8); BAR; WAIT_L(0); MMA(0, 0, At, B0); BAR; SCHED;
    LDB(B1, 0, 1); STAGE_B(SB(0, 0), 0, t + 2);
    BAR; WAIT_L(0); MMA(0, 1, At, B1); BAR;
    LDA(At, 0, 1); STAGE_A(SA(0, 0), 0, t + 2);
    BAR; WAIT_L(0); MMA(1, 0, At, B0); BAR; SCHED;
    STAGE_B(SB(0, 1), HALF, t + 2);
    WAIT_V(6); BAR; MMA(1, 1, At, B1); BAR;
    LDB(B0, 1, 0); SCHED; LDA(At, 1, 0); STAGE_A(SA(0, 1), HALF, t + 2);
    WAIT_L(8); BAR; WAIT_L(0); MMA(0, 0, At, B0); BAR; SCHED;
    LDB(B1, 1, 1); STAGE_B(SB(1, 0), 0, t + 3);
    BAR; WAIT_L(0); MMA(0, 1, At, B1); BAR;
    LDA(At, 1, 1); STAGE_A(SA(1, 0), 0, t + 3);
    BAR; WAIT_L(0); MMA(1, 0, At, B0); BAR; SCHED;
    STAGE_B(SB(1, 1), HALF, t + 3);
    WAIT_V(6); BAR; MMA(1, 1, At, B1); BAR;
  }
  int tz = threadIdx.x; asm volatile("" : "+v"(tz)); wid = tz >> 6; lane = tz & 63; wr = wid >> 2; wc = wid & 3; fr = lane & 15; fq = lane >> 4;
  { LDB(B0, 0, 0); WAIT_V(0); LDA(At, 0, 0); STAGE_X(tz, SA(1, 1), A, lda, HALF, nt - 1);
    BAR; WAIT_L(0); MMA(0, 0, At, B0); BAR;
    LDB(B1, 0, 1); BAR; WAIT_L(0); MMA(0, 1, At, B1); BAR;
    LDA(At, 0, 1); WAIT_V(4); BAR; WAIT_L(0); MMA(1, 0, At, B0); MMA(1, 1, At, B1); BAR; }
  { LDB(B0, 1, 0); LDA(At, 1, 0); WAIT_V(2); BAR; WAIT_L(0); MMA(0, 0, At, B0); BAR;
    LDB(B1, 1, 1); WAIT_V(0); BAR; WAIT_L(0); MMA(0, 1, At, B1); BAR;
    LDA(At, 1, 1); BAR; WAIT_L(0); MMA(1, 0, At, B0); MMA(1, 1, At, B1); BAR; }
  if (wr == 0) BAR;
  epi(acc, wr, wc, fr, fq);
  __syncthreads();
#undef SA
#undef SB
}

#define UNR _Pragma("unroll")
#define EPI_LOOP UNR for (int ai = 0; ai < 2; ++ai) UNR for (int bj = 0; bj < 2; ++bj) UNR for (int m = 0; m < 4; ++m) UNR for (int n = 0; n < 2; ++n) UNR for (int j = 0; j < 4; ++j)
#define EPI_ROW (ai * HALF + wr * 64 + m * 16 + fq * 4 + j)
#define EPI_COL (bj * HALF + wc * 32 + n * 16 + fr)

struct EpiProj {
  u16* proj; int brow, bcol;
  __device__ __forceinline__ void operator()(const f32x4 (&acc)[2][2][4][2], int wr, int wc, int fr, int fq) const {
    EPI_LOOP { int row = brow + EPI_ROW, col = bcol + EPI_COL; float v = acc[ai][bj][m][n][j]; if (col >= OFF_G) v = sigmoidf_(v); proj[(long)row * PC + col] = f2bf(v); }
  }
};
struct EpiMerge {
  const u16* proj; float* mbuf; u16* merged; int kb, brow, bcol;
  __device__ __forceinline__ void operator()(const f32x4 (&acc)[2][2][4][2], int wr, int wc, int fr, int fq) const {
    EPI_LOOP { int row = brow + EPI_ROW, col = bcol + EPI_COL; long idx = (long)row * DM + col;
      float g = bf2f(proj[(long)row * PC + OFF_G + kb * DM + col]); float v = g * acc[ai][bj][m][n][j];
      if (kb > 0) v += mbuf[idx];
      if (kb < 3) mbuf[idx] = v; else merged[idx] = f2bf(v); }
  }
};
struct EpiResid {
  float* h; int brow, bcol;
  __device__ __forceinline__ void operator()(const f32x4 (&acc)[2][2][4][2], int wr, int wc, int fr, int fq) const {
    EPI_LOOP { int row = brow + EPI_ROW, col = bcol + EPI_COL; long idx = (long)row * DM + col; h[idx] += acc[ai][bj][m][n][j]; }
  }
};
struct EpiGateUp {
  u16* hmid; int brow, ct;
  __device__ __forceinline__ void operator()(const f32x4 (&acc)[2][2][4][2], int wr, int wc, int fr, int fq) const {
    u16* base = hmid + (long)(brow + wr * 64 + fq * 4) * DEXP + ct * 128 + wc * 32 + fr;
    UNR for (int ai = 0; ai < 2; ++ai) UNR for (int m = 0; m < 4; ++m) {
      UNR for (int n = 0; n < 2; ++n) UNR for (int j = 0; j < 4; ++j) {
        float g = acc[ai][0][m][n][j], u = acc[ai][1][m][n][j];
        base[(long)(ai * HALF + m * 16 + j) * DEXP + n * 16] = f2bf(g * sigmoidf_(g) * u); }
      asm volatile("" ::: "memory"); }
  }
};
struct EpiDown {
  float* ybuf; const int* row_slot; const float* row_gate; int brow, bcol;
  __device__ __forceinline__ void operator()(const f32x4 (&acc)[2][2][4][2], int wr, int wc, int fr, int fq) const {
    UNR for (int ai = 0; ai < 2; ++ai) UNR for (int m = 0; m < 4; ++m) UNR for (int j = 0; j < 4; ++j) {
      int row = brow + ai * HALF + wr * 64 + m * 16 + fq * 4 + j; int slot = row_slot[row]; float gt = row_gate[row];
      if (slot >= 0) UNR for (int bj = 0; bj < 2; ++bj) UNR for (int n = 0; n < 2; ++n) { int col = bcol + EPI_COL; ybuf[(long)slot * DM + col] = gt * acc[ai][bj][m][n][j]; } }
  }
};

struct GemmArgs {
  const u16* A; const u16* Bt; u16* proj; float* mbuf; u16* merged; float* h; u16* hmid; float* ybuf;
  const int* row_slot; const float* row_gate; const int* tile_exp; const int* nrt; int kb; int pad;
};
__device__ __forceinline__ void unit_map(int b, int round, int& pm, int& pn) {
  int xcd = b & 7, i = b >> 3, pr = xcd >> 1, pc = xcd & 1, lr = i & 7, lc = i >> 3;
  pm = pr * 8 + lr; pn = round * 8 + pc * 4 + lc;
}
template <int MODE>
__global__ __launch_bounds__(512, 2) void k_gemm(GemmArgs a) {
  extern __shared__ __attribute__((aligned(16))) u16 shm[];
  if (MODE == 0) {
    for (int round = 0; round < (PC / 256 + 7) / 8; ++round) {
      int pm, pn; unit_map(blockIdx.x, round, pm, pn);
      if (pn >= PC / 256) continue;
      EpiProj e{a.proj, pm * 256, pn * 256};
      gemm256(a.A + (long)pm * 256 * DM, DM, a.Bt + (long)pn * 256 * DM, DM, DM, shm, e);
    }
  } else if (MODE == 1) {
    int pm, pn; unit_map(blockIdx.x, 0, pm, pn);
    EpiMerge e{a.proj, a.mbuf, a.merged, a.kb, pm * 256, pn * 256};
    gemm256(a.A + (long)pm * 256 * DM + a.kb * MIXW, DM, a.Bt + ((long)a.kb * DM + pn * 256) * MIXW, MIXW, MIXW, shm, e);
  } else if (MODE == 2) {
    int pm, pn; unit_map(blockIdx.x, 0, pm, pn);
    EpiResid e{a.h, pm * 256, pn * 256};
    gemm256(a.A + (long)pm * 256 * DM, DM, a.Bt + (long)pn * 256 * DM, DM, DM, shm, e);
  } else if (MODE == 3) {
    const int nu = a.nrt[0] * 8;
    for (int u = blockIdx.x; u < nu; u += gridDim.x) {
      int rt = u >> 3, ct = u & 7, ex = a.tile_exp[rt];
      EpiGateUp e{a.hmid, rt * 256, ct};
      gemm256(a.A + (long)rt * 256 * DM, DM, a.Bt + ((long)ex * 2048 + ct * 256) * DM, DM, DM, shm, e);
    }
  } else {
    const int nu = a.nrt[0] * 8;
    for (int u = blockIdx.x; u < nu; u += gridDim.x) {
      int rt = u >> 3, ct = u & 7, ex = a.tile_exp[rt];
      EpiDown e{a.ybuf, a.row_slot, a.row_gate, rt * 256, ct * 256};
      gemm256(a.A + (long)rt * 256 * DEXP, DEXP, a.Bt + ((long)ex * DM + ct * 256) * DEXP, DEXP, DEXP, shm, e);
    }
  }
}

constexpr int CH = 64, NCH = T_ / CH;
constexpr int LD = 72;

struct RwkvP { const float *mu, *w0, *w_up, *a0, *a_up, *g_up, *k_k, *k_a, *r_k, *ln_g, *ln_b; };
struct LruP { const float *conv_w, *conv_b, *w_a, *b_a, *w_x, *b_x, *lam; };
struct MixBuf {
  u16 *rw_Rb, *rw_Pab, *rw_Pak, *rw_VT, *rw_S0, *rw_UT, *rw_WpF, *rw_BtF, *rw_G, *rw_BV; float *rw_U0F, *rw_KVF, *rw_gam;
  u16 *rt_Rb, *rt_Pak, *rt_VT, *rt_S0; float* rt_KVT;
  u16 *gl_Rb, *gl_Pak, *gl_VT, *gl_S0; float *gl_KVT, *gl_gam;
  float *lr_h, *lr_A, *lr_Hp;
};
struct MixP {
  const u16* proj; const int* pos; u16* ycat; MixBuf b;
  RwkvP rw; const float* ret_norm_g; LruP lru; const float *gla_alpha_up, *gla_alpha_b, *gla_norm_g;
};

__device__ __forceinline__ float gelu_tanh(float x) {
  const float u = 0.7978845608028654f * (x + 0.044715f * x * x * x);
  return 0.5f * x * (1.f + tanhf(u));
}
__device__ __forceinline__ float red16(float v) {
  v += __shfl_xor(v, 1, 64); v += __shfl_xor(v, 2, 64); v += __shfl_xor(v, 4, 64); v += __shfl_xor(v, 8, 64);
  return v;
}
__device__ __forceinline__ uint4 pack8(const u16 (&a)[8]) {
  uint4 r;
  r.x = (unsigned)a[0] | ((unsigned)a[1] << 16); r.y = (unsigned)a[2] | ((unsigned)a[3] << 16);
  r.z = (unsigned)a[4] | ((unsigned)a[5] << 16); r.w = (unsigned)a[6] | ((unsigned)a[7] << 16);
  return r;
}
__device__ __forceinline__ f32x4 tile_nt(const u16* sA, const u16* sB, int mt, int nt, int r, int g) {
  f32x4 c = {0.f, 0.f, 0.f, 0.f};
#pragma unroll
  for (int s = 0; s < 2; ++s) {
    bf16x8 a = *(const bf16x8*)(sA + (16 * mt + r) * LD + 32 * s + 8 * g);
    bf16x8 b = *(const bf16x8*)(sB + (16 * nt + r) * LD + 32 * s + 8 * g);
    c = __builtin_amdgcn_mfma_f32_16x16x32_bf16(a, b, c, 0, 0, 0);
  }
  return c;
}
__device__ __forceinline__ void copy_out(const u16* s, u16* gp, int rows, int tid) {
  for (int idx = tid; idx < rows * 8; idx += 512) { int row = idx >> 3, seg = idx & 7; *(uint4*)(gp + row * 64 + seg * 8) = *(const uint4*)(s + row * LD + seg * 8); }
}
__device__ __forceinline__ void inv_perm(int x, int& s, int& g, int& j) { s = x >> 5; int rr = x & 31; g = (rr >> 2) & 3; j = 4 * (rr >> 4) + (rr & 3); }

__device__ __forceinline__ void p3_ret(const MixP& p, int c, int h, char* smem) {
  u16* sRb = (u16*)smem; u16* sKb = sRb + 64 * LD; u16* sKtT = sKb + 64 * LD; u16* sVT = sKtT + 64 * LD;
  int tid = threadIdx.x; asm volatile("" : "+v"(tid));
  const int cc = tid & 63, tg = tid >> 6, r = cc & 15, g = cc >> 4, uid = c * 8 + h;
  const float lg2 = log2f(1.f - exp2f(-(5.f + 4.f * (float)h / 7.f)));
  const float inv = exp2f(-(float)(cc & 31) * (13.287712379549449f / 32.f));
  u16 kt8[8], v8[8];
#pragma unroll
  for (int i = 0; i < 8; ++i) {
    const int tl = tg * 8 + i, t = c * 64 + tl; const u16* row = p.proj + (long)t * PC + OFF_B;
    const float q = bf2f(row[h * 64 + cc]), k = bf2f(row[512 + h * 64 + cc]);
    float sn, cs; sincosf((float)p.pos[t] * inv, &sn, &cs);
    const float qo = __shfl_xor(q, 32, 64), ko = __shfl_xor(k, 32, 64);
    const float qr = cc < 32 ? q * cs - qo * sn : q * cs + qo * sn;
    const float kr = (cc < 32 ? k * cs - ko * sn : k * cs + ko * sn) * 0.125f;
    const float e = exp2f(lg2 * (float)(tl + 1)), ei = exp2f(-lg2 * (float)(tl + 1)), et = exp2f(lg2 * (float)(63 - tl));
    sRb[tl * LD + cc] = f2bf(qr * e); sKb[tl * LD + cc] = f2bf(kr * ei); kt8[i] = f2bf(kr * et); v8[i] = row[1024 + h * 64 + cc];
  }
  *(uint4*)(sKtT + cc * LD + tg * 8) = pack8(kt8); *(uint4*)(sVT + cc * LD + tg * 8) = pack8(v8);
  __syncthreads();
  for (int tile = tg; tile < 32; tile += 8) {
    if (tile < 16) {
      const int mt = tile >> 2, nt = tile & 3; f32x4 c4 = tile_nt(sRb, sKb, mt, nt, r, g);
#pragma unroll
      for (int reg = 0; reg < 4; ++reg) { int t = 16 * mt + 4 * g + reg, i = 16 * nt + r; p.b.rt_Pak[(long)uid * 4096 + t * 64 + i] = f2bf(i <= t ? c4[reg] : 0.f); }
    } else {
      const int q = tile - 16, mt = q >> 2, nt = q & 3; f32x4 c4 = tile_nt(sVT, sKtT, mt, nt, r, g);
#pragma unroll
      for (int reg = 0; reg < 4; ++reg) { int v = 16 * mt + 4 * g + reg, k = 16 * nt + r; p.b.rt_KVT[(long)uid * 4096 + v * 64 + k] = c4[reg]; }
    }
  }
  copy_out(sRb, p.b.rt_Rb + (long)uid * 4096, 64, tid); copy_out(sVT, p.b.rt_VT + (long)uid * 4096, 64, tid);
  __syncthreads();
}

__device__ __forceinline__ void p3_gla(const MixP& p, int c, int h, char* smem) {
  u16* sRb = (u16*)smem; u16* sKb = sRb + 64 * LD; u16* sKtT = sKb + 64 * LD; u16* sVT = sKtT + 64 * LD;
  float* pre = (float*)(smem + 5 * 64 * LD * 2); float* sal = pre + 512;
  int tid = threadIdx.x; asm volatile("" : "+v"(tid));
  const int cc = tid & 63, tg = tid >> 6, r = cc & 15, g = cc >> 4, uid = c * 4 + h, hd = h * 64 + cc;
  for (int idx = tid; idx < 1024; idx += 512) { int tl = idx >> 4, j = idx & 15; sal[idx] = bf2f(p.proj[(long)(c * 64 + tl) * PC + OFF_D + 1024 + j]); }
  __syncthreads();
  float au[16];
#pragma unroll
  for (int j = 0; j < 16; ++j) au[j] = p.gla_alpha_up[j * 256 + hd];
  const float ab = p.gla_alpha_b[hd];
  float cum[8]; float run = 0.f;
#pragma unroll
  for (int i = 0; i < 8; ++i) {
    const int tl = tg * 8 + i; float x = ab;
#pragma unroll
    for (int j = 0; j < 16; ++j) x += sal[tl * 16 + j] * au[j];
    const float ls = x >= 0.f ? -log1pf(__expf(-x)) : x - log1pf(__expf(x));
    run += ls * (1.f / 16.f); cum[i] = run;
  }
  pre[tg * 64 + cc] = run;
  __syncthreads();
  float off = 0.f, tot = 0.f;
#pragma unroll
  for (int q = 0; q < 8; ++q) { float v = pre[q * 64 + cc]; tot += v; if (q < tg) off += v; }
  u16 kt8[8], v8a[8], v8b[8];
#pragma unroll
  for (int i = 0; i < 8; ++i) {
    const int tl = tg * 8 + i, t = c * 64 + tl; const u16* row = p.proj + (long)t * PC + OFF_D;
    const float cm = cum[i] + off;
    const float q = bf2f(row[hd]) * 0.125f, k = bf2f(row[256 + hd]);
    sRb[tl * LD + cc] = f2bf(q * __expf(cm)); sKb[tl * LD + cc] = f2bf(k * __expf(-cm)); kt8[i] = f2bf(k * __expf(tot - cm));
    v8a[i] = row[512 + h * 128 + cc]; v8b[i] = row[512 + h * 128 + 64 + cc];
  }
  *(uint4*)(sKtT + cc * LD + tg * 8) = pack8(kt8); *(uint4*)(sVT + cc * LD + tg * 8) = pack8(v8a); *(uint4*)(sVT + (64 + cc) * LD + tg * 8) = pack8(v8b);
  if (tg == 0) p.b.gl_gam[uid * 64 + cc] = __expf(tot);
  __syncthreads();
  for (int tile = tg; tile < 48; tile += 8) {
    if (tile < 16) {
      const int mt = tile >> 2, nt = tile & 3; f32x4 c4 = tile_nt(sRb, sKb, mt, nt, r, g);
#pragma unroll
      for (int reg = 0; reg < 4; ++reg) { int t = 16 * mt + 4 * g + reg, i = 16 * nt + r; p.b.gl_Pak[(long)uid * 4096 + t * 64 + i] = f2bf(i <= t ? c4[reg] : 0.f); }
    } else {
      const int q = tile - 16, mt = q >> 2, nt = q & 3; f32x4 c4 = tile_nt(sVT, sKtT, mt, nt, r, g);
#pragma unroll
      for (int reg = 0; reg < 4; ++reg) { int v = 16 * mt + 4 * g + reg, k = 16 * nt + r; p.b.gl_KVT[(long)uid * 8192 + v * 64 + k] = c4[reg]; }
    }
  }
  copy_out(sRb, p.b.gl_Rb + (long)uid * 4096, 64, tid); copy_out(sVT, p.b.gl_VT + (long)uid * 8192, 128, tid);
  __syncthreads();
}

__device__ __forceinline__ void p3_lru(const MixP& p, int c, int gq, char* smem) {
  float* sxc = (float*)smem; float* preA = sxc + 4096; float* preB = preA + 512;
  int tid = threadIdx.x; asm volatile("" : "+v"(tid));
  const int cc = tid & 63, tg = tid >> 6, ch = gq * 64 + cc, t0 = c * 64 + tg * 8;
  float xb[11];
#pragma unroll
  for (int i = 0; i < 11; ++i) { int t = t0 - 3 + i; xb[i] = t >= 0 ? bf2f(p.proj[(long)t * PC + OFF_C + ch]) : 0.f; }
  const float cw0 = p.lru.conv_w[ch], cw1 = p.lru.conv_w[512 + ch], cw2 = p.lru.conv_w[1024 + ch], cw3 = p.lru.conv_w[1536 + ch], cb = p.lru.conv_b[ch];
  float xc[8];
#pragma unroll
  for (int i = 0; i < 8; ++i) { xc[i] = cb + cw0 * xb[i] + cw1 * xb[i + 1] + cw2 * xb[i + 2] + cw3 * xb[i + 3]; sxc[(tg * 8 + i) * 64 + cc] = xc[i]; }
  __syncthreads();
  float ra[8], ix[8];
  const float ba = p.lru.b_a[ch], bx = p.lru.b_x[ch];
#pragma unroll
  for (int i = 0; i < 8; ++i) { ra[i] = ba; ix[i] = bx; }
  const float* wa = p.lru.w_a + (long)gq * 4096 + cc; const float* wx = p.lru.w_x + (long)gq * 4096 + cc;
#pragma unroll 2
  for (int ii = 0; ii < 64; ii += 4) {
    float a0 = wa[(ii + 0) * 64], a1 = wa[(ii + 1) * 64], a2 = wa[(ii + 2) * 64], a3 = wa[(ii + 3) * 64];
    float x0 = wx[(ii + 0) * 64], x1 = wx[(ii + 1) * 64], x2 = wx[(ii + 2) * 64], x3 = wx[(ii + 3) * 64];
#pragma unroll
    for (int i = 0; i < 8; ++i) {
      f32x4 xv = *(const f32x4*)(sxc + (tg * 8 + i) * 64 + ii);
      ra[i] += xv[0] * a0 + xv[1] * a1 + xv[2] * a2 + xv[3] * a3;
      ix[i] += xv[0] * x0 + xv[1] * x1 + xv[2] * x2 + xv[3] * x3;
    }
  }
  const float lam = p.lru.lam[ch]; const float sp = (-lam) > 20.f ? (-lam) : log1pf(__expf(-lam));
  float hl[8], ac[8]; float A = 1.f, B = 0.f;
#pragma unroll
  for (int i = 0; i < 8; ++i) {
    const float rr = sigmoidf_(ra[i]), ig = sigmoidf_(ix[i]); const float log_a = -8.f * rr * sp;
    const bool reset = p.pos[t0 + i] == 0;
    const float av = reset ? 0.f : __expf(log_a); const float mult = reset ? 1.f : sqrtf(-expm1f(2.f * log_a));
    const float bv = mult * ig * xc[i];
    B = av * B + bv; A *= av; hl[i] = B; ac[i] = A;
  }
  preA[tg * 64 + cc] = A; preB[tg * 64 + cc] = B;
  __syncthreads();
  float Ap = 1.f, Bp = 0.f;
#pragma unroll
  for (int q = 0; q < 7; ++q) if (q < tg) { float a = preA[q * 64 + cc], b = preB[q * 64 + cc]; Bp = a * Bp + b; Ap *= a; }
#pragma unroll
  for (int i = 0; i < 8; ++i) { long o = (long)(t0 + i) * 512 + ch; p.b.lr_h[o] = hl[i] + ac[i] * Bp; p.b.lr_A[o] = ac[i] * Ap; }
  __syncthreads();
}

template <int I, int N> struct SolveDot {
  static __device__ __forceinline__ void run(const float* arow, const float (&X)[64], float (&acc)[4]) {
    if constexpr (I + 4 <= N) {
      const f32x4 a = *(const f32x4*)(arow + I);
      acc[0] += a[0] * X[I]; acc[1] += a[1] * X[I + 1]; acc[2] += a[2] * X[I + 2]; acc[3] += a[3] * X[I + 3];
      SolveDot<I + 4, N>::run(arow, X, acc);
    } else if constexpr (I < N) { acc[I & 3] += arow[I] * X[I]; SolveDot<I + 1, N>::run(arow, X, acc); }
  }
};
template <int T> struct SolveRow {
  static __device__ __forceinline__ void run(const float* sAab, const float* sRhs, int tid, float (&X)[64]) {
    if constexpr (T < 64) {
      float acc[4] = {sRhs[T * 128 + tid], 0.f, 0.f, 0.f};
      SolveDot<0, T>::run(sAab + T * 64, X, acc);
      X[T] = (acc[0] + acc[1]) + (acc[2] + acc[3]);
      asm volatile("" ::: "memory");
      SolveRow<T + 1>::run(sAab, sRhs, tid, X);
    }
  }
};
__device__ __forceinline__ void p3_rwkv_solve(const MixP& p, int uid, int tid, const float* sRhs, const float* sAab) {
  float X[64];
  const int col = tid & 63; const bool isAl = tid < 64;
  SolveRow<0>::run(sAab, sRhs, tid, X);
  if (isAl) {
    int s, g_, j; inv_perm(col, s, g_, j);
#pragma unroll
    for (int t = 0; t < 64; ++t) p.b.rw_WpF[(long)uid * 4096 + (((t >> 4) * 2 + s) * 64 + g_ * 16 + (t & 15)) * 8 + j] = f2bf(X[t]);
  } else {
    const int vs = col >> 4, r_ = col & 15;
#pragma unroll
    for (int tt = 0; tt < 4; ++tt)
#pragma unroll
      for (int g_ = 0; g_ < 4; ++g_) {
        f32x4 o = {X[16 * tt + 4 * g_], X[16 * tt + 4 * g_ + 1], X[16 * tt + 4 * g_ + 2], X[16 * tt + 4 * g_ + 3]};
        *(f32x4*)(p.b.rw_U0F + (((long)uid * 4 + vs) * 4 + tt) * 256 + (g_ * 16 + r_) * 4) = o;
      }
  }
}
__device__ __forceinline__ void p3_rwkv(const MixP& p, int c, int h, char* smem) {
  u16* sRb = (u16*)smem; u16* sKb = sRb + 64 * LD; u16* sAl = sKb + 64 * LD; u16* sBe = sAl + 64 * LD; u16* sKtT = sBe + 64 * LD; u16* sVT = sKtT + 64 * LD;
  float* pre = (float*)(smem + 55296);
  char* R2 = smem + 57344;
  float* tw = (float*)R2; float* za = tw + 2048; float* sg = za + 2048;
  float* sAab = (float*)R2; u16* sAak = (u16*)(R2 + 16384); float* sRhs = (float*)(R2 + 16384 + 9216);
  int tid = threadIdx.x; asm volatile("" : "+v"(tid));
  const int cc = tid & 63, tg = tid >> 6, r = cc & 15, g = cc >> 4, uid = c * 8 + h, hc = h * 64 + cc, t0 = c * 64 + tg * 8;
  const u16* proj = p.proj;
  for (int idx = tid; idx < 64 * 160; idx += 512) {
    const int tl = idx / 160, j = idx - tl * 160, t = c * 64 + tl, col = 1536 + j;
    const float cur = bf2f(proj[(long)t * PC + col]); const float prev = t > 0 ? bf2f(proj[(long)(t - 1) * PC + col]) : 0.f;
    const float z = cur + (prev - cur) * p.rw.mu[col];
    if (j < 32) tw[tl * 32 + j] = tanhf(z); else if (j < 64) za[tl * 32 + (j - 32)] = z; else sg[tl * 96 + (j - 64)] = sigmoidf_(z);
  }
  float zr[8], zk[8], zv[8];
  {
    float pr[9], pk[9], pv[9];
#pragma unroll
    for (int i = 0; i < 9; ++i) { int t = t0 - 1 + i; if (t >= 0) { const u16* row = proj + (long)t * PC; pr[i] = bf2f(row[hc]); pk[i] = bf2f(row[512 + hc]); pv[i] = bf2f(row[1024 + hc]); } else { pr[i] = pk[i] = pv[i] = 0.f; } }
    const float mr = p.rw.mu[hc], mk = p.rw.mu[512 + hc], mv = p.rw.mu[1024 + hc];
#pragma unroll
    for (int i = 0; i < 8; ++i) { zr[i] = pr[i + 1] + (pr[i] - pr[i + 1]) * mr; zk[i] = pk[i + 1] + (pk[i] - pk[i + 1]) * mk; zv[i] = pv[i + 1] + (pv[i] - pv[i + 1]) * mv; }
  }
  __syncthreads();
  float wv[8], av[8], gv[8];
  { const float w0 = p.rw.w0[hc], a0 = p.rw.a0[hc];
#pragma unroll
    for (int i = 0; i < 8; ++i) { wv[i] = w0; av[i] = a0; gv[i] = 0.f; } }
#pragma unroll 2
  for (int j = 0; j < 32; j += 4) {
    float wu0 = p.rw.w_up[(j + 0) * 512 + hc], wu1 = p.rw.w_up[(j + 1) * 512 + hc], wu2 = p.rw.w_up[(j + 2) * 512 + hc], wu3 = p.rw.w_up[(j + 3) * 512 + hc];
    float au0 = p.rw.a_up[(j + 0) * 512 + hc], au1 = p.rw.a_up[(j + 1) * 512 + hc], au2 = p.rw.a_up[(j + 2) * 512 + hc], au3 = p.rw.a_up[(j + 3) * 512 + hc];
#pragma unroll
    for (int i = 0; i < 8; ++i) {
      f32x4 t4 = *(const f32x4*)(tw + (tg * 8 + i) * 32 + j), z4 = *(const f32x4*)(za + (tg * 8 + i) * 32 + j);
      wv[i] += t4[0] * wu0 + t4[1] * wu1 + t4[2] * wu2 + t4[3] * wu3;
      av[i] += z4[0] * au0 + z4[1] * au1 + z4[2] * au2 + z4[3] * au3;
    }
  }
#pragma unroll 2
  for (int j = 0; j < 96; j += 4) {
    float gu0 = p.rw.g_up[(j + 0) * 512 + hc], gu1 = p.rw.g_up[(j + 1) * 512 + hc], gu2 = p.rw.g_up[(j + 2) * 512 + hc], gu3 = p.rw.g_up[(j + 3) * 512 + hc];
#pragma unroll
    for (int i = 0; i < 8; ++i) { f32x4 s4 = *(const f32x4*)(sg + (tg * 8 + i) * 96 + j); gv[i] += s4[0] * gu0 + s4[1] * gu1 + s4[2] * gu2 + s4[3] * gu3; }
  }
  const float kkw = p.rw.k_k[hc], kaw = p.rw.k_a[hc], rkw = p.rw.r_k[hc];
  float lw[8], aa[8], kk[8], kp[8], cum[8]; float run = 0.f;
#pragma unroll
  for (int i = 0; i < 8; ++i) {
    lw[i] = -0.6065306597126334f * sigmoidf_(wv[i]); aa[i] = sigmoidf_(av[i]);
    float k0 = zk[i] * kkw; const float ss = wave_sum(k0 * k0); kk[i] = k0 / fmaxf(sqrtf(ss), 1e-12f);
    kp[i] = zk[i] * (1.f + (aa[i] - 1.f) * kaw);
    const float bs = wave_sum(zr[i] * kp[i] * rkw);
    const long o = (long)(t0 + i) * 512 + hc;
    p.b.rw_G[o] = f2bf(gv[i]); p.b.rw_BV[o] = f2bf(bs * zv[i]);
    run += lw[i]; cum[i] = run;
  }
  pre[tg * 64 + cc] = run;
  __syncthreads();
  float off = 0.f, tot = 0.f;
#pragma unroll
  for (int q = 0; q < 8; ++q) { float v = pre[q * 64 + cc]; tot += v; if (q < tg) off += v; }
  {
    u16 kt8[8], v8[8];
    const int kt = cc >> 4, r_ = cc & 15;
#pragma unroll
    for (int i = 0; i < 8; ++i) {
      const int tl = tg * 8 + i; const float cm = cum[i] + off, cx = cm - lw[i];
      const float en = __expf(-cm), et = __expf(tot - cm);
      sAl[tl * LD + cc] = f2bf(-kk[i] * __expf(cx)); sBe[tl * LD + cc] = f2bf(kk[i] * aa[i] * en);
      sKb[tl * LD + cc] = f2bf(kp[i] * en); sRb[tl * LD + cc] = f2bf(zr[i] * __expf(cm));
      kt8[i] = f2bf(kp[i] * et); v8[i] = f2bf(zv[i]);
      int s, g_, j; inv_perm(tl, s, g_, j);
      p.b.rw_BtF[(long)uid * 4096 + ((kt * 2 + s) * 64 + g_ * 16 + r_) * 8 + j] = f2bf(kk[i] * aa[i] * et);
    }
    *(uint4*)(sKtT + cc * LD + tg * 8) = pack8(kt8); *(uint4*)(sVT + cc * LD + tg * 8) = pack8(v8);
    if (tg == 0) p.b.rw_gam[uid * 64 + cc] = __expf(tot);
  }
  __syncthreads();
  for (int q = tg; q < 80; q += 8) {
    const int kind = q >> 4, tt = q & 15, mt = tt >> 2, nt = tt & 3;
    if (kind == 0) { f32x4 c4 = tile_nt(sAl, sBe, mt, nt, r, g);
#pragma unroll
      for (int reg = 0; reg < 4; ++reg) { int t = 16 * mt + 4 * g + reg, i = 16 * nt + r; sAab[t * 64 + i] = i < t ? c4[reg] : 0.f; }
    } else if (kind == 1) { f32x4 c4 = tile_nt(sAl, sKb, mt, nt, r, g);
#pragma unroll
      for (int reg = 0; reg < 4; ++reg) { int t = 16 * mt + 4 * g + reg, i = 16 * nt + r; sAak[t * LD + i] = f2bf(i < t ? c4[reg] : 0.f); }
    } else if (kind == 2) { f32x4 c4 = tile_nt(sRb, sBe, mt, nt, r, g);
#pragma unroll
      for (int reg = 0; reg < 4; ++reg) { int t = 16 * mt + 4 * g + reg, i = 16 * nt + r; p.b.rw_Pab[(long)uid * 4096 + t * 64 + i] = f2bf(i <= t ? c4[reg] : 0.f); }
    } else if (kind == 3) { f32x4 c4 = tile_nt(sRb, sKb, mt, nt, r, g);
#pragma unroll
      for (int reg = 0; reg < 4; ++reg) { int t = 16 * mt + 4 * g + reg, i = 16 * nt + r; p.b.rw_Pak[(long)uid * 4096 + t * 64 + i] = f2bf(i <= t ? c4[reg] : 0.f); }
    } else { f32x4 c4 = tile_nt(sKtT, sVT, mt, nt, r, g);
      *(f32x4*)(p.b.rw_KVF + (((long)uid * 4 + nt) * 4 + mt) * 256 + cc * 4) = c4;
    }
  }
  __syncthreads();
  for (int q = tg; q < 16; q += 8) { const int mt = q >> 2, nt = q & 3; f32x4 c4 = tile_nt(sAak, sVT, mt, nt, r, g);
#pragma unroll
    for (int reg = 0; reg < 4; ++reg) { int t = 16 * mt + 4 * g + reg, v = 16 * nt + r; sRhs[t * 128 + 64 + v] = c4[reg]; } }
  for (int idx = tid; idx < 4096; idx += 512) { int t = idx >> 6, k = idx & 63; sRhs[t * 128 + k] = bf2f(sAl[t * LD + k]); }
  copy_out(sRb, p.b.rw_Rb + (long)uid * 4096, 64, tid); copy_out(sVT, p.b.rw_VT + (long)uid * 4096, 64, tid);
  __syncthreads();
  if (tid < 128) p3_rwkv_solve(p, uid, tid, sRhs, sAab);
  __syncthreads();
}

constexpr int RING_SLOT = 8192 + 8192 + 4096 + 4096 + 256;
__device__ __forceinline__ void chain_issue(const MixP& p, int uid, int vs, char* slot, int lane) {
  const u16* wp = p.b.rw_WpF + (long)uid * 4096 + lane * 8; const u16* bt = p.b.rw_BtF + (long)uid * 4096 + lane * 8;
#pragma unroll
  for (int i = 0; i < 8; ++i) __builtin_amdgcn_global_load_lds((const unsigned*)(wp + i * 512), (unsigned*)(slot + i * 1024 + lane * 16), 16, 0, 0);
#pragma unroll
  for (int i = 0; i < 8; ++i) __builtin_amdgcn_global_load_lds((const unsigned*)(bt + i * 512), (unsigned*)(slot + 8192 + i * 1024 + lane * 16), 16, 0, 0);
  const float* u0 = p.b.rw_U0F + ((long)uid * 4 + vs) * 1024 + lane * 4; const float* kv = p.b.rw_KVF + ((long)uid * 4 + vs) * 1024 + lane * 4;
#pragma unroll
  for (int i = 0; i < 4; ++i) __builtin_amdgcn_global_load_lds((const unsigned*)(u0 + i * 256), (unsigned*)(slot + 16384 + i * 1024 + lane * 16), 16, 0, 0);
#pragma unroll
  for (int i = 0; i < 4; ++i) __builtin_amdgcn_global_load_lds((const unsigned*)(kv + i * 256), (unsigned*)(slot + 20480 + i * 1024 + lane * 16), 16, 0, 0);
  __builtin_amdgcn_global_load_lds((const unsigned*)(p.b.rw_gam + uid * 64 + lane), (unsigned*)(slot + 24576 + lane * 4), 4, 0, 0);
}
__device__ __forceinline__ bf16x8 cvt_frag(const f32x4& lo, const f32x4& hi) {
  bf16x8 f;
  f[0] = (short)f2bf(lo[0]); f[1] = (short)f2bf(lo[1]); f[2] = (short)f2bf(lo[2]); f[3] = (short)f2bf(lo[3]);
  f[4] = (short)f2bf(hi[0]); f[5] = (short)f2bf(hi[1]); f[6] = (short)f2bf(hi[2]); f[7] = (short)f2bf(hi[3]);
  return f;
}
__device__ __forceinline__ void p4_rwkv_chain(const MixP& p, int h, int vs, char* ring, int lane) {
  const int r = lane & 15, g = lane >> 4, v = vs * 16 + r;
  f32x4 ST[4];
#pragma unroll
  for (int kt = 0; kt < 4; ++kt) ST[kt] = (f32x4){0.f, 0.f, 0.f, 0.f};
  chain_issue(p, 0 * 8 + h, vs, ring, lane);
  chain_issue(p, 1 * 8 + h, vs, ring + RING_SLOT, lane);
  for (int c = 0; c < NCH; ++c) {
    const int uid = c * 8 + h; char* slot = ring + (c % 3) * RING_SLOT;
    if (c + 2 < NCH) { chain_issue(p, (c + 2) * 8 + h, vs, ring + ((c + 2) % 3) * RING_SLOT, lane); asm volatile("s_waitcnt vmcnt(50)" ::: "memory"); }
    else if (c + 1 < NCH) asm volatile("s_waitcnt vmcnt(25)" ::: "memory");
    else asm volatile("s_waitcnt vmcnt(0)" ::: "memory");
    bf16x8 bS[2];
#pragma unroll
    for (int s = 0; s < 2; ++s) bS[s] = cvt_frag(ST[2 * s], ST[2 * s + 1]);
#pragma unroll
    for (int kt = 0; kt < 4; ++kt) {
      uint2 pk; pk.x = (unsigned)f2bf(ST[kt][0]) | ((unsigned)f2bf(ST[kt][1]) << 16); pk.y = (unsigned)f2bf(ST[kt][2]) | ((unsigned)f2bf(ST[kt][3]) << 16);
      *(uint2*)(p.b.rw_S0 + (long)uid * 4096 + v * 64 + 16 * kt + 4 * g) = pk;
    }
    f32x4 U[4];
#pragma unroll
    for (int tt = 0; tt < 4; ++tt) {
      U[tt] = *(const f32x4*)(slot + 16384 + tt * 1024 + lane * 16);
#pragma unroll
      for (int s = 0; s < 2; ++s) { bf16x8 a = *(const bf16x8*)(slot + (tt * 2 + s) * 1024 + lane * 16); U[tt] = __builtin_amdgcn_mfma_f32_16x16x32_bf16(a, bS[s], U[tt], 0, 0, 0); }
    }
    bf16x8 bU[2];
#pragma unroll
    for (int s = 0; s < 2; ++s) bU[s] = cvt_frag(U[2 * s], U[2 * s + 1]);
#pragma unroll
    for (int tt = 0; tt < 4; ++tt) {
      uint2 pk; pk.x = (unsigned)f2bf(U[tt][0]) | ((unsigned)f2bf(U[tt][1]) << 16); pk.y = (unsigned)f2bf(U[tt][2]) | ((unsigned)f2bf(U[tt][3]) << 16);
      *(uint2*)(p.b.rw_UT + (long)uid * 4096 + v * 64 + 16 * tt + 4 * g) = pk;
    }
#pragma unroll
    for (int kt = 0; kt < 4; ++kt) {
      const f32x4 gm = *(const f32x4*)(slot + 24576 + (16 * kt + 4 * g) * 4); const f32x4 kv = *(const f32x4*)(slot + 20480 + kt * 1024 + lane * 16);
      f32x4 a4 = ST[kt] * gm + kv;
#pragma unroll
      for (int s = 0; s < 2; ++s) { bf16x8 a = *(const bf16x8*)(slot + 8192 + (kt * 2 + s) * 1024 + lane * 16); a4 = __builtin_amdgcn_mfma_f32_16x16x32_bf16(a, bU[s], a4, 0, 0, 0); }
      ST[kt] = a4;
    }
    asm volatile("s_waitcnt lgkmcnt(0)" ::: "memory");
  }
}
__device__ __forceinline__ void p4_elem(const MixP& p, int e) {
  if (e < 32768) {
    const int h = e >> 12, vk = e & 4095; const float lg2 = log2f(1.f - exp2f(-(5.f + 4.f * (float)h / 7.f))); const float gm = exp2f(lg2 * 64.f);
    float S = 0.f;
    for (int c0 = 0; c0 < NCH; c0 += 8) {
      float kv[8];
#pragma unroll
      for (int i = 0; i < 8; ++i) kv[i] = p.b.rt_KVT[(long)((c0 + i) * 8 + h) * 4096 + vk];
#pragma unroll
      for (int i = 0; i < 8; ++i) { p.b.rt_S0[(long)((c0 + i) * 8 + h) * 4096 + vk] = f2bf(S); S = S * gm + kv[i]; }
    }
  } else {
    const int e2 = e - 32768, h = e2 >> 13, vk = e2 & 8191, k = vk & 63;
    float S = 0.f;
    for (int c0 = 0; c0 < NCH; c0 += 8) {
      float kv[8], gm[8];
#pragma unroll
      for (int i = 0; i < 8; ++i) { kv[i] = p.b.gl_KVT[(long)((c0 + i) * 4 + h) * 8192 + vk]; gm[i] = p.b.gl_gam[((c0 + i) * 4 + h) * 64 + k]; }
#pragma unroll
      for (int i = 0; i < 8; ++i) { p.b.gl_S0[(long)((c0 + i) * 4 + h) * 8192 + vk] = f2bf(S); S = S * gm[i] + kv[i]; }
    }
  }
}
__device__ __forceinline__ void p4_lru(const MixP& p, int ch) {
  float H = 0.f;
  for (int c0 = 0; c0 < NCH; c0 += 8) {
    float a[8], b[8];
#pragma unroll
    for (int i = 0; i < 8; ++i) { long o = (long)((c0 + i) * 64 + 63) * 512 + ch; a[i] = p.b.lr_A[o]; b[i] = p.b.lr_h[o]; }
#pragma unroll
    for (int i = 0; i < 8; ++i) { p.b.lr_Hp[(c0 + i) * 512 + ch] = H; H = a[i] * H + b[i]; }
  }
}

template <int NVT, bool DELTA, int NMT>
__device__ __forceinline__ void p5_mm(const u16* Rb, const u16* S0, const u16* Pak, const u16* VT, const u16* Pab, const u16* UT, int mt0, int r, int g, f32x4 (&acc)[NMT][4 * NVT]) {
#pragma unroll
  for (int mt = 0; mt < NMT; ++mt)
#pragma unroll
    for (int nt = 0; nt < 4 * NVT; ++nt) acc[mt][nt] = (f32x4){0.f, 0.f, 0.f, 0.f};
#pragma unroll 1
  for (int pr = 0; pr < (DELTA ? 3 : 2); ++pr) {
    const u16* A = pr == 0 ? Rb : (pr == 1 ? Pak : Pab); const u16* B = pr == 0 ? S0 : (pr == 1 ? VT : UT);
#pragma unroll
    for (int s = 0; s < 2; ++s) {
      bf16x8 af[NMT];
#pragma unroll
      for (int mt = 0; mt < NMT; ++mt) af[mt] = *(const bf16x8*)(A + (16 * (mt0 + mt) + r) * 64 + 32 * s + 8 * g);
#pragma unroll
      for (int nt = 0; nt < 4 * NVT; ++nt) {
        bf16x8 bfr = *(const bf16x8*)(B + (16 * nt + r) * 64 + 32 * s + 8 * g);
#pragma unroll
        for (int mt = 0; mt < NMT; ++mt) acc[mt][nt] = __builtin_amdgcn_mfma_f32_16x16x32_bf16(af[mt], bfr, acc[mt][nt], 0, 0, 0);
      }
    }
  }
}
__device__ __forceinline__ void p5_rwkv(const MixP& p, int c, int h, int lane) {
  const int r = lane & 15, g = lane >> 4; const long uo = (long)(c * 8 + h) * 4096;
  float lg[4], lb[4];
#pragma unroll
  for (int nt = 0; nt < 4; ++nt) { lg[nt] = p.rw.ln_g[h * 64 + 16 * nt + r]; lb[nt] = p.rw.ln_b[h * 64 + 16 * nt + r]; }
#pragma unroll 1
  for (int mh = 0; mh < 2; ++mh) {
    f32x4 acc[2][4];
    p5_mm<1, true, 2>(p.b.rw_Rb + uo, p.b.rw_S0 + uo, p.b.rw_Pak + uo, p.b.rw_VT + uo, p.b.rw_Pab + uo, p.b.rw_UT + uo, mh * 2, r, g, acc);
#pragma unroll
    for (int mt = 0; mt < 2; ++mt)
#pragma unroll
      for (int reg = 0; reg < 4; ++reg) {
        const int t = c * 64 + 16 * (mh * 2 + mt) + 4 * g + reg;
        float s1 = acc[mt][0][reg] + acc[mt][1][reg] + acc[mt][2][reg] + acc[mt][3][reg]; s1 = red16(s1);
        const float mean = s1 * (1.f / 64.f);
        float s2 = 0.f;
#pragma unroll
        for (int nt = 0; nt < 4; ++nt) { float d = acc[mt][nt][reg] - mean; s2 += d * d; }
        s2 = red16(s2);
        const float rs = rsqrtf(s2 * (1.f / 64.f) + 64e-5f);
#pragma unroll
        for (int nt = 0; nt < 4; ++nt) {
          const int hc = h * 64 + 16 * nt + r; const long o = (long)t * 512 + hc;
          const float yn = (acc[mt][nt][reg] - mean) * rs * lg[nt] + lb[nt];
          p.ycat[(long)t * DM + hc] = f2bf((yn + bf2f(p.b.rw_BV[o])) * bf2f(p.b.rw_G[o]));
        }
      }
  }
}
__device__ __forceinline__ void p5_ret(const MixP& p, int c, int h, int lane) {
  const int r = lane & 15, g = lane >> 4; const long uo = (long)(c * 8 + h) * 4096;
  f32x4 acc[4][4];
  p5_mm<1, false, 4>(p.b.rt_Rb + uo, p.b.rt_S0 + uo, p.b.rt_Pak + uo, p.b.rt_VT + uo, nullptr, nullptr, 0, r, g, acc);
  float ng[4];
#pragma unroll
  for (int nt = 0; nt < 4; ++nt) ng[nt] = p.ret_norm_g[h * 64 + 16 * nt + r];
#pragma unroll
  for (int mt = 0; mt < 4; ++mt)
#pragma unroll
    for (int reg = 0; reg < 4; ++reg) {
      const int t = c * 64 + 16 * mt + 4 * g + reg;
      float s2 = 0.f;
#pragma unroll
      for (int nt = 0; nt < 4; ++nt) s2 += acc[mt][nt][reg] * acc[mt][nt][reg];
      s2 = red16(s2);
      const float rs = rsqrtf(s2 * (1.f / 64.f) + 1e-6f);
#pragma unroll
      for (int nt = 0; nt < 4; ++nt) {
        const int hc = h * 64 + 16 * nt + r; const float gt = bf2f(p.proj[(long)t * PC + OFF_B + 1536 + hc]);
        p.ycat[(long)t * DM + 512 + hc] = f2bf(acc[mt][nt][reg] * rs * ng[nt] * gt * sigmoidf_(gt));
      }
    }
}
__device__ __forceinline__ void p5_gla(const MixP& p, int c, int h, int lane) {
  const int r = lane & 15, g = lane >> 4; const int uid = c * 4 + h;
  float ng[8];
#pragma unroll
  for (int nt = 0; nt < 8; ++nt) ng[nt] = p.gla_norm_g[h * 128 + 16 * nt + r];
#pragma unroll 1
  for (int mh = 0; mh < 2; ++mh) {
    f32x4 acc[2][8];
    p5_mm<2, false, 2>(p.b.gl_Rb + (long)uid * 4096, p.b.gl_S0 + (long)uid * 8192, p.b.gl_Pak + (long)uid * 4096, p.b.gl_VT + (long)uid * 8192, nullptr, nullptr, mh * 2, r, g, acc);
#pragma unroll
    for (int mt = 0; mt < 2; ++mt)
#pragma unroll
      for (int reg = 0; reg < 4; ++reg) {
        const int t = c * 64 + 16 * (mh * 2 + mt) + 4 * g + reg;
        float s2 = 0.f;
#pragma unroll
        for (int nt = 0; nt < 8; ++nt) s2 += acc[mt][nt][reg] * acc[mt][nt][reg];
        s2 = red16(s2);
        const float rs = rsqrtf(s2 * (1.f / 128.f) + 1e-6f);
#pragma unroll
        for (int nt = 0; nt < 8; ++nt) {
          const int hc = h * 128 + 16 * nt + r; const float gt = bf2f(p.proj[(long)t * PC + OFF_D + 1040 + hc]);
          p.ycat[(long)t * DM + 1536 + hc] = f2bf(acc[mt][nt][reg] * rs * ng[nt] * gt * sigmoidf_(gt));
        }
      }
  }
}
__device__ __forceinline__ void p5_lru(const MixP& p, long idx) {
  const int t = (int)(idx >> 9), ch = (int)(idx & 511), c = t >> 6;
  const float hv = p.b.lr_h[idx] + p.b.lr_A[idx] * p.b.lr_Hp[c * 512 + ch];
  p.ycat[(long)t * DM + 1024 + ch] = f2bf(hv * gelu_tanh(bf2f(p.proj[(long)t * PC + OFF_C + 512 + ch])));
}

constexpr bool RWKV_CHUNKED = RWKV_CHUNKED_FLAG;
__device__ __forceinline__ void phase_mix3(const MixP& p, char* smem) {
  for (int u = blockIdx.x; u < 3584; u += gridDim.x) {
    if (u < 1024) { if (RWKV_CHUNKED) p3_rwkv(p, u >> 3, u & 7, smem); }
    else if (u < 2048) p3_ret(p, (u - 1024) >> 3, (u - 1024) & 7, smem);
    else if (u < 2560) p3_gla(p, (u - 2048) >> 2, (u - 2048) & 3, smem);
    else p3_lru(p, (u - 2560) >> 3, (u - 2560) & 7, smem);
  }
}
__device__ __forceinline__ void phase_mix4(const MixP& p, char* smem) {
  const int b = blockIdx.x, tid = threadIdx.x;
  if (b < 32) { if (RWKV_CHUNKED && tid < 64) p4_rwkv_chain(p, b >> 2, b & 3, smem, tid); }
  else if (b >= 64 && b < 192) p4_elem(p, (b - 64) * 512 + tid);
  else if (b == 200) p4_lru(p, tid);
}
__device__ __forceinline__ void phase_mix5(const MixP& p) {
  const int wave = blockIdx.x * 8 + (threadIdx.x >> 6), nw = gridDim.x * 8, lane = threadIdx.x & 63;
  for (int u = wave; u < 2560; u += nw) {
    if (u < 512) p5_gla(p, u >> 2, u & 3, lane);
    else if (u < 1536) { if (RWKV_CHUNKED) p5_rwkv(p, (u - 512) >> 3, (u - 512) & 7, lane); }
    else p5_ret(p, (u - 1536) >> 3, (u - 1536) & 7, lane);
  }
  for (long idx = (long)blockIdx.x * 512 + threadIdx.x; idx < (long)T_ * 512; idx += (long)gridDim.x * 512) p5_lru(p, idx);
}
template <int PH>
__global__ __launch_bounds__(512, 2) void k_mix(MixP p) {
  extern __shared__ __attribute__((aligned(16))) char smem_mix[];
  if (PH == 3) phase_mix3(p, smem_mix); else if (PH == 4) phase_mix4(p, smem_mix); else phase_mix5(p);
}
__global__ __launch_bounds__(512) void k_rwkv_prep(const u16* __restrict__ proj, RwkvP p, float* R, float* W, float* Kp, float* V, float* KK, float* AB, float* G, float* BS) {
  __shared__ float z[1696]; __shared__ float tw[32]; __shared__ float sg[96];
  const int t = blockIdx.x, c = threadIdx.x;
  for (int i = c; i < 1696; i += 512) {
    float cur = bf2f(proj[(long)t * PC + i]); float prev = t > 0 ? bf2f(proj[(long)(t - 1) * PC + i]) : 0.f;
    z[i] = cur + (prev - cur) * p.mu[i];
  }
  __syncthreads();
  if (c < 32) tw[c] = tanhf(z[1536 + c]);
  if (c >= 64 && c < 160) sg[c - 64] = sigmoidf_(z[1600 + c - 64]);
  __syncthreads();
  float wv = p.w0[c], av = p.a0[c], gv = 0.f;
  for (int j = 0; j < 32; ++j) { wv += tw[j] * p.w_up[j * 512 + c]; av += z[1568 + j] * p.a_up[j * 512 + c]; }
  for (int j = 0; j < 96; ++j) gv += sg[j] * p.g_up[j * 512 + c];
  const float w = __expf(-0.6065306597126334f * sigmoidf_(wv)), av2 = sigmoidf_(av);
  const float r = z[c], k = z[512 + c], v = z[1024 + c];
  float kk = k * p.k_k[c]; float ss = wave_sum(kk * kk); kk = kk / fmaxf(sqrtf(ss), 1e-12f);
  const float kp = k * (1.f + (av2 - 1.f) * p.k_a[c]);
  const float bs = wave_sum(r * kp * p.r_k[c]);
  const long o = (long)t * 512 + c;
  R[o] = r; W[o] = w; Kp[o] = kp; V[o] = v; KK[o] = kk; AB[o] = kk * av2; G[o] = gv;
  if ((c & 63) == 0) BS[t * 8 + (c >> 6)] = bs;
}
__global__ __launch_bounds__(64) void k_rwkv_scan(const float* R, const float* W, const float* Kp, const float* V, const float* KK, const float* AB, const float* G, const float* BS,
                                                  const float* ln_g, const float* ln_b, u16* ycat) {
  __shared__ float sR[16][64], sW[16][64], sK[16][64], sKK[16][64], sAB[16][64];
  const int h = blockIdx.x, l = threadIdx.x, c = h * 64 + l;
  float S[64];
#pragma unroll
  for (int k = 0; k < 64; ++k) S[k] = 0.f;
  const float lg = ln_g[c], lb = ln_b[c];
  for (int t0 = 0; t0 < T_; t0 += 16) {
    __syncthreads();
    for (int i = 0; i < 16; ++i) { long o = (long)(t0 + i) * 512 + c; sR[i][l] = R[o]; sW[i][l] = W[o]; sK[i][l] = Kp[o]; sKK[i][l] = KK[o]; sAB[i][l] = AB[o]; }
    __syncthreads();
#pragma unroll 1
    for (int i = 0; i < 16; ++i) {
      const long o = (long)(t0 + i) * 512 + c;
      const float vt = V[o];
      float sa = 0.f;
#pragma unroll
      for (int k = 0; k < 64; ++k) sa -= S[k] * sKK[i][k];
#pragma unroll
      for (int k = 0; k < 64; ++k) S[k] = S[k] * sW[i][k] + sa * sAB[i][k] + vt * sK[i][k];
      float y = 0.f;
#pragma unroll
      for (int k = 0; k < 64; ++k) y += S[k] * sR[i][k];
      const float mean = wave_sum(y) * (1.f / 64.f); const float d = y - mean; const float var = wave_sum(d * d) * (1.f / 64.f);
      const float yn = d * rsqrtf(var + 64e-5f) * lg + lb;
      ycat[(long)(t0 + i) * DM + c] = f2bf((yn + BS[(t0 + i) * 8 + h] * vt) * G[o]);
    }
  }
}

__global__ __launch_bounds__(512) void k_ret_prep(const u16* __restrict__ proj, const int* __restrict__ pos, float* Q, float* Kr) {
  const int t = blockIdx.x, c = threadIdx.x, h = c >> 6, d = c & 63, j = d & 31;
  const float inv = exp2f(-(float)j * (13.287712379549449f / 32.f));
  const float ang = (float)pos[t] * inv; float sn, cs; sincosf(ang, &sn, &cs);
  const u16* row = proj + (long)t * PC + OFF_B;
  const float q1 = bf2f(row[h * 64 + j]), q2 = bf2f(row[h * 64 + 32 + j]);
  const float k1 = bf2f(row[512 + h * 64 + j]), k2 = bf2f(row[512 + h * 64 + 32 + j]);
  float qo, ko;
  if (d < 32) { qo = q1 * cs - q2 * sn; ko = k1 * cs - k2 * sn; } else { qo = q2 * cs + q1 * sn; ko = k2 * cs + k1 * sn; }
  Q[(long)t * 512 + c] = qo; Kr[(long)t * 512 + c] = ko * 0.125f;
}
__global__ __launch_bounds__(64) void k_ret_scan(const u16* __restrict__ proj, const float* Q, const float* Kr, const float* norm_g, u16* ycat) {
  __shared__ float sQ[16][64], sK[16][64];
  const int h = blockIdx.x, l = threadIdx.x, c = h * 64 + l;
  const float gdec = 1.f - exp2f(-(5.f + 4.f * (float)h / 7.f));
  float S[64];
#pragma unroll
  for (int k = 0; k < 64; ++k) S[k] = 0.f;
  const float ng = norm_g[c];
  for (int t0 = 0; t0 < T_; t0 += 16) {
    __syncthreads();
    for (int i = 0; i < 16; ++i) { long o = (long)(t0 + i) * 512 + c; sQ[i][l] = Q[o]; sK[i][l] = Kr[o]; }
    __syncthreads();
#pragma unroll 1
    for (int i = 0; i < 16; ++i) {
      const u16* row = proj + (long)(t0 + i) * PC + OFF_B;
      const float vt = bf2f(row[1024 + c]), gt = bf2f(row[1536 + c]);
      float o = 0.f;
#pragma unroll
      for (int d = 0; d < 64; ++d) { S[d] = gdec * S[d] + sK[i][d] * vt; o += sQ[i][d] * S[d]; }
      const float ms = wave_sum(o * o) * (1.f / 64.f);
      const float on = o * rsqrtf(ms + 1e-6f) * ng;
      ycat[(long)(t0 + i) * DM + 512 + c] = f2bf(on * gt * sigmoidf_(gt));
    }
  }
}

__global__ __launch_bounds__(256) void k_gla_prep(const u16* __restrict__ proj, const float* alpha_up, const float* alpha_b, float* GA) {
  const int t = blockIdx.x, c = threadIdx.x;
  const u16* row = proj + (long)t * PC + OFF_D + 1024;
  float x = alpha_b[c];
  for (int j = 0; j < 16; ++j) x += bf2f(row[j]) * alpha_up[j * 256 + c];
  const float ls = x >= 0.f ? -log1pf(__expf(-x)) : x - log1pf(__expf(x));
  GA[(long)t * 256 + c] = __expf(ls * (1.f / 16.f));
}
__global__ __launch_bounds__(128) void k_gla_scan(const u16* __restrict__ proj, const float* GA, const float* norm_g, u16* ycat) {
  __shared__ float sQ[16][64], sK[16][64], sA[16][64]; __shared__ float red[2];
  const int h = blockIdx.x, e = threadIdx.x, c = h * 128 + e;
  float S[64];
#pragma unroll
  for (int k = 0; k < 64; ++k) S[k] = 0.f;
  const float ng = norm_g[c];
  for (int t0 = 0; t0 < T_; t0 += 16) {
    __syncthreads();
    for (int i = e; i < 16 * 64; i += 128) { int ti = i >> 6, d = i & 63; const u16* row = proj + (long)(t0 + ti) * PC + OFF_D;
      sQ[ti][d] = bf2f(row[h * 64 + d]) * 0.125f; sK[ti][d] = bf2f(row[256 + h * 64 + d]); sA[ti][d] = GA[(long)(t0 + ti) * 256 + h * 64 + d]; }
    __syncthreads();
#pragma unroll 1
    for (int i = 0; i < 16; ++i) {
      const u16* row = proj + (long)(t0 + i) * PC + OFF_D;
      const float vt = bf2f(row[512 + c]), gt = bf2f(row[1040 + c]);
      float o = 0.f;
#pragma unroll
      for (int d = 0; d < 64; ++d) { S[d] = sA[i][d] * S[d] + sK[i][d] * vt; o += sQ[i][d] * S[d]; }
      const float part = wave_sum(o * o);
      if ((e & 63) == 0) red[e >> 6] = part;
      __syncthreads();
      const float ms = (red[0] + red[1]) * (1.f / 128.f);
      __syncthreads();
      const float on = o * rsqrtf(ms + 1e-6f) * ng;
      ycat[(long)(t0 + i) * DM + 1536 + c] = f2bf(on * gt * sigmoidf_(gt));
    }
  }
}

__global__ __launch_bounds__(512) void k_lru_prep(const u16* __restrict__ proj, const int* __restrict__ pos, LruP p, float* LA, float* LB) {
  __shared__ float sx[512];
  const int t = blockIdx.x, c = threadIdx.x;
  float xc = p.conv_b[c];
  for (int j = 0; j < 4; ++j) { int tt = t - 3 + j; if (tt >= 0) xc += p.conv_w[j * 512 + c] * bf2f(proj[(long)tt * PC + OFF_C + c]); }
  sx[c] = xc;
  __syncthreads();
  const int g = c >> 6, jj = c & 63;
  float ra = p.b_a[c], ix = p.b_x[c];
  for (int i = 0; i < 64; ++i) { float xv = sx[g * 64 + i]; ra += xv * p.w_a[(g * 64 + i) * 64 + jj]; ix += xv * p.w_x[(g * 64 + i) * 64 + jj]; }
  const float r = sigmoidf_(ra), ig = sigmoidf_(ix);
  const float lam = p.lam[c];
  const float sp = (-lam) > 20.f ? (-lam) : log1pf(__expf(-lam));
  const float log_a = -8.f * r * sp;
  const bool reset = pos[t] == 0;
  const float av = reset ? 0.f : __expf(log_a);
  const float mult = reset ? 1.f : sqrtf(-expm1f(2.f * log_a));
  LA[(long)t * 512 + c] = av; LB[(long)t * 512 + c] = mult * ig * xc;
}
__global__ __launch_bounds__(64) void k_lru_scan(const u16* __restrict__ proj, const float* LA, const float* LB, u16* ycat) {
  const int c = blockIdx.x * 64 + threadIdx.x;
  float hs = 0.f;
  for (int t0 = 0; t0 < T_; t0 += 8) {
    float la[8], lb[8], gb[8];
#pragma unroll
    for (int i = 0; i < 8; ++i) { la[i] = LA[(long)(t0 + i) * 512 + c]; lb[i] = LB[(long)(t0 + i) * 512 + c]; gb[i] = bf2f(proj[(long)(t0 + i) * PC + OFF_C + 512 + c]); }
#pragma unroll
    for (int i = 0; i < 8; ++i) { hs = la[i] * hs + lb[i]; ycat[(long)(t0 + i) * DM + 1024 + c] = f2bf(hs * gelu_tanh(gb[i])); }
  }
}

__global__ __launch_bounds__(1024) void k_moe_route(const int* __restrict__ tok_e, const float* __restrict__ tok_g, int* row_tok, int* row_slot, float* row_gate, int* tile_exp, int* nrt) {
  __shared__ int cnt[32], pstart[32], fill[32];
  const int tid = threadIdx.x;
  if (tid < 32) { cnt[tid] = 0; fill[tid] = 0; }
  __syncthreads();
  for (int i = tid; i < 2 * T_; i += 1024) atomicAdd(&cnt[tok_e[i]], 1);
  __syncthreads();
  if (tid == 0) {
    int acc = 0, rt = 0;
    for (int e = 0; e < 32; ++e) { pstart[e] = acc; int nt = (cnt[e] + 255) / 256; for (int j = 0; j < nt; ++j) tile_exp[rt++] = e; acc += nt * 256; }
    nrt[0] = rt;
  }
  for (int i = tid; i < MAXROWS; i += 1024) { row_tok[i] = -1; row_slot[i] = -1; row_gate[i] = 0.f; }
  __syncthreads();
  for (int i = tid; i < 2 * T_; i += 1024) {
    int e = tok_e[i]; int pos = atomicAdd(&fill[e], 1); int dest = pstart[e] + pos;
    row_tok[dest] = i >> 1; row_slot[dest] = i; row_gate[dest] = tok_g[i];
  }
}
__global__ __launch_bounds__(256) void k_gather(const u16* __restrict__ hn, const int* __restrict__ row_tok, const int* __restrict__ nrt, u16* xg) {
  const int row = blockIdx.x * 4 + (threadIdx.x >> 6), lane = threadIdx.x & 63;
  if (row >= nrt[0] * 256) return;
  const int tok = row_tok[row];
#pragma unroll
  for (int i = 0; i < 4; ++i) {
    uint4 v = make_uint4(0, 0, 0, 0);
    if (tok >= 0) v = *(const uint4*)(hn + (long)tok * DM + i * 512 + lane * 8);
    *(uint4*)(xg + (long)row * DM + i * 512 + lane * 8) = v;
  }
}

static inline size_t al256(size_t x) { return (x + 255) & ~(size_t)255; }

extern "C" void kernel_launch(void* const* d_in, const int* in_sizes, int n_in, void* d_out, int out_size, void* d_ws, size_t ws_size, hipStream_t stream) {
  (void)in_sizes; (void)n_in; (void)out_size; (void)ws_size;
  const float* x = (const float*)d_in[0]; const int* pos = (const int*)d_in[1];
#define FIN(i) ((const float*)d_in[i])
  char* ws = (char*)d_ws; size_t off = 0;
  auto take = [&](size_t bytes) { char* p = ws + off; off += al256(bytes); return p; };
  take(65536);
  u16* Wt_in = (u16*)take((size_t)NL * PC * DM * 2);
  u16* Wt_o = (u16*)take((size_t)NL * 4 * DM * MIXW * 2);
  u16* Wt_out = (u16*)take((size_t)NL * DM * DM * 2);
  u16* Wgu = (u16*)take((size_t)NL * NEXP * 2048 * DM * 2);
  u16* Wdn = (u16*)take((size_t)NL * NEXP * DM * DEXP * 2);
  float* h = (float*)take((size_t)T_ * DM * 4);
  u16* xn = (u16*)take((size_t)T_ * DM * 2);
  u16* proj = (u16*)take((size_t)T_ * PC * 2);
  u16* ycat = (u16*)take((size_t)T_ * DM * 2);
  float* mbuf = (float*)take((size_t)T_ * DM * 4);
  u16* merged = (u16*)take((size_t)T_ * DM * 2);
  int* tok_e = (int*)take((size_t)2 * T_ * 4); float* tok_g = (float*)take((size_t)2 * T_ * 4);
  int* row_tok = (int*)take((size_t)MAXROWS * 4); int* row_slot = (int*)take((size_t)MAXROWS * 4); float* row_gate = (float*)take((size_t)MAXROWS * 4);
  int* tile_exp = (int*)take(1024); int* nrt = (int*)take(256);
  char* moe0 = ws + off;
  u16* xg = (u16*)take((size_t)MAXROWS * DM * 2);
  u16* hmid = (u16*)take((size_t)MAXROWS * DEXP * 2);
  float* ybuf = (float*)take((size_t)2 * T_ * DM * 4);
  float* sc = (float*)moe0; const size_t SA = (size_t)T_ * 512;
  float *sR = sc, *sW = sc + SA, *sKp = sc + 2 * SA, *sV = sc + 3 * SA, *sKK = sc + 4 * SA, *sAB = sc + 5 * SA, *sG = sc + 6 * SA, *sBS = sc + 7 * SA;
  float *sQ = sc + 8 * SA, *sKr = sc + 9 * SA, *sGA = sc + 10 * SA, *sLA = sc + 11 * SA, *sLB = sc + 12 * SA;

  MixBuf mb{};
  { const size_t U8 = (size_t)1024 * 4096 * 2;
    mb.rw_Rb = (u16*)take(U8); mb.rw_Pab = (u16*)take(U8); mb.rw_Pak = (u16*)take(U8); mb.rw_VT = (u16*)take(U8); mb.rw_S0 = (u16*)take(U8); mb.rw_UT = (u16*)take(U8);
    mb.rw_WpF = (u16*)take(U8); mb.rw_BtF = (u16*)take(U8); mb.rw_G = (u16*)take((size_t)T_ * 512 * 2); mb.rw_BV = (u16*)take((size_t)T_ * 512 * 2);
    mb.rw_U0F = (float*)take(2 * U8); mb.rw_KVF = (float*)take(2 * U8); mb.rw_gam = (float*)take((size_t)1024 * 64 * 4);
    mb.rt_Rb = (u16*)take(U8); mb.rt_Pak = (u16*)take(U8); mb.rt_VT = (u16*)take(U8); mb.rt_S0 = (u16*)take(U8); mb.rt_KVT = (float*)take(2 * U8);
    mb.gl_Rb = (u16*)take(U8 / 2); mb.gl_Pak = (u16*)take(U8 / 2); mb.gl_VT = (u16*)take(U8); mb.gl_S0 = (u16*)take(U8); mb.gl_KVT = (float*)take(2 * U8); mb.gl_gam = (float*)take((size_t)512 * 64 * 4);
    mb.lr_h = (float*)take((size_t)T_ * 512 * 4); mb.lr_A = (float*)take((size_t)T_ * 512 * 4); mb.lr_Hp = (float*)take((size_t)NCH * 512 * 4); }
  static bool attr = false;
  if (!attr) {
    (void)hipFuncSetAttribute((const void*)k_gemm<0>, hipFuncAttributeMaxDynamicSharedMemorySize, SHM_B);
    (void)hipFuncSetAttribute((const void*)k_gemm<1>, hipFuncAttributeMaxDynamicSharedMemorySize, SHM_B);
    (void)hipFuncSetAttribute((const void*)k_gemm<2>, hipFuncAttributeMaxDynamicSharedMemorySize, SHM_B);
    (void)hipFuncSetAttribute((const void*)k_gemm<3>, hipFuncAttributeMaxDynamicSharedMemorySize, SHM_B);
    (void)hipFuncSetAttribute((const void*)k_gemm<4>, hipFuncAttributeMaxDynamicSharedMemorySize, SHM_B);
    (void)hipFuncSetAttribute((const void*)k_mix<3>, hipFuncAttributeMaxDynamicSharedMemorySize, SHM_B);
    (void)hipFuncSetAttribute((const void*)k_mix<4>, hipFuncAttributeMaxDynamicSharedMemorySize, SHM_B);
    (void)hipFuncSetAttribute((const void*)k_mix<5>, hipFuncAttributeMaxDynamicSharedMemorySize, SHM_B);
    attr = true;
  }
  k_transpose<<<dim3(PC / 64, DM / 64, NL), 256, 0, stream>>>(FIN(3), Wt_in, DM, IN_COLS, (long)DM * IN_COLS, (long)PC * DM, 0);
  const int woi[4] = {15, 17, 25, 29};
  for (int k = 0; k < 4; ++k)
    for (int l = 0; l < NL; ++l)
      k_transpose<<<dim3(DM / 64, MIXW / 64, 1), 256, 0, stream>>>(FIN(woi[k]) + (long)l * MIXW * DM, Wt_o + ((long)l * 4 + k) * DM * MIXW, MIXW, DM, 0, 0, 0);
  k_transpose<<<dim3(DM / 64, DM / 64, NL), 256, 0, stream>>>(FIN(30), Wt_out, DM, DM, (long)DM * DM, (long)DM * DM, 0);
  k_transpose<<<dim3(DEXP / 64, DM / 64, NL * NEXP), 256, 0, stream>>>(FIN(36), Wgu, DM, DEXP, (long)DM * DEXP, (long)2048 * DM, 1);
  k_transpose<<<dim3(DEXP / 64, DM / 64, NL * NEXP), 256, 0, stream>>>(FIN(37), Wgu, DM, DEXP, (long)DM * DEXP, (long)2048 * DM, 2);
  k_transpose<<<dim3(DM / 64, DEXP / 64, NL * NEXP), 256, 0, stream>>>(FIN(38), Wdn, DEXP, DM, (long)DEXP * DM, (long)DM * DEXP, 0);

  for (int l = 0; l < NL; ++l) {
    NormArgs na{}; na.x = x; na.h = h; na.g = FIN(2) + (long)l * DM; na.xn = xn; na.out = (float*)d_out; na.ybuf = ybuf;
    if (l == 0) k_norm<0><<<T_ / 4, 256, 0, stream>>>(na); else k_norm<1><<<T_ / 4, 256, 0, stream>>>(na);
    GemmArgs ga{}; ga.proj = proj; ga.mbuf = mbuf; ga.merged = merged; ga.h = h; ga.hmid = hmid; ga.ybuf = ybuf; ga.row_slot = row_slot; ga.row_gate = row_gate; ga.tile_exp = tile_exp; ga.nrt = nrt;
    ga.A = xn; ga.Bt = Wt_in + (long)l * PC * DM;
    k_gemm<0><<<256, 512, SHM_B, stream>>>(ga);
    RwkvP rp{FIN(4) + l * 1696, FIN(5) + l * 512, FIN(6) + l * 32 * 512, FIN(7) + l * 512, FIN(8) + l * 32 * 512, FIN(9) + l * 96 * 512, FIN(10) + l * 512, FIN(11) + l * 512, FIN(12) + l * 512, FIN(13) + l * 512, FIN(14) + l * 512};
    LruP lp{FIN(18) + l * 4 * 512, FIN(19) + l * 512, FIN(20) + l * 8 * 64 * 64, FIN(21) + l * 512, FIN(22) + l * 8 * 64 * 64, FIN(23) + l * 512, FIN(24) + l * 512};
    if (!RWKV_CHUNKED) {
      k_rwkv_prep<<<T_, 512, 0, stream>>>(proj, rp, sR, sW, sKp, sV, sKK, sAB, sG, sBS);
      k_rwkv_scan<<<8, 64, 0, stream>>>(sR, sW, sKp, sV, sKK, sAB, sG, sBS, rp.ln_g, rp.ln_b, ycat);
    }
    MixP mp{}; mp.proj = proj; mp.pos = pos; mp.ycat = ycat; mp.b = mb; mp.rw = rp; mp.ret_norm_g = FIN(16) + l * 512; mp.lru = lp;
    mp.gla_alpha_up = FIN(26) + l * 16 * 256; mp.gla_alpha_b = FIN(27) + l * 256; mp.gla_norm_g = FIN(28) + l * 512;
    k_mix<3><<<256, 512, SHM_B, stream>>>(mp);
    k_mix<4><<<256, 512, SHM_B, stream>>>(mp);
    k_mix<5><<<256, 512, SHM_B, stream>>>(mp);
    ga.A = ycat; ga.Bt = Wt_o + (long)l * 4 * DM * MIXW;
    for (int kb = 0; kb < 4; ++kb) { ga.kb = kb; k_gemm<1><<<256, 512, SHM_B, stream>>>(ga); }
    ga.kb = 0; ga.A = merged; ga.Bt = Wt_out + (long)l * DM * DM;
    k_gemm<2><<<256, 512, SHM_B, stream>>>(ga);
    NormArgs nf{}; nf.h = h; nf.g = FIN(31) + (long)l * DM; nf.xn = xn; nf.wg = FIN(32) + (long)l * DM * 4; nf.bg = FIN(33) + l * 4; nf.we = FIN(34) + (long)l * DM * 32; nf.be = FIN(35) + l * 32;
    nf.tok_e = tok_e; nf.tok_g = tok_g;
    k_norm<3><<<T_ / 4, 256, 0, stream>>>(nf);
    k_moe_route<<<1, 1024, 0, stream>>>(tok_e, tok_g, row_tok, row_slot, row_gate, tile_exp, nrt);
    k_gather<<<MAXROWS / 4, 256, 0, stream>>>(xn, row_tok, nrt, xg);
    ga.A = xg; ga.Bt = Wgu + (long)l * NEXP * 2048 * DM;
    k_gemm<3><<<256, 512, SHM_B, stream>>>(ga);
    ga.A = hmid; ga.Bt = Wdn + (long)l * NEXP * DM * DEXP;
    k_gemm<4><<<256, 512, SHM_B, stream>>>(ga);
  }
  NormArgs nz{}; nz.h = h; nz.g = FIN(39); nz.out = (float*)d_out; nz.ybuf = ybuf;
  k_norm<2><<<T_ / 4, 256, 0, stream>>>(nz);
}
```

```cpp
#define RWKV_CHUNKED_FLAG true
#define MK_SPLIT 0
#include <hip/hip_runtime.h>
#include <stdint.h>

typedef unsigned short u16;
typedef __attribute__((ext_vector_type(8))) short bf16x8;
typedef __attribute__((ext_vector_type(4))) float f32x4;

constexpr int T_ = 8192, DM = 2048, NL = 2, MIXW = 512;
constexpr int IN_COLS = 14512, PC = 14592;
constexpr int OFF_A = 0, OFF_B = 1696, OFF_C = 3744, OFF_D = 4768, OFF_G = 6400, NONGATE = 6320;
constexpr int NEXP = 32, DEXP = 1024;
constexpr int MAXROWS = 24576, MAXRT = 96;

__device__ __forceinline__ u16 f2bf(float f) { unsigned u = __float_as_uint(f); u += 0x7fffu + ((u >> 16) & 1u); return (u16)(u >> 16); }
__device__ __forceinline__ float bf2f(u16 h) { return __uint_as_float(((unsigned)h) << 16); }
__device__ __forceinline__ float sigmoidf_(float x) { return 1.f / (1.f + __expf(-x)); }
__device__ __forceinline__ float wave_sum(float v) {
#pragma unroll
  for (int o = 32; o > 0; o >>= 1) v += __shfl_xor(v, o, 64);
  return v;
}

constexpr int BKK = 64, HALF = 128, HT = HALF * BKK, SHM_B = 8 * HT * 2;
__device__ __forceinline__ int lds_byte(int r, int c) {
  int st = (r >> 4) * 2 + (c >> 5), rr = r & 15, cc = c & 31, ob = rr * 64 + cc * 2;
  return st * 1024 + (ob ^ (((ob >> 9) & 1) << 5));
}
__device__ __forceinline__ void stage_rc(int b, int& R, int& C) {
  int st = b / 1024, sb = b % 1024, swz = sb ^ (((sb >> 9) & 1) << 5);
  R = (st >> 1) * 16 + swz / 64; C = (st & 1) * 32 + (swz % 64) / 2;
}

template <class Epi>
__device__ __forceinline__ void gemm256(const u16* __restrict__ A, int lda, const u16* __restrict__ Bt, int ldb, int K, u16* shm, const Epi& epi) {
#define SA(b, h) (shm + ((b) * 2 + (h)) * HT)
#define SB(b, h) (shm + (4 + (b) * 2 + (h)) * HT)
#define STAGE_X(TT, P, BASE, LD, br, kt) do { const u16* _g = (BASE) + (long)(br) * (LD) + (long)(kt) * BKK; \
    _Pragma("unroll") for (int _i = 0; _i < 2; ++_i) { int _b = (TT) * 16 + _i * 8192; int _r, _c; stage_rc(_b, _r, _c); \
      __builtin_amdgcn_global_load_lds((const unsigned*)(_g + (long)_r * (LD) + _c), (unsigned*)((char*)(P) + _b), 16, 0, 0); } } while (0)
#define STAGE_A(P, br, kt) STAGE_X(tid0, P, A, lda, br, kt)
#define STAGE_B(P, br, kt) STAGE_X(tid0, P, Bt, ldb, br, kt)
#define LDA(dst, b, h) _Pragma("unroll") for (int m = 0; m < 4; ++m) _Pragma("unroll") for (int k = 0; k < 2; ++k) \
    dst[m][k] = *reinterpret_cast<const bf16x8*>((char*)SA(b, h) + lds_byte(wr * 64 + m * 16 + fr, k * 32 + fq * 8))
#define LDB(dst, b, h) _Pragma("unroll") for (int n = 0; n < 2; ++n) _Pragma("unroll") for (int k = 0; k < 2; ++k) \
    dst[n][k] = *reinterpret_cast<const bf16x8*>((char*)SB(b, h) + lds_byte(wc * 32 + n * 16 + fr, k * 32 + fq * 8))
#define MMA(ai, bj, At, Bx) do { __builtin_amdgcn_s_setprio(1); \
    _Pragma("unroll") for (int m = 0; m < 4; ++m) _Pragma("unroll") for (int n = 0; n < 2; ++n) _Pragma("unroll") for (int k = 0; k < 2; ++k) \
      acc[ai][bj][m][n] = __builtin_amdgcn_mfma_f32_16x16x32_bf16(At[m][k], Bx[n][k], acc[ai][bj][m][n], 0, 0, 0); \
    __builtin_amdgcn_s_setprio(0); } while (0)
#define WAIT_V(n) asm volatile("s_waitcnt vmcnt(" #n ")" ::: "memory")
#define WAIT_L(n) asm volatile("s_waitcnt lgkmcnt(" #n ")" ::: "memory")
#define BAR __builtin_amdgcn_s_barrier()
#define SCHED __builtin_amdgcn_sched_barrier(0)
  int tid0 = threadIdx.x; asm volatile("" : "+v"(tid0));
  int wid = tid0 >> 6, lane = tid0 & 63, wr = wid >> 2, wc = wid & 3, fr = lane & 15, fq = lane >> 4;
  f32x4 acc[2][2][4][2] = {};
  bf16x8 At[4][2], B0[2][2], B1[2][2];
  const int nt = K / BKK;
  STAGE_B(SB(0, 0), 0, 0); STAGE_A(SA(0, 0), 0, 0);
  STAGE_B(SB(0, 1), HALF, 0); STAGE_A(SA(0, 1), HALF, 0);
  if (wr == 1) BAR;
  WAIT_V(4); BAR;
  STAGE_B(SB(1, 0), 0, 1); STAGE_A(SA(1, 0), 0, 1); STAGE_B(SB(1, 1), HALF, 1);
  WAIT_V(6); BAR;
  for (int t = 0; t < nt - 2; t += 2) {
    LDB(B0, 0, 0); SCHED; LDA(At, 0, 0); STAGE_A(SA(1, 1), HALF, t + 1);
    WAIT_L(8); BAR; WAIT_L(0); MMA(0, 0, At, B0); BAR; SCHED;
    LDB(B1, 0, 1); STAGE_B(SB(0, 0), 0, t + 2);
    BAR; WAIT_L(0); MMA(0, 1, At, B1); BAR;
    LDA(At, 0, 1); STAGE_A(SA(0, 0), 0, t + 2);
    BAR; WAIT_L(0); MMA(1, 0, At, B0); BAR; SCHED;
    STAGE_B(SB(0, 1), HALF, t + 2);
    WAIT_V(6); BAR; MMA(1, 1, At, B1); BAR;
    LDB(B0, 1, 0); SCHED; LDA(At, 1, 0); STAGE_A(SA(0, 1), HALF, t + 2);
    WAIT_L(8); BAR; WAIT_L(0); MMA(0, 0, At, B0); BAR; SCHED;
    LDB(B1, 1, 1); STAGE_B(SB(1, 0), 0, t + 3);
    BAR; WAIT_L(0); MMA(0, 1, At, B1); BAR;
    LDA(At, 1, 1); STAGE_A(SA(1, 0), 0, t + 3);
    BAR; WAIT_L(0); MMA(1, 0, At, B0); BAR; SCHED;
    STAGE_B(SB(1, 1), HALF, t + 3);
    WAIT_V(6); BAR; MMA(1, 1, At, B1); BAR;
  }
  int tz = threadIdx.x; asm volatile("" : "+v"(tz)); wid = tz >> 6; lane = tz & 63; wr = wid >> 2; wc = wid & 3; fr = lane & 15; fq = lane >> 4;
  { LDB(B0, 0, 0); WAIT_V(0); LDA(At, 0, 0); STAGE_X(tz, SA(1, 1), A, lda, HALF, nt - 1);
    BAR; WAIT_L(0); MMA(0, 0, At, B0); BAR;
    LDB(B1, 0, 1); BAR; WAIT_L(0); MMA(0, 1, At, B1); BAR;
    LDA(At, 0, 1); WAIT_V(4); BAR; WAIT_L(0); MMA(1, 0, At, B0); MMA(1, 1, At, B1); BAR; }
  { LDB(B0, 1, 0); LDA(At, 1, 0); WAIT_V(2); BAR; WAIT_L(0); MMA(0, 0, At, B0); BAR;
    LDB(B1, 1, 1); WAIT_V(0); BAR; WAIT_L(0); MMA(0, 1, At, B1); BAR;
    LDA(At, 1, 1); BAR; WAIT_L(0); MMA(1, 0, At, B0); MMA(1, 1, At, B1); BAR; }
  if (wr == 0) BAR;
  epi(acc, wr, wc, fr, fq);
  __syncthreads();
#undef SA
#undef SB
}

#define UNR _Pragma("unroll")
#define EPI_LOOP UNR for (int ai = 0; ai < 2; ++ai) UNR for (int bj = 0; bj < 2; ++bj) UNR for (int m = 0; m < 4; ++m) UNR for (int n = 0; n < 2; ++n) UNR for (int j = 0; j < 4; ++j)
#define EPI_ROW (ai * HALF + wr * 64 + m * 16 + fq * 4 + j)
#define EPI_COL (bj * HALF + wc * 32 + n * 16 + fr)

struct EpiProj {
  u16* proj; int brow, bcol;
  __device__ __forceinline__ void operator()(const f32x4 (&acc)[2][2][4][2], int wr, int wc, int fr, int fq) const {
    u16* base = proj + (long)(brow + wr * 64 + fq * 4) * PC + bcol + wc * 32 + fr;
    if (bcol >= OFF_G) {
      EPI_LOOP { base[(long)(ai * HALF + m * 16 + j) * PC + bj * HALF + n * 16] = f2bf(sigmoidf_(acc[ai][bj][m][n][j])); }
    } else {
      EPI_LOOP { base[(long)(ai * HALF + m * 16 + j) * PC + bj * HALF + n * 16] = f2bf(acc[ai][bj][m][n][j]); }
    }
  }
};
struct EpiMerge {
  const u16* proj; float* mbuf; u16* merged; int kb, brow, bcol;
  __device__ __forceinline__ void operator()(const f32x4 (&acc)[2][2][4][2], int wr, int wc, int fr, int fq) const {
    EPI_LOOP { int row = brow + EPI_ROW, col = bcol + EPI_COL; long idx = (long)row * DM + col;
      float g = bf2f(proj[(long)row * PC + OFF_G + kb * DM + col]); float v = g * acc[ai][bj][m][n][j];
      if (kb > 0) v += mbuf[idx];
      if (kb < 3) mbuf[idx] = v; else merged[idx] = f2bf(v); }
  }
};
struct EpiResid {
  float* h; int brow, bcol;
  __device__ __forceinline__ void operator()(const f32x4 (&acc)[2][2][4][2], int wr, int wc, int fr, int fq) const {
    EPI_LOOP { int row = brow + EPI_ROW, col = bcol + EPI_COL; long idx = (long)row * DM + col; h[idx] += acc[ai][bj][m][n][j]; }
  }
};
struct EpiGateUp {
  u16* hmid; int brow, ct;
  __device__ __forceinline__ void operator()(const f32x4 (&acc)[2][2][4][2], int wr, int wc, int fr, int fq) const {
    u16* base = hmid + (long)(brow + wr * 64 + fq * 4) * DEXP + ct * 128 + wc * 32 + fr;
    UNR for (int ai = 0; ai < 2; ++ai) UNR for (int m = 0; m < 4; ++m) {
      UNR for (int n = 0; n < 2; ++n) UNR for (int j = 0; j < 4; ++j) {
        float g = acc[ai][0][m][n][j], u = acc[ai][1][m][n][j];
        base[(long)(ai * HALF + m * 16 + j) * DEXP + n * 16] = f2bf(g * sigmoidf_(g) * u); }
      asm volatile("" ::: "memory"); }
  }
};
struct EpiDown {
  float* ybuf; const int* row_slot; const float* row_gate; int brow, bcol;
  __device__ __forceinline__ void operator()(const f32x4 (&acc)[2][2][4][2], int wr, int wc, int fr, int fq) const {
    UNR for (int ai = 0; ai < 2; ++ai) UNR for (int m = 0; m < 4; ++m) UNR for (int j = 0; j < 4; ++j) {
      int row = brow + ai * HALF + wr * 64 + m * 16 + fq * 4 + j; int slot = row_slot[row]; float gt = row_gate[row];
      if (slot >= 0) UNR for (int bj = 0; bj < 2; ++bj) UNR for (int n = 0; n < 2; ++n) { int col = bcol + EPI_COL; ybuf[(long)slot * DM + col] = gt * acc[ai][bj][m][n][j]; } }
  }
};

__device__ __forceinline__ void unit_map(int b, int round, int& pm, int& pn) {
  int xcd = b & 7, i = b >> 3, pr = xcd >> 1, pc = xcd & 1, lr = i & 7, lc = i >> 3;
  pm = pr * 8 + lr; pn = round * 8 + pc * 4 + lc;
}
constexpr int CH = 64, NCH = T_ / CH;
constexpr int LD = 72;

struct RwkvP { const float *mu, *w0, *w_up, *a0, *a_up, *g_up, *k_k, *k_a, *r_k, *ln_g, *ln_b; };
struct LruP { const float *conv_w, *conv_b, *w_a, *b_a, *w_x, *b_x, *lam; };
struct MixBuf {
  u16 *rw_Rb, *rw_Pab, *rw_Pak, *rw_VT, *rw_S0, *rw_UT, *rw_WpF, *rw_BtF, *rw_G, *rw_BV; float *rw_U0F, *rw_KVF, *rw_gam;
  u16 *rt_Rb, *rt_Pak, *rt_VT, *rt_S0; float* rt_KVT;
  u16 *gl_Rb, *gl_Pak, *gl_VT, *gl_S0; float *gl_KVT, *gl_gam;
  float *lr_h, *lr_A, *lr_Hp;
};
struct MixP {
  const u16* proj; const int* pos; u16* ycat; MixBuf b;
  RwkvP rw; const float* ret_norm_g; LruP lru; const float *gla_alpha_up, *gla_alpha_b, *gla_norm_g;
};

__device__ __forceinline__ float gelu_tanh(float x) {
  const float u = 0.7978845608028654f * (x + 0.044715f * x * x * x);
  return 0.5f * x * (1.f + tanhf(u));
}
__device__ __forceinline__ float red16(float v) {
  v += __shfl_xor(v, 1, 64); v += __shfl_xor(v, 2, 64); v += __shfl_xor(v, 4, 64); v += __shfl_xor(v, 8, 64);
  return v;
}
__device__ __forceinline__ uint4 pack8(const u16 (&a)[8]) {
  uint4 r;
  r.x = (unsigned)a[0] | ((unsigned)a[1] << 16); r.y = (unsigned)a[2] | ((unsigned)a[3] << 16);
  r.z = (unsigned)a[4] | ((unsigned)a[5] << 16); r.w = (unsigned)a[6] | ((unsigned)a[7] << 16);
  return r;
}
__device__ __forceinline__ f32x4 tile_nt(const u16* sA, const u16* sB, int mt, int nt, int r, int g) {
  f32x4 c = {0.f, 0.f, 0.f, 0.f};
#pragma unroll
  for (int s = 0; s < 2; ++s) {
    bf16x8 a = *(const bf16x8*)(sA + (16 * mt + r) * LD + 32 * s + 8 * g);
    bf16x8 b = *(const bf16x8*)(sB + (16 * nt + r) * LD + 32 * s + 8 * g);
    c = __builtin_amdgcn_mfma_f32_16x16x32_bf16(a, b, c, 0, 0, 0);
  }
  return c;
}
__device__ __forceinline__ void copy_out(const u16* s, u16* gp, int rows, int tid) {
  for (int idx = tid; idx < rows * 8; idx += 512) { int row = idx >> 3, seg = idx & 7; *(uint4*)(gp + row * 64 + seg * 8) = *(const uint4*)(s + row * LD + seg * 8); }
}
__device__ __forceinline__ void inv_perm(int x, int& s, int& g, int& j) { s = x >> 5; int rr = x & 31; g = (rr >> 2) & 3; j = 4 * (rr >> 4) + (rr & 3); }

__device__ __forceinline__ void p3_ret(const MixP& p, int c, int h, char* smem) {
  u16* sRb = (u16*)smem; u16* sKb = sRb + 64 * LD; u16* sKtT = sKb + 64 * LD; u16* sVT = sKtT + 64 * LD;
  int tid = threadIdx.x; asm volatile("" : "+v"(tid));
  const int cc = tid & 63, tg = tid >> 6, r = cc & 15, g = cc >> 4, uid = c * 8 + h;
  const float lg2 = log2f(1.f - exp2f(-(5.f + 4.f * (float)h / 7.f)));
  const float inv = exp2f(-(float)(cc & 31) * (13.287712379549449f / 32.f));
  u16 kt8[8], v8[8];
#pragma unroll
  for (int i = 0; i < 8; ++i) {
    const int tl = tg * 8 + i, t = c * 64 + tl; const u16* row = p.proj + (long)t * PC + OFF_B;
    const float q = bf2f(row[h * 64 + cc]), k = bf2f(row[512 + h * 64 + cc]);
    float sn, cs; sincosf((float)p.pos[t] * inv, &sn, &cs);
    const float qo = __shfl_xor(q, 32, 64), ko = __shfl_xor(k, 32, 64);
    const float qr = cc < 32 ? q * cs - qo * sn : q * cs + qo * sn;
    const float kr = (cc < 32 ? k * cs - ko * sn : k * cs + ko * sn) * 0.125f;
    const float e = exp2f(lg2 * (float)(tl + 1)), ei = exp2f(-lg2 * (float)(tl + 1)), et = exp2f(lg2 * (float)(63 - tl));
    sRb[tl * LD + cc] = f2bf(qr * e); sKb[tl * LD + cc] = f2bf(kr * ei); kt8[i] = f2bf(kr * et); v8[i] = row[1024 + h * 64 + cc];
  }
  *(uint4*)(sKtT + cc * LD + tg * 8) = pack8(kt8); *(uint4*)(sVT + cc * LD + tg * 8) = pack8(v8);
  __syncthreads();
  for (int tile = tg; tile < 32; tile += 8) {
    if (tile < 16) {
      const int mt = tile >> 2, nt = tile & 3; f32x4 c4 = tile_nt(sRb, sKb, mt, nt, r, g);
#pragma unroll
      for (int reg = 0; reg < 4; ++reg) { int t = 16 * mt + 4 * g + reg, i = 16 * nt + r; p.b.rt_Pak[(long)uid * 4096 + t * 64 + i] = f2bf(i <= t ? c4[reg] : 0.f); }
    } else {
      const int q = tile - 16, mt = q >> 2, nt = q & 3; f32x4 c4 = tile_nt(sVT, sKtT, mt, nt, r, g);
#pragma unroll
      for (int reg = 0; reg < 4; ++reg) { int v = 16 * mt + 4 * g + reg, k = 16 * nt + r; p.b.rt_KVT[(long)uid * 4096 + v * 64 + k] = c4[reg]; }
    }
  }
  copy_out(sRb, p.b.rt_Rb + (long)uid * 4096, 64, tid); copy_out(sVT, p.b.rt_VT + (long)uid * 4096, 64, tid);
  __syncthreads();
}

__device__ __forceinline__ void p3_gla(const MixP& p, int c, int h, char* smem) {
  u16* sRb = (u16*)smem; u16* sKb = sRb + 64 * LD; u16* sKtT = sKb + 64 * LD; u16* sVT = sKtT + 64 * LD;
  float* pre = (float*)(smem + 5 * 64 * LD * 2); float* sal = pre + 512;
  int tid = threadIdx.x; asm volatile("" : "+v"(tid));
  const int cc = tid & 63, tg = tid >> 6, r = cc & 15, g = cc >> 4, uid = c * 4 + h, hd = h * 64 + cc;
  for (int idx = tid; idx < 1024; idx += 512) { int tl = idx >> 4, j = idx & 15; sal[idx] = bf2f(p.proj[(long)(c * 64 + tl) * PC + OFF_D + 1024 + j]); }
  __syncthreads();
  float au[16];
#pragma unroll
  for (int j = 0; j < 16; ++j) au[j] = p.gla_alpha_up[j * 256 + hd];
  const float ab = p.gla_alpha_b[hd];
  float cum[8]; float run = 0.f;
#pragma unroll
  for (int i = 0; i < 8; ++i) {
    const int tl = tg * 8 + i; float x = ab;
#pragma unroll
    for (int j = 0; j < 16; ++j) x += sal[tl * 16 + j] * au[j];
    const float ls = fminf(x, 0.f) - __logf(1.f + __expf(-fabsf(x)));
    run += ls * (1.f / 16.f); cum[i] = run;
  }
  pre[tg * 64 + cc] = run;
  __syncthreads();
  float off = 0.f, tot = 0.f;
#pragma unroll
  for (int q = 0; q < 8; ++q) { float v = pre[q * 64 + cc]; tot += v; if (q < tg) off += v; }
  u16 kt8[8], v8a[8], v8b[8];
#pragma unroll
  for (int i = 0; i < 8; ++i) {
    const int tl = tg * 8 + i, t = c * 64 + tl; const u16* row = p.proj + (long)t * PC + OFF_D;
    const float cm = cum[i] + off;
    const float q = bf2f(row[hd]) * 0.125f, k = bf2f(row[256 + hd]);
    sRb[tl * LD + cc] = f2bf(q * __expf(cm)); sKb[tl * LD + cc] = f2bf(k * __expf(-cm)); kt8[i] = f2bf(k * __expf(tot - cm));
    v8a[i] = row[512 + h * 128 + cc]; v8b[i] = row[512 + h * 128 + 64 + cc];
  }
  *(uint4*)(sKtT + cc * LD + tg * 8) = pack8(kt8); *(uint4*)(sVT + cc * LD + tg * 8) = pack8(v8a); *(uint4*)(sVT + (64 + cc) * LD + tg * 8) = pack8(v8b);
  if (tg == 0) p.b.gl_gam[uid * 64 + cc] = __expf(tot);
  __syncthreads();
  for (int tile = tg; tile < 48; tile += 8) {
    if (tile < 16) {
      const int mt = tile >> 2, nt = tile & 3; f32x4 c4 = tile_nt(sRb, sKb, mt, nt, r, g);
#pragma unroll
      for (int reg = 0; reg < 4; ++reg) { int t = 16 * mt + 4 * g + reg, i = 16 * nt + r; p.b.gl_Pak[(long)uid * 4096 + t * 64 + i] = f2bf(i <= t ? c4[reg] : 0.f); }
    } else {
      const int q = tile - 16, mt = q >> 2, nt = q & 3; f32x4 c4 = tile_nt(sVT, sKtT, mt, nt, r, g);
#pragma unroll
      for (int reg = 0; reg < 4; ++reg) { int v = 16 * mt + 4 * g + reg, k = 16 * nt + r; p.b.gl_KVT[(long)uid * 8192 + v * 64 + k] = c4[reg]; }
    }
  }
  copy_out(sRb, p.b.gl_Rb + (long)uid * 4096, 64, tid); copy_out(sVT, p.b.gl_VT + (long)uid * 8192, 128, tid);
  __syncthreads();
}

__device__ __forceinline__ void p3_lru(const MixP& p, int c, int gq, char* smem) {
  float* sxc = (float*)smem; float* preA = sxc + 4096; float* preB = preA + 512;
  int tid = threadIdx.x; asm volatile("" : "+v"(tid));
  const int cc = tid & 63, tg = tid >> 6, ch = gq * 64 + cc, t0 = c * 64 + tg * 8;
  float xb[11];
#pragma unroll
  for (int i = 0; i < 11; ++i) { int t = t0 - 3 + i; xb[i] = t >= 0 ? bf2f(p.proj[(long)t * PC + OFF_C + ch]) : 0.f; }
  const float cw0 = p.lru.conv_w[ch], cw1 = p.lru.conv_w[512 + ch], cw2 = p.lru.conv_w[1024 + ch], cw3 = p.lru.conv_w[1536 + ch], cb = p.lru.conv_b[ch];
  float xc[8];
#pragma unroll
  for (int i = 0; i < 8; ++i) { xc[i] = cb + cw0 * xb[i] + cw1 * xb[i + 1] + cw2 * xb[i + 2] + cw3 * xb[i + 3]; sxc[(tg * 8 + i) * 64 + cc] = xc[i]; }
  __syncthreads();
  float ra[8], ix[8];
  const float ba = p.lru.b_a[ch], bx = p.lru.b_x[ch];
#pragma unroll
  for (int i = 0; i < 8; ++i) { ra[i] = ba; ix[i] = bx; }
  const float* wa = p.lru.w_a + (long)gq * 4096 + cc; const float* wx = p.lru.w_x + (long)gq * 4096 + cc;
#pragma unroll 2
  for (int ii = 0; ii < 64; ii += 4) {
    float a0 = wa[(ii + 0) * 64], a1 = wa[(ii + 1) * 64], a2 = wa[(ii + 2) * 64], a3 = wa[(ii + 3) * 64];
    float x0 = wx[(ii + 0) * 64], x1 = wx[(ii + 1) * 64], x2 = wx[(ii + 2) * 64], x3 = wx[(ii + 3) * 64];
#pragma unroll
    for (int i = 0; i < 8; ++i) {
      f32x4 xv = *(const f32x4*)(sxc + (tg * 8 + i) * 64 + ii);
      ra[i] += xv[0] * a0 + xv[1] * a1 + xv[2] * a2 + xv[3] * a3;
      ix[i] += xv[0] * x0 + xv[1] * x1 + xv[2] * x2 + xv[3] * x3;
    }
  }
  const float lam = p.lru.lam[ch]; const float sp = fmaxf(-lam, 0.f) + log1pf(__expf(-fabsf(lam)));
  float hl[8], ac[8]; float A = 1.f, B = 0.f;
#pragma unroll
  for (int i = 0; i < 8; ++i) {
    const float rr = sigmoidf_(ra[i]), ig = sigmoidf_(ix[i]); const float log_a = -8.f * rr * sp;
    const bool reset = p.pos[t0 + i] == 0;
    const float av = reset ? 0.f : __expf(log_a); const float mult = reset ? 1.f : sqrtf(fmaxf(1.f - av * av, 0.f));
    const float bv = mult * ig * xc[i];
    B = av * B + bv; A *= av; hl[i] = B; ac[i] = A;
  }
  preA[tg * 64 + cc] = A; preB[tg * 64 + cc] = B;
  __syncthreads();
  float Ap = 1.f, Bp = 0.f;
#pragma unroll
  for (int q = 0; q < 7; ++q) if (q < tg) { float a = preA[q * 64 + cc], b = preB[q * 64 + cc]; Bp = a * Bp + b; Ap *= a; }
#pragma unroll
  for (int i = 0; i < 8; ++i) { long o = (long)(t0 + i) * 512 + ch; p.b.lr_h[o] = hl[i] + ac[i] * Bp; p.b.lr_A[o] = ac[i] * Ap; }
  __syncthreads();
}

template <int I, int N> struct SolveDot {
  static __device__ __forceinline__ void run(const float* arow, const float (&X)[64], float (&acc)[4]) {
    if constexpr (I + 4 <= N) {
      const f32x4 a = *(const f32x4*)(arow + I);
      acc[0] += a[0] * X[I]; acc[1] += a[1] * X[I + 1]; acc[2] += a[2] * X[I + 2]; acc[3] += a[3] * X[I + 3];
      SolveDot<I + 4, N>::run(arow, X, acc);
    } else if constexpr (I < N) { acc[I & 3] += arow[I] * X[I]; SolveDot<I + 1, N>::run(arow, X, acc); }
  }
};
template <int T> struct SolveRow {
  static __device__ __forceinline__ void run(const float* sAab, const float* sRhs, int tid, float (&X)[64]) {
    if constexpr (T < 64) {
      float acc[4] = {sRhs[T * 128 + tid], 0.f, 0.f, 0.f};
      SolveDot<0, T>::run(sAab + T * 64, X, acc);
      X[T] = (acc[0] + acc[1]) + (acc[2] + acc[3]);
      asm volatile("" ::: "memory");
      SolveRow<T + 1>::run(sAab, sRhs, tid, X);
    }
  }
};
__device__ __forceinline__ void p3_rwkv_solve(const MixP& p, int uid, int tid, const float* sRhs, const float* sAab) {
  float X[64];
  const int col = tid & 63; const bool isAl = tid < 64;
  asm volatile("" : "+v"(sAab), "+v"(sRhs));
  SolveRow<0>::run(sAab, sRhs, tid, X);
  if (isAl) {
    int s, g_, j; inv_perm(col, s, g_, j);
#pragma unroll
    for (int t = 0; t < 64; ++t) p.b.rw_WpF[(long)uid * 4096 + (((t >> 4) * 2 + s) * 64 + g_ * 16 + (t & 15)) * 8 + j] = f2bf(X[t]);
  } else {
    const int vs = col >> 4, r_ = col & 15;
#pragma unroll
    for (int tt = 0; tt < 4; ++tt)
#pragma unroll
      for (int g_ = 0; g_ < 4; ++g_) {
        f32x4 o = {X[16 * tt + 4 * g_], X[16 * tt + 4 * g_ + 1], X[16 * tt + 4 * g_ + 2], X[16 * tt + 4 * g_ + 3]};
        *(f32x4*)(p.b.rw_U0F + (((long)uid * 4 + vs) * 4 + tt) * 256 + (g_ * 16 + r_) * 4) = o;
      }
  }
}
__device__ __forceinline__ void p3_rwkv(const MixP& p, int c, int h, char* smem) {
  u16* sRb = (u16*)smem; u16* sKb = sRb + 64 * LD; u16* sAl = sKb + 64 * LD; u16* sBe = sAl + 64 * LD; u16* sKtT = sBe + 64 * LD; u16* sVT = sKtT + 64 * LD;
  float* pre = (float*)(smem + 55296);
  char* R2 = smem + 57344;
  float* tw = (float*)R2; float* za = tw + 2048; float* sg = za + 2048;
  float* sAab = (float*)R2; u16* sAak = (u16*)(R2 + 16384); float* sRhs = (float*)(R2 + 16384 + 9216);
  int tid = threadIdx.x; asm volatile("" : "+v"(tid));
  const int cc = tid & 63, tg = tid >> 6, r = cc & 15, g = cc >> 4, uid = c * 8 + h, hc = h * 64 + cc, t0 = c * 64 + tg * 8;
  const u16* proj = p.proj;
  for (int idx = tid; idx < 64 * 160; idx += 512) {
    const int tl = idx / 160, j = idx - tl * 160, t = c * 64 + tl, col = 1536 + j;
    const float cur = bf2f(proj[(long)t * PC + col]); const float prev = t > 0 ? bf2f(proj[(long)(t - 1) * PC + col]) : 0.f;
    const float z = cur + (prev - cur) * p.rw.mu[col];
    if (j < 32) tw[tl * 32 + j] = tanhf(z); else if (j < 64) za[tl * 32 + (j - 32)] = z; else sg[tl * 96 + (j - 64)] = sigmoidf_(z);
  }
  float zr[8], zk[8], zv[8];
  {
    float pr[9], pk[9], pv[9];
#pragma unroll
    for (int i = 0; i < 9; ++i) { int t = t0 - 1 + i; if (t >= 0) { const u16* row = proj + (long)t * PC; pr[i] = bf2f(row[hc]); pk[i] = bf2f(row[512 + hc]); pv[i] = bf2f(row[1024 + hc]); } else { pr[i] = pk[i] = pv[i] = 0.f; } }
    const float mr = p.rw.mu[hc], mk = p.rw.mu[512 + hc], mv = p.rw.mu[1024 + hc];
#pragma unroll
    for (int i = 0; i < 8; ++i) { zr[i] = pr[i + 1] + (pr[i] - pr[i + 1]) * mr; zk[i] = pk[i + 1] + (pk[i] - pk[i + 1]) * mk; zv[i] = pv[i + 1] + (pv[i] - pv[i + 1]) * mv; }
  }
  __syncthreads();
  float wv[8], av[8], gv[8];
  { const float w0 = p.rw.w0[hc], a0 = p.rw.a0[hc];
#pragma unroll
    for (int i = 0; i < 8; ++i) { wv[i] = w0; av[i] = a0; gv[i] = 0.f; } }
#pragma unroll 2
  for (int j = 0; j < 32; j += 4) {
    float wu0 = p.rw.w_up[(j + 0) * 512 + hc], wu1 = p.rw.w_up[(j + 1) * 512 + hc], wu2 = p.rw.w_up[(j + 2) * 512 + hc], wu3 = p.rw.w_up[(j + 3) * 512 + hc];
    float au0 = p.rw.a_up[(j + 0) * 512 + hc], au1 = p.rw.a_up[(j + 1) * 512 + hc], au2 = p.rw.a_up[(j + 2) * 512 + hc], au3 = p.rw.a_up[(j + 3) * 512 + hc];
#pragma unroll
    for (int i = 0; i < 8; ++i) {
      f32x4 t4 = *(const f32x4*)(tw + (tg * 8 + i) * 32 + j), z4 = *(const f32x4*)(za + (tg * 8 + i) * 32 + j);
      wv[i] += t4[0] * wu0 + t4[1] * wu1 + t4[2] * wu2 + t4[3] * wu3;
      av[i] += z4[0] * au0 + z4[1] * au1 + z4[2] * au2 + z4[3] * au3;
    }
  }
#pragma unroll 2
  for (int j = 0; j < 96; j += 4) {
    float gu0 = p.rw.g_up[(j + 0) * 512 + hc], gu1 = p.rw.g_up[(j + 1) * 512 + hc], gu2 = p.rw.g_up[(j + 2) * 512 + hc], gu3 = p.rw.g_up[(j + 3) * 512 + hc];
#pragma unroll
    for (int i = 0; i < 8; ++i) { f32x4 s4 = *(const f32x4*)(sg + (tg * 8 + i) * 96 + j); gv[i] += s4[0] * gu0 + s4[1] * gu1 + s4[2] * gu2 + s4[3] * gu3; }
  }
  const float kkw = p.rw.k_k[hc], kaw = p.rw.k_a[hc], rkw = p.rw.r_k[hc];
  float lw[8], aa[8], kk[8], kp[8], cum[8]; float run = 0.f;
#pragma unroll
  for (int i = 0; i < 8; ++i) {
    lw[i] = -0.6065306597126334f * sigmoidf_(wv[i]); aa[i] = sigmoidf_(av[i]);
    float k0 = zk[i] * kkw; const float ss = wave_sum(k0 * k0); kk[i] = k0 / fmaxf(sqrtf(ss), 1e-12f);
    kp[i] = zk[i] * (1.f + (aa[i] - 1.f) * kaw);
    const float bs = wave_sum(zr[i] * kp[i] * rkw);
    const long o = (long)(t0 + i) * 512 + hc;
    p.b.rw_G[o] = f2bf(gv[i]); p.b.rw_BV[o] = f2bf(bs * zv[i]);
    run += lw[i]; cum[i] = run;
  }
  pre[tg * 64 + cc] = run;
  __syncthreads();
  float off = 0.f, tot = 0.f;
#pragma unroll
  for (int q = 0; q < 8; ++q) { float v = pre[q * 64 + cc]; tot += v; if (q < tg) off += v; }
  {
    u16 kt8[8], v8[8];
    const int kt = cc >> 4, r_ = cc & 15;
#pragma unroll
    for (int i = 0; i < 8; ++i) {
      const int tl = tg * 8 + i; const float cm = cum[i] + off, cx = cm - lw[i];
      const float en = __expf(-cm), et = __expf(tot - cm);
      sAl[tl * LD + cc] = f2bf(-kk[i] * __expf(cx)); sBe[tl * LD + cc] = f2bf(kk[i] * aa[i] * en);
      sKb[tl * LD + cc] = f2bf(kp[i] * en); sRb[tl * LD + cc] = f2bf(zr[i] * __expf(cm));
      kt8[i] = f2bf(kp[i] * et); v8[i] = f2bf(zv[i]);
      int s, g_, j; inv_perm(tl, s, g_, j);
      p.b.rw_BtF[(long)uid * 4096 + ((kt * 2 + s) * 64 + g_ * 16 + r_) * 8 + j] = f2bf(kk[i] * aa[i] * et);
    }
    *(uint4*)(sKtT + cc * LD + tg * 8) = pack8(kt8); *(uint4*)(sVT + cc * LD + tg * 8) = pack8(v8);
    if (tg == 0) p.b.rw_gam[uid * 64 + cc] = __expf(tot);
  }
  __syncthreads();
  for (int q = tg; q < 80; q += 8) {
    const int kind = q >> 4, tt = q & 15, mt = tt >> 2, nt = tt & 3;
    if (kind == 0) { f32x4 c4 = tile_nt(sAl, sBe, mt, nt, r, g);
#pragma unroll
      for (int reg = 0; reg < 4; ++reg) { int t = 16 * mt + 4 * g + reg, i = 16 * nt + r; sAab[t * 64 + i] = i < t ? c4[reg] : 0.f; }
    } else if (kind == 1) { f32x4 c4 = tile_nt(sAl, sKb, mt, nt, r, g);
#pragma unroll
      for (int reg = 0; reg < 4; ++reg) { int t = 16 * mt + 4 * g + reg, i = 16 * nt + r; sAak[t * LD + i] = f2bf(i < t ? c4[reg] : 0.f); }
    } else if (kind == 2) { f32x4 c4 = tile_nt(sRb, sBe, mt, nt, r, g);
#pragma unroll
      for (int reg = 0; reg < 4; ++reg) { int t = 16 * mt + 4 * g + reg, i = 16 * nt + r; p.b.rw_Pab[(long)uid * 4096 + t * 64 + i] = f2bf(i <= t ? c4[reg] : 0.f); }
    } else if (kind == 3) { f32x4 c4 = tile_nt(sRb, sKb, mt, nt, r, g);
#pragma unroll
      for (int reg = 0; reg < 4; ++reg) { int t = 16 * mt + 4 * g + reg, i = 16 * nt + r; p.b.rw_Pak[(long)uid * 4096 + t * 64 + i] = f2bf(i <= t ? c4[reg] : 0.f); }
    } else { f32x4 c4 = tile_nt(sKtT, sVT, mt, nt, r, g);
      *(f32x4*)(p.b.rw_KVF + (((long)uid * 4 + nt) * 4 + mt) * 256 + cc * 4) = c4;
    }
  }
  __syncthreads();
  for (int q = tg; q < 16; q += 8) { const int mt = q >> 2, nt = q & 3; f32x4 c4 = tile_nt(sAak, sVT, mt, nt, r, g);
#pragma unroll
    for (int reg = 0; reg < 4; ++reg) { int t = 16 * mt + 4 * g + reg, v = 16 * nt + r; sRhs[t * 128 + 64 + v] = c4[reg]; } }
  for (int idx = tid; idx < 4096; idx += 512) { int t = idx >> 6, k = idx & 63; sRhs[t * 128 + k] = bf2f(sAl[t * LD + k]); }
  copy_out(sRb, p.b.rw_Rb + (long)uid * 4096, 64, tid); copy_out(sVT, p.b.rw_VT + (long)uid * 4096, 64, tid);
  __syncthreads();
  if (tid < 128) p3_rwkv_solve(p, uid, tid, sRhs, sAab);
  __syncthreads();
}

constexpr int RING_SLOT = 8192 + 8192 + 4096 + 4096 + 256;
__device__ __forceinline__ void chain_issue(const MixP& p, int uid, int vs, char* slot, int lane) {
  const u16* wp = p.b.rw_WpF + (long)uid * 4096 + lane * 8; const u16* bt = p.b.rw_BtF + (long)uid * 4096 + lane * 8;
#pragma unroll
  for (int i = 0; i < 8; ++i) __builtin_amdgcn_global_load_lds((const unsigned*)(wp + i * 512), (unsigned*)(slot + i * 1024 + lane * 16), 16, 0, 0);
#pragma unroll
  for (int i = 0; i < 8; ++i) __builtin_amdgcn_global_load_lds((const unsigned*)(bt + i * 512), (unsigned*)(slot + 8192 + i * 1024 + lane * 16), 16, 0, 0);
  const float* u0 = p.b.rw_U0F + ((long)uid * 4 + vs) * 1024 + lane * 4; const float* kv = p.b.rw_KVF + ((long)uid * 4 + vs) * 1024 + lane * 4;
#pragma unroll
  for (int i = 0; i < 4; ++i) __builtin_amdgcn_global_load_lds((const unsigned*)(u0 + i * 256), (unsigned*)(slot + 16384 + i * 1024 + lane * 16), 16, 0, 0);
#pragma unroll
  for (int i = 0; i < 4; ++i) __builtin_amdgcn_global_load_lds((const unsigned*)(kv + i * 256), (unsigned*)(slot + 20480 + i * 1024 + lane * 16), 16, 0, 0);
  __builtin_amdgcn_global_load_lds((const unsigned*)(p.b.rw_gam + uid * 64 + lane), (unsigned*)(slot + 24576 + lane * 4), 4, 0, 0);
}
__device__ __forceinline__ bf16x8 cvt_frag(const f32x4& lo, const f32x4& hi) {
  bf16x8 f;
  f[0] = (short)f2bf(lo[0]); f[1] = (short)f2bf(lo[1]); f[2] = (short)f2bf(lo[2]); f[3] = (short)f2bf(lo[3]);
  f[4] = (short)f2bf(hi[0]); f[5] = (short)f2bf(hi[1]); f[6] = (short)f2bf(hi[2]); f[7] = (short)f2bf(hi[3]);
  return f;
}
__device__ __forceinline__ void p4_rwkv_chain(const MixP& p, int h, int vs, char* ring, int lane) {
  const int r = lane & 15, g = lane >> 4, v = vs * 16 + r;
  f32x4 ST[4];
#pragma unroll
  for (int kt = 0; kt < 4; ++kt) ST[kt] = (f32x4){0.f, 0.f, 0.f, 0.f};
  chain_issue(p, 0 * 8 + h, vs, ring, lane);
  chain_issue(p, 1 * 8 + h, vs, ring + RING_SLOT, lane);
  for (int c = 0; c < NCH; ++c) {
    const int uid = c * 8 + h; char* slot = ring + (c % 3) * RING_SLOT;
    if (c + 2 < NCH) { chain_issue(p, (c + 2) * 8 + h, vs, ring + ((c + 2) % 3) * RING_SLOT, lane); asm volatile("s_waitcnt vmcnt(50)" ::: "memory"); }
    else if (c + 1 < NCH) asm volatile("s_waitcnt vmcnt(25)" ::: "memory");
    else asm volatile("s_waitcnt vmcnt(0)" ::: "memory");
    bf16x8 bS[2];
#pragma unroll
    for (int s = 0; s < 2; ++s) bS[s] = cvt_frag(ST[2 * s], ST[2 * s + 1]);
#pragma unroll
    for (int kt = 0; kt < 4; ++kt) {
      uint2 pk; pk.x = (unsigned)f2bf(ST[kt][0]) | ((unsigned)f2bf(ST[kt][1]) << 16); pk.y = (unsigned)f2bf(ST[kt][2]) | ((unsigned)f2bf(ST[kt][3]) << 16);
      *(uint2*)(p.b.rw_S0 + (long)uid * 4096 + v * 64 + 16 * kt + 4 * g) = pk;
    }
    f32x4 U[4];
#pragma unroll
    for (int tt = 0; tt < 4; ++tt) {
      U[tt] = *(const f32x4*)(slot + 16384 + tt * 1024 + lane * 16);
#pragma unroll
      for (int s = 0; s < 2; ++s) { bf16x8 a = *(const bf16x8*)(slot + (tt * 2 + s) * 1024 + lane * 16); U[tt] = __builtin_amdgcn_mfma_f32_16x16x32_bf16(a, bS[s], U[tt], 0, 0, 0); }
    }
    bf16x8 bU[2];
#pragma unroll
    for (int s = 0; s < 2; ++s) bU[s] = cvt_frag(U[2 * s], U[2 * s + 1]);
#pragma unroll
    for (int tt = 0; tt < 4; ++tt) {
      uint2 pk; pk.x = (unsigned)f2bf(U[tt][0]) | ((unsigned)f2bf(U[tt][1]) << 16); pk.y = (unsigned)f2bf(U[tt][2]) | ((unsigned)f2bf(U[tt][3]) << 16);
      *(uint2*)(p.b.rw_UT + (long)uid * 4096 + v * 64 + 16 * tt + 4 * g) = pk;
    }
#pragma unroll
    for (int kt = 0; kt < 4; ++kt) {
      const f32x4 gm = *(const f32x4*)(slot + 24576 + (16 * kt + 4 * g) * 4); const f32x4 kv = *(const f32x4*)(slot + 20480 + kt * 1024 + lane * 16);
      f32x4 a4 = ST[kt] * gm + kv;
#pragma unroll
      for (int s = 0; s < 2; ++s) { bf16x8 a = *(const bf16x8*)(slot + 8192 + (kt * 2 + s) * 1024 + lane * 16); a4 = __builtin_amdgcn_mfma_f32_16x16x32_bf16(a, bU[s], a4, 0, 0, 0); }
      ST[kt] = a4;
    }
    asm volatile("s_waitcnt lgkmcnt(0)" ::: "memory");
  }
}
__device__ __forceinline__ void p4_elem(const MixP& p, int e) {
  if (e < 32768) {
    const int h = e >> 12, vk = e & 4095; const float lg2 = log2f(1.f - exp2f(-(5.f + 4.f * (float)h / 7.f))); const float gm = exp2f(lg2 * 64.f);
    float S = 0.f;
    for (int c0 = 0; c0 < NCH; c0 += 8) {
      float kv[8];
#pragma unroll
      for (int i = 0; i < 8; ++i) kv[i] = p.b.rt_KVT[(long)((c0 + i) * 8 + h) * 4096 + vk];
#pragma unroll
      for (int i = 0; i < 8; ++i) { p.b.rt_S0[(long)((c0 + i) * 8 + h) * 4096 + vk] = f2bf(S); S = S * gm + kv[i]; }
    }
  } else {
    const int e2 = e - 32768, h = e2 >> 13, vk = e2 & 8191, k = vk & 63;
    float S = 0.f;
    for (int c0 = 0; c0 < NCH; c0 += 8) {
      float kv[8], gm[8];
#pragma unroll
      for (int i = 0; i < 8; ++i) { kv[i] = p.b.gl_KVT[(long)((c0 + i) * 4 + h) * 8192 + vk]; gm[i] = p.b.gl_gam[((c0 + i) * 4 + h) * 64 + k]; }
#pragma unroll
      for (int i = 0; i < 8; ++i) { p.b.gl_S0[(long)((c0 + i) * 4 + h) * 8192 + vk] = f2bf(S); S = S * gm[i] + kv[i]; }
    }
  }
}
__device__ __forceinline__ void p4_lru(const MixP& p, int ch) {
  float H = 0.f;
  for (int c0 = 0; c0 < NCH; c0 += 8) {
    float a[8], b[8];
#pragma unroll
    for (int i = 0; i < 8; ++i) { long o = (long)((c0 + i) * 64 + 63) * 512 + ch; a[i] = p.b.lr_A[o]; b[i] = p.b.lr_h[o]; }
#pragma unroll
    for (int i = 0; i < 8; ++i) { p.b.lr_Hp[(c0 + i) * 512 + ch] = H; H = a[i] * H + b[i]; }
  }
}

template <int NVT, bool DELTA, int NMT>
__device__ __forceinline__ void p5_mm(const u16* Rb, const u16* S0, const u16* Pak, const u16* VT, const u16* Pab, const u16* UT, int mt0, int r, int g, f32x4 (&acc)[NMT][4 * NVT]) {
#pragma unroll
  for (int mt = 0; mt < NMT; ++mt)
#pragma unroll
    for (int nt = 0; nt < 4 * NVT; ++nt) acc[mt][nt] = (f32x4){0.f, 0.f, 0.f, 0.f};
#pragma unroll 1
  for (int pr = 0; pr < (DELTA ? 3 : 2); ++pr) {
    const u16* A = pr == 0 ? Rb : (pr == 1 ? Pak : Pab); const u16* B = pr == 0 ? S0 : (pr == 1 ? VT : UT);
#pragma unroll
    for (int s = 0; s < 2; ++s) {
      bf16x8 af[NMT];
#pragma unroll
      for (int mt = 0; mt < NMT; ++mt) af[mt] = *(const bf16x8*)(A + (16 * (mt0 + mt) + r) * 64 + 32 * s + 8 * g);
#pragma unroll
      for (int nt = 0; nt < 4 * NVT; ++nt) {
        bf16x8 bfr = *(const bf16x8*)(B + (16 * nt + r) * 64 + 32 * s + 8 * g);
#pragma unroll
        for (int mt = 0; mt < NMT; ++mt) acc[mt][nt] = __builtin_amdgcn_mfma_f32_16x16x32_bf16(af[mt], bfr, acc[mt][nt], 0, 0, 0);
      }
    }
  }
}
__device__ __forceinline__ void p5_rwkv(const MixP& p, int c, int h, int lane) {
  const int r = lane & 15, g = lane >> 4; const long uo = (long)(c * 8 + h) * 4096;
  float lg[4], lb[4];
#pragma unroll
  for (int nt = 0; nt < 4; ++nt) { lg[nt] = p.rw.ln_g[h * 64 + 16 * nt + r]; lb[nt] = p.rw.ln_b[h * 64 + 16 * nt + r]; }
#pragma unroll 1
  for (int mh = 0; mh < 2; ++mh) {
    f32x4 acc[2][4];
    p5_mm<1, true, 2>(p.b.rw_Rb + uo, p.b.rw_S0 + uo, p.b.rw_Pak + uo, p.b.rw_VT + uo, p.b.rw_Pab + uo, p.b.rw_UT + uo, mh * 2, r, g, acc);
#pragma unroll
    for (int mt = 0; mt < 2; ++mt)
#pragma unroll
      for (int reg = 0; reg < 4; ++reg) {
        const int t = c * 64 + 16 * (mh * 2 + mt) + 4 * g + reg;
        float s1 = acc[mt][0][reg] + acc[mt][1][reg] + acc[mt][2][reg] + acc[mt][3][reg]; s1 = red16(s1);
        const float mean = s1 * (1.f / 64.f);
        float s2 = 0.f;
#pragma unroll
        for (int nt = 0; nt < 4; ++nt) { float d = acc[mt][nt][reg] - mean; s2 += d * d; }
        s2 = red16(s2);
        const float rs = rsqrtf(s2 * (1.f / 64.f) + 64e-5f);
#pragma unroll
        for (int nt = 0; nt < 4; ++nt) {
          const int hc = h * 64 + 16 * nt + r; const long o = (long)t * 512 + hc;
          const float yn = (acc[mt][nt][reg] - mean) * rs * lg[nt] + lb[nt];
          p.ycat[(long)t * DM + hc] = f2bf((yn + bf2f(p.b.rw_BV[o])) * bf2f(p.b.rw_G[o]));
        }
      }
  }
}
__device__ __forceinline__ void p5_ret(const MixP& p, int c, int h, int lane) {
  const int r = lane & 15, g = lane >> 4; const long uo = (long)(c * 8 + h) * 4096;
  f32x4 acc[4][4];
  p5_mm<1, false, 4>(p.b.rt_Rb + uo, p.b.rt_S0 + uo, p.b.rt_Pak + uo, p.b.rt_VT + uo, nullptr, nullptr, 0, r, g, acc);
  float ng[4];
#pragma unroll
  for (int nt = 0; nt < 4; ++nt) ng[nt] = p.ret_norm_g[h * 64 + 16 * nt + r];
#pragma unroll
  for (int mt = 0; mt < 4; ++mt)
#pragma unroll
    for (int reg = 0; reg < 4; ++reg) {
      const int t = c * 64 + 16 * mt + 4 * g + reg;
      float s2 = 0.f;
#pragma unroll
      for (int nt = 0; nt < 4; ++nt) s2 += acc[mt][nt][reg] * acc[mt][nt][reg];
      s2 = red16(s2);
      const float rs = rsqrtf(s2 * (1.f / 64.f) + 1e-6f);
#pragma unroll
      for (int nt = 0; nt < 4; ++nt) {
        const int hc = h * 64 + 16 * nt + r; const float gt = bf2f(p.proj[(long)t * PC + OFF_B + 1536 + hc]);
        p.ycat[(long)t * DM + 512 + hc] = f2bf(acc[mt][nt][reg] * rs * ng[nt] * gt * sigmoidf_(gt));
      }
    }
}
__device__ __forceinline__ void p5_gla(const MixP& p, int c, int h, int lane) {
  const int r = lane & 15, g = lane >> 4; const int uid = c * 4 + h;
  float ng[8];
#pragma unroll
  for (int nt = 0; nt < 8; ++nt) ng[nt] = p.gla_norm_g[h * 128 + 16 * nt + r];
#pragma unroll 1
  for (int mh = 0; mh < 2; ++mh) {
    f32x4 acc[2][8];
    p5_mm<2, false, 2>(p.b.gl_Rb + (long)uid * 4096, p.b.gl_S0 + (long)uid * 8192, p.b.gl_Pak + (long)uid * 4096, p.b.gl_VT + (long)uid * 8192, nullptr, nullptr, mh * 2, r, g, acc);
#pragma unroll
    for (int mt = 0; mt < 2; ++mt)
#pragma unroll
      for (int reg = 0; reg < 4; ++reg) {
        const int t = c * 64 + 16 * (mh * 2 + mt) + 4 * g + reg;
        float s2 = 0.f;
#pragma unroll
        for (int nt = 0; nt < 8; ++nt) s2 += acc[mt][nt][reg] * acc[mt][nt][reg];
        s2 = red16(s2);
        const float rs = rsqrtf(s2 * (1.f / 128.f) + 1e-6f);
#pragma unroll
        for (int nt = 0; nt < 8; ++nt) {
          const int hc = h * 128 + 16 * nt + r; const float gt = bf2f(p.proj[(long)t * PC + OFF_D + 1040 + hc]);
          p.ycat[(long)t * DM + 1536 + hc] = f2bf(acc[mt][nt][reg] * rs * ng[nt] * gt * sigmoidf_(gt));
        }
      }
  }
}
__device__ __forceinline__ void p5_lru(const MixP& p, long idx) {
  const int t = (int)(idx >> 9), ch = (int)(idx & 511), c = t >> 6;
  const float hv = p.b.lr_h[idx] + p.b.lr_A[idx] * p.b.lr_Hp[c * 512 + ch];
  p.ycat[(long)t * DM + 1024 + ch] = f2bf(hv * gelu_tanh(bf2f(p.proj[(long)t * PC + OFF_C + 512 + ch])));
}

__device__ __forceinline__ void phase_mix3(const MixP& p, char* smem) {
  for (int u = blockIdx.x; u < 3584; u += gridDim.x) {
    if (u < 1024) p3_rwkv(p, u >> 3, u & 7, smem);
    else if (u < 2048) p3_ret(p, (u - 1024) >> 3, (u - 1024) & 7, smem);
    else if (u < 2560) p3_gla(p, (u - 2048) >> 2, (u - 2048) & 3, smem);
    else p3_lru(p, (u - 2560) >> 3, (u - 2560) & 7, smem);
  }
}
__device__ __forceinline__ void phase_mix4(const MixP& p, char* smem) {
  int tid = threadIdx.x; asm volatile("" : "+v"(tid));
#pragma unroll 1
  for (int b = blockIdx.x; b < 256; b += gridDim.x) {
    if (b < 32) { if (tid < 64) p4_rwkv_chain(p, b >> 2, b & 3, smem, tid); }
    else if (b >= 64 && b < 192) p4_elem(p, (b - 64) * 512 + tid);
    else if (b == 200) p4_lru(p, tid);
    __syncthreads();
  }
}
__device__ __forceinline__ void phase_mix5(const MixP& p) {
  int tid = threadIdx.x; asm volatile("" : "+v"(tid));
  const int wave = blockIdx.x * 8 + (tid >> 6), nw = gridDim.x * 8, lane = tid & 63;
  for (int u = wave; u < 2560; u += nw) {
    if (u < 512) p5_gla(p, u >> 2, u & 3, lane);
    else if (u < 1536) p5_rwkv(p, (u - 512) >> 3, (u - 512) & 7, lane);
    else p5_ret(p, (u - 1536) >> 3, (u - 1536) & 7, lane);
  }
  for (long idx = (long)blockIdx.x * 512 + tid; idx < (long)T_ * 512; idx += (long)gridDim.x * 512) p5_lru(p, idx);
}

#define XB_TMO      128
#define XB_XCNT(j)  (256  + 64 * (j))
#define XB_XSUB(j)  (1280 + 64 * (j))
#define XB_XGEN(j)  (2304 + 64 * (j))
#define XB_TOP      3328
#define XB_TOPGEN   3392
#define XCD_BAR_WORDS 3456
#define XB_SPIN_CAP (1u << 18)
#define LAS __attribute__((address_space(3)))
__device__ __forceinline__ unsigned xb_ld(unsigned* p)              { return __hip_atomic_load(p, __ATOMIC_RELAXED, __HIP_MEMORY_SCOPE_AGENT); }
__device__ __forceinline__ unsigned xb_add(unsigned* p, unsigned v) { return __hip_atomic_fetch_add(p, v, __ATOMIC_RELAXED, __HIP_MEMORY_SCOPE_AGENT); }
__device__ __forceinline__ unsigned xb_xcc_id() { return (unsigned)__builtin_amdgcn_s_getreg((3 << 11) | 20) & 0xFu; }
#define XB_SPIN(cond, bar) do { unsigned _sp = 0; while (cond) { __builtin_amdgcn_s_sleep(1); \
    if ((++_sp & 255u) == 0u) { if (xb_ld(&(bar)[XB_TMO])) break; if (_sp > XB_SPIN_CAP) { atomicAdd(&(bar)[XB_TMO], 1u); break; } } } } while (0)
struct XcdBarrier { unsigned* bar; unsigned x; volatile LAS unsigned* st; };
__device__ __forceinline__ XcdBarrier xcd_barrier_post(unsigned* bar, volatile LAS unsigned* st) {
    XcdBarrier b; b.bar = bar; b.x = xb_xcc_id(); b.st = st;
    if (threadIdx.x == 0) (void)xb_add(&bar[XB_XCNT(b.x)], 1u);
    return b;
}
__device__ __forceinline__ void xcd_barrier_complete(unsigned* bar, unsigned x, unsigned& nloc, unsigned& nx) {
    const unsigned G = gridDim.x * gridDim.y * gridDim.z;
    unsigned sum, cnt, mine, sp = 0u;
    for (;;) {
        sum = 0u; cnt = 0u; mine = 0u;
#pragma unroll
        for (unsigned j = 0; j < 16; ++j) { const unsigned c = xb_ld(&bar[XB_XCNT(j)]); sum += c; cnt += (c > 0u) ? 1u : 0u; mine = (j == x) ? c : mine; }
        if (sum == G) break;
        __builtin_amdgcn_s_sleep(1);
        if ((++sp & 255u) == 0u) { if (xb_ld(&bar[XB_TMO])) break; if (sp > XB_SPIN_CAP) { atomicAdd(&bar[XB_TMO], 1u); break; } }
    }
    nloc = mine > 0u ? mine : 1u; nx = cnt > 0u ? cnt : 1u;
}
__device__ __forceinline__ void xcd_barrier(const XcdBarrier& b) {
    asm volatile("s_waitcnt vmcnt(0)" ::: "memory");
    __syncthreads();
    if (threadIdx.x == 0) {
        unsigned* bar = b.bar;
        __builtin_amdgcn_s_waitcnt(0);
        unsigned nloc = b.st[0], nx = b.st[1];
        if (nloc == 0u) { xcd_barrier_complete(bar, b.x, nloc, nx); b.st[0] = nloc; b.st[1] = nx; }
        const unsigned old = xb_add(&bar[XB_XSUB(b.x)], 1u);
        const unsigned gen = old / nloc;
        if (old + 1u == (gen + 1u) * nloc) {
            __builtin_amdgcn_fence(__ATOMIC_RELEASE, "agent");
            asm volatile("s_waitcnt vmcnt(0)" ::: "memory");
            const unsigned og = xb_add(&bar[XB_TOP], 1u);
            const unsigned tg = og / nx;
            if (og + 1u == (tg + 1u) * nx) xb_add(&bar[XB_TOPGEN], 1u);
            else XB_SPIN(xb_ld(&bar[XB_TOPGEN]) == tg, bar);
            __builtin_amdgcn_fence(__ATOMIC_ACQUIRE, "agent");
            xb_add(&bar[XB_XGEN(b.x)], 1u);
            asm volatile("s_waitcnt vmcnt(0)" ::: "memory");
        } else {
            XB_SPIN(xb_ld(&bar[XB_XGEN(b.x)]) == gen, bar);
            __builtin_amdgcn_fence(__ATOMIC_ACQUIRE, "agent");
            asm volatile("s_waitcnt vmcnt(0)" ::: "memory");
        }
    }
    __syncthreads();
}

__device__ __forceinline__ void xcd_barrier_l(const XcdBarrier& b) {
    asm volatile("s_waitcnt vmcnt(0)" ::: "memory");
    __syncthreads();
    if (threadIdx.x == 0) {
        unsigned* bar = b.bar; unsigned x = b.x;
        asm volatile("" : "+s"(bar), "+s"(x));
        __builtin_amdgcn_s_waitcnt(0);
        const unsigned nloc = b.st[0], nx = b.st[1];
        const unsigned old = xb_add(&bar[XB_XSUB(x)], 1u);
        const unsigned gen = old / nloc;
        if (old + 1u == (gen + 1u) * nloc) {
            __builtin_amdgcn_fence(__ATOMIC_RELEASE, "agent");
            asm volatile("s_waitcnt vmcnt(0)" ::: "memory");
            const unsigned og = xb_add(&bar[XB_TOP], 1u);
            const unsigned tg = og / nx;
            if (og + 1u == (tg + 1u) * nx) xb_add(&bar[XB_TOPGEN], 1u);
            else XB_SPIN(xb_ld(&bar[XB_TOPGEN]) == tg, bar);
            __builtin_amdgcn_fence(__ATOMIC_ACQUIRE, "agent");
            xb_add(&bar[XB_XGEN(x)], 1u);
            asm volatile("s_waitcnt vmcnt(0)" ::: "memory");
        } else {
            XB_SPIN(xb_ld(&bar[XB_XGEN(x)]) == gen, bar);
            __builtin_amdgcn_fence(__ATOMIC_ACQUIRE, "agent");
            asm volatile("s_waitcnt vmcnt(0)" ::: "memory");
        }
    }
    __syncthreads();
}

struct MegaP { const float* in[40]; char* ws; float* out; };
namespace WS {
constexpr size_t al(size_t x) { return (x + 255) & ~(size_t)255; }
constexpr size_t U8 = (size_t)1024 * 4096 * 2;
constexpr size_t BARW = 0;
constexpr size_t WT_IN = BARW + 65536;
constexpr size_t WT_O = WT_IN + al((size_t)NL * PC * DM * 2);
constexpr size_t WT_OUT = WT_O + al((size_t)NL * 4 * DM * MIXW * 2);
constexpr size_t WGU = WT_OUT + al((size_t)NL * DM * DM * 2);
constexpr size_t WDN = WGU + al((size_t)NL * NEXP * 2048 * DM * 2);
constexpr size_t H = WDN + al((size_t)NL * NEXP * DM * DEXP * 2);
constexpr size_t XN = H + al((size_t)T_ * DM * 4);
constexpr size_t PROJ = XN + al((size_t)T_ * DM * 2);
constexpr size_t YCAT = PROJ + al((size_t)T_ * PC * 2);
constexpr size_t MBUF = YCAT + al((size_t)T_ * DM * 2);
constexpr size_t MERGED = MBUF + al((size_t)T_ * DM * 4);
constexpr size_t TOK_E = MERGED + al((size_t)T_ * DM * 2);
constexpr size_t TOK_G = TOK_E + al((size_t)2 * T_ * 4);
constexpr size_t ROW_TOK = TOK_G + al((size_t)2 * T_ * 4);
constexpr size_t ROW_SLOT = ROW_TOK + al((size_t)MAXROWS * 4);
constexpr size_t ROW_GATE = ROW_SLOT + al((size_t)MAXROWS * 4);
constexpr size_t TILE_EXP = ROW_GATE + al((size_t)MAXROWS * 4);
constexpr size_t NRT = TILE_EXP + 1024;
constexpr size_t XG = NRT + 256;
constexpr size_t HMID = XG + al((size_t)MAXROWS * DM * 2);
constexpr size_t YBUF = HMID + al((size_t)MAXROWS * DEXP * 2);
constexpr size_t RW_RB = YBUF + al((size_t)2 * T_ * DM * 4);
constexpr size_t RW_PAB = RW_RB + U8, RW_PAK = RW_PAB + U8, RW_VT = RW_PAK + U8, RW_S0 = RW_VT + U8, RW_UT = RW_S0 + U8, RW_WPF = RW_UT + U8, RW_BTF = RW_WPF + U8;
constexpr size_t RW_G = RW_BTF + U8, RW_BV = RW_G + U8, RW_U0F = RW_BV + U8, RW_KVF = RW_U0F + 2 * U8, RW_GAM = RW_KVF + 2 * U8;
constexpr size_t RT_RB = RW_GAM + 262144, RT_PAK = RT_RB + U8, RT_VT = RT_PAK + U8, RT_S0 = RT_VT + U8, RT_KVT = RT_S0 + U8;
constexpr size_t GL_RB = RT_KVT + 2 * U8, GL_PAK = GL_RB + U8 / 2, GL_VT = GL_PAK + U8 / 2, GL_S0 = GL_VT + U8, GL_KVT = GL_S0 + U8, GL_GAM = GL_KVT + 2 * U8;
constexpr size_t LR_H = GL_GAM + 131072, LR_A = LR_H + (size_t)T_ * 512 * 4, LR_HP = LR_A + (size_t)T_ * 512 * 4;
constexpr size_t END = LR_HP + (size_t)NCH * 512 * 4;
}
constexpr int TBL_OFF = 0, XBW_OFF = 320, PH_OFF = 512;
constexpr int LDS_BYTES = PH_OFF + SHM_B;
__device__ __forceinline__ const float* in_ptr(const char* smem, int i) {
  const unsigned long long v = *(const unsigned long long*)(smem - PH_OFF + TBL_OFF + i * 8);
  const unsigned lo = __builtin_amdgcn_readfirstlane((unsigned)v), hi = __builtin_amdgcn_readfirstlane((unsigned)(v >> 32));
  return (const float*)(((unsigned long long)hi << 32) | lo);
}
template <class T> __device__ __forceinline__ T* wsp(char* ws, size_t off) { return (T*)(ws + off); }
__device__ __forceinline__ int ld_i(const int* p) { return __hip_atomic_load(p, __ATOMIC_RELAXED, __HIP_MEMORY_SCOPE_AGENT); }
#define OPAQUE_WS(w) asm volatile("" : "+s"(w))
__device__ __forceinline__ int bidx() { int b = blockIdx.x; asm volatile("" : "+s"(b)); return b; }
__device__ __forceinline__ int gdim() { int g = gridDim.x; asm volatile("" : "+s"(g)); return g; }

__device__ __forceinline__ void transpose_tile(const float* __restrict__ src, int sld, int nvalid, u16* __restrict__ dst, int K, int n0, int k0, int drow0, int mode, float* tile, int tid) {
  const int tx = tid & 63, ty = tid >> 6;
#pragma unroll
  for (int r = 0; r < 8; ++r) { const int k = k0 + ty + 8 * r, n = n0 + tx; tile[(ty + 8 * r) * 65 + tx] = (n < nvalid) ? src[(long)k * sld + n] : 0.f; }
  __syncthreads();
#pragma unroll
  for (int r = 0; r < 8; ++r) {
    const int n = n0 + ty + 8 * r, k = k0 + tx;
    const int row = (mode == 0) ? drow0 + n : ((n >> 7) * 256 + (mode == 2 ? 128 : 0) + (n & 127));
    dst[(long)row * K + k] = f2bf(tile[tx * 65 + ty + 8 * r]);
  }
  __syncthreads();
}
__device__ __forceinline__ void phase_convert(char* ws, char* smem) {
  OPAQUE_WS(ws); float* tile = (float*)smem; int tid = threadIdx.x; asm volatile("" : "+v"(tid));
  const int G = gridDim.x, b0 = blockIdx.x;
  for (int j = b0; j < 2 * 100 * 32; j += G) { const int l = j / 3200, q = j % 3200, nt = q / 32, kt = q % 32;
    transpose_tile(in_ptr(smem, 3) + (long)l * DM * IN_COLS, IN_COLS, NONGATE, wsp<u16>(ws, WS::WT_IN) + (long)l * PC * DM, DM, nt * 64, kt * 64, 0, 0, tile, tid); }
  for (int j = b0; j < 2 * 128 * 32; j += G) { const int l = j / 4096, q = j % 4096, nt = q / 32, kt = q % 32;
    transpose_tile(in_ptr(smem, 3) + (long)l * DM * IN_COLS + NONGATE, IN_COLS, 8192, wsp<u16>(ws, WS::WT_IN) + (long)l * PC * DM, DM, nt * 64, kt * 64, OFF_G, 0, tile, tid); }
  for (int j = b0; j < 8 * 256; j += G) { const int lk = j / 256, q = j % 256, l = lk >> 2, kb = lk & 3, nt = q / 8, kt = q % 8;
    const float* src = in_ptr(smem, kb == 0 ? 15 : kb == 1 ? 17 : kb == 2 ? 25 : 29) + (long)l * MIXW * DM;
    transpose_tile(src, DM, DM, wsp<u16>(ws, WS::WT_O) + (long)lk * DM * MIXW, MIXW, nt * 64, kt * 64, 0, 0, tile, tid); }
  for (int j = b0; j < 2 * 1024; j += G) { const int l = j / 1024, q = j % 1024, nt = q / 32, kt = q % 32;
    transpose_tile(in_ptr(smem, 30) + (long)l * DM * DM, DM, DM, wsp<u16>(ws, WS::WT_OUT) + (long)l * DM * DM, DM, nt * 64, kt * 64, 0, 0, tile, tid); }
  for (int j = b0; j < 64 * 512; j += G) { const int e = j / 512, q = j % 512, nt = q / 32, kt = q % 32;
    transpose_tile(in_ptr(smem, 36) + (long)e * DM * DEXP, DEXP, DEXP, wsp<u16>(ws, WS::WGU) + (long)e * 2048 * DM, DM, nt * 64, kt * 64, 0, 1, tile, tid); }
  for (int j = b0; j < 64 * 512; j += G) { const int e = j / 512, q = j % 512, nt = q / 32, kt = q % 32;
    transpose_tile(in_ptr(smem, 37) + (long)e * DM * DEXP, DEXP, DEXP, wsp<u16>(ws, WS::WGU) + (long)e * 2048 * DM, DM, nt * 64, kt * 64, 0, 2, tile, tid); }
  for (int j = b0; j < 64 * 512; j += G) { const int e = j / 512, q = j % 512, nt = q / 16, kt = q % 16;
    transpose_tile(in_ptr(smem, 38) + (long)e * DEXP * DM, DM, DM, wsp<u16>(ws, WS::WDN) + (long)e * DM * DEXP, DEXP, nt * 64, kt * 64, 0, 0, tile, tid); }
}

struct NormArgs {
  const float* x; float* h; const float* g; u16* xn; float* out; const float* ybuf;
  const float* wg; const float* bg; const float* we; const float* be; int* tok_e; float* tok_g;
};
template <int MODE>
__device__ __forceinline__ void norm_row(const NormArgs& a, int row, int lane) {
  float v[32];
  const float* src = (MODE == 0) ? a.x : a.h;
#pragma unroll
  for (int i = 0; i < 8; ++i) {
    f32x4 t = *(const f32x4*)(src + (long)row * DM + i * 256 + lane * 4);
    if (MODE == 1 || MODE == 2) {
      f32x4 y0 = *(const f32x4*)(a.ybuf + (long)(2 * row) * DM + i * 256 + lane * 4);
      f32x4 y1 = *(const f32x4*)(a.ybuf + (long)(2 * row + 1) * DM + i * 256 + lane * 4);
      t = t + y0 + y1;
    }
    if (MODE != 3 && MODE != 2) *(f32x4*)(a.h + (long)row * DM + i * 256 + lane * 4) = t;
    v[i * 4 + 0] = t[0]; v[i * 4 + 1] = t[1]; v[i * 4 + 2] = t[2]; v[i * 4 + 3] = t[3];
  }
  float ss = 0.f;
#pragma unroll
  for (int i = 0; i < 32; ++i) ss += v[i] * v[i];
  ss = wave_sum(ss);
  const float rs = rsqrtf(ss * (1.f / DM) + 1e-6f);
#pragma unroll
  for (int i = 0; i < 8; ++i) {
    f32x4 g = *(const f32x4*)(a.g + i * 256 + lane * 4);
#pragma unroll
    for (int j = 0; j < 4; ++j) v[i * 4 + j] = v[i * 4 + j] * rs * g[j];
    if (MODE == 2) {
      f32x4 o = {v[i * 4], v[i * 4 + 1], v[i * 4 + 2], v[i * 4 + 3]};
      *(f32x4*)(a.out + (long)row * DM + i * 256 + lane * 4) = o;
    } else {
      uint2 pk;
      pk.x = (unsigned)f2bf(v[i * 4]) | ((unsigned)f2bf(v[i * 4 + 1]) << 16);
      pk.y = (unsigned)f2bf(v[i * 4 + 2]) | ((unsigned)f2bf(v[i * 4 + 3]) << 16);
      *(uint2*)(a.xn + (long)row * DM + i * 256 + lane * 4) = pk;
    }
  }
  if (MODE == 3) {
    float tot = 0.f;
    {
      float p[20];
#pragma unroll
      for (int c = 0; c < 20; ++c) p[c] = 0.f;
#pragma unroll
      for (int i = 0; i < 8; ++i) {
#pragma unroll
        for (int j = 0; j < 4; ++j) {
          const int e = i * 256 + lane * 4 + j; const float xv = v[i * 4 + j];
          f32x4 wg = *(const f32x4*)(a.wg + (long)e * 4);
#pragma unroll
          for (int c = 0; c < 4; ++c) p[c] += xv * wg[c];
#pragma unroll
          for (int q = 0; q < 4; ++q) { f32x4 we = *(const f32x4*)(a.we + (long)e * 32 + q * 4);
#pragma unroll
            for (int c = 0; c < 4; ++c) p[4 + q * 4 + c] += xv * we[c]; }
        }
        asm volatile("" ::: "memory");
      }
#pragma unroll
      for (int c = 0; c < 20; ++c) { const float t = wave_sum(p[c]); tot = (lane == c) ? t : tot; }
    }
    {
      float p[16];
#pragma unroll
      for (int c = 0; c < 16; ++c) p[c] = 0.f;
#pragma unroll
      for (int i = 0; i < 8; ++i) {
#pragma unroll
        for (int j = 0; j < 4; ++j) {
          const int e = i * 256 + lane * 4 + j; const float xv = v[i * 4 + j];
#pragma unroll
          for (int q = 0; q < 4; ++q) { f32x4 we = *(const f32x4*)(a.we + (long)e * 32 + 16 + q * 4);
#pragma unroll
            for (int c = 0; c < 4; ++c) p[q * 4 + c] += xv * we[c]; }
        }
        asm volatile("" ::: "memory");
      }
#pragma unroll
      for (int c = 0; c < 16; ++c) { const float t = wave_sum(p[c]); tot = (lane == 20 + c) ? t : tot; }
    }
#define RL(c) __int_as_float(__builtin_amdgcn_readlane(__float_as_int(tot), (c)))
    float lg[4];
#pragma unroll
    for (int c = 0; c < 4; ++c) lg[c] = RL(c) + a.bg[c];
    int gi = 0; float gm = lg[0];
#pragma unroll
    for (int c = 1; c < 4; ++c) if (lg[c] > gm) { gm = lg[c]; gi = c; }
    float gs = 0.f;
#pragma unroll
    for (int c = 0; c < 4; ++c) gs += __expf(lg[c] - gm);
    const float pg = 1.f / gs;
    float le[8];
#pragma unroll
    for (int j = 0; j < 8; ++j) {
      float l0 = RL(4 + j) + a.be[j], l1 = RL(12 + j) + a.be[8 + j], l2 = RL(20 + j) + a.be[16 + j], l3 = RL(28 + j) + a.be[24 + j];
      le[j] = gi == 0 ? l0 : (gi == 1 ? l1 : (gi == 2 ? l2 : l3));
    }
    int i1 = 0; float m1 = le[0];
#pragma unroll
    for (int j = 1; j < 8; ++j) if (le[j] > m1) { m1 = le[j]; i1 = j; }
    int i2 = -1; float m2 = -3.0e38f;
#pragma unroll
    for (int j = 0; j < 8; ++j) if (j != i1 && le[j] > m2) { m2 = le[j]; i2 = j; }
    const float w1 = 1.f / (1.f + __expf(m2 - m1)), w2 = 1.f - w1;
    if (lane == 0) {
      a.tok_e[2 * row] = gi * 8 + i1; a.tok_e[2 * row + 1] = gi * 8 + i2;
      a.tok_g[2 * row] = pg * w1; a.tok_g[2 * row + 1] = pg * w2;
    }
#undef RL
  }
}
template <int MODE>
__device__ __forceinline__ void phase_norm(const NormArgs& a) {
  int tid = threadIdx.x; asm volatile("" : "+v"(tid));
  const int lane = tid & 63;
  for (int row = blockIdx.x * 8 + (tid >> 6); row < T_; row += gridDim.x * 8) norm_row<MODE>(a, row, lane);
}

__device__ __forceinline__ void phase_route(char* ws, char* smem) {
  if (blockIdx.x != 0) return;
  OPAQUE_WS(ws);
  const int* tok_e = wsp<int>(ws, WS::TOK_E); const float* tok_g = wsp<float>(ws, WS::TOK_G);
  int* row_tok = wsp<int>(ws, WS::ROW_TOK); int* row_slot = wsp<int>(ws, WS::ROW_SLOT); float* row_gate = wsp<float>(ws, WS::ROW_GATE);
  int* tile_exp = wsp<int>(ws, WS::TILE_EXP); int* nrt = wsp<int>(ws, WS::NRT);
  int* cnt = (int*)smem; int* pstart = cnt + 32; int* fill = pstart + 32;
  int tid = threadIdx.x; asm volatile("" : "+v"(tid));
  if (tid < 32) { cnt[tid] = 0; fill[tid] = 0; }
  __syncthreads();
  for (int i = tid; i < 2 * T_; i += 512) atomicAdd(&cnt[ld_i(tok_e + i)], 1);
  __syncthreads();
  if (tid < 32) {
    int acc = 0;
#pragma unroll 1
    for (int e2 = 0; e2 < tid; ++e2) acc += (cnt[e2] + 255) >> 8;
    const int nt = (cnt[tid] + 255) >> 8;
    pstart[tid] = acc * 256;
#pragma unroll 1
    for (int j = 0; j < nt; ++j) tile_exp[acc + j] = tid;
    if (tid == 31) nrt[0] = acc + nt;
  }
  for (int i = tid; i < MAXROWS; i += 512) { row_tok[i] = -1; row_slot[i] = -1; row_gate[i] = 0.f; }
  __syncthreads();
  for (int i = tid; i < 2 * T_; i += 512) {
    int e = ld_i(tok_e + i); int pos = atomicAdd(&fill[e], 1); int dest = pstart[e] + pos;
    row_tok[dest] = i >> 1; row_slot[dest] = i; row_gate[dest] = tok_g[i];
  }
}
__device__ __forceinline__ void phase_gather(char* ws) {
  OPAQUE_WS(ws);
  int tid = threadIdx.x; asm volatile("" : "+v"(tid));
  const int* row_tok = wsp<int>(ws, WS::ROW_TOK); const u16* xn = wsp<u16>(ws, WS::XN); u16* xg = wsp<u16>(ws, WS::XG);
  const int lane = tid & 63, nrows = ld_i(wsp<int>(ws, WS::NRT)) * 256;
  for (int row = blockIdx.x * 8 + (tid >> 6); row < nrows; row += gridDim.x * 8) {
    const int tok = row_tok[row];
#pragma unroll
    for (int i = 0; i < 4; ++i) {
      uint4 v = make_uint4(0, 0, 0, 0);
      if (tok >= 0) v = *(const uint4*)(xn + (long)tok * DM + i * 512 + lane * 8);
      *(uint4*)(xg + (long)row * DM + i * 512 + lane * 8) = v;
    }
  }
}

template <int MODE>
__device__ __forceinline__ void phase_gemm(char* ws, int l, u16* shm) {
  OPAQUE_WS(ws);
  if (MODE == 0) {
    const u16* Bt = wsp<u16>(ws, WS::WT_IN) + (long)l * PC * DM; const u16* xn = wsp<u16>(ws, WS::XN); u16* proj = wsp<u16>(ws, WS::PROJ);
#pragma unroll 1
    for (int u = blockIdx.x; u < ((PC / 256 + 7) / 8) * 256; u += gridDim.x) {
      int pm, pn; unit_map(u & 255, u >> 8, pm, pn);
      if (pn >= PC / 256) continue;
      EpiProj e{proj, pm * 256, pn * 256};
      gemm256(xn + (long)pm * 256 * DM, DM, Bt + (long)pn * 256 * DM, DM, DM, shm, e);
    }
  } else if (MODE == 1) {
    const u16* Bt = wsp<u16>(ws, WS::WT_O) + (long)l * 4 * DM * MIXW; const u16* ycat = wsp<u16>(ws, WS::YCAT);
#pragma unroll 1
    for (int u = blockIdx.x; u < 256; u += gridDim.x) {
      int pm, pn; unit_map(u, 0, pm, pn);
#pragma unroll 1
      for (int kb = 0; kb < 4; ++kb) {
        EpiMerge e{wsp<u16>(ws, WS::PROJ), wsp<float>(ws, WS::MBUF), wsp<u16>(ws, WS::MERGED), kb, pm * 256, pn * 256};
        gemm256(ycat + (long)pm * 256 * DM + kb * MIXW, DM, Bt + ((long)kb * DM + pn * 256) * MIXW, MIXW, MIXW, shm, e);
      }
    }
  } else if (MODE == 2) {
    const u16* Bt = wsp<u16>(ws, WS::WT_OUT) + (long)l * DM * DM; const u16* merged = wsp<u16>(ws, WS::MERGED);
#pragma unroll 1
    for (int u = blockIdx.x; u < 256; u += gridDim.x) {
      int pm, pn; unit_map(u, 0, pm, pn);
      EpiResid e{wsp<float>(ws, WS::H), pm * 256, pn * 256};
      gemm256(merged + (long)pm * 256 * DM, DM, Bt + (long)pn * 256 * DM, DM, DM, shm, e);
    }
  } else if (MODE == 3) {
    const int nu = ld_i(wsp<int>(ws, WS::NRT)) * 8; const u16* Bt = wsp<u16>(ws, WS::WGU) + (long)l * NEXP * 2048 * DM; const u16* xg = wsp<u16>(ws, WS::XG);
#pragma unroll 1
    for (int u = blockIdx.x; u < nu; u += gridDim.x) {
      const int rt = u >> 3, ct = u & 7, ex = ld_i(wsp<int>(ws, WS::TILE_EXP) + rt);
      EpiGateUp e{wsp<u16>(ws, WS::HMID), rt * 256, ct};
      gemm256(xg + (long)rt * 256 * DM, DM, Bt + ((long)ex * 2048 + ct * 256) * DM, DM, DM, shm, e);
    }
  } else {
    const int nu = ld_i(wsp<int>(ws, WS::NRT)) * 8; const u16* Bt = wsp<u16>(ws, WS::WDN) + (long)l * NEXP * DM * DEXP; const u16* hmid = wsp<u16>(ws, WS::HMID);
#pragma unroll 1
    for (int u = blockIdx.x; u < nu; u += gridDim.x) {
      const int rt = u >> 3, ct = u & 7, ex = ld_i(wsp<int>(ws, WS::TILE_EXP) + rt);
      EpiDown e{wsp<float>(ws, WS::YBUF), wsp<int>(ws, WS::ROW_SLOT), wsp<float>(ws, WS::ROW_GATE), rt * 256, ct * 256};
      gemm256(hmid + (long)rt * 256 * DEXP, DEXP, Bt + ((long)ex * DM + ct * 256) * DEXP, DEXP, DEXP, shm, e);
    }
  }
}

__device__ __forceinline__ MixP make_mixp(char* ws, const char* smem, int l) {
  OPAQUE_WS(ws); asm volatile("" : "+s"(l));
  MixP mp;
  mp.proj = wsp<u16>(ws, WS::PROJ); mp.pos = (const int*)in_ptr(smem, 1); mp.ycat = wsp<u16>(ws, WS::YCAT);
  MixBuf& b = mp.b;
  b.rw_Rb = wsp<u16>(ws, WS::RW_RB); b.rw_Pab = wsp<u16>(ws, WS::RW_PAB); b.rw_Pak = wsp<u16>(ws, WS::RW_PAK); b.rw_VT = wsp<u16>(ws, WS::RW_VT); b.rw_S0 = wsp<u16>(ws, WS::RW_S0); b.rw_UT = wsp<u16>(ws, WS::RW_UT);
  b.rw_WpF = wsp<u16>(ws, WS::RW_WPF); b.rw_BtF = wsp<u16>(ws, WS::RW_BTF); b.rw_G = wsp<u16>(ws, WS::RW_G); b.rw_BV = wsp<u16>(ws, WS::RW_BV);
  b.rw_U0F = wsp<float>(ws, WS::RW_U0F); b.rw_KVF = wsp<float>(ws, WS::RW_KVF); b.rw_gam = wsp<float>(ws, WS::RW_GAM);
  b.rt_Rb = wsp<u16>(ws, WS::RT_RB); b.rt_Pak = wsp<u16>(ws, WS::RT_PAK); b.rt_VT = wsp<u16>(ws, WS::RT_VT); b.rt_S0 = wsp<u16>(ws, WS::RT_S0); b.rt_KVT = wsp<float>(ws, WS::RT_KVT);
  b.gl_Rb = wsp<u16>(ws, WS::GL_RB); b.gl_Pak = wsp<u16>(ws, WS::GL_PAK); b.gl_VT = wsp<u16>(ws, WS::GL_VT); b.gl_S0 = wsp<u16>(ws, WS::GL_S0); b.gl_KVT = wsp<float>(ws, WS::GL_KVT); b.gl_gam = wsp<float>(ws, WS::GL_GAM);
  b.lr_h = wsp<float>(ws, WS::LR_H); b.lr_A = wsp<float>(ws, WS::LR_A); b.lr_Hp = wsp<float>(ws, WS::LR_HP);
  mp.rw = RwkvP{in_ptr(smem, 4) + l * 1696, in_ptr(smem, 5) + l * 512, in_ptr(smem, 6) + l * 32 * 512, in_ptr(smem, 7) + l * 512, in_ptr(smem, 8) + l * 32 * 512, in_ptr(smem, 9) + l * 96 * 512,
                in_ptr(smem, 10) + l * 512, in_ptr(smem, 11) + l * 512, in_ptr(smem, 12) + l * 512, in_ptr(smem, 13) + l * 512, in_ptr(smem, 14) + l * 512};
  mp.ret_norm_g = in_ptr(smem, 16) + l * 512;
  mp.lru = LruP{in_ptr(smem, 18) + l * 4 * 512, in_ptr(smem, 19) + l * 512, in_ptr(smem, 20) + l * 8 * 64 * 64, in_ptr(smem, 21) + l * 512, in_ptr(smem, 22) + l * 8 * 64 * 64, in_ptr(smem, 23) + l * 512, in_ptr(smem, 24) + l * 512};
  mp.gla_alpha_up = in_ptr(smem, 26) + l * 16 * 256; mp.gla_alpha_b = in_ptr(smem, 27) + l * 256; mp.gla_norm_g = in_ptr(smem, 28) + l * 512;
  return mp;
}
constexpr int PH_PER_LAYER = 12, N_PHASES = 1 + NL * PH_PER_LAYER + 1;
#define RUN_PH(id, code) do { const int _id = (id); if (_id >= ph0 && _id < ph1) { code; if (_id + 1 < ph1) xcd_barrier_l(bar); } } while (0)
__global__ __launch_bounds__(512, 2) void k_mega(MegaP p, int ph0, int ph1) {
  extern __shared__ __attribute__((aligned(16))) char smem0[];
  volatile LAS unsigned* xbw = (volatile LAS unsigned*)(smem0 + XBW_OFF);
  char* const smem = smem0 + PH_OFF;
  if (threadIdx.x == 0) {
    xbw[0] = 0u; xbw[1] = 0u; xbw[2] = 0u; xbw[3] = 0u;
    unsigned long long* tbl = (unsigned long long*)(smem0 + TBL_OFF);
#pragma unroll
    for (int i = 0; i < 40; ++i) tbl[i] = (unsigned long long)p.in[i];
  }
  __syncthreads();
  char* ws = p.ws; float* outp = p.out;
  const XcdBarrier bar = xcd_barrier_post((unsigned*)ws, xbw);
  if (ph1 - ph0 > 1) xcd_barrier(bar);
  RUN_PH(0, { phase_convert(ws, smem); NormArgs a{}; a.x = in_ptr(smem, 0); a.h = wsp<float>(ws, WS::H); a.g = in_ptr(smem, 2); a.xn = wsp<u16>(ws, WS::XN); phase_norm<0>(a); });
#pragma unroll 1
  for (int l = 0; l < NL; ++l) {
    const int pb = 1 + l * PH_PER_LAYER;
    RUN_PH(pb + 0, { if (l > 0) { NormArgs a{}; a.h = wsp<float>(ws, WS::H); a.g = in_ptr(smem, 2) + (long)l * DM; a.xn = wsp<u16>(ws, WS::XN); a.ybuf = wsp<float>(ws, WS::YBUF); phase_norm<1>(a); } });
    RUN_PH(pb + 1, phase_gemm<0>(ws, l, (u16*)smem));
    RUN_PH(pb + 2, { const MixP mp = make_mixp(ws, smem, l); phase_mix3(mp, smem); });
    RUN_PH(pb + 3, { const MixP mp = make_mixp(ws, smem, l); phase_mix4(mp, smem); });
    RUN_PH(pb + 4, { const MixP mp = make_mixp(ws, smem, l); phase_mix5(mp); });
    RUN_PH(pb + 5, phase_gemm<1>(ws, l, (u16*)smem));
    RUN_PH(pb + 6, phase_gemm<2>(ws, l, (u16*)smem));
    RUN_PH(pb + 7, { NormArgs a{}; a.h = wsp<float>(ws, WS::H); a.g = in_ptr(smem, 31) + (long)l * DM; a.xn = wsp<u16>(ws, WS::XN); a.wg = in_ptr(smem, 32) + (long)l * DM * 4; a.bg = in_ptr(smem, 33) + l * 4;
      a.we = in_ptr(smem, 34) + (long)l * DM * 32; a.be = in_ptr(smem, 35) + l * 32; a.tok_e = wsp<int>(ws, WS::TOK_E); a.tok_g = wsp<float>(ws, WS::TOK_G); phase_norm<3>(a); });
    RUN_PH(pb + 8, phase_route(ws, smem));
    RUN_PH(pb + 9, phase_gather(ws));
    RUN_PH(pb + 10, phase_gemm<3>(ws, l, (u16*)smem));
    RUN_PH(pb + 11, phase_gemm<4>(ws, l, (u16*)smem));
  }
  RUN_PH(N_PHASES - 1, { NormArgs a{}; a.h = wsp<float>(ws, WS::H); a.g = in_ptr(smem, 39); a.out = outp; a.ybuf = wsp<float>(ws, WS::YBUF); phase_norm<2>(a); });
}


template <int MODE>
__global__ __launch_bounds__(256) void k_norm(NormArgs a) {
  const int row = blockIdx.x * 4 + (threadIdx.x >> 6), lane = threadIdx.x & 63;
  float v[32];
  const float* src = (MODE == 0) ? a.x : a.h;
#pragma unroll
  for (int i = 0; i < 8; ++i) {
    f32x4 t = *(const f32x4*)(src + (long)row * DM + i * 256 + lane * 4);
    if (MODE == 1 || MODE == 2) {
      f32x4 y0 = *(const f32x4*)(a.ybuf + (long)(2 * row) * DM + i * 256 + lane * 4);
      f32x4 y1 = *(const f32x4*)(a.ybuf + (long)(2 * row + 1) * DM + i * 256 + lane * 4);
      t = t + y0 + y1;
    }
    if (MODE != 3 && MODE != 2) *(f32x4*)(a.h + (long)row * DM + i * 256 + lane * 4) = t;
    v[i * 4 + 0] = t[0]; v[i * 4 + 1] = t[1]; v[i * 4 + 2] = t[2]; v[i * 4 + 3] = t[3];
  }
  float ss = 0.f;
#pragma unroll
  for (int i = 0; i < 32; ++i) ss += v[i] * v[i];
  ss = wave_sum(ss);
  const float rs = rsqrtf(ss * (1.f / DM) + 1e-6f);
#pragma unroll
  for (int i = 0; i < 8; ++i) {
    f32x4 g = *(const f32x4*)(a.g + i * 256 + lane * 4);
#pragma unroll
    for (int j = 0; j < 4; ++j) v[i * 4 + j] = v[i * 4 + j] * rs * g[j];
    if (MODE == 2) {
      f32x4 o = {v[i * 4], v[i * 4 + 1], v[i * 4 + 2], v[i * 4 + 3]};
      *(f32x4*)(a.out + (long)row * DM + i * 256 + lane * 4) = o;
    } else {
      uint2 pk;
      pk.x = (unsigned)f2bf(v[i * 4]) | ((unsigned)f2bf(v[i * 4 + 1]) << 16);
      pk.y = (unsigned)f2bf(v[i * 4 + 2]) | ((unsigned)f2bf(v[i * 4 + 3]) << 16);
      *(uint2*)(a.xn + (long)row * DM + i * 256 + lane * 4) = pk;
    }
  }
  if (MODE == 3) {
    float p[36];
#pragma unroll
    for (int c = 0; c < 36; ++c) p[c] = 0.f;
#pragma unroll
    for (int i = 0; i < 8; ++i) {
#pragma unroll
      for (int j = 0; j < 4; ++j) {
        const int e = i * 256 + lane * 4 + j;
        const float xv = v[i * 4 + j];
        f32x4 wg = *(const f32x4*)(a.wg + (long)e * 4);
#pragma unroll
        for (int c = 0; c < 4; ++c) p[c] += xv * wg[c];
#pragma unroll
        for (int q = 0; q < 8; ++q) {
          f32x4 we = *(const f32x4*)(a.we + (long)e * 32 + q * 4);
#pragma unroll
          for (int c = 0; c < 4; ++c) p[4 + q * 4 + c] += xv * we[c];
        }
      }
    }
#pragma unroll
    for (int c = 0; c < 36; ++c) p[c] = wave_sum(p[c]);
    if (lane == 0) {
      float lg[4];
#pragma unroll
      for (int c = 0; c < 4; ++c) lg[c] = p[c] + a.bg[c];
      int gi = 0; float gm = lg[0];
#pragma unroll
      for (int c = 1; c < 4; ++c) if (lg[c] > gm) { gm = lg[c]; gi = c; }
      float gs = 0.f;
#pragma unroll
      for (int c = 0; c < 4; ++c) gs += __expf(lg[c] - gm);
      const float pg = 1.f / gs;
      float le[8];
#pragma unroll
      for (int j = 0; j < 8; ++j) {
        float l0 = p[4 + j] + a.be[j], l1 = p[12 + j] + a.be[8 + j], l2 = p[20 + j] + a.be[16 + j], l3 = p[28 + j] + a.be[24 + j];
        le[j] = gi == 0 ? l0 : (gi == 1 ? l1 : (gi == 2 ? l2 : l3));
      }
      int i1 = 0; float m1 = le[0];
#pragma unroll
      for (int j = 1; j < 8; ++j) if (le[j] > m1) { m1 = le[j]; i1 = j; }
      int i2 = -1; float m2 = -3.0e38f;
#pragma unroll
      for (int j = 0; j < 8; ++j) if (j != i1 && le[j] > m2) { m2 = le[j]; i2 = j; }
      const float w1 = 1.f / (1.f + __expf(m2 - m1)), w2 = 1.f - w1;
      a.tok_e[2 * row] = gi * 8 + i1; a.tok_e[2 * row + 1] = gi * 8 + i2;
      a.tok_g[2 * row] = pg * w1; a.tok_g[2 * row + 1] = pg * w2;
    }
  }
}

__global__ __launch_bounds__(1024) void k_moe_route(const int* __restrict__ tok_e, const float* __restrict__ tok_g, int* row_tok, int* row_slot, float* row_gate, int* tile_exp, int* nrt) {
  __shared__ int cnt[32], pstart[32], fill[32];
  const int tid = threadIdx.x;
  if (tid < 32) { cnt[tid] = 0; fill[tid] = 0; }
  __syncthreads();
  for (int i = tid; i < 2 * T_; i += 1024) atomicAdd(&cnt[tok_e[i]], 1);
  __syncthreads();
  if (tid == 0) {
    int acc = 0, rt = 0;
    for (int e = 0; e < 32; ++e) { pstart[e] = acc; int nt = (cnt[e] + 255) / 256; for (int j = 0; j < nt; ++j) tile_exp[rt++] = e; acc += nt * 256; }
    nrt[0] = rt;
  }
  for (int i = tid; i < MAXROWS; i += 1024) { row_tok[i] = -1; row_slot[i] = -1; row_gate[i] = 0.f; }
  __syncthreads();
  for (int i = tid; i < 2 * T_; i += 1024) {
    int e = tok_e[i]; int pos = atomicAdd(&fill[e], 1); int dest = pstart[e] + pos;
    row_tok[dest] = i >> 1; row_slot[dest] = i; row_gate[dest] = tok_g[i];
  }
}
__global__ __launch_bounds__(256) void k_gather(const u16* __restrict__ hn, const int* __restrict__ row_tok, const int* __restrict__ nrt, u16* xg) {
  const int row = blockIdx.x * 4 + (threadIdx.x >> 6), lane = threadIdx.x & 63;
  if (row >= nrt[0] * 256) return;
  const int tok = row_tok[row];
#pragma unroll
  for (int i = 0; i < 4; ++i) {
    uint4 v = make_uint4(0, 0, 0, 0);
    if (tok >= 0) v = *(const uint4*)(hn + (long)tok * DM + i * 512 + lane * 8);
    *(uint4*)(xg + (long)row * DM + i * 512 + lane * 8) = v;
  }
}

extern "C" void kernel_launch(void* const* d_in, const int* in_sizes, int n_in, void* d_out, int out_size, void* d_ws, size_t ws_size, hipStream_t stream) {
  (void)in_sizes; (void)n_in; (void)out_size; (void)ws_size;
  MegaP p{};
  for (int i = 0; i < 40; ++i) p.in[i] = (const float*)d_in[i];
  p.ws = (char*)d_ws; p.out = (float*)d_out;
  static int grid = 0;
  if (!grid) {
    (void)hipFuncSetAttribute((const void*)k_mega, hipFuncAttributeMaxDynamicSharedMemorySize, LDS_BYTES);
    int dev = 0, cus = 0, per_cu = 0;
    (void)hipGetDevice(&dev);
    (void)hipDeviceGetAttribute(&cus, hipDeviceAttributeMultiprocessorCount, dev);
    (void)hipOccupancyMaxActiveBlocksPerMultiprocessor(&per_cu, (const void*)k_mega, 512, LDS_BYTES);
    grid = cus < 256 ? cus : 256;
    if (per_cu < 1) grid = 0;
  }
#ifndef MK_SPLIT
#define MK_SPLIT 0
#endif
  if (grid > 0) {
    if (MK_SPLIT) {
      char* ws = p.ws;
      for (int ph = 0; ph < N_PHASES; ++ph) {
        const int rel = (ph - 1) % PH_PER_LAYER, l = (ph - 1) / PH_PER_LAYER;
        if (ph == 0) { k_mega<<<grid, 512, LDS_BYTES, stream>>>(p, ph, ph + 1); continue; }
        if (0 && ph == N_PHASES - 1) { NormArgs a{}; a.h = (float*)(ws + WS::H); a.g = p.in[39]; a.out = p.out; a.ybuf = (float*)(ws + WS::YBUF); k_norm<2><<<T_ / 4, 256, 0, stream>>>(a); continue; }
        if (0 && rel == 0) { if (l > 0) { NormArgs a{}; a.h = (float*)(ws + WS::H); a.g = p.in[2] + (long)l * DM; a.xn = (u16*)(ws + WS::XN); a.ybuf = (float*)(ws + WS::YBUF); k_norm<1><<<T_ / 4, 256, 0, stream>>>(a); } continue; }
        if (0 && rel == 7) { NormArgs a{}; a.h = (float*)(ws + WS::H); a.g = p.in[31] + (long)l * DM; a.xn = (u16*)(ws + WS::XN); a.wg = p.in[32] + (long)l * DM * 4; a.bg = p.in[33] + l * 4; a.we = p.in[34] + (long)l * DM * 32; a.be = p.in[35] + l * 32;
          a.tok_e = (int*)(ws + WS::TOK_E); a.tok_g = (float*)(ws + WS::TOK_G); k_norm<3><<<T_ / 4, 256, 0, stream>>>(a); continue; }
        if (0 && rel == 8) { k_moe_route<<<1, 1024, 0, stream>>>((int*)(ws + WS::TOK_E), (float*)(ws + WS::TOK_G), (int*)(ws + WS::ROW_TOK), (int*)(ws + WS::ROW_SLOT), (float*)(ws + WS::ROW_GATE), (int*)(ws + WS::TILE_EXP), (int*)(ws + WS::NRT)); continue; }
        if (0 && rel == 9) { k_gather<<<MAXROWS / 4, 256, 0, stream>>>((u16*)(ws + WS::XN), (int*)(ws + WS::ROW_TOK), (int*)(ws + WS::NRT), (u16*)(ws + WS::XG)); continue; }
        k_mega<<<grid, 512, LDS_BYTES, stream>>>(p, ph, ph + 1);
      }
    }
    else { (void)hipMemsetAsync(d_ws, 0, XCD_BAR_WORDS * sizeof(unsigned), stream); k_mega<<<grid, 512, LDS_BYTES, stream>>>(p, 0, N_PHASES); }
  }
}
```

```cpp
#define RWKV_CHUNKED_FLAG true
#define MK_SPLIT 0
#define PROBE_MASK 0
#include <hip/hip_runtime.h>
#include <stdint.h>

#define LAS __attribute__((address_space(3)))
typedef unsigned short u16;
typedef __attribute__((ext_vector_type(8))) short bf16x8;
typedef __attribute__((ext_vector_type(4))) float f32x4;

constexpr int T_ = 8192, DM = 2048, NL = 2, MIXW = 512;
constexpr int IN_COLS = 14512, PC = 14592;
constexpr int OFF_A = 0, OFF_B = 1696, OFF_C = 3744, OFF_D = 4768, OFF_G = 6400, NONGATE = 6320;
constexpr int NEXP = 32, DEXP = 1024;
constexpr int MAXROWS = 24576, MAXRT = 96, LCAP = 8192;

typedef __attribute__((ext_vector_type(2))) float f32x2_t;
typedef __attribute__((ext_vector_type(2))) __bf16 bf16x2_t;
__device__ __forceinline__ unsigned pack_bf16(float lo, float hi) { f32x2_t v = {lo, hi}; return __builtin_bit_cast(unsigned, __builtin_convertvector(v, bf16x2_t)); }
__device__ __forceinline__ u16 f2bf(float f) { return (u16)pack_bf16(f, 0.f); }
__device__ __forceinline__ float bf2f(u16 h) { return __uint_as_float(((unsigned)h) << 16); }
__device__ __forceinline__ float sigmoidf_(float x) { return 1.f / (1.f + __expf(-x)); }
__device__ __forceinline__ float wave_sum(float v) {
#pragma unroll
  for (int o = 32; o > 0; o >>= 1) v += __shfl_xor(v, o, 64);
  return v;
}

constexpr int BKK = 64, HALF = 128, HT = HALF * BKK, SHM_B = 8 * HT * 2;
__device__ __forceinline__ int lds_byte(int r, int c) {
  int st = (r >> 4) * 2 + (c >> 5), rr = r & 15, cc = c & 31, ob = rr * 64 + cc * 2;
  return st * 1024 + (ob ^ (((ob >> 9) & 1) << 5));
}
__device__ __forceinline__ void stage_rc(int b, int& R, int& C) {
  int st = b / 1024, sb = b % 1024, swz = sb ^ (((sb >> 9) & 1) << 5);
  R = (st >> 1) * 16 + swz / 64; C = (st & 1) * 32 + (swz % 64) / 2;
}

template <bool GATHER, class Epi>
__device__ __forceinline__ void gemm256g(const u16* __restrict__ A, int lda, const u16* __restrict__ Bt, int ldb, int K, u16* shm, const Epi& epi, const int (&arow)[4]) {
#define SA(b, h) (shm + ((b) * 2 + (h)) * HT)
#define SB(b, h) (shm + (4 + (b) * 2 + (h)) * HT)
#define STAGE_X(TT, P, BASE, LD, br, kt) do { const u16* _g = (BASE) + (long)(br) * (LD) + (long)(kt) * BKK; \
    _Pragma("unroll") for (int _i = 0; _i < 2; ++_i) { int _b = (TT) * 16 + _i * 8192; int _r, _c; stage_rc(_b, _r, _c); \
      __builtin_amdgcn_global_load_lds((const unsigned*)(_g + (long)_r * (LD) + _c), (unsigned*)((char*)(P) + _b), 16, 0, 0); } } while (0)
#define STAGE_AG(TT, P, br, kt) do { \
    _Pragma("unroll") for (int _i = 0; _i < 2; ++_i) { int _b = (TT) * 16 + _i * 8192; \
      __builtin_amdgcn_global_load_lds((const unsigned*)((const char*)A + (unsigned)(arow[((br) / HALF) * 2 + _i] + (kt) * (BKK * 2))), (unsigned*)((char*)(P) + _b), 16, 0, 0); } } while (0)
#define STAGE_A(P, br, kt) do { if (GATHER) STAGE_AG(tid0, P, br, kt); else STAGE_X(tid0, P, A, lda, br, kt); } while (0)
#define STAGE_B(P, br, kt) STAGE_X(tid0, P, Bt, ldb, br, kt)
#define LDA(dst, b, h) _Pragma("unroll") for (int m = 0; m < 4; ++m) _Pragma("unroll") for (int k = 0; k < 2; ++k) \
    dst[m][k] = *reinterpret_cast<const bf16x8*>((char*)SA(b, h) + lds_byte(wr * 64 + m * 16 + fr, k * 32 + fq * 8))
#define LDB(dst, b, h) _Pragma("unroll") for (int n = 0; n < 2; ++n) _Pragma("unroll") for (int k = 0; k < 2; ++k) \
    dst[n][k] = *reinterpret_cast<const bf16x8*>((char*)SB(b, h) + lds_byte(wc * 32 + n * 16 + fr, k * 32 + fq * 8))
#define MMA(ai, bj, At, Bx) do { __builtin_amdgcn_s_setprio(1); \
    _Pragma("unroll") for (int m = 0; m < 4; ++m) _Pragma("unroll") for (int n = 0; n < 2; ++n) _Pragma("unroll") for (int k = 0; k < 2; ++k) \
      acc[ai][bj][m][n] = __builtin_amdgcn_mfma_f32_16x16x32_bf16(At[m][k], Bx[n][k], acc[ai][bj][m][n], 0, 0, 0); \
    __builtin_amdgcn_s_setprio(0); } while (0)
#define WAIT_V(n) asm volatile("s_waitcnt vmcnt(" #n ")" ::: "memory")
#define WAIT_L(n) asm volatile("s_waitcnt lgkmcnt(" #n ")" ::: "memory")
#define BAR __builtin_amdgcn_s_barrier()
#define SCHED __builtin_amdgcn_sched_barrier(0)
  int tid0 = threadIdx.x; asm volatile("" : "+v"(tid0));
  int wid = tid0 >> 6, lane = tid0 & 63, wr = wid >> 2, wc = wid & 3, fr = lane & 15, fq = lane >> 4;
  f32x4 acc[2][2][4][2] = {};
  bf16x8 At[4][2], B0[2][2], B1[2][2];
  const int nt = K / BKK;
  STAGE_B(SB(0, 0), 0, 0); STAGE_A(SA(0, 0), 0, 0);
  STAGE_B(SB(0, 1), HALF, 0); STAGE_A(SA(0, 1), HALF, 0);
  if (wr == 1) BAR;
  WAIT_V(4); BAR;
  STAGE_B(SB(1, 0), 0, 1); STAGE_A(SA(1, 0), 0, 1); STAGE_B(SB(1, 1), HALF, 1);
  WAIT_V(6); BAR;
  for (int t = 0; t < nt - 2; t += 2) {
    LDB(B0, 0, 0); SCHED; LDA(At, 0, 0); STAGE_A(SA(1, 1), HALF, t + 1);
    WAIT_L(8); BAR; WAIT_L(0); MMA(0, 0, At, B0); BAR; SCHED;
    LDB(B1, 0, 1); STAGE_B(SB(0, 0), 0, t + 2);
    BAR; WAIT_L(0); MMA(0, 1, At, B1); BAR;
    LDA(At, 0, 1); STAGE_A(SA(0, 0), 0, t + 2);
    BAR; WAIT_L(0); MMA(1, 0, At, B0); BAR; SCHED;
    STAGE_B(SB(0, 1), HALF, t + 2);
    WAIT_V(6); BAR; MMA(1, 1, At, B1); BAR;
    LDB(B0, 1, 0); SCHED; LDA(At, 1, 0); STAGE_A(SA(0, 1), HALF, t + 2);
    WAIT_L(8); BAR; WAIT_L(0); MMA(0, 0, At, B0); BAR; SCHED;
    LDB(B1, 1, 1); STAGE_B(SB(1, 0), 0, t + 3);
    BAR; WAIT_L(0); MMA(0, 1, At, B1); BAR;
    LDA(At, 1, 1); STAGE_A(SA(1, 0), 0, t + 3);
    BAR; WAIT_L(0); MMA(1, 0, At, B0); BAR; SCHED;
    STAGE_B(SB(1, 1), HALF, t + 3);
    WAIT_V(6); BAR; MMA(1, 1, At, B1); BAR;
  }
  int tz = threadIdx.x; asm volatile("" : "+v"(tz)); wid = tz >> 6; lane = tz & 63; wr = wid >> 2; wc = wid & 3; fr = lane & 15; fq = lane >> 4;
  { LDB(B0, 0, 0); WAIT_V(0); LDA(At, 0, 0); if (GATHER) STAGE_AG(tz, SA(1, 1), HALF, nt - 1); else STAGE_X(tz, SA(1, 1), A, lda, HALF, nt - 1);
    BAR; WAIT_L(0); MMA(0, 0, At, B0); BAR;
    LDB(B1, 0, 1); BAR; WAIT_L(0); MMA(0, 1, At, B1); BAR;
    LDA(At, 0, 1); WAIT_V(4); BAR; WAIT_L(0); MMA(1, 0, At, B0); MMA(1, 1, At, B1); BAR; }
  { LDB(B0, 1, 0); LDA(At, 1, 0); WAIT_V(2); BAR; WAIT_L(0); MMA(0, 0, At, B0); BAR;
    LDB(B1, 1, 1); WAIT_V(0); BAR; WAIT_L(0); MMA(0, 1, At, B1); BAR;
    LDA(At, 1, 1); BAR; WAIT_L(0); MMA(1, 0, At, B0); MMA(1, 1, At, B1); BAR; }
  if (wr == 0) BAR;
  epi(acc, wr, wc, fr, fq);
  __syncthreads();
#undef SA
#undef SB
}

template <class Epi>
__device__ __forceinline__ void gemm256(const u16* __restrict__ A, int lda, const u16* __restrict__ Bt, int ldb, int K, u16* shm, const Epi& epi) {
  const int dummy[4] = {0, 0, 0, 0};
  gemm256g<false>(A, lda, Bt, ldb, K, shm, epi, dummy);
}
#define UNR _Pragma("unroll")
#define EPI_LOOP UNR for (int ai = 0; ai < 2; ++ai) UNR for (int bj = 0; bj < 2; ++bj) UNR for (int m = 0; m < 4; ++m) UNR for (int n = 0; n < 2; ++n) UNR for (int j = 0; j < 4; ++j)
#define EPI_ROW (ai * HALF + wr * 64 + m * 16 + fq * 4 + j)
#define EPI_COL (bj * HALF + wc * 32 + n * 16 + fr)

struct EpiProj {
  u16* proj; int brow, bcol;
  __device__ __forceinline__ void operator()(const f32x4 (&acc)[2][2][4][2], int wr, int wc, int fr, int fq) const {
    u16* base = proj + (long)(brow + wr * 64 + fq * 4) * PC + bcol + wc * 32 + fr;
    if (bcol >= OFF_G) {
      EPI_LOOP { base[(long)(ai * HALF + m * 16 + j) * PC + bj * HALF + n * 16] = f2bf(sigmoidf_(acc[ai][bj][m][n][j])); }
    } else {
      EPI_LOOP { base[(long)(ai * HALF + m * 16 + j) * PC + bj * HALF + n * 16] = f2bf(acc[ai][bj][m][n][j]); }
    }
  }
};
struct EpiMerge {
  const u16* proj; float* mbuf; u16* merged; int kb, brow, bcol;
  __device__ __forceinline__ void operator()(const f32x4 (&acc)[2][2][4][2], int wr, int wc, int fr, int fq) const {
    EPI_LOOP { int row = brow + EPI_ROW, col = bcol + EPI_COL; long idx = (long)row * DM + col;
      float g = bf2f(proj[(long)row * PC + OFF_G + kb * DM + col]); float v = g * acc[ai][bj][m][n][j];
      if (kb > 0) v += mbuf[idx];
      if (kb < 3) mbuf[idx] = v; else merged[idx] = f2bf(v); }
  }
};
struct EpiResid {
  float* h; int brow, bcol;
  __device__ __forceinline__ void operator()(const f32x4 (&acc)[2][2][4][2], int wr, int wc, int fr, int fq) const {
    EPI_LOOP { int row = brow + EPI_ROW, col = bcol + EPI_COL; long idx = (long)row * DM + col; h[idx] += acc[ai][bj][m][n][j]; }
  }
};
struct EpiGateUp {
  u16* hmid; int brow, ct;
  __device__ __forceinline__ void operator()(const f32x4 (&acc)[2][2][4][2], int wr, int wc, int fr, int fq) const {
    u16* base = hmid + (long)(brow + wr * 64 + fq * 4) * DEXP + ct * 128 + wc * 32 + fr;
    UNR for (int ai = 0; ai < 2; ++ai) UNR for (int m = 0; m < 4; ++m) {
      UNR for (int n = 0; n < 2; ++n) UNR for (int j = 0; j < 4; ++j) {
        float g = acc[ai][0][m][n][j], u = acc[ai][1][m][n][j];
        base[(long)(ai * HALF + m * 16 + j) * DEXP + n * 16] = f2bf(g * sigmoidf_(g) * u); }
      asm volatile("" ::: "memory"); }
  }
};
struct EpiDown {
  float* ybuf; const int* lslot; const float* lgate; int nvalid, bcol;
  __device__ __forceinline__ void operator()(const f32x4 (&acc)[2][2][4][2], int wr, int wc, int fr, int fq) const {
    UNR for (int ai = 0; ai < 2; ++ai) UNR for (int m = 0; m < 4; ++m) UNR for (int j = 0; j < 4; ++j) {
      const int r = ai * HALF + wr * 64 + m * 16 + fq * 4 + j;
      if (r < nvalid) { const int slot = lslot[r]; const float gt = lgate[r];
        UNR for (int bj = 0; bj < 2; ++bj) UNR for (int n = 0; n < 2; ++n) { int col = bcol + EPI_COL; ybuf[(long)slot * DM + col] = gt * acc[ai][bj][m][n][j]; } } }
  }
};

__device__ __forceinline__ void gemm_merge(const u16* __restrict__ A, const u16* __restrict__ Bt, const u16* __restrict__ gates, u16* __restrict__ out, int brow, int bcol, u16* shm) {
#define MA(b, h) (shm + ((b) * 3 + (h)) * HT)
#define MB(b) (shm + ((b) * 3 + 2) * HT)
#define MSTAGE(P, BASE, LD_, br, kt) do { const u16* _g = (BASE) + (long)(br) * (LD_) + (long)(kt) * BKK; \
    _Pragma("unroll") for (int _i = 0; _i < 2; ++_i) { int _b = tid0 * 16 + _i * 8192; int _r, _c; stage_rc(_b, _r, _c); \
      __builtin_amdgcn_global_load_lds((const unsigned*)(_g + (long)_r * (LD_) + _c), (unsigned*)((char*)(P) + _b), 16, 0, 0); } } while (0)
  int tid0 = threadIdx.x; asm volatile("" : "+v"(tid0));
  const int wid = tid0 >> 6, lane = tid0 & 63, wr = wid >> 2, wc = wid & 3, fr = lane & 15, fq = lane >> 4;
  f32x4 acc[2][4][2], R[2][4][2];
#pragma unroll
  for (int ai = 0; ai < 2; ++ai)
#pragma unroll
    for (int m = 0; m < 4; ++m)
#pragma unroll
      for (int n = 0; n < 2; ++n) { acc[ai][m][n] = (f32x4){0.f, 0.f, 0.f, 0.f}; R[ai][m][n] = (f32x4){0.f, 0.f, 0.f, 0.f}; }
  const u16* Ab = A + (long)brow * DM; const u16* Bb = Bt + (long)bcol * DM;
  MSTAGE(MA(0, 0), Ab, DM, 0, 0); MSTAGE(MA(0, 1), Ab, DM, HALF, 0); MSTAGE(MB(0), Bb, DM, 0, 0);
  asm volatile("s_waitcnt vmcnt(0)" ::: "memory"); __syncthreads();
#pragma unroll 1
  for (int q = 0; q < 32; ++q) {
    const int b = q & 1;
    if (q + 1 < 32) { MSTAGE(MA(b ^ 1, 0), Ab, DM, 0, q + 1); MSTAGE(MA(b ^ 1, 1), Ab, DM, HALF, q + 1); MSTAGE(MB(b ^ 1), Bb, DM, 0, q + 1); }
    bf16x8 Bf[2][2], Af[4][2];
#pragma unroll
    for (int n = 0; n < 2; ++n)
#pragma unroll
      for (int k = 0; k < 2; ++k) Bf[n][k] = *reinterpret_cast<const bf16x8*>((char*)MB(b) + lds_byte(wc * 32 + n * 16 + fr, k * 32 + fq * 8));
#pragma unroll
    for (int ai = 0; ai < 2; ++ai) {
#pragma unroll
      for (int m = 0; m < 4; ++m)
#pragma unroll
        for (int k = 0; k < 2; ++k) Af[m][k] = *reinterpret_cast<const bf16x8*>((char*)MA(b, ai) + lds_byte(wr * 64 + m * 16 + fr, k * 32 + fq * 8));
#pragma unroll
      for (int m = 0; m < 4; ++m)
#pragma unroll
        for (int n = 0; n < 2; ++n)
#pragma unroll
          for (int k = 0; k < 2; ++k) acc[ai][m][n] = __builtin_amdgcn_mfma_f32_16x16x32_bf16(Af[m][k], Bf[n][k], acc[ai][m][n], 0, 0, 0);
    }
    if ((q & 7) == 7) {
      const int kb = q >> 3;
      const u16* gp = gates + (long)(brow + wr * 64 + fq * 4) * PC + kb * DM + bcol + wc * 32 + fr;
#pragma unroll
      for (int ai = 0; ai < 2; ++ai)
#pragma unroll
        for (int m = 0; m < 4; ++m) {
          u16 g16[2][4];
#pragma unroll
          for (int n = 0; n < 2; ++n)
#pragma unroll
            for (int j = 0; j < 4; ++j) g16[n][j] = gp[(long)(ai * HALF + m * 16 + j) * PC + n * 16];
#pragma unroll
          for (int n = 0; n < 2; ++n)
#pragma unroll
            for (int j = 0; j < 4; ++j) { R[ai][m][n][j] += bf2f(g16[n][j]) * acc[ai][m][n][j]; acc[ai][m][n][j] = 0.f; }
        }
    }
    asm volatile("s_waitcnt vmcnt(0)" ::: "memory"); __syncthreads();
  }
  u16* op = out + (long)(brow + wr * 64 + fq * 4) * DM + bcol + wc * 32 + fr;
#pragma unroll
  for (int ai = 0; ai < 2; ++ai)
#pragma unroll
    for (int m = 0; m < 4; ++m)
#pragma unroll
      for (int n = 0; n < 2; ++n)
#pragma unroll
        for (int j = 0; j < 4; ++j) op[(long)(ai * HALF + m * 16 + j) * DM + n * 16] = f2bf(R[ai][m][n][j]);
#undef MA
#undef MB
#undef MSTAGE
}
__device__ __forceinline__ void unit_map(int b, int round, int& pm, int& pn) {
  int xcd = b & 7, i = b >> 3, pr = xcd >> 1, pc = xcd & 1, lr = i & 7, lc = i >> 3;
  pm = pr * 8 + lr; pn = round * 8 + pc * 4 + lc;
}
constexpr int CH = 64, NCH = T_ / CH;
constexpr int LD = 72;

struct RwkvP { const float *mu, *w0, *w_up, *a0, *a_up, *g_up, *k_k, *k_a, *r_k, *ln_g, *ln_b; };
struct LruP { const float *conv_w, *conv_b, *w_a, *b_a, *w_x, *b_x, *lam; };
struct MixBuf {
  u16 *rw_Rb, *rw_Pab, *rw_Pak, *rw_VT, *rw_S0, *rw_UT, *rw_WpF, *rw_BtF, *rw_G, *rw_BV; float *rw_U0F, *rw_KVF, *rw_gam;
  u16 *rt_Rb, *rt_Pak, *rt_VT, *rt_S0; float* rt_KVT;
  u16 *gl_Rb, *gl_Pak, *gl_VT, *gl_S0; float *gl_KVT, *gl_gam;
  float *lr_h, *lr_A, *lr_Hp;
};
struct MixP {
  const u16* proj; const int* pos; u16* ycat; MixBuf b;
  RwkvP rw; const float* ret_norm_g; LruP lru; const float *gla_alpha_up, *gla_alpha_b, *gla_norm_g;
};

__device__ __forceinline__ float gelu_tanh(float x) {
  const float u = 0.7978845608028654f * (x + 0.044715f * x * x * x);
  return 0.5f * x * (1.f + tanhf(u));
}
__device__ __forceinline__ float red16(float v) {
  v += __shfl_xor(v, 1, 64); v += __shfl_xor(v, 2, 64); v += __shfl_xor(v, 4, 64); v += __shfl_xor(v, 8, 64);
  return v;
}
__device__ __forceinline__ uint4 pack8(const u16 (&a)[8]) {
  uint4 r;
  r.x = (unsigned)a[0] | ((unsigned)a[1] << 16); r.y = (unsigned)a[2] | ((unsigned)a[3] << 16);
  r.z = (unsigned)a[4] | ((unsigned)a[5] << 16); r.w = (unsigned)a[6] | ((unsigned)a[7] << 16);
  return r;
}
__device__ __forceinline__ f32x4 tile_nt(const u16* sA, const u16* sB, int mt, int nt, int r, int g) {
  f32x4 c = {0.f, 0.f, 0.f, 0.f};
#pragma unroll
  for (int s = 0; s < 2; ++s) {
    bf16x8 a = *(const bf16x8*)(sA + (16 * mt + r) * LD + 32 * s + 8 * g);
    bf16x8 b = *(const bf16x8*)(sB + (16 * nt + r) * LD + 32 * s + 8 * g);
    c = __builtin_amdgcn_mfma_f32_16x16x32_bf16(a, b, c, 0, 0, 0);
  }
  return c;
}
__device__ __forceinline__ void copy_out(const u16* s, u16* gp, int rows, int tid) {
  for (int idx = tid; idx < rows * 8; idx += 512) { int row = idx >> 3, seg = idx & 7; *(uint4*)(gp + row * 64 + seg * 8) = *(const uint4*)(s + row * LD + seg * 8); }
}
__device__ __forceinline__ void inv_perm(int x, int& s, int& g, int& j) { s = x >> 5; int rr = x & 31; g = (rr >> 2) & 3; j = 4 * (rr >> 4) + (rr & 3); }

__device__ __forceinline__ void p3_ret(const MixP& p, int c, int h, char* smem) {
  u16* sRb = (u16*)smem; u16* sKb = sRb + 64 * LD; u16* sKtT = sKb + 64 * LD; u16* sVT = sKtT + 64 * LD;
  int tid = threadIdx.x; asm volatile("" : "+v"(tid));
  const int cc = tid & 63, tg = tid >> 6, r = cc & 15, g = cc >> 4, uid = c * 8 + h;
  const float lg2 = log2f(1.f - exp2f(-(5.f + 4.f * (float)h / 7.f)));
  const float inv = exp2f(-(float)(cc & 31) * (13.287712379549449f / 32.f));
  u16 kt8[8], v8[8];
#pragma unroll
  for (int i = 0; i < 8; ++i) {
    const int tl = tg * 8 + i, t = c * 64 + tl; const u16* row = p.proj + (long)t * PC + OFF_B;
    const float q = bf2f(row[h * 64 + cc]), k = bf2f(row[512 + h * 64 + cc]);
    float sn, cs; sincosf((float)p.pos[t] * inv, &sn, &cs);
    const float qo = __shfl_xor(q, 32, 64), ko = __shfl_xor(k, 32, 64);
    const float qr = cc < 32 ? q * cs - qo * sn : q * cs + qo * sn;
    const float kr = (cc < 32 ? k * cs - ko * sn : k * cs + ko * sn) * 0.125f;
    const float e = exp2f(lg2 * (float)(tl + 1)), ei = exp2f(-lg2 * (float)(tl + 1)), et = exp2f(lg2 * (float)(63 - tl));
    sRb[tl * LD + cc] = f2bf(qr * e); sKb[tl * LD + cc] = f2bf(kr * ei); kt8[i] = f2bf(kr * et); v8[i] = row[1024 + h * 64 + cc];
  }
  *(uint4*)(sKtT + cc * LD + tg * 8) = pack8(kt8); *(uint4*)(sVT + cc * LD + tg * 8) = pack8(v8);
  __syncthreads();
  for (int tile = tg; tile < 32; tile += 8) {
    if (tile < 16) {
      const int mt = tile >> 2, nt = tile & 3; f32x4 c4 = tile_nt(sRb, sKb, mt, nt, r, g);
#pragma unroll
      for (int reg = 0; reg < 4; ++reg) { int t = 16 * mt + 4 * g + reg, i = 16 * nt + r; p.b.rt_Pak[(long)uid * 4096 + t * 64 + i] = f2bf(i <= t ? c4[reg] : 0.f); }
    } else {
      const int q = tile - 16, mt = q >> 2, nt = q & 3; f32x4 c4 = tile_nt(sVT, sKtT, mt, nt, r, g);
#pragma unroll
      for (int reg = 0; reg < 4; ++reg) { int v = 16 * mt + 4 * g + reg, k = 16 * nt + r; p.b.rt_KVT[(long)uid * 4096 + v * 64 + k] = c4[reg]; }
    }
  }
  copy_out(sRb, p.b.rt_Rb + (long)uid * 4096, 64, tid); copy_out(sVT, p.b.rt_VT + (long)uid * 4096, 64, tid);
  __syncthreads();
}

__device__ __forceinline__ void p3_gla(const MixP& p, int c, int h, char* smem) {
  u16* sRb = (u16*)smem; u16* sKb = sRb + 64 * LD; u16* sKtT = sKb + 64 * LD; u16* sVT = sKtT + 64 * LD;
  float* pre = (float*)(smem + 5 * 64 * LD * 2); float* sal = pre + 512;
  int tid = threadIdx.x; asm volatile("" : "+v"(tid));
  const int cc = tid & 63, tg = tid >> 6, r = cc & 15, g = cc >> 4, uid = c * 4 + h, hd = h * 64 + cc;
  for (int idx = tid; idx < 1024; idx += 512) { int tl = idx >> 4, j = idx & 15; sal[idx] = bf2f(p.proj[(long)(c * 64 + tl) * PC + OFF_D + 1024 + j]); }
  __syncthreads();
  float au[16];
#pragma unroll
  for (int j = 0; j < 16; ++j) au[j] = p.gla_alpha_up[j * 256 + hd];
  const float ab = p.gla_alpha_b[hd];
  float cum[8]; float run = 0.f;
#pragma unroll
  for (int i = 0; i < 8; ++i) {
    const int tl = tg * 8 + i; float x = ab;
#pragma unroll
    for (int j = 0; j < 16; ++j) x += sal[tl * 16 + j] * au[j];
    const float ls = fminf(x, 0.f) - __logf(1.f + __expf(-fabsf(x)));
    run += ls * (1.f / 16.f); cum[i] = run;
  }
  pre[tg * 64 + cc] = run;
  __syncthreads();
  float off = 0.f, tot = 0.f;
#pragma unroll
  for (int q = 0; q < 8; ++q) { float v = pre[q * 64 + cc]; tot += v; if (q < tg) off += v; }
  u16 kt8[8], v8a[8], v8b[8];
#pragma unroll
  for (int i = 0; i < 8; ++i) {
    const int tl = tg * 8 + i, t = c * 64 + tl; const u16* row = p.proj + (long)t * PC + OFF_D;
    const float cm = cum[i] + off;
    const float q = bf2f(row[hd]) * 0.125f, k = bf2f(row[256 + hd]);
    sRb[tl * LD + cc] = f2bf(q * __expf(cm)); sKb[tl * LD + cc] = f2bf(k * __expf(-cm)); kt8[i] = f2bf(k * __expf(tot - cm));
    v8a[i] = row[512 + h * 128 + cc]; v8b[i] = row[512 + h * 128 + 64 + cc];
  }
  *(uint4*)(sKtT + cc * LD + tg * 8) = pack8(kt8); *(uint4*)(sVT + cc * LD + tg * 8) = pack8(v8a); *(uint4*)(sVT + (64 + cc) * LD + tg * 8) = pack8(v8b);
  if (tg == 0) p.b.gl_gam[uid * 64 + cc] = __expf(tot);
  __syncthreads();
  for (int tile = tg; tile < 48; tile += 8) {
    if (tile < 16) {
      const int mt = tile >> 2, nt = tile & 3; f32x4 c4 = tile_nt(sRb, sKb, mt, nt, r, g);
#pragma unroll
      for (int reg = 0; reg < 4; ++reg) { int t = 16 * mt + 4 * g + reg, i = 16 * nt + r; p.b.gl_Pak[(long)uid * 4096 + t * 64 + i] = f2bf(i <= t ? c4[reg] : 0.f); }
    } else {
      const int q = tile - 16, mt = q >> 2, nt = q & 3; f32x4 c4 = tile_nt(sVT, sKtT, mt, nt, r, g);
#pragma unroll
      for (int reg = 0; reg < 4; ++reg) { int v = 16 * mt + 4 * g + reg, k = 16 * nt + r; p.b.gl_KVT[(long)uid * 8192 + v * 64 + k] = c4[reg]; }
    }
  }
  copy_out(sRb, p.b.gl_Rb + (long)uid * 4096, 64, tid); copy_out(sVT, p.b.gl_VT + (long)uid * 8192, 128, tid);
  __syncthreads();
}

__device__ __forceinline__ void p3_lru(const MixP& p, int c, int gq, char* smem) {
  float* sxc = (float*)smem; float* preA = sxc + 4096; float* preB = preA + 512;
  int tid = threadIdx.x; asm volatile("" : "+v"(tid));
  const int cc = tid & 63, tg = tid >> 6, ch = gq * 64 + cc, t0 = c * 64 + tg * 8;
  {
    f32x4 wr4[4];
#pragma unroll
    for (int q = 0; q < 4; ++q) { const int idx = tid + 512 * q; const float* src = idx < 1024 ? p.lru.w_a + (long)gq * 4096 + idx * 4 : p.lru.w_x + (long)gq * 4096 + (idx - 1024) * 4; wr4[q] = *(const f32x4*)src; }
#pragma unroll
    for (int q = 0; q < 4; ++q) { const int idx = tid + 512 * q; *(f32x4*)(sxc + 5120 + idx * 4) = wr4[q]; }
  }
  float xb[11];
#pragma unroll
  for (int i = 0; i < 11; ++i) { int t = t0 - 3 + i; xb[i] = t >= 0 ? bf2f(p.proj[(long)t * PC + OFF_C + ch]) : 0.f; }
  const float cw0 = p.lru.conv_w[ch], cw1 = p.lru.conv_w[512 + ch], cw2 = p.lru.conv_w[1024 + ch], cw3 = p.lru.conv_w[1536 + ch], cb = p.lru.conv_b[ch];
  float xc[8];
#pragma unroll
  for (int i = 0; i < 8; ++i) { xc[i] = cb + cw0 * xb[i] + cw1 * xb[i + 1] + cw2 * xb[i + 2] + cw3 * xb[i + 3]; sxc[(tg * 8 + i) * 64 + cc] = xc[i]; }
  __syncthreads();
  float ra[8], ix[8];
  const float ba = p.lru.b_a[ch], bx = p.lru.b_x[ch];
#pragma unroll
  for (int i = 0; i < 8; ++i) { ra[i] = ba; ix[i] = bx; }
  const float* wa = sxc + 5120 + cc; const float* wx = wa + 4096;
#pragma unroll 2
  for (int ii = 0; ii < 64; ii += 4) {
    float a0 = wa[(ii + 0) * 64], a1 = wa[(ii + 1) * 64], a2 = wa[(ii + 2) * 64], a3 = wa[(ii + 3) * 64];
    float x0 = wx[(ii + 0) * 64], x1 = wx[(ii + 1) * 64], x2 = wx[(ii + 2) * 64], x3 = wx[(ii + 3) * 64];
#pragma unroll
    for (int i = 0; i < 8; ++i) {
      f32x4 xv = *(const f32x4*)(sxc + (tg * 8 + i) * 64 + ii);
      ra[i] += xv[0] * a0 + xv[1] * a1 + xv[2] * a2 + xv[3] * a3;
      ix[i] += xv[0] * x0 + xv[1] * x1 + xv[2] * x2 + xv[3] * x3;
    }
  }
  const float lam = p.lru.lam[ch]; const float sp = fmaxf(-lam, 0.f) + log1pf(__expf(-fabsf(lam)));
  float hl[8], ac[8]; float A = 1.f, B = 0.f;
#pragma unroll
  for (int i = 0; i < 8; ++i) {
    const float rr = sigmoidf_(ra[i]), ig = sigmoidf_(ix[i]); const float log_a = -8.f * rr * sp;
    const bool reset = p.pos[t0 + i] == 0;
    const float av = reset ? 0.f : __expf(log_a); const float mult = reset ? 1.f : sqrtf(fmaxf(1.f - av * av, 0.f));
    const float bv = mult * ig * xc[i];
    B = av * B + bv; A *= av; hl[i] = B; ac[i] = A;
  }
  preA[tg * 64 + cc] = A; preB[tg * 64 + cc] = B;
  __syncthreads();
  float Ap = 1.f, Bp = 0.f;
#pragma unroll
  for (int q = 0; q < 7; ++q) if (q < tg) { float a = preA[q * 64 + cc], b = preB[q * 64 + cc]; Bp = a * Bp + b; Ap *= a; }
#pragma unroll
  for (int i = 0; i < 8; ++i) { long o = (long)(t0 + i) * 512 + ch; p.b.lr_h[o] = hl[i] + ac[i] * Bp; p.b.lr_A[o] = ac[i] * Ap; }
  __syncthreads();
}

template <int I, int N> struct SolveDot {
  static __device__ __forceinline__ void run(const LAS float* arow, const float (&X)[64], float (&acc)[4]) {
    if constexpr (I + 4 <= N) {
      const f32x4 a = *(const LAS f32x4*)(arow + I);
      acc[0] += a[0] * X[I]; acc[1] += a[1] * X[I + 1]; acc[2] += a[2] * X[I + 2]; acc[3] += a[3] * X[I + 3];
      SolveDot<I + 4, N>::run(arow, X, acc);
    } else if constexpr (I < N) { acc[I & 3] += arow[I] * X[I]; SolveDot<I + 1, N>::run(arow, X, acc); }
  }
};
template <int T> struct SolveRow {
  static __device__ __forceinline__ void run(const LAS float* sAab, const LAS float* sRhs, int tid, float (&X)[64]) {
    if constexpr (T < 64) {
      float acc[4] = {sRhs[T * 128 + tid], 0.f, 0.f, 0.f};
      SolveDot<0, T>::run(sAab + T * 64, X, acc);
      X[T] = (acc[0] + acc[1]) + (acc[2] + acc[3]);
      asm volatile("" ::: "memory");
      SolveRow<T + 1>::run(sAab, sRhs, tid, X);
    }
  }
};
__device__ __forceinline__ void p3_rwkv_solve(const MixP& p, int uid, int tid, const float* sRhs, const float* sAab) {
  float X[64];
  const int col = tid & 63; const bool isAl = tid < 64;
  const LAS float* lA = (const LAS float*)sAab; const LAS float* lR = (const LAS float*)sRhs;
  asm volatile("" : "+v"(lA), "+v"(lR));
  SolveRow<0>::run(lA, lR, tid, X);
  if (isAl) {
    int s, g_, j; inv_perm(col, s, g_, j);
#pragma unroll
    for (int t = 0; t < 64; ++t) p.b.rw_WpF[(long)uid * 4096 + (((t >> 4) * 2 + s) * 64 + g_ * 16 + (t & 15)) * 8 + j] = f2bf(X[t]);
  } else {
    const int vs = col >> 4, r_ = col & 15;
#pragma unroll
    for (int tt = 0; tt < 4; ++tt)
#pragma unroll
      for (int g_ = 0; g_ < 4; ++g_) {
        f32x4 o = {X[16 * tt + 4 * g_], X[16 * tt + 4 * g_ + 1], X[16 * tt + 4 * g_ + 2], X[16 * tt + 4 * g_ + 3]};
        *(f32x4*)(p.b.rw_U0F + (((long)uid * 4 + vs) * 4 + tt) * 256 + (g_ * 16 + r_) * 4) = o;
      }
  }
}
__device__ __forceinline__ void p3_rwkv(const MixP& p, int c, int h, char* smem) {
  u16* sRb = (u16*)smem; u16* sKb = sRb + 64 * LD; u16* sAl = sKb + 64 * LD; u16* sBe = sAl + 64 * LD; u16* sKtT = sBe + 64 * LD; u16* sVT = sKtT + 64 * LD;
  float* pre = (float*)(smem + 55296);
  char* R2 = smem + 57344;
  float* tw = (float*)R2; float* za = tw + 2048; float* sg = za + 2048;
  float* sAab = (float*)R2; u16* sAak = (u16*)(R2 + 16384); float* sRhs = (float*)(R2 + 16384 + 9216);
  int tid = threadIdx.x; asm volatile("" : "+v"(tid));
  const int cc = tid & 63, tg = tid >> 6, r = cc & 15, g = cc >> 4, uid = c * 8 + h, hc = h * 64 + cc, t0 = c * 64 + tg * 8;
  const u16* proj = p.proj;
  float* wW = (float*)(smem + 98304); float* wA = wW + 2048; float* wG = wA + 2048;
  {
    f32x4 wreg[5];
#pragma unroll
    for (int q = 0; q < 5; ++q) { const int idx = tid + 512 * q, row = idx >> 4, seg = idx & 15;
      const float* src = row < 32 ? p.rw.w_up + row * 512 : (row < 64 ? p.rw.a_up + (row - 32) * 512 : p.rw.g_up + (row - 64) * 512);
      wreg[q] = *(const f32x4*)(src + h * 64 + seg * 4); }
#pragma unroll
    for (int q = 0; q < 5; ++q) { const int idx = tid + 512 * q; *(f32x4*)(wW + idx * 4) = wreg[q]; }
  }
  {
    u16 c16[20], p16[20]; float mu20[20];
#pragma unroll
    for (int q = 0; q < 20; ++q) {
      const int idx = tid + 512 * q, tl = idx / 160, j = idx - tl * 160, t = c * 64 + tl, col = 1536 + j;
      c16[q] = proj[(long)t * PC + col]; p16[q] = t > 0 ? proj[(long)(t - 1) * PC + col] : (u16)0; mu20[q] = p.rw.mu[col];
    }
#pragma unroll
    for (int q = 0; q < 20; ++q) {
      const int idx = tid + 512 * q, tl = idx / 160, j = idx - tl * 160;
      const float cur = bf2f(c16[q]), prev = bf2f(p16[q]);
      const float z = cur + (prev - cur) * mu20[q];
      if (j < 32) tw[tl * 32 + j] = tanhf(z); else if (j < 64) za[tl * 32 + (j - 32)] = z; else sg[tl * 96 + (j - 64)] = sigmoidf_(z);
    }
  }
  float zr[8], zk[8], zv[8];
  {
    float pr[9], pk[9], pv[9];
#pragma unroll
    for (int i = 0; i < 9; ++i) { int t = t0 - 1 + i; if (t >= 0) { const u16* row = proj + (long)t * PC; pr[i] = bf2f(row[hc]); pk[i] = bf2f(row[512 + hc]); pv[i] = bf2f(row[1024 + hc]); } else { pr[i] = pk[i] = pv[i] = 0.f; } }
    const float mr = p.rw.mu[hc], mk = p.rw.mu[512 + hc], mv = p.rw.mu[1024 + hc];
#pragma unroll
    for (int i = 0; i < 8; ++i) { zr[i] = pr[i + 1] + (pr[i] - pr[i + 1]) * mr; zk[i] = pk[i + 1] + (pk[i] - pk[i + 1]) * mk; zv[i] = pv[i + 1] + (pv[i] - pv[i + 1]) * mv; }
  }
  __syncthreads();
  float wv[8], av[8], gv[8];
  { const float w0 = p.rw.w0[hc], a0 = p.rw.a0[hc];
#pragma unroll
    for (int i = 0; i < 8; ++i) { wv[i] = w0; av[i] = a0; gv[i] = 0.f; } }
#pragma unroll 2
  for (int j = 0; j < 32; j += 4) {
    const float wu0 = wW[(j + 0) * 64 + cc], wu1 = wW[(j + 1) * 64 + cc], wu2 = wW[(j + 2) * 64 + cc], wu3 = wW[(j + 3) * 64 + cc];
    const float au0 = wA[(j + 0) * 64 + cc], au1 = wA[(j + 1) * 64 + cc], au2 = wA[(j + 2) * 64 + cc], au3 = wA[(j + 3) * 64 + cc];
#pragma unroll
    for (int i = 0; i < 8; ++i) {
      f32x4 t4 = *(const f32x4*)(tw + (tg * 8 + i) * 32 + j), z4 = *(const f32x4*)(za + (tg * 8 + i) * 32 + j);
      wv[i] += t4[0] * wu0 + t4[1] * wu1 + t4[2] * wu2 + t4[3] * wu3;
      av[i] += z4[0] * au0 + z4[1] * au1 + z4[2] * au2 + z4[3] * au3;
    }
  }
#pragma unroll 2
  for (int j = 0; j < 96; j += 4) {
    const float gu0 = wG[(j + 0) * 64 + cc], gu1 = wG[(j + 1) * 64 + cc], gu2 = wG[(j + 2) * 64 + cc], gu3 = wG[(j + 3) * 64 + cc];
#pragma unroll
    for (int i = 0; i < 8; ++i) { f32x4 s4 = *(const f32x4*)(sg + (tg * 8 + i) * 96 + j); gv[i] += s4[0] * gu0 + s4[1] * gu1 + s4[2] * gu2 + s4[3] * gu3; }
  }
  const float kkw = p.rw.k_k[hc], kaw = p.rw.k_a[hc], rkw = p.rw.r_k[hc];
  float lw[8], aa[8], kk[8], kp[8], cum[8]; float run = 0.f;
#pragma unroll
  for (int i = 0; i < 8; ++i) {
    lw[i] = -0.6065306597126334f * sigmoidf_(wv[i]); aa[i] = sigmoidf_(av[i]);
    float k0 = zk[i] * kkw; const float ss = wave_sum(k0 * k0); kk[i] = k0 / fmaxf(sqrtf(ss), 1e-12f);
    kp[i] = zk[i] * (1.f + (aa[i] - 1.f) * kaw);
    const float bs = wave_sum(zr[i] * kp[i] * rkw);
    const long o = (long)(t0 + i) * 512 + hc;
    p.b.rw_G[o] = f2bf(gv[i]); p.b.rw_BV[o] = f2bf(bs * zv[i]);
    run += lw[i]; cum[i] = run;
  }
  pre[tg * 64 + cc] = run;
  __syncthreads();
  float off = 0.f, tot = 0.f;
#pragma unroll
  for (int q = 0; q < 8; ++q) { float v = pre[q * 64 + cc]; tot += v; if (q < tg) off += v; }
  {
    u16 kt8[8], v8[8];
    const int kt = cc >> 4, r_ = cc & 15;
#pragma unroll
    for (int i = 0; i < 8; ++i) {
      const int tl = tg * 8 + i; const float cm = cum[i] + off, cx = cm - lw[i];
      const float en = __expf(-cm), et = __expf(tot - cm);
      sAl[tl * LD + cc] = f2bf(-kk[i] * __expf(cx)); sBe[tl * LD + cc] = f2bf(kk[i] * aa[i] * en);
      sKb[tl * LD + cc] = f2bf(kp[i] * en); sRb[tl * LD + cc] = f2bf(zr[i] * __expf(cm));
      kt8[i] = f2bf(kp[i] * et); v8[i] = f2bf(zv[i]);
      int s, g_, j; inv_perm(tl, s, g_, j);
      p.b.rw_BtF[(long)uid * 4096 + ((kt * 2 + s) * 64 + g_ * 16 + r_) * 8 + j] = f2bf(kk[i] * aa[i] * et);
    }
    *(uint4*)(sKtT + cc * LD + tg * 8) = pack8(kt8); *(uint4*)(sVT + cc * LD + tg * 8) = pack8(v8);
    if (tg == 0) p.b.rw_gam[uid * 64 + cc] = __expf(tot);
  }
  __syncthreads();
  for (int q = tg; q < 80; q += 8) {
    const int kind = q >> 4, tt = q & 15, mt = tt >> 2, nt = tt & 3;
    if (kind == 0) { f32x4 c4 = tile_nt(sAl, sBe, mt, nt, r, g);
#pragma unroll
      for (int reg = 0; reg < 4; ++reg) { int t = 16 * mt + 4 * g + reg, i = 16 * nt + r; sAab[t * 64 + i] = i < t ? c4[reg] : 0.f; }
    } else if (kind == 1) { f32x4 c4 = tile_nt(sAl, sKb, mt, nt, r, g);
#pragma unroll
      for (int reg = 0; reg < 4; ++reg) { int t = 16 * mt + 4 * g + reg, i = 16 * nt + r; sAak[t * LD + i] = f2bf(i < t ? c4[reg] : 0.f); }
    } else if (kind == 2) { f32x4 c4 = tile_nt(sRb, sBe, mt, nt, r, g);
#pragma unroll
      for (int reg = 0; reg < 4; ++reg) { int t = 16 * mt + 4 * g + reg, i = 16 * nt + r; p.b.rw_Pab[(long)uid * 4096 + t * 64 + i] = f2bf(i <= t ? c4[reg] : 0.f); }
    } else if (kind == 3) { f32x4 c4 = tile_nt(sRb, sKb, mt, nt, r, g);
#pragma unroll
      for (int reg = 0; reg < 4; ++reg) { int t = 16 * mt + 4 * g + reg, i = 16 * nt + r; p.b.rw_Pak[(long)uid * 4096 + t * 64 + i] = f2bf(i <= t ? c4[reg] : 0.f); }
    } else { f32x4 c4 = tile_nt(sKtT, sVT, mt, nt, r, g);
      *(f32x4*)(p.b.rw_KVF + (((long)uid * 4 + nt) * 4 + mt) * 256 + cc * 4) = c4;
    }
  }
  __syncthreads();
  for (int q = tg; q < 16; q += 8) { const int mt = q >> 2, nt = q & 3; f32x4 c4 = tile_nt(sAak, sVT, mt, nt, r, g);
#pragma unroll
    for (int reg = 0; reg < 4; ++reg) { int t = 16 * mt + 4 * g + reg, v = 16 * nt + r; sRhs[t * 128 + 64 + v] = c4[reg]; } }
  for (int idx = tid; idx < 4096; idx += 512) { int t = idx >> 6, k = idx & 63; sRhs[t * 128 + k] = bf2f(sAl[t * LD + k]); }
  copy_out(sRb, p.b.rw_Rb + (long)uid * 4096, 64, tid); copy_out(sVT, p.b.rw_VT + (long)uid * 4096, 64, tid);
  __syncthreads();
  if (tid < 128) p3_rwkv_solve(p, uid, tid, sRhs, sAab);
  __syncthreads();
}

constexpr int CH_SLOT = 24832;
constexpr int CH_LA = 3, CH_NS = 4;
__device__ __forceinline__ void chain_piece(const MixP& p, int uid, int vs, int pc, char* slot, int lane) {
  if (pc < 8) __builtin_amdgcn_global_load_lds((const unsigned*)(p.b.rw_WpF + (long)uid * 4096 + pc * 512 + lane * 8), (unsigned*)(slot + pc * 1024 + lane * 16), 16, 0, 0);
  else if (pc < 16) __builtin_amdgcn_global_load_lds((const unsigned*)(p.b.rw_BtF + (long)uid * 4096 + (pc - 8) * 512 + lane * 8), (unsigned*)(slot + 8192 + (pc - 8) * 1024 + lane * 16), 16, 0, 0);
  else if (pc < 20) __builtin_amdgcn_global_load_lds((const unsigned*)(p.b.rw_U0F + ((long)uid * 4 + vs) * 1024 + (pc - 16) * 256 + lane * 4), (unsigned*)(slot + 16384 + (pc - 16) * 1024 + lane * 16), 16, 0, 0);
  else if (pc < 24) __builtin_amdgcn_global_load_lds((const unsigned*)(p.b.rw_KVF + ((long)uid * 4 + vs) * 1024 + (pc - 20) * 256 + lane * 4), (unsigned*)(slot + 20480 + (pc - 20) * 1024 + lane * 16), 16, 0, 0);
  else __builtin_amdgcn_global_load_lds((const unsigned*)(p.b.rw_gam + uid * 64 + lane), (unsigned*)(slot + 24576 + lane * 4), 4, 0, 0);
}
__device__ __forceinline__ void chain_issue(const MixP& p, int uid, int vs, char* slot, int w, int lane) {
#pragma unroll
  for (int i = 0; i < 4; ++i) { const int pc = (w - 1) + 7 * i; if (pc < 25) chain_piece(p, uid, vs, pc, slot, lane); }
}
typedef __attribute__((ext_vector_type(4))) unsigned u32x4;
__device__ __forceinline__ bf16x8 frag_of(unsigned a, unsigned b, unsigned c, unsigned d) { u32x4 v = {a, b, c, d}; return __builtin_bit_cast(bf16x8, v); }
__device__ __forceinline__ void p4_rwkv_chain(const MixP& p, int h, int vs, char* ring, int w, int lane) {
  const int r = lane & 15, g = lane >> 4, v = vs * 16 + r;
  const bool loader = w > 0; const int npc = (w >= 1 && w <= 4) ? 4 : 3;
  f32x4 ST[4];
#pragma unroll
  for (int kt = 0; kt < 4; ++kt) ST[kt] = (f32x4){0.f, 0.f, 0.f, 0.f};
  if (loader) { for (int c = 0; c < CH_LA; ++c) chain_issue(p, c * 8 + h, vs, ring + c * CH_SLOT, w, lane); }
#pragma unroll 1
  for (int c = 0; c < NCH; ++c) {
    const int uid = c * 8 + h; char* slot = ring + (c % CH_NS) * CH_SLOT;
    if (loader) {
      const int younger = (NCH - 1 - c < CH_LA - 1 ? NCH - 1 - c : CH_LA - 1);
      if (younger == 2) { if (npc == 4) asm volatile("s_waitcnt vmcnt(8)" ::: "memory"); else asm volatile("s_waitcnt vmcnt(6)" ::: "memory"); }
      else if (younger == 1) { if (npc == 4) asm volatile("s_waitcnt vmcnt(4)" ::: "memory"); else asm volatile("s_waitcnt vmcnt(3)" ::: "memory"); }
      else asm volatile("s_waitcnt vmcnt(0)" ::: "memory");
    }
    __builtin_amdgcn_s_barrier();
    if (loader) { if (c + CH_LA < NCH) chain_issue(p, (c + CH_LA) * 8 + h, vs, ring + ((c + CH_LA) % CH_NS) * CH_SLOT, w, lane); }
    else {
      unsigned ps[4][2];
#pragma unroll
      for (int kt = 0; kt < 4; ++kt) { ps[kt][0] = pack_bf16(ST[kt][0], ST[kt][1]); ps[kt][1] = pack_bf16(ST[kt][2], ST[kt][3]); }
      bf16x8 bS[2];
#pragma unroll
      for (int s = 0; s < 2; ++s) bS[s] = frag_of(ps[2 * s][0], ps[2 * s][1], ps[2 * s + 1][0], ps[2 * s + 1][1]);
#pragma unroll
      for (int kt = 0; kt < 4; ++kt) { uint2 pk; pk.x = ps[kt][0]; pk.y = ps[kt][1]; *(uint2*)(p.b.rw_S0 + (long)uid * 4096 + v * 64 + 16 * kt + 4 * g) = pk; }
      f32x4 U[4];
#pragma unroll
      for (int tt = 0; tt < 4; ++tt) {
        U[tt] = *(const f32x4*)(slot + 16384 + tt * 1024 + lane * 16);
#pragma unroll
        for (int s = 0; s < 2; ++s) { bf16x8 a = *(const bf16x8*)(slot + (tt * 2 + s) * 1024 + lane * 16); U[tt] = __builtin_amdgcn_mfma_f32_16x16x32_bf16(a, bS[s], U[tt], 0, 0, 0); }
      }
      unsigned pu[4][2];
#pragma unroll
      for (int tt = 0; tt < 4; ++tt) { pu[tt][0] = pack_bf16(U[tt][0], U[tt][1]); pu[tt][1] = pack_bf16(U[tt][2], U[tt][3]); }
      bf16x8 bU[2];
#pragma unroll
      for (int s = 0; s < 2; ++s) bU[s] = frag_of(pu[2 * s][0], pu[2 * s][1], pu[2 * s + 1][0], pu[2 * s + 1][1]);
#pragma unroll
      for (int tt = 0; tt < 4; ++tt) { uint2 pk; pk.x = pu[tt][0]; pk.y = pu[tt][1]; *(uint2*)(p.b.rw_UT + (long)uid * 4096 + v * 64 + 16 * tt + 4 * g) = pk; }
#pragma unroll
      for (int kt = 0; kt < 4; ++kt) {
        const f32x4 gm = *(const f32x4*)(slot + 24576 + (16 * kt + 4 * g) * 4); const f32x4 kv = *(const f32x4*)(slot + 20480 + kt * 1024 + lane * 16);
        f32x4 a4 = ST[kt] * gm + kv;
#pragma unroll
        for (int s = 0; s < 2; ++s) { bf16x8 a = *(const bf16x8*)(slot + 8192 + (kt * 2 + s) * 1024 + lane * 16); a4 = __builtin_amdgcn_mfma_f32_16x16x32_bf16(a, bU[s], a4, 0, 0, 0); }
        ST[kt] = a4;
      }
      asm volatile("s_waitcnt lgkmcnt(0)" ::: "memory");
    }
  }
}
__device__ __forceinline__ void p4_elem(const MixP& p, int e) {
  if (e < 32768) {
    const int h = e >> 12, vk = e & 4095; const float lg2 = log2f(1.f - exp2f(-(5.f + 4.f * (float)h / 7.f))); const float gm = exp2f(lg2 * 64.f);
    float S = 0.f;
    for (int c0 = 0; c0 < NCH; c0 += 8) {
      float kv[8];
#pragma unroll
      for (int i = 0; i < 8; ++i) kv[i] = p.b.rt_KVT[(long)((c0 + i) * 8 + h) * 4096 + vk];
#pragma unroll
      for (int i = 0; i < 8; ++i) { p.b.rt_S0[(long)((c0 + i) * 8 + h) * 4096 + vk] = f2bf(S); S = S * gm + kv[i]; }
    }
  } else {
    const int e2 = e - 32768, h = e2 >> 13, vk = e2 & 8191, k = vk & 63;
    float S = 0.f;
    for (int c0 = 0; c0 < NCH; c0 += 8) {
      float kv[8], gm[8];
#pragma unroll
      for (int i = 0; i < 8; ++i) { kv[i] = p.b.gl_KVT[(long)((c0 + i) * 4 + h) * 8192 + vk]; gm[i] = p.b.gl_gam[((c0 + i) * 4 + h) * 64 + k]; }
#pragma unroll
      for (int i = 0; i < 8; ++i) { p.b.gl_S0[(long)((c0 + i) * 4 + h) * 8192 + vk] = f2bf(S); S = S * gm[i] + kv[i]; }
    }
  }
}
__device__ __forceinline__ void p4_lru(const MixP& p, int ch) {
  float H = 0.f;
  for (int c0 = 0; c0 < NCH; c0 += 8) {
    float a[8], b[8];
#pragma unroll
    for (int i = 0; i < 8; ++i) { long o = (long)((c0 + i) * 64 + 63) * 512 + ch; a[i] = p.b.lr_A[o]; b[i] = p.b.lr_h[o]; }
#pragma unroll
    for (int i = 0; i < 8; ++i) { p.b.lr_Hp[(c0 + i) * 512 + ch] = H; H = a[i] * H + b[i]; }
  }
}

template <int NVT, bool DELTA, int NMT>
__device__ __forceinline__ void p5_mm(const u16* Rb, const u16* S0, const u16* Pak, const u16* VT, const u16* Pab, const u16* UT, int mt0, int r, int g, f32x4 (&acc)[NMT][4 * NVT]) {
#pragma unroll
  for (int mt = 0; mt < NMT; ++mt)
#pragma unroll
    for (int nt = 0; nt < 4 * NVT; ++nt) acc[mt][nt] = (f32x4){0.f, 0.f, 0.f, 0.f};
#pragma unroll 1
  for (int pr = 0; pr < (DELTA ? 3 : 2); ++pr) {
    const u16* A = pr == 0 ? Rb : (pr == 1 ? Pak : Pab); const u16* B = pr == 0 ? S0 : (pr == 1 ? VT : UT);
    bf16x8 af[NMT][2], bfr[4 * NVT][2];
#pragma unroll
    for (int s = 0; s < 2; ++s) {
#pragma unroll
      for (int mt = 0; mt < NMT; ++mt) af[mt][s] = *(const bf16x8*)(A + (16 * (mt0 + mt) + r) * 64 + 32 * s + 8 * g);
#pragma unroll
      for (int nt = 0; nt < 4 * NVT; ++nt) bfr[nt][s] = *(const bf16x8*)(B + (16 * nt + r) * 64 + 32 * s + 8 * g);
    }
#pragma unroll
    for (int s = 0; s < 2; ++s)
#pragma unroll
      for (int nt = 0; nt < 4 * NVT; ++nt)
#pragma unroll
        for (int mt = 0; mt < NMT; ++mt) acc[mt][nt] = __builtin_amdgcn_mfma_f32_16x16x32_bf16(af[mt][s], bfr[nt][s], acc[mt][nt], 0, 0, 0);
  }
}
__device__ __forceinline__ void p5_rwkv(const MixP& p, int c, int h, int lane) {
  const int r = lane & 15, g = lane >> 4; const long uo = (long)(c * 8 + h) * 4096;
  float lg[4], lb[4];
#pragma unroll
  for (int nt = 0; nt < 4; ++nt) { lg[nt] = p.rw.ln_g[h * 64 + 16 * nt + r]; lb[nt] = p.rw.ln_b[h * 64 + 16 * nt + r]; }
#pragma unroll 1
  for (int mh = 0; mh < 2; ++mh) {
    f32x4 acc[2][4];
    p5_mm<1, true, 2>(p.b.rw_Rb + uo, p.b.rw_S0 + uo, p.b.rw_Pak + uo, p.b.rw_VT + uo, p.b.rw_Pab + uo, p.b.rw_UT + uo, mh * 2, r, g, acc);
#pragma unroll
    for (int mt = 0; mt < 2; ++mt)
#pragma unroll
      for (int reg = 0; reg < 4; ++reg) {
        const int t = c * 64 + 16 * (mh * 2 + mt) + 4 * g + reg;
        float s1 = acc[mt][0][reg] + acc[mt][1][reg] + acc[mt][2][reg] + acc[mt][3][reg]; s1 = red16(s1);
        const float mean = s1 * (1.f / 64.f);
        float s2 = 0.f;
#pragma unroll
        for (int nt = 0; nt < 4; ++nt) { float d = acc[mt][nt][reg] - mean; s2 += d * d; }
        s2 = red16(s2);
        const float rs = rsqrtf(s2 * (1.f / 64.f) + 64e-5f);
#pragma unroll
        for (int nt = 0; nt < 4; ++nt) {
          const int hc = h * 64 + 16 * nt + r; const long o = (long)t * 512 + hc;
          const float yn = (acc[mt][nt][reg] - mean) * rs * lg[nt] + lb[nt];
          p.ycat[(long)t * DM + hc] = f2bf((yn + bf2f(p.b.rw_BV[o])) * bf2f(p.b.rw_G[o]));
        }
      }
  }
}
__device__ __forceinline__ void p5_ret(const MixP& p, int c, int h, int lane) {
  const int r = lane & 15, g = lane >> 4; const long uo = (long)(c * 8 + h) * 4096;
  f32x4 acc[4][4];
  p5_mm<1, false, 4>(p.b.rt_Rb + uo, p.b.rt_S0 + uo, p.b.rt_Pak + uo, p.b.rt_VT + uo, nullptr, nullptr, 0, r, g, acc);
  float ng[4];
#pragma unroll
  for (int nt = 0; nt < 4; ++nt) ng[nt] = p.ret_norm_g[h * 64 + 16 * nt + r];
#pragma unroll
  for (int mt = 0; mt < 4; ++mt)
#pragma unroll
    for (int reg = 0; reg < 4; ++reg) {
      const int t = c * 64 + 16 * mt + 4 * g + reg;
      float s2 = 0.f;
#pragma unroll
      for (int nt = 0; nt < 4; ++nt) s2 += acc[mt][nt][reg] * acc[mt][nt][reg];
      s2 = red16(s2);
      const float rs = rsqrtf(s2 * (1.f / 64.f) + 1e-6f);
#pragma unroll
      for (int nt = 0; nt < 4; ++nt) {
        const int hc = h * 64 + 16 * nt + r; const float gt = bf2f(p.proj[(long)t * PC + OFF_B + 1536 + hc]);
        p.ycat[(long)t * DM + 512 + hc] = f2bf(acc[mt][nt][reg] * rs * ng[nt] * gt * sigmoidf_(gt));
      }
    }
}
__device__ __forceinline__ void p5_gla(const MixP& p, int c, int h, int lane) {
  const int r = lane & 15, g = lane >> 4; const int uid = c * 4 + h;
  float ng[8];
#pragma unroll
  for (int nt = 0; nt < 8; ++nt) ng[nt] = p.gla_norm_g[h * 128 + 16 * nt + r];
#pragma unroll 1
  for (int mh = 0; mh < 2; ++mh) {
    f32x4 acc[2][8];
    p5_mm<2, false, 2>(p.b.gl_Rb + (long)uid * 4096, p.b.gl_S0 + (long)uid * 8192, p.b.gl_Pak + (long)uid * 4096, p.b.gl_VT + (long)uid * 8192, nullptr, nullptr, mh * 2, r, g, acc);
#pragma unroll
    for (int mt = 0; mt < 2; ++mt)
#pragma unroll
      for (int reg = 0; reg < 4; ++reg) {
        const int t = c * 64 + 16 * (mh * 2 + mt) + 4 * g + reg;
        float s2 = 0.f;
#pragma unroll
        for (int nt = 0; nt < 8; ++nt) s2 += acc[mt][nt][reg] * acc[mt][nt][reg];
        s2 = red16(s2);
        const float rs = rsqrtf(s2 * (1.f / 128.f) + 1e-6f);
#pragma unroll
        for (int nt = 0; nt < 8; ++nt) {
          const int hc = h * 128 + 16 * nt + r; const float gt = bf2f(p.proj[(long)t * PC + OFF_D + 1040 + hc]);
          p.ycat[(long)t * DM + 1536 + hc] = f2bf(acc[mt][nt][reg] * rs * ng[nt] * gt * sigmoidf_(gt));
        }
      }
  }
}
__device__ __forceinline__ void p5_lru8(const MixP& p, long idx0, long stride) {
  float hv[8], av[8], hp[8]; u16 gb[8];
#pragma unroll
  for (int q = 0; q < 8; ++q) { const long idx = idx0 + q * stride; const int t = (int)(idx >> 9), ch = (int)(idx & 511), c = t >> 6;
    hv[q] = p.b.lr_h[idx]; av[q] = p.b.lr_A[idx]; hp[q] = p.b.lr_Hp[c * 512 + ch]; gb[q] = p.proj[(long)t * PC + OFF_C + 512 + ch]; }
#pragma unroll
  for (int q = 0; q < 8; ++q) { const long idx = idx0 + q * stride; const int t = (int)(idx >> 9), ch = (int)(idx & 511);
    p.ycat[(long)t * DM + 1024 + ch] = f2bf((hv[q] + av[q] * hp[q]) * gelu_tanh(bf2f(gb[q]))); }
}
__device__ __forceinline__ void phase_mix3(const MixP& p, char* smem) {
  for (int u = blockIdx.x; u < 3584; u += gridDim.x) {
    if (u < 1024) p3_rwkv(p, u >> 3, u & 7, smem);
    else if (u < 2048) p3_ret(p, (u - 1024) >> 3, (u - 1024) & 7, smem);
    else if (u < 2560) p3_gla(p, (u - 2048) >> 2, (u - 2048) & 3, smem);
    else p3_lru(p, (u - 2560) >> 3, (u - 2560) & 7, smem);
  }
}
__device__ __forceinline__ void phase_mix4(const MixP& p, char* smem) {
  int tid = threadIdx.x; asm volatile("" : "+v"(tid));
#pragma unroll 1
  for (int b = blockIdx.x; b < 256; b += gridDim.x) {
    if (b < 32) p4_rwkv_chain(p, b >> 2, b & 3, smem, __builtin_amdgcn_readfirstlane(tid >> 6), tid & 63);
    else if (b >= 64 && b < 192) p4_elem(p, (b - 64) * 512 + tid);
    else if (b == 200) p4_lru(p, tid);
    __syncthreads();
  }
}
__device__ __forceinline__ void phase_mix5(const MixP& p) {
  int tid = threadIdx.x; asm volatile("" : "+v"(tid));
  const int wave = blockIdx.x * 8 + (tid >> 6), nw = gridDim.x * 8, lane = tid & 63;
  for (int u = wave; u < 2560; u += nw) {
    if (u < 512) p5_gla(p, u >> 2, u & 3, lane);
    else if (u < 1536) p5_rwkv(p, (u - 512) >> 3, (u - 512) & 7, lane);
    else p5_ret(p, (u - 1536) >> 3, (u - 1536) & 7, lane);
  }
  { const long nthr = (long)gridDim.x * 512;
    long idx = (long)blockIdx.x * 512 + tid;
    for (; idx + 7 * nthr < (long)T_ * 512; idx += 8 * nthr) p5_lru8(p, idx, nthr);
    for (; idx < (long)T_ * 512; idx += nthr) {
      const int t = (int)(idx >> 9), ch = (int)(idx & 511), c = t >> 6;
      p.ycat[(long)t * DM + 1024 + ch] = f2bf((p.b.lr_h[idx] + p.b.lr_A[idx] * p.b.lr_Hp[c * 512 + ch]) * gelu_tanh(bf2f(p.proj[(long)t * PC + OFF_C + 512 + ch]))); } }
}

#define XB_TMO      128
#define XB_XCNT(j)  (256  + 64 * (j))
#define XB_XSUB(j)  (1280 + 64 * (j))
#define XB_XGEN(j)  (2304 + 64 * (j))
#define XB_TOP      3328
#define XB_TOPGEN   3392
#define XCD_BAR_WORDS 3456
#define XB_SPIN_CAP (1u << 18)
__device__ __forceinline__ unsigned xb_ld(unsigned* p)              { return __hip_atomic_load(p, __ATOMIC_RELAXED, __HIP_MEMORY_SCOPE_AGENT); }
__device__ __forceinline__ unsigned xb_add(unsigned* p, unsigned v) { return __hip_atomic_fetch_add(p, v, __ATOMIC_RELAXED, __HIP_MEMORY_SCOPE_AGENT); }
__device__ __forceinline__ unsigned xb_xcc_id() { return (unsigned)__builtin_amdgcn_s_getreg((3 << 11) | 20) & 0xFu; }
#define XB_SPIN(cond, bar) do { unsigned _sp = 0; while (cond) { __builtin_amdgcn_s_sleep(1); \
    if ((++_sp & 255u) == 0u) { if (xb_ld(&(bar)[XB_TMO])) break; if (_sp > XB_SPIN_CAP) { atomicAdd(&(bar)[XB_TMO], 1u); break; } } } } while (0)
struct XcdBarrier { unsigned* bar; unsigned x; volatile LAS unsigned* st; };
__device__ __forceinline__ XcdBarrier xcd_barrier_post(unsigned* bar, volatile LAS unsigned* st) {
    XcdBarrier b; b.bar = bar; b.x = xb_xcc_id(); b.st = st;
    if (threadIdx.x == 0) (void)xb_add(&bar[XB_XCNT(b.x)], 1u);
    return b;
}
__device__ __forceinline__ void xcd_barrier_complete(unsigned* bar, unsigned x, unsigned& nloc, unsigned& nx) {
    const unsigned G = gridDim.x * gridDim.y * gridDim.z;
    unsigned sum, cnt, mine, sp = 0u;
    for (;;) {
        sum = 0u; cnt = 0u; mine = 0u;
#pragma unroll
        for (unsigned j = 0; j < 16; ++j) { const unsigned c = xb_ld(&bar[XB_XCNT(j)]); sum += c; cnt += (c > 0u) ? 1u : 0u; mine = (j == x) ? c : mine; }
        if (sum == G) break;
        __builtin_amdgcn_s_sleep(1);
        if ((++sp & 255u) == 0u) { if (xb_ld(&bar[XB_TMO])) break; if (sp > XB_SPIN_CAP) { atomicAdd(&bar[XB_TMO], 1u); break; } }
    }
    nloc = mine > 0u ? mine : 1u; nx = cnt > 0u ? cnt : 1u;
}
__device__ __forceinline__ void xcd_barrier(const XcdBarrier& b) {
    asm volatile("s_waitcnt vmcnt(0)" ::: "memory");
    __syncthreads();
    if (threadIdx.x == 0) {
        unsigned* bar = b.bar;
        __builtin_amdgcn_s_waitcnt(0);
        unsigned nloc = b.st[0], nx = b.st[1];
        if (nloc == 0u) { xcd_barrier_complete(bar, b.x, nloc, nx); b.st[0] = nloc; b.st[1] = nx; }
        const unsigned old = xb_add(&bar[XB_XSUB(b.x)], 1u);
        const unsigned gen = old / nloc;
        if (old + 1u == (gen + 1u) * nloc) {
            __builtin_amdgcn_fence(__ATOMIC_RELEASE, "agent");
            asm volatile("s_waitcnt vmcnt(0)" ::: "memory");
            const unsigned og = xb_add(&bar[XB_TOP], 1u);
            const unsigned tg = og / nx;
            if (og + 1u == (tg + 1u) * nx) xb_add(&bar[XB_TOPGEN], 1u);
            else XB_SPIN(xb_ld(&bar[XB_TOPGEN]) == tg, bar);
            __builtin_amdgcn_fence(__ATOMIC_ACQUIRE, "agent");
            xb_add(&bar[XB_XGEN(b.x)], 1u);
            asm volatile("s_waitcnt vmcnt(0)" ::: "memory");
        } else {
            XB_SPIN(xb_ld(&bar[XB_XGEN(b.x)]) == gen, bar);
            __builtin_amdgcn_fence(__ATOMIC_ACQUIRE, "agent");
            asm volatile("s_waitcnt vmcnt(0)" ::: "memory");
        }
    }
    __syncthreads();
}

__device__ __forceinline__ void xcd_barrier_l(const XcdBarrier& b) {
    asm volatile("s_waitcnt vmcnt(0)" ::: "memory");
    __syncthreads();
    if (threadIdx.x == 0) {
        unsigned* bar = b.bar; unsigned x = b.x;
        { unsigned long long _z = 0; asm volatile("" : "+s"(_z), "+s"(x)); bar = (unsigned*)(unsigned __attribute__((address_space(1)))*)((unsigned long long)bar + _z); }
        __builtin_amdgcn_s_waitcnt(0);
        const unsigned nloc = b.st[0], nx = b.st[1];
        const unsigned old = xb_add(&bar[XB_XSUB(x)], 1u);
        const unsigned gen = old / nloc;
        if (old + 1u == (gen + 1u) * nloc) {
            __builtin_amdgcn_fence(__ATOMIC_RELEASE, "agent");
            asm volatile("s_waitcnt vmcnt(0)" ::: "memory");
            const unsigned og = xb_add(&bar[XB_TOP], 1u);
            const unsigned tg = og / nx;
            if (og + 1u == (tg + 1u) * nx) xb_add(&bar[XB_TOPGEN], 1u);
            else XB_SPIN(xb_ld(&bar[XB_TOPGEN]) == tg, bar);
            __builtin_amdgcn_fence(__ATOMIC_ACQUIRE, "agent");
            xb_add(&bar[XB_XGEN(x)], 1u);
            asm volatile("s_waitcnt vmcnt(0)" ::: "memory");
        } else {
            XB_SPIN(xb_ld(&bar[XB_XGEN(x)]) == gen, bar);
            __builtin_amdgcn_fence(__ATOMIC_ACQUIRE, "agent");
            asm volatile("s_waitcnt vmcnt(0)" ::: "memory");
        }
    }
    __syncthreads();
}

struct MegaP { const float* in[40]; char* ws; float* out; };
namespace WS {
constexpr size_t al(size_t x) { return (x + 255) & ~(size_t)255; }
constexpr size_t U8 = (size_t)1024 * 4096 * 2;
constexpr size_t BARW = 0;
constexpr size_t WT_IN = BARW + 65536;
constexpr size_t WT_O = WT_IN + al((size_t)NL * PC * DM * 2);
constexpr size_t WT_OUT = WT_O + al((size_t)NL * 4 * DM * MIXW * 2);
constexpr size_t WGU = WT_OUT + al((size_t)NL * DM * DM * 2);
constexpr size_t WDN = WGU + al((size_t)NL * NEXP * 2048 * DM * 2);
constexpr size_t H = WDN + al((size_t)NL * NEXP * DM * DEXP * 2);
constexpr size_t XN = H + al((size_t)T_ * DM * 4);
constexpr size_t PROJ = XN + al((size_t)T_ * DM * 2);
constexpr size_t YCAT = PROJ + al((size_t)T_ * PC * 2);
constexpr size_t MBUF = YCAT + al((size_t)T_ * DM * 2);
constexpr size_t MERGED = MBUF + al((size_t)T_ * DM * 4);
constexpr size_t TOK_E = MERGED + al((size_t)T_ * DM * 2);
constexpr size_t TOK_G = TOK_E + al((size_t)2 * T_ * 4);
constexpr size_t ROW_TOK = TOK_G + al((size_t)2 * T_ * 4);
constexpr size_t ROW_SLOT = ROW_TOK + al((size_t)MAXROWS * 4);
constexpr size_t ROW_GATE = ROW_SLOT + al((size_t)MAXROWS * 4);
constexpr size_t TILE_EXP = ROW_GATE + al((size_t)MAXROWS * 4);
constexpr size_t NRT = TILE_EXP + 1024;
constexpr size_t XG = NRT + 256;
constexpr size_t HMID = XG + al((size_t)MAXROWS * DM * 2);
constexpr size_t YBUF = HMID + al((size_t)MAXROWS * DEXP * 2);
constexpr size_t RW_RB = YBUF + al((size_t)2 * T_ * DM * 4);
constexpr size_t RW_PAB = RW_RB + U8, RW_PAK = RW_PAB + U8, RW_VT = RW_PAK + U8, RW_S0 = RW_VT + U8, RW_UT = RW_S0 + U8, RW_WPF = RW_UT + U8, RW_BTF = RW_WPF + U8;
constexpr size_t RW_G = RW_BTF + U8, RW_BV = RW_G + U8, RW_U0F = RW_BV + U8, RW_KVF = RW_U0F + 2 * U8, RW_GAM = RW_KVF + 2 * U8;
constexpr size_t RT_RB = RW_GAM + 262144, RT_PAK = RT_RB + U8, RT_VT = RT_PAK + U8, RT_S0 = RT_VT + U8, RT_KVT = RT_S0 + U8;
constexpr size_t GL_RB = RT_KVT + 2 * U8, GL_PAK = GL_RB + U8 / 2, GL_VT = GL_PAK + U8 / 2, GL_S0 = GL_VT + U8, GL_KVT = GL_S0 + U8, GL_GAM = GL_KVT + 2 * U8;
constexpr size_t LR_H = GL_GAM + 131072, LR_A = LR_H + (size_t)T_ * 512 * 4, LR_HP = LR_A + (size_t)T_ * 512 * 4;
constexpr size_t LST_SLOT = LR_HP + (size_t)NCH * 512 * 4;
constexpr size_t LST_GATE = LST_SLOT + (size_t)32 * 8192 * 4;
constexpr size_t END = LST_GATE + (size_t)32 * 8192 * 4;
}
constexpr int TBL_OFF = 0, XBW_OFF = 320, PH_OFF = 512;
constexpr int PH_BYTES = 153600;
constexpr int LDS_BYTES = PH_OFF + PH_BYTES;
__device__ __forceinline__ const float* in_ptr(const char* smem, int i) {
  const unsigned long long v = *(const unsigned long long*)(smem - PH_OFF + TBL_OFF + i * 8);
  const unsigned lo = __builtin_amdgcn_readfirstlane((unsigned)v), hi = __builtin_amdgcn_readfirstlane((unsigned)(v >> 32));
  return (const float*)(const float __attribute__((address_space(1)))*)(((unsigned long long)hi << 32) | lo);
}
template <class T> __device__ __forceinline__ T* wsp(char* ws, size_t off) { return (T*)(ws + off); }
__device__ __forceinline__ int ld_i(const int* p) { return __hip_atomic_load(p, __ATOMIC_RELAXED, __HIP_MEMORY_SCOPE_AGENT); }
#define OPAQUE_WS(w) do { unsigned long long _z = 0; asm volatile("" : "+s"(_z)); (w) = (char*)(char __attribute__((address_space(1)))*)((unsigned long long)(w) + _z); } while (0)
__device__ __forceinline__ int bidx() { int b = blockIdx.x; asm volatile("" : "+s"(b)); return b; }
__device__ __forceinline__ int gdim() { int g = gridDim.x; asm volatile("" : "+s"(g)); return g; }

__device__ __forceinline__ void transpose_tile_w(const float* __restrict__ src, int sld, int nvalid, u16* __restrict__ dst, int K, int n0, int k0, int drow0, int mode, int lane) {
  const int kq = lane >> 4, n4 = lane & 15, nb = n0 + n4 * 4;
  f32x4 v[16];
  if (nb < nvalid) {
    const float* sp = src + (long)(k0 + kq * 16) * sld + nb;
#pragma unroll
    for (int i = 0; i < 16; ++i) v[i] = *(const f32x4*)(sp + (long)i * sld);
  } else {
#pragma unroll
    for (int i = 0; i < 16; ++i) v[i] = (f32x4){0.f, 0.f, 0.f, 0.f};
  }
#pragma unroll
  for (int jn = 0; jn < 4; ++jn) {
    const int n = nb + jn;
    const int row = (mode == 0) ? drow0 + n : ((n >> 7) * 256 + (mode == 2 ? 128 : 0) + (n & 127));
    u16* dp = dst + (long)row * K + k0 + kq * 16;
    uint4 lo, hi;
    lo.x = (unsigned)f2bf(v[0][jn]) | ((unsigned)f2bf(v[1][jn]) << 16); lo.y = (unsigned)f2bf(v[2][jn]) | ((unsigned)f2bf(v[3][jn]) << 16);
    lo.z = (unsigned)f2bf(v[4][jn]) | ((unsigned)f2bf(v[5][jn]) << 16); lo.w = (unsigned)f2bf(v[6][jn]) | ((unsigned)f2bf(v[7][jn]) << 16);
    hi.x = (unsigned)f2bf(v[8][jn]) | ((unsigned)f2bf(v[9][jn]) << 16); hi.y = (unsigned)f2bf(v[10][jn]) | ((unsigned)f2bf(v[11][jn]) << 16);
    hi.z = (unsigned)f2bf(v[12][jn]) | ((unsigned)f2bf(v[13][jn]) << 16); hi.w = (unsigned)f2bf(v[14][jn]) | ((unsigned)f2bf(v[15][jn]) << 16);
    *(uint4*)dp = lo; *(uint4*)(dp + 8) = hi;
  }
}
__device__ __forceinline__ void phase_convert(char* ws, char* smem) {
  OPAQUE_WS(ws); int tid = threadIdx.x; asm volatile("" : "+v"(tid));
  const int lane = tid & 63, G = gridDim.x * 8, b0 = blockIdx.x * 8 + __builtin_amdgcn_readfirstlane(tid >> 6);
#pragma unroll 1
  for (int j = b0; j < 64 * 512; j += G) { const int e = j / 512, q = j % 512, nt = q / 32, kt = q % 32;
    transpose_tile_w(in_ptr(smem, 36) + (long)e * DM * DEXP, DEXP, DEXP, wsp<u16>(ws, WS::WGU) + (long)e * 2048 * DM, DM, nt * 64, kt * 64, 0, 1, lane); }
#pragma unroll 1
  for (int j = b0; j < 64 * 512; j += G) { const int e = j / 512, q = j % 512, nt = q / 32, kt = q % 32;
    transpose_tile_w(in_ptr(smem, 37) + (long)e * DM * DEXP, DEXP, DEXP, wsp<u16>(ws, WS::WGU) + (long)e * 2048 * DM, DM, nt * 64, kt * 64, 0, 2, lane); }
#pragma unroll 1
  for (int j = b0; j < 64 * 512; j += G) { const int e = j / 512, q = j % 512, nt = q / 16, kt = q % 16;
    transpose_tile_w(in_ptr(smem, 38) + (long)e * DEXP * DM, DM, DM, wsp<u16>(ws, WS::WDN) + (long)e * DM * DEXP, DEXP, nt * 64, kt * 64, 0, 0, lane); }
#pragma unroll 1
  for (int j = b0; j < 2 * 100 * 32; j += G) { const int l = j / 3200, q = j % 3200, nt = q / 32, kt = q % 32;
    transpose_tile_w(in_ptr(smem, 3) + (long)l * DM * IN_COLS, IN_COLS, NONGATE, wsp<u16>(ws, WS::WT_IN) + (long)l * PC * DM, DM, nt * 64, kt * 64, 0, 0, lane); }
#pragma unroll 1
  for (int j = b0; j < 2 * 128 * 32; j += G) { const int l = j / 4096, q = j % 4096, nt = q / 32, kt = q % 32;
    transpose_tile_w(in_ptr(smem, 3) + (long)l * DM * IN_COLS + NONGATE, IN_COLS, 8192, wsp<u16>(ws, WS::WT_IN) + (long)l * PC * DM, DM, nt * 64, kt * 64, OFF_G, 0, lane); }
#pragma unroll 1
  for (int j = b0; j < 8 * 256; j += G) { const int lk = j / 256, q = j % 256, l = lk >> 2, kb = lk & 3, nt = q / 8, kt = q % 8;
    const float* src = in_ptr(smem, kb == 0 ? 15 : kb == 1 ? 17 : kb == 2 ? 25 : 29) + (long)l * MIXW * DM;
    transpose_tile_w(src, DM, DM, wsp<u16>(ws, WS::WT_O) + (long)l * DM * DM + kb * MIXW, DM, nt * 64, kt * 64, 0, 0, lane); }
#pragma unroll 1
  for (int j = b0; j < 2 * 1024; j += G) { const int l = j / 1024, q = j % 1024, nt = q / 32, kt = q % 32;
    transpose_tile_w(in_ptr(smem, 30) + (long)l * DM * DM, DM, DM, wsp<u16>(ws, WS::WT_OUT) + (long)l * DM * DM, DM, nt * 64, kt * 64, 0, 0, lane); }
}

struct NormArgs {
  const float* x; float* h; const float* g; u16* xn; float* out; const float* ybuf;
  const float* wg; const float* bg; const float* we; const float* be; int* tok_e; float* tok_g;
};
template <int MODE>
__device__ __forceinline__ void norm_row(const NormArgs& a, int row, int lane) {
  float v[32];
  const float* src = (MODE == 0) ? a.x : a.h;
#pragma unroll
  for (int i = 0; i < 8; ++i) {
    f32x4 t = *(const f32x4*)(src + (long)row * DM + i * 256 + lane * 4);
    if (MODE == 1 || MODE == 2) {
      f32x4 y0 = *(const f32x4*)(a.ybuf + (long)(2 * row) * DM + i * 256 + lane * 4);
      f32x4 y1 = *(const f32x4*)(a.ybuf + (long)(2 * row + 1) * DM + i * 256 + lane * 4);
      t = t + y0 + y1;
    }
    if (MODE != 3 && MODE != 2) *(f32x4*)(a.h + (long)row * DM + i * 256 + lane * 4) = t;
    v[i * 4 + 0] = t[0]; v[i * 4 + 1] = t[1]; v[i * 4 + 2] = t[2]; v[i * 4 + 3] = t[3];
  }
  float ss = 0.f;
#pragma unroll
  for (int i = 0; i < 32; ++i) ss += v[i] * v[i];
  ss = wave_sum(ss);
  const float rs = rsqrtf(ss * (1.f / DM) + 1e-6f);
#pragma unroll
  for (int i = 0; i < 8; ++i) {
    f32x4 g = *(const f32x4*)(a.g + i * 256 + lane * 4);
#pragma unroll
    for (int j = 0; j < 4; ++j) v[i * 4 + j] = v[i * 4 + j] * rs * g[j];
    if (MODE == 2) {
      f32x4 o = {v[i * 4], v[i * 4 + 1], v[i * 4 + 2], v[i * 4 + 3]};
      *(f32x4*)(a.out + (long)row * DM + i * 256 + lane * 4) = o;
    } else {
      uint2 pk;
      pk.x = (unsigned)f2bf(v[i * 4]) | ((unsigned)f2bf(v[i * 4 + 1]) << 16);
      pk.y = (unsigned)f2bf(v[i * 4 + 2]) | ((unsigned)f2bf(v[i * 4 + 3]) << 16);
      *(uint2*)(a.xn + (long)row * DM + i * 256 + lane * 4) = pk;
    }
  }
}
template <int MODE>
__device__ __forceinline__ void phase_norm(const NormArgs& a) {
  int tid = threadIdx.x; asm volatile("" : "+v"(tid));
  const int lane = tid & 63;
  for (int row = blockIdx.x * 8 + (tid >> 6); row < T_; row += gridDim.x * 8) norm_row<MODE>(a, row, lane);
}

typedef const float __attribute__((address_space(4))) cfl;
__device__ __forceinline__ void router_job(const NormArgs& a, int job, char* smem, int tid, int* cnt, int* lst_slot, float* lst_gate) {
  const int w = __builtin_amdgcn_readfirstlane(tid >> 6), tl = tid & 63, t = job * 64 + tl;
  float* part = (float*)smem;
  {
    const float* hrow = a.h + (long)t * DM + w * 256;
    cfl* gk = (cfl*)(unsigned long long)(a.g + w * 256); cfl* wg = (cfl*)(unsigned long long)(a.wg + (long)w * 256 * 4); cfl* we = (cfl*)(unsigned long long)(a.we + (long)w * 256 * 32);
    float acc[36]; float ss = 0.f;
#pragma unroll
    for (int c = 0; c < 36; ++c) acc[c] = 0.f;
    f32x4 xc[4], xn[4];
#pragma unroll
    for (int q = 0; q < 4; ++q) xc[q] = *(const f32x4*)(hrow + q * 4);
#pragma unroll 1
    for (int kb = 0; kb < 256; kb += 16) {
      const int kn = kb + 16 < 256 ? kb + 16 : kb;
#pragma unroll
      for (int q = 0; q < 4; ++q) xn[q] = *(const f32x4*)(hrow + kn + q * 4);
#pragma unroll
      for (int q = 0; q < 4; ++q) {
#pragma unroll
        for (int i = 0; i < 4; ++i) {
          const int k = kb + q * 4 + i; const float xv = xc[q][i]; ss += xv * xv; const float xg = xv * gk[k];
#pragma unroll
          for (int c = 0; c < 4; ++c) acc[c] += xg * wg[k * 4 + c];
#pragma unroll
          for (int c = 0; c < 32; ++c) acc[4 + c] += xg * we[k * 32 + c];
        }
        asm volatile("" ::: "memory");
      }
#pragma unroll
      for (int q = 0; q < 4; ++q) xc[q] = xn[q];
    }
#pragma unroll
    for (int c = 0; c < 36; ++c) part[(w * 37 + c) * 64 + tl] = acc[c];
    part[(w * 37 + 36) * 64 + tl] = ss;
  }
  __syncthreads();
  if (tid < 64) {
    float lgt[36]; float ss = 0.f;
#pragma unroll
    for (int c = 0; c < 36; ++c) lgt[c] = 0.f;
#pragma unroll 1
    for (int q = 0; q < 8; ++q) {
#pragma unroll
      for (int c = 0; c < 36; ++c) lgt[c] += part[(q * 37 + c) * 64 + tl];
      ss += part[(q * 37 + 36) * 64 + tl];
    }
    const float rs = rsqrtf(ss * (1.f / DM) + 1e-6f);
    float lg[4];
#pragma unroll
    for (int c = 0; c < 4; ++c) lg[c] = lgt[c] * rs + a.bg[c];
    int gi = 0; float gm = lg[0];
#pragma unroll
    for (int c = 1; c < 4; ++c) if (lg[c] > gm) { gm = lg[c]; gi = c; }
    float gs = 0.f;
#pragma unroll
    for (int c = 0; c < 4; ++c) gs += __expf(lg[c] - gm);
    const float pg = 1.f / gs;
    float le[8];
#pragma unroll
    for (int j = 0; j < 8; ++j) {
      const float l0 = lgt[4 + j] * rs + a.be[j], l1 = lgt[12 + j] * rs + a.be[8 + j], l2 = lgt[20 + j] * rs + a.be[16 + j], l3 = lgt[28 + j] * rs + a.be[24 + j];
      le[j] = gi == 0 ? l0 : (gi == 1 ? l1 : (gi == 2 ? l2 : l3));
    }
    int i1 = 0; float m1 = le[0];
#pragma unroll
    for (int j = 1; j < 8; ++j) if (le[j] > m1) { m1 = le[j]; i1 = j; }
    int i2 = -1; float m2 = -3.0e38f;
#pragma unroll
    for (int j = 0; j < 8; ++j) if (j != i1 && le[j] > m2) { m2 = le[j]; i2 = j; }
    const float w1 = 1.f / (1.f + __expf(m2 - m1)), w2 = 1.f - w1;
    if (i2 < 0) i2 = (i1 + 1) & 7;
    const int e0 = gi * 8 + i1, e1 = gi * 8 + i2;
    const int p0 = atomicAdd(cnt + e0, 1) & (LCAP - 1), p1 = atomicAdd(cnt + e1, 1) & (LCAP - 1);
    lst_slot[e0 * LCAP + p0] = 2 * t; lst_gate[e0 * LCAP + p0] = pg * w1;
    lst_slot[e1 * LCAP + p1] = 2 * t + 1; lst_gate[e1 * LCAP + p1] = pg * w2;
  }
  __syncthreads();
}
__device__ __forceinline__ void phase_n3(char* ws, const NormArgs& a, char* smem) {
  OPAQUE_WS(ws);
  int tid = threadIdx.x; asm volatile("" : "+v"(tid));
  int* cnt = wsp<int>(ws, WS::TILE_EXP); int* lst_slot = wsp<int>(ws, WS::LST_SLOT); float* lst_gate = wsp<float>(ws, WS::LST_GATE);
#pragma unroll 1
  for (int job = blockIdx.x; job < 256; job += gridDim.x) {
    if (job < 128) router_job(a, job, smem, tid, cnt, lst_slot, lst_gate);
    else { const int r0 = (job - 128) * 64 + (tid >> 6) * 8;
#pragma unroll 1
      for (int i = 0; i < 8; ++i) norm_row<3>(a, r0 + i, tid & 63); }
  }
}
__device__ __forceinline__ void moe_tiles(char* ws, int* tstart, int tid) {
  const int* cnt = wsp<int>(ws, WS::TILE_EXP);
  if (tid < 32) {
    int acc = 0;
#pragma unroll 1
    for (int e2 = 0; e2 < tid; ++e2) acc += (ld_i(cnt + e2) + 255) >> 8;
    const int c = ld_i(cnt + tid);
    tstart[tid] = acc; tstart[40 + tid] = c;
    if (tid == 31) tstart[32] = acc + ((c + 255) >> 8);
  }
  __syncthreads();
}

template <int MODE>
__device__ __forceinline__ void phase_gemm(char* ws, int l, u16* shm) {
  OPAQUE_WS(ws);
  if (MODE == 0) {
    const u16* Bt = wsp<u16>(ws, WS::WT_IN) + (long)l * PC * DM; const u16* xn = wsp<u16>(ws, WS::XN); u16* proj = wsp<u16>(ws, WS::PROJ);
#pragma unroll 1
    for (int u = blockIdx.x; u < ((PC / 256 + 7) / 8) * 256; u += gridDim.x) {
      int pm, pn; unit_map(u & 255, u >> 8, pm, pn);
      if (pn >= PC / 256) continue;
      EpiProj e{proj, pm * 256, pn * 256};
      gemm256(xn + (long)pm * 256 * DM, DM, Bt + (long)pn * 256 * DM, DM, DM, shm, e);
    }
  } else if (MODE == 1) {
    const u16* Bt = wsp<u16>(ws, WS::WT_O) + (long)l * DM * DM; const u16* ycat = wsp<u16>(ws, WS::YCAT);
    const u16* gates = wsp<u16>(ws, WS::PROJ) + OFF_G; u16* merged = wsp<u16>(ws, WS::MERGED);
#pragma unroll 1
    for (int u = blockIdx.x; u < 512; u += gridDim.x) {
      int pm, pn2; unit_map(u & 255, 0, pm, pn2);
      const int pn = pn2 * 2 + (u >> 8);
      gemm_merge(ycat, Bt, gates, merged, pm * 256, pn * 128, shm);
    }
  } else if (MODE == 2) {
    const u16* Bt = wsp<u16>(ws, WS::WT_OUT) + (long)l * DM * DM; const u16* merged = wsp<u16>(ws, WS::MERGED);
#pragma unroll 1
    for (int u = blockIdx.x; u < 256; u += gridDim.x) {
      int pm, pn; unit_map(u, 0, pm, pn);
      EpiResid e{wsp<float>(ws, WS::H), pm * 256, pn * 256};
      gemm256(merged + (long)pm * 256 * DM, DM, Bt + (long)pn * 256 * DM, DM, DM, shm, e);
    }
  } else if (MODE == 3) {
    int tid = threadIdx.x; asm volatile("" : "+v"(tid));
    int* tstart = (int*)((char*)shm + SHM_B); moe_tiles(ws, tstart, tid);
    const int nu = tstart[32] * 8; const u16* Bt = wsp<u16>(ws, WS::WGU) + (long)l * NEXP * 2048 * DM; const u16* xn = wsp<u16>(ws, WS::XN);
    const int* lst_slot = wsp<int>(ws, WS::LST_SLOT);
#pragma unroll 1
    for (int u = blockIdx.x; u < nu; u += gridDim.x) {
      const int rt = u >> 3, ct = u & 7; int ex = 0;
#pragma unroll 1
      while (rt >= tstart[ex + 1]) ++ex;
      const int rtl = rt - tstart[ex], nvalid = tstart[40 + ex] - rtl * 256;
      int arow[4];
#pragma unroll
      for (int i = 0; i < 2; ++i) { int r_, c_; stage_rc(tid * 16 + i * 8192, r_, c_);
#pragma unroll
        for (int hf = 0; hf < 2; ++hf) { const int r = hf * HALF + r_; arow[hf * 2 + i] = (r < nvalid ? (lst_slot[ex * LCAP + rtl * 256 + r] >> 1) : 0) * (DM * 2) + c_ * 2; } }
      EpiGateUp e{wsp<u16>(ws, WS::HMID), rt * 256, ct};
      gemm256g<true>(xn, DM, Bt + ((long)ex * 2048 + ct * 256) * DM, DM, DM, shm, e, arow);
    }
  } else {
    int tid = threadIdx.x; asm volatile("" : "+v"(tid));
    int* tstart = (int*)((char*)shm + SHM_B); moe_tiles(ws, tstart, tid);
    const int nu = tstart[32] * 8; const u16* Bt = wsp<u16>(ws, WS::WDN) + (long)l * NEXP * DM * DEXP; const u16* hmid = wsp<u16>(ws, WS::HMID);
#pragma unroll 1
    for (int u = blockIdx.x; u < nu; u += gridDim.x) {
      const int rt = u >> 3, ct = u & 7; int ex = 0;
#pragma unroll 1
      while (rt >= tstart[ex + 1]) ++ex;
      const int rtl = rt - tstart[ex], nvalid = tstart[40 + ex] - rtl * 256;
      EpiDown e{wsp<float>(ws, WS::YBUF), wsp<int>(ws, WS::LST_SLOT) + ex * LCAP + rtl * 256, wsp<float>(ws, WS::LST_GATE) + ex * LCAP + rtl * 256, nvalid, ct * 256};
      gemm256(hmid + (long)rt * 256 * DEXP, DEXP, Bt + ((long)ex * DM + ct * 256) * DEXP, DEXP, DEXP, shm, e);
    }
  }
}

__device__ __forceinline__ MixP make_mixp(char* ws, const char* smem, int l) {
  OPAQUE_WS(ws); asm volatile("" : "+s"(l));
  MixP mp;
  mp.proj = wsp<u16>(ws, WS::PROJ); mp.pos = (const int*)in_ptr(smem, 1); mp.ycat = wsp<u16>(ws, WS::YCAT);
  MixBuf& b = mp.b;
  b.rw_Rb = wsp<u16>(ws, WS::RW_RB); b.rw_Pab = wsp<u16>(ws, WS::RW_PAB); b.rw_Pak = wsp<u16>(ws, WS::RW_PAK); b.rw_VT = wsp<u16>(ws, WS::RW_VT); b.rw_S0 = wsp<u16>(ws, WS::RW_S0); b.rw_UT = wsp<u16>(ws, WS::RW_UT);
  b.rw_WpF = wsp<u16>(ws, WS::RW_WPF); b.rw_BtF = wsp<u16>(ws, WS::RW_BTF); b.rw_G = wsp<u16>(ws, WS::RW_G); b.rw_BV = wsp<u16>(ws, WS::RW_BV);
  b.rw_U0F = wsp<float>(ws, WS::RW_U0F); b.rw_KVF = wsp<float>(ws, WS::RW_KVF); b.rw_gam = wsp<float>(ws, WS::RW_GAM);
  b.rt_Rb = wsp<u16>(ws, WS::RT_RB); b.rt_Pak = wsp<u16>(ws, WS::RT_PAK); b.rt_VT = wsp<u16>(ws, WS::RT_VT); b.rt_S0 = wsp<u16>(ws, WS::RT_S0); b.rt_KVT = wsp<float>(ws, WS::RT_KVT);
  b.gl_Rb = wsp<u16>(ws, WS::GL_RB); b.gl_Pak = wsp<u16>(ws, WS::GL_PAK); b.gl_VT = wsp<u16>(ws, WS::GL_VT); b.gl_S0 = wsp<u16>(ws, WS::GL_S0); b.gl_KVT = wsp<float>(ws, WS::GL_KVT); b.gl_gam = wsp<float>(ws, WS::GL_GAM);
  b.lr_h = wsp<float>(ws, WS::LR_H); b.lr_A = wsp<float>(ws, WS::LR_A); b.lr_Hp = wsp<float>(ws, WS::LR_HP);
  mp.rw = RwkvP{in_ptr(smem, 4) + l * 1696, in_ptr(smem, 5) + l * 512, in_ptr(smem, 6) + l * 32 * 512, in_ptr(smem, 7) + l * 512, in_ptr(smem, 8) + l * 32 * 512, in_ptr(smem, 9) + l * 96 * 512,
                in_ptr(smem, 10) + l * 512, in_ptr(smem, 11) + l * 512, in_ptr(smem, 12) + l * 512, in_ptr(smem, 13) + l * 512, in_ptr(smem, 14) + l * 512};
  mp.ret_norm_g = in_ptr(smem, 16) + l * 512;
  mp.lru = LruP{in_ptr(smem, 18) + l * 4 * 512, in_ptr(smem, 19) + l * 512, in_ptr(smem, 20) + l * 8 * 64 * 64, in_ptr(smem, 21) + l * 512, in_ptr(smem, 22) + l * 8 * 64 * 64, in_ptr(smem, 23) + l * 512, in_ptr(smem, 24) + l * 512};
  mp.gla_alpha_up = in_ptr(smem, 26) + l * 16 * 256; mp.gla_alpha_b = in_ptr(smem, 27) + l * 256; mp.gla_norm_g = in_ptr(smem, 28) + l * 512;
  return mp;
}
constexpr int PH_PER_LAYER = 10, N_PHASES = 1 + NL * PH_PER_LAYER + 1;
#ifndef PROBE_MASK
#define PROBE_MASK 0
#endif
#define RUN_PH(id, code) do { const int _id = (id); if (_id >= ph0 && _id < ph1) { const int _kind = _id == 0 ? 12 : (_id == N_PHASES - 1 ? 13 : (_id - 1) % PH_PER_LAYER); \
    if ((PROBE_MASK >> _kind) & 1) { code; xcd_barrier_l(bar); } code; if (_id + 1 < ph1) xcd_barrier_l(bar); } } while (0)
__global__ __launch_bounds__(512, 2) void k_mega(MegaP p, int ph0, int ph1) {
  extern __shared__ __attribute__((aligned(16))) char smem0[];
  volatile LAS unsigned* xbw = (volatile LAS unsigned*)(smem0 + XBW_OFF);
  char* const smem = smem0 + PH_OFF;
  if (threadIdx.x == 0) {
    xbw[0] = 0u; xbw[1] = 0u; xbw[2] = 0u; xbw[3] = 0u;
    unsigned long long* tbl = (unsigned long long*)(smem0 + TBL_OFF);
#pragma unroll
    for (int i = 0; i < 40; ++i) tbl[i] = (unsigned long long)p.in[i];
  }
  __syncthreads();
  char* ws = p.ws; float* outp = p.out;
  const XcdBarrier bar = xcd_barrier_post((unsigned*)ws, xbw);
  if (ph1 - ph0 > 1) xcd_barrier(bar);
  RUN_PH(0, { phase_convert(ws, smem); NormArgs a{}; a.x = in_ptr(smem, 0); a.h = wsp<float>(ws, WS::H); a.g = in_ptr(smem, 2); a.xn = wsp<u16>(ws, WS::XN); phase_norm<0>(a); });
#pragma unroll 1
  for (int l = 0; l < NL; ++l) {
    const int pb = 1 + l * PH_PER_LAYER;
    RUN_PH(pb + 0, { if (l > 0) { NormArgs a{}; a.h = wsp<float>(ws, WS::H); a.g = in_ptr(smem, 2) + (long)l * DM; a.xn = wsp<u16>(ws, WS::XN); a.ybuf = wsp<float>(ws, WS::YBUF); phase_norm<1>(a); } });
    RUN_PH(pb + 1, phase_gemm<0>(ws, l, (u16*)smem));
    RUN_PH(pb + 2, { const MixP mp = make_mixp(ws, smem, l); phase_mix3(mp, smem); });
    RUN_PH(pb + 3, { const MixP mp = make_mixp(ws, smem, l); phase_mix4(mp, smem); });
    RUN_PH(pb + 4, { const MixP mp = make_mixp(ws, smem, l); phase_mix5(mp); { int t_ = threadIdx.x; asm volatile("" : "+v"(t_)); if (blockIdx.x == 0 && t_ < 32) wsp<int>(ws, WS::TILE_EXP)[t_] = 0; } });
    RUN_PH(pb + 5, phase_gemm<1>(ws, l, (u16*)smem));
    RUN_PH(pb + 6, phase_gemm<2>(ws, l, (u16*)smem));
    RUN_PH(pb + 7, { NormArgs a{}; a.h = wsp<float>(ws, WS::H); a.g = in_ptr(smem, 31) + (long)l * DM; a.xn = wsp<u16>(ws, WS::XN); a.wg = in_ptr(smem, 32) + (long)l * DM * 4; a.bg = in_ptr(smem, 33) + l * 4;
      a.we = in_ptr(smem, 34) + (long)l * DM * 32; a.be = in_ptr(smem, 35) + l * 32; phase_n3(ws, a, smem); });
    RUN_PH(pb + 8, phase_gemm<3>(ws, l, (u16*)smem));
    RUN_PH(pb + 9, phase_gemm<4>(ws, l, (u16*)smem));
  }
  RUN_PH(N_PHASES - 1, { NormArgs a{}; a.h = wsp<float>(ws, WS::H); a.g = in_ptr(smem, 39); a.out = outp; a.ybuf = wsp<float>(ws, WS::YBUF); phase_norm<2>(a); });
}


extern "C" void kernel_launch(void* const* d_in, const int* in_sizes, int n_in, void* d_out, int out_size, void* d_ws, size_t ws_size, hipStream_t stream) {
  (void)in_sizes; (void)n_in; (void)out_size; (void)ws_size;
  MegaP p{};
  for (int i = 0; i < 40; ++i) p.in[i] = (const float*)d_in[i];
  p.ws = (char*)d_ws; p.out = (float*)d_out;
  static int grid = 0;
  if (!grid) {
    (void)hipFuncSetAttribute((const void*)k_mega, hipFuncAttributeMaxDynamicSharedMemorySize, LDS_BYTES);
    int dev = 0, cus = 0, per_cu = 0;
    (void)hipGetDevice(&dev);
    (void)hipDeviceGetAttribute(&cus, hipDeviceAttributeMultiprocessorCount, dev);
    (void)hipOccupancyMaxActiveBlocksPerMultiprocessor(&per_cu, (const void*)k_mega, 512, LDS_BYTES);
    grid = cus < 256 ? cus : 256;
    if (per_cu < 1) grid = 0;
  }
#ifndef MK_SPLIT
#define MK_SPLIT 0
#define PROBE_MASK 0
#endif
  if (grid > 0) {
    if (MK_SPLIT) { for (int ph = 0; ph < N_PHASES; ++ph) k_mega<<<grid, 512, LDS_BYTES, stream>>>(p, ph, ph + 1); }
    else { (void)hipMemsetAsync(d_ws, 0, XCD_BAR_WORDS * sizeof(unsigned), stream); k_mega<<<grid, 512, LDS_BYTES, stream>>>(p, 0, N_PHASES); }
  }
}
```

```cpp
#define RWKV_CHUNKED_FLAG true
#define MK_SPLIT 0
#define PROBE_MASK 0
#include <hip/hip_runtime.h>
#include <stdint.h>

#define LAS __attribute__((address_space(3)))
typedef unsigned short u16;
typedef __attribute__((ext_vector_type(8))) short bf16x8;
typedef __attribute__((ext_vector_type(4))) float f32x4;

constexpr int T_ = 8192, DM = 2048, NL = 2, MIXW = 512;
constexpr int IN_COLS = 14512, PC = 14592;
constexpr int OFF_A = 0, OFF_B = 1696, OFF_C = 3744, OFF_D = 4768, OFF_G = 6400, NONGATE = 6320;
constexpr int NEXP = 32, DEXP = 1024;
constexpr int MAXROWS = 24576, MAXRT = 96, LCAP = 8192;

typedef __attribute__((ext_vector_type(2))) float f32x2_t;
typedef __attribute__((ext_vector_type(2))) __bf16 bf16x2_t;
__device__ __forceinline__ unsigned pack_bf16(float lo, float hi) { f32x2_t v = {lo, hi}; return __builtin_bit_cast(unsigned, __builtin_convertvector(v, bf16x2_t)); }
__device__ __forceinline__ u16 f2bf(float f) { return (u16)pack_bf16(f, 0.f); }
__device__ __forceinline__ float bf2f(u16 h) { return __uint_as_float(((unsigned)h) << 16); }
__device__ __forceinline__ float sigmoidf_(float x) { return __builtin_amdgcn_rcpf(1.f + __expf(-x)); }
__device__ __forceinline__ void lds_barrier() { asm volatile("s_waitcnt lgkmcnt(0)" ::: "memory"); __builtin_amdgcn_s_barrier(); asm volatile("" ::: "memory"); }
__device__ __forceinline__ float wave_sum(float v) {
#pragma unroll
  for (int o = 32; o > 0; o >>= 1) v += __shfl_xor(v, o, 64);
  return v;
}

constexpr int BKK = 64, HALF = 128, HT = HALF * BKK, SHM_B = 8 * HT * 2;
__device__ __forceinline__ int lds_byte(int r, int c) {
  int st = (r >> 4) * 2 + (c >> 5), rr = r & 15, cc = c & 31, ob = rr * 64 + cc * 2;
  return st * 1024 + (ob ^ (((ob >> 9) & 1) << 5));
}
__device__ __forceinline__ void stage_rc(int b, int& R, int& C) {
  int st = b / 1024, sb = b % 1024, swz = sb ^ (((sb >> 9) & 1) << 5);
  R = (st >> 1) * 16 + swz / 64; C = (st & 1) * 32 + (swz % 64) / 2;
}

template <bool GATHER, class Epi>
__device__ __forceinline__ void gemm256g(const u16* __restrict__ A, int lda, const u16* __restrict__ Bt, int ldb, int K, u16* shm, const Epi& epi, const int (&arow)[4]) {
#define SA(b, h) (shm + ((b) * 2 + (h)) * HT)
#define SB(b, h) (shm + (4 + (b) * 2 + (h)) * HT)
#define STAGE_X(TT, P, BASE, LD, br, kt) do { const u16* _g = (BASE) + (long)(br) * (LD) + (long)(kt) * BKK; \
    _Pragma("unroll") for (int _i = 0; _i < 2; ++_i) { int _b = (TT) * 16 + _i * 8192; int _r, _c; stage_rc(_b, _r, _c); \
      __builtin_amdgcn_global_load_lds((const unsigned*)(_g + (long)_r * (LD) + _c), (unsigned*)((char*)(P) + _b), 16, 0, 0); } } while (0)
#define STAGE_AG(TT, P, br, kt) do { \
    _Pragma("unroll") for (int _i = 0; _i < 2; ++_i) { int _b = (TT) * 16 + _i * 8192; \
      __builtin_amdgcn_global_load_lds((const unsigned*)((const char*)A + (unsigned)(arow[((br) / HALF) * 2 + _i] + (kt) * (BKK * 2))), (unsigned*)((char*)(P) + _b), 16, 0, 0); } } while (0)
#define STAGE_A(P, br, kt) do { if (GATHER) STAGE_AG(tid0, P, br, kt); else STAGE_X(tid0, P, A, lda, br, kt); } while (0)
#define STAGE_B(P, br, kt) STAGE_X(tid0, P, Bt, ldb, br, kt)
#define LDA(dst, b, h) _Pragma("unroll") for (int m = 0; m < 4; ++m) _Pragma("unroll") for (int k = 0; k < 2; ++k) \
    dst[m][k] = *reinterpret_cast<const bf16x8*>((char*)SA(b, h) + lds_byte(wr * 64 + m * 16 + fr, k * 32 + fq * 8))
#define LDB(dst, b, h) _Pragma("unroll") for (int n = 0; n < 2; ++n) _Pragma("unroll") for (int k = 0; k < 2; ++k) \
    dst[n][k] = *reinterpret_cast<const bf16x8*>((char*)SB(b, h) + lds_byte(wc * 32 + n * 16 + fr, k * 32 + fq * 8))
#define MMA(ai, bj, At, Bx) do { __builtin_amdgcn_s_setprio(1); \
    _Pragma("unroll") for (int m = 0; m < 4; ++m) _Pragma("unroll") for (int n = 0; n < 2; ++n) _Pragma("unroll") for (int k = 0; k < 2; ++k) \
      acc[ai][bj][m][n] = __builtin_amdgcn_mfma_f32_16x16x32_bf16(Bx[n][k], At[m][k], acc[ai][bj][m][n], 0, 0, 0); \
    __builtin_amdgcn_s_setprio(0); } while (0)
#define WAIT_V(n) asm volatile("s_waitcnt vmcnt(" #n ")" ::: "memory")
#define WAIT_L(n) asm volatile("s_waitcnt lgkmcnt(" #n ")" ::: "memory")
#define BAR __builtin_amdgcn_s_barrier()
#define SCHED __builtin_amdgcn_sched_barrier(0)
  int tid0 = threadIdx.x; asm volatile("" : "+v"(tid0));
  int wid = tid0 >> 6, lane = tid0 & 63, wr = wid >> 2, wc = wid & 3, fr = lane & 15, fq = lane >> 4;
  f32x4 acc[2][2][4][2] = {};
  bf16x8 At[4][2], B0[2][2], B1[2][2];
  const int nt = K / BKK;
  STAGE_B(SB(0, 0), 0, 0); STAGE_A(SA(0, 0), 0, 0);
  STAGE_B(SB(0, 1), HALF, 0); STAGE_A(SA(0, 1), HALF, 0);
  if (wr == 1) BAR;
  WAIT_V(4); BAR;
  STAGE_B(SB(1, 0), 0, 1); STAGE_A(SA(1, 0), 0, 1); STAGE_B(SB(1, 1), HALF, 1);
  WAIT_V(6); BAR;
  for (int t = 0; t < nt - 2; t += 2) {
    LDB(B0, 0, 0); SCHED; LDA(At, 0, 0); STAGE_A(SA(1, 1), HALF, t + 1);
    WAIT_L(8); BAR; WAIT_L(0); MMA(0, 0, At, B0); BAR; SCHED;
    LDB(B1, 0, 1); STAGE_B(SB(0, 0), 0, t + 2);
    BAR; WAIT_L(0); MMA(0, 1, At, B1); BAR;
    LDA(At, 0, 1); STAGE_A(SA(0, 0), 0, t + 2);
    BAR; WAIT_L(0); MMA(1, 0, At, B0); BAR; SCHED;
    STAGE_B(SB(0, 1), HALF, t + 2);
    WAIT_V(6); BAR; MMA(1, 1, At, B1); BAR;
    LDB(B0, 1, 0); SCHED; LDA(At, 1, 0); STAGE_A(SA(0, 1), HALF, t + 2);
    WAIT_L(8); BAR; WAIT_L(0); MMA(0, 0, At, B0); BAR; SCHED;
    LDB(B1, 1, 1); STAGE_B(SB(1, 0), 0, t + 3);
    BAR; WAIT_L(0); MMA(0, 1, At, B1); BAR;
    LDA(At, 1, 1); STAGE_A(SA(1, 0), 0, t + 3);
    BAR; WAIT_L(0); MMA(1, 0, At, B0); BAR; SCHED;
    STAGE_B(SB(1, 1), HALF, t + 3);
    WAIT_V(6); BAR; MMA(1, 1, At, B1); BAR;
  }
  int tz = threadIdx.x; asm volatile("" : "+v"(tz)); wid = tz >> 6; lane = tz & 63; wr = wid >> 2; wc = wid & 3; fr = lane & 15; fq = lane >> 4;
  { LDB(B0, 0, 0); WAIT_V(0); LDA(At, 0, 0); if (GATHER) STAGE_AG(tz, SA(1, 1), HALF, nt - 1); else STAGE_X(tz, SA(1, 1), A, lda, HALF, nt - 1);
    BAR; WAIT_L(0); MMA(0, 0, At, B0); BAR;
    LDB(B1, 0, 1); BAR; WAIT_L(0); MMA(0, 1, At, B1); BAR;
    LDA(At, 0, 1); WAIT_V(4); BAR; WAIT_L(0); MMA(1, 0, At, B0); MMA(1, 1, At, B1); BAR; }
  { LDB(B0, 1, 0); LDA(At, 1, 0); WAIT_V(2); BAR; WAIT_L(0); MMA(0, 0, At, B0); BAR;
    LDB(B1, 1, 1); WAIT_V(0); BAR; WAIT_L(0); MMA(0, 1, At, B1); BAR;
    LDA(At, 1, 1); BAR; WAIT_L(0); MMA(1, 0, At, B0); MMA(1, 1, At, B1); BAR; }
  if (wr == 0) BAR;
  epi(acc, wr, wc, fr, fq);
  __syncthreads();
#undef SA
#undef SB
}

template <class Epi>
__device__ __forceinline__ void gemm256(const u16* __restrict__ A, int lda, const u16* __restrict__ Bt, int ldb, int K, u16* shm, const Epi& epi) {
  const int dummy[4] = {0, 0, 0, 0};
  gemm256g<false>(A, lda, Bt, ldb, K, shm, epi, dummy);
}
#define UNR _Pragma("unroll")
#define EPI4 UNR for (int ai = 0; ai < 2; ++ai) UNR for (int bj = 0; bj < 2; ++bj) UNR for (int m = 0; m < 4; ++m) UNR for (int n = 0; n < 2; ++n)
#define EPI_R (ai * HALF + wr * 64 + m * 16 + fr)
#define EPI_C (bj * HALF + wc * 32 + n * 16 + fq * 4)
__device__ __forceinline__ uint2 pack4(const f32x4& v) { uint2 r; r.x = pack_bf16(v[0], v[1]); r.y = pack_bf16(v[2], v[3]); return r; }

struct EpiProj {
  u16* proj; int brow, bcol;
  __device__ __forceinline__ void operator()(const f32x4 (&acc)[2][2][4][2], int wr, int wc, int fr, int fq) const {
    u16* base = proj + (long)(brow + wr * 64 + fr) * PC + bcol + wc * 32 + fq * 4;
    if (bcol >= OFF_G) {
      EPI4 { f32x4 v = acc[ai][bj][m][n]; v[0] = sigmoidf_(v[0]); v[1] = sigmoidf_(v[1]); v[2] = sigmoidf_(v[2]); v[3] = sigmoidf_(v[3]);
             *(uint2*)(base + (long)(ai * HALF + m * 16) * PC + bj * HALF + n * 16) = pack4(v); }
    } else {
      EPI4 { *(uint2*)(base + (long)(ai * HALF + m * 16) * PC + bj * HALF + n * 16) = pack4(acc[ai][bj][m][n]); }
    }
  }
};
struct EpiResid {
  float* h; int brow, bcol;
  __device__ __forceinline__ void operator()(const f32x4 (&acc)[2][2][4][2], int wr, int wc, int fr, int fq) const {
    float* base = h + (long)(brow + wr * 64 + fr) * DM + bcol + wc * 32 + fq * 4;
    UNR for (int ai = 0; ai < 2; ++ai) UNR for (int m = 0; m < 4; ++m) {
      f32x4 o[2][2];
      UNR for (int bj = 0; bj < 2; ++bj) UNR for (int n = 0; n < 2; ++n) o[bj][n] = *(const f32x4*)(base + (long)(ai * HALF + m * 16) * DM + bj * HALF + n * 16);
      UNR for (int bj = 0; bj < 2; ++bj) UNR for (int n = 0; n < 2; ++n) *(f32x4*)(base + (long)(ai * HALF + m * 16) * DM + bj * HALF + n * 16) = o[bj][n] + acc[ai][bj][m][n];
    }
  }
};
struct EpiGateUp {
  u16* hmid; int brow, ct;
  __device__ __forceinline__ void operator()(const f32x4 (&acc)[2][2][4][2], int wr, int wc, int fr, int fq) const {
    u16* base = hmid + (long)(brow + wr * 64 + fr) * DEXP + ct * 128 + wc * 32 + fq * 4;
    UNR for (int ai = 0; ai < 2; ++ai) UNR for (int m = 0; m < 4; ++m) UNR for (int n = 0; n < 2; ++n) {
      const f32x4 g = acc[ai][0][m][n], u = acc[ai][1][m][n]; f32x4 v;
      UNR for (int j = 0; j < 4; ++j) v[j] = g[j] * sigmoidf_(g[j]) * u[j];
      *(uint2*)(base + (long)(ai * HALF + m * 16) * DEXP + n * 16) = pack4(v); }
  }
};
struct EpiDown {
  float* ybuf; const int* lslot; const float* lgate; int nvalid, bcol;
  __device__ __forceinline__ void operator()(const f32x4 (&acc)[2][2][4][2], int wr, int wc, int fr, int fq) const {
    UNR for (int ai = 0; ai < 2; ++ai) UNR for (int m = 0; m < 4; ++m) {
      const int r = ai * HALF + wr * 64 + m * 16 + fr;
      if (r < nvalid) { const int slot = lslot[r]; const float gt = lgate[r];
        float* yp = ybuf + (long)slot * DM + bcol + wc * 32 + fq * 4;
        UNR for (int bj = 0; bj < 2; ++bj) UNR for (int n = 0; n < 2; ++n) *(f32x4*)(yp + bj * HALF + n * 16) = acc[ai][bj][m][n] * gt; } }
  }
};

__device__ __forceinline__ void gemm_merge(const u16* __restrict__ A, const u16* __restrict__ Bt, const u16* __restrict__ gates, u16* __restrict__ out, int brow, int bcol, u16* shm) {
#define MA(b, h) (shm + ((b) * 3 + (h)) * HT)
#define MB(b) (shm + ((b) * 3 + 2) * HT)
#define MSTAGE(P, BASE, LD_, br, kt) do { const u16* _g = (BASE) + (long)(br) * (LD_) + (long)(kt) * BKK; \
    _Pragma("unroll") for (int _i = 0; _i < 2; ++_i) { int _b = tid0 * 16 + _i * 8192; int _r, _c; stage_rc(_b, _r, _c); \
      __builtin_amdgcn_global_load_lds((const unsigned*)(_g + (long)_r * (LD_) + _c), (unsigned*)((char*)(P) + _b), 16, 0, 0); } } while (0)
  int tid0 = threadIdx.x; asm volatile("" : "+v"(tid0));
  const int wid = tid0 >> 6, lane = tid0 & 63, wr = wid >> 2, wc = wid & 3, fr = lane & 15, fq = lane >> 4;
  f32x4 acc[2][4][2], R[2][4][2];
#pragma unroll
  for (int ai = 0; ai < 2; ++ai)
#pragma unroll
    for (int m = 0; m < 4; ++m)
#pragma unroll
      for (int n = 0; n < 2; ++n) { acc[ai][m][n] = (f32x4){0.f, 0.f, 0.f, 0.f}; R[ai][m][n] = (f32x4){0.f, 0.f, 0.f, 0.f}; }
  const u16* Ab = A + (long)brow * DM; const u16* Bb = Bt + (long)bcol * DM;
  MSTAGE(MA(0, 0), Ab, DM, 0, 0); MSTAGE(MA(0, 1), Ab, DM, HALF, 0); MSTAGE(MB(0), Bb, DM, 0, 0);
  asm volatile("s_waitcnt vmcnt(0)" ::: "memory"); __syncthreads();
#pragma unroll 1
  for (int q = 0; q < 32; ++q) {
    const int b = q & 1;
    if (q + 1 < 32) { MSTAGE(MA(b ^ 1, 0), Ab, DM, 0, q + 1); MSTAGE(MA(b ^ 1, 1), Ab, DM, HALF, q + 1); MSTAGE(MB(b ^ 1), Bb, DM, 0, q + 1); }
    bf16x8 Bf[2][2], Af[4][2];
#pragma unroll
    for (int n = 0; n < 2; ++n)
#pragma unroll
      for (int k = 0; k < 2; ++k) Bf[n][k] = *reinterpret_cast<const bf16x8*>((char*)MB(b) + lds_byte(wc * 32 + n * 16 + fr, k * 32 + fq * 8));
#pragma unroll
    for (int ai = 0; ai < 2; ++ai) {
#pragma unroll
      for (int m = 0; m < 4; ++m)
#pragma unroll
        for (int k = 0; k < 2; ++k) Af[m][k] = *reinterpret_cast<const bf16x8*>((char*)MA(b, ai) + lds_byte(wr * 64 + m * 16 + fr, k * 32 + fq * 8));
#pragma unroll
      for (int m = 0; m < 4; ++m)
#pragma unroll
        for (int n = 0; n < 2; ++n)
#pragma unroll
          for (int k = 0; k < 2; ++k) acc[ai][m][n] = __builtin_amdgcn_mfma_f32_16x16x32_bf16(Bf[n][k], Af[m][k], acc[ai][m][n], 0, 0, 0);
    }
    if ((q & 7) == 7) {
      const int kb = q >> 3;
      const u16* gp = gates + (long)(brow + wr * 64 + fr) * PC + kb * DM + bcol + wc * 32 + fq * 4;
#pragma unroll
      for (int ai = 0; ai < 2; ++ai) {
        uint2 g2[4][2];
#pragma unroll
        for (int m = 0; m < 4; ++m)
#pragma unroll
          for (int n = 0; n < 2; ++n) g2[m][n] = *(const uint2*)(gp + (long)(ai * HALF + m * 16) * PC + n * 16);
#pragma unroll
        for (int m = 0; m < 4; ++m)
#pragma unroll
          for (int n = 0; n < 2; ++n) {
            const f32x4 gv = {__uint_as_float(g2[m][n].x << 16), __uint_as_float(g2[m][n].x & 0xffff0000u), __uint_as_float(g2[m][n].y << 16), __uint_as_float(g2[m][n].y & 0xffff0000u)};
            R[ai][m][n] += gv * acc[ai][m][n]; acc[ai][m][n] = (f32x4){0.f, 0.f, 0.f, 0.f};
          }
      }
    }
    asm volatile("s_waitcnt vmcnt(0)" ::: "memory"); __syncthreads();
  }
  u16* op = out + (long)(brow + wr * 64 + fr) * DM + bcol + wc * 32 + fq * 4;
#pragma unroll
  for (int ai = 0; ai < 2; ++ai)
#pragma unroll
    for (int m = 0; m < 4; ++m)
#pragma unroll
      for (int n = 0; n < 2; ++n) *(uint2*)(op + (long)(ai * HALF + m * 16) * DM + n * 16) = pack4(R[ai][m][n]);
#undef MA
#undef MB
#undef MSTAGE
}
__device__ __forceinline__ void unit_map(int b, int round, int& pm, int& pn) {
  int xcd = b & 7, i = b >> 3, pr = xcd >> 1, pc = xcd & 1, lr = i & 7, lc = i >> 3;
  pm = pr * 8 + lr; pn = round * 8 + pc * 4 + lc;
}
constexpr int CH = 64, NCH = T_ / CH;
struct MegaP { const float* in[40]; char* ws; float* out; };
namespace WS {
constexpr size_t al(size_t x) { return (x + 255) & ~(size_t)255; }
constexpr size_t U8 = (size_t)1024 * 4096 * 2;
constexpr size_t BARW = 0;
constexpr size_t WT_IN = BARW + 65536;
constexpr size_t WT_O = WT_IN + al((size_t)NL * PC * DM * 2);
constexpr size_t WT_OUT = WT_O + al((size_t)NL * 4 * DM * MIXW * 2);
constexpr size_t WGU = WT_OUT + al((size_t)NL * DM * DM * 2);
constexpr size_t WDN = WGU + al((size_t)NL * NEXP * 2048 * DM * 2);
constexpr size_t H = WDN + al((size_t)NL * NEXP * DM * DEXP * 2);
constexpr size_t XN = H + al((size_t)T_ * DM * 4);
constexpr size_t PROJ = XN + al((size_t)T_ * DM * 2);
constexpr size_t YCAT = PROJ + al((size_t)T_ * PC * 2);
constexpr size_t MBUF = YCAT + al((size_t)T_ * DM * 2);
constexpr size_t MERGED = MBUF + al((size_t)T_ * DM * 4);
constexpr size_t TOK_E = MERGED + al((size_t)T_ * DM * 2);
constexpr size_t TOK_G = TOK_E + al((size_t)2 * T_ * 4);
constexpr size_t ROW_TOK = TOK_G + al((size_t)2 * T_ * 4);
constexpr size_t ROW_SLOT = ROW_TOK + al((size_t)MAXROWS * 4);
constexpr size_t ROW_GATE = ROW_SLOT + al((size_t)MAXROWS * 4);
constexpr size_t TILE_EXP = ROW_GATE + al((size_t)MAXROWS * 4);
constexpr size_t NRT = TILE_EXP + 1024;
constexpr size_t XG = NRT + 256;
constexpr size_t HMID = XG + al((size_t)MAXROWS * DM * 2);
constexpr size_t YBUF = HMID + al((size_t)MAXROWS * DEXP * 2);
constexpr size_t RW_RB = YBUF + al((size_t)2 * T_ * DM * 4);
constexpr size_t RW_PAB = RW_RB + U8, RW_PAK = RW_PAB + U8, RW_VT = RW_PAK + U8, RW_S0 = RW_VT + U8, RW_UT = RW_S0 + U8, RW_WPF = RW_UT + U8, RW_BTF = RW_WPF + U8;
constexpr size_t RW_G = RW_BTF + U8, RW_BV = RW_G + U8, RW_U0F = RW_BV + U8, RW_KVF = RW_U0F + 2 * U8, RW_GAM = RW_KVF + 2 * U8;
constexpr size_t RT_RB = RW_GAM + 262144, RT_PAK = RT_RB + U8, RT_VT = RT_PAK + U8, RT_S0 = RT_VT + U8, RT_KVT = RT_S0 + U8;
constexpr size_t GL_RB = RT_KVT + 2 * U8, GL_PAK = GL_RB + U8 / 2, GL_VT = GL_PAK + U8 / 2, GL_S0 = GL_VT + U8, GL_KVT = GL_S0 + U8, GL_GAM = GL_KVT + 2 * U8;
constexpr size_t LR_H = GL_GAM + 131072, LR_A = LR_H + (size_t)T_ * 512 * 4, LR_HP = LR_A + (size_t)T_ * 512 * 4;
constexpr size_t LST_SLOT = LR_HP + (size_t)NCH * 512 * 4;
constexpr size_t LST_GATE = LST_SLOT + (size_t)32 * 8192 * 4;
constexpr size_t RT_HI = LST_GATE + (size_t)32 * 8192 * 4;
constexpr size_t RT_LO = RT_HI + (size_t)NL * 48 * 2048 * 2;
constexpr size_t LORA_W = RT_LO + (size_t)NL * 48 * 2048 * 2;
constexpr size_t LRU_W = LORA_W + (size_t)NL * 512 * 160 * 2;
constexpr size_t END = LRU_W + (size_t)NL * 2 * 8 * 4096 * 2;
}
constexpr int TBL_OFF = 0, XBW_OFF = 320, PH_OFF = 512;
constexpr int PH_BYTES = 153600;
constexpr int LDS_BYTES = PH_OFF + PH_BYTES;
__device__ __forceinline__ const float* in_ptr(const char* smem, int i) {
  const unsigned long long v = *(const unsigned long long*)(smem - PH_OFF + TBL_OFF + i * 8);
  const unsigned lo = __builtin_amdgcn_readfirstlane((unsigned)v), hi = __builtin_amdgcn_readfirstlane((unsigned)(v >> 32));
  return (const float*)(const float __attribute__((address_space(1)))*)(((unsigned long long)hi << 32) | lo);
}
template <class T> __device__ __forceinline__ T* wsp(char* ws, size_t off) { return (T*)(ws + off); }
__device__ __forceinline__ int ld_i(const int* p) { return __hip_atomic_load(p, __ATOMIC_RELAXED, __HIP_MEMORY_SCOPE_AGENT); }
#define OPAQUE_WS(w) do { unsigned long long _z = 0; asm volatile("" : "+s"(_z)); (w) = (char*)(char __attribute__((address_space(1)))*)((unsigned long long)(w) + _z); } while (0)
__device__ __forceinline__ int bidx() { int b = blockIdx.x; asm volatile("" : "+s"(b)); return b; }
__device__ __forceinline__ int gdim() { int g = gridDim.x; asm volatile("" : "+s"(g)); return g; }

__device__ __forceinline__ void transpose_tile_w(const float* __restrict__ src, int sld, int nvalid, u16* __restrict__ dst, int K, int n0, int k0, int drow0, int mode, int lane) {
  const int kq = lane >> 4, n4 = lane & 15, nb = n0 + n4 * 4;
  f32x4 v[16];
  if (nb < nvalid) {
    const float* sp = src + (long)(k0 + kq * 16) * sld + nb;
#pragma unroll
    for (int i = 0; i < 16; ++i) v[i] = *(const f32x4*)(sp + (long)i * sld);
  } else {
#pragma unroll
    for (int i = 0; i < 16; ++i) v[i] = (f32x4){0.f, 0.f, 0.f, 0.f};
  }
#pragma unroll
  for (int jn = 0; jn < 4; ++jn) {
    const int n = nb + jn;
    const int row = (mode == 0) ? drow0 + n : ((n >> 7) * 256 + (mode == 2 ? 128 : 0) + (n & 127));
    u16* dp = dst + (long)row * K + k0 + kq * 16;
    uint4 lo, hi;
    lo.x = (unsigned)f2bf(v[0][jn]) | ((unsigned)f2bf(v[1][jn]) << 16); lo.y = (unsigned)f2bf(v[2][jn]) | ((unsigned)f2bf(v[3][jn]) << 16);
    lo.z = (unsigned)f2bf(v[4][jn]) | ((unsigned)f2bf(v[5][jn]) << 16); lo.w = (unsigned)f2bf(v[6][jn]) | ((unsigned)f2bf(v[7][jn]) << 16);
    hi.x = (unsigned)f2bf(v[8][jn]) | ((unsigned)f2bf(v[9][jn]) << 16); hi.y = (unsigned)f2bf(v[10][jn]) | ((unsigned)f2bf(v[11][jn]) << 16);
    hi.z = (unsigned)f2bf(v[12][jn]) | ((unsigned)f2bf(v[13][jn]) << 16); hi.w = (unsigned)f2bf(v[14][jn]) | ((unsigned)f2bf(v[15][jn]) << 16);
    *(uint4*)dp = lo; *(uint4*)(dp + 8) = hi;
  }
}
__device__ __forceinline__ void moe_tile(char* ws, const char* smem, int l, int t, int lane) {
  if (t < 32768) { const int up = t >> 14, e = (t & 16383) >> 9, q = t & 511, nt = q >> 5, kt = q & 31;
    transpose_tile_w(in_ptr(smem, up ? 37 : 36) + ((long)l * NEXP + e) * DM * DEXP, DEXP, DEXP, wsp<u16>(ws, WS::WGU) + ((long)l * NEXP + e) * 2048 * DM, DM, nt * 64, kt * 64, 0, up ? 2 : 1, lane);
  } else { const int t2 = t - 32768, e = t2 >> 9, q = t2 & 511, nt = q >> 4, kt = q & 15;
    transpose_tile_w(in_ptr(smem, 38) + ((long)l * NEXP + e) * DEXP * DM, DM, DM, wsp<u16>(ws, WS::WDN) + ((long)l * NEXP + e) * DM * DEXP, DEXP, nt * 64, kt * 64, 0, 0, lane); }
}
constexpr int CV_SOLVE = 6144;
constexpr int LD = 72;

struct RwkvP { const float *mu, *w0, *w_up, *a0, *a_up, *g_up, *k_k, *k_a, *r_k, *ln_g, *ln_b; const u16* lora_w; };
struct LruP { const float *conv_w, *conv_b, *w_a, *b_a, *w_x, *b_x, *lam; const u16* wt; };
struct MixBuf {
  u16 *rw_Rb, *rw_Pab, *rw_Pak, *rw_VT, *rw_S0, *rw_UT, *rw_WpF, *rw_BtF, *rw_G, *rw_BV; float *rw_U0F, *rw_KVF, *rw_gam;
  u16 *rt_Rb, *rt_Pak, *rt_VT, *rt_S0; float* rt_KVT;
  u16 *gl_Rb, *gl_Pak, *gl_VT, *gl_S0; float *gl_KVT, *gl_gam;
  float *lr_h, *lr_A, *lr_Hp;
};
struct MixP {
  const u16* proj; const int* pos; u16* ycat; MixBuf b; char* ws; const char* smem; int layer;
  RwkvP rw; const float* ret_norm_g; LruP lru; const float *gla_alpha_up, *gla_alpha_b, *gla_norm_g;
};

__device__ __forceinline__ float gelu_tanh(float x) {
  const float u = 0.7978845608028654f * (x + 0.044715f * x * x * x);
  return 0.5f * x * (1.f + tanhf(u));
}
__device__ __forceinline__ float red16(float v) {
  v += __shfl_xor(v, 1, 64); v += __shfl_xor(v, 2, 64); v += __shfl_xor(v, 4, 64); v += __shfl_xor(v, 8, 64);
  return v;
}
__device__ __forceinline__ uint4 pack8(const u16 (&a)[8]) {
  uint4 r;
  r.x = (unsigned)a[0] | ((unsigned)a[1] << 16); r.y = (unsigned)a[2] | ((unsigned)a[3] << 16);
  r.z = (unsigned)a[4] | ((unsigned)a[5] << 16); r.w = (unsigned)a[6] | ((unsigned)a[7] << 16);
  return r;
}
__device__ __forceinline__ f32x4 tile_nt(const u16* sA, const u16* sB, int mt, int nt, int r, int g) {
  f32x4 c = {0.f, 0.f, 0.f, 0.f};
#pragma unroll
  for (int s = 0; s < 2; ++s) {
    bf16x8 a = *(const bf16x8*)(sA + (16 * mt + r) * LD + 32 * s + 8 * g);
    bf16x8 b = *(const bf16x8*)(sB + (16 * nt + r) * LD + 32 * s + 8 * g);
    c = __builtin_amdgcn_mfma_f32_16x16x32_bf16(a, b, c, 0, 0, 0);
  }
  return c;
}
__device__ __forceinline__ void copy_out(const u16* s, u16* gp, int rows, int tid) {
  for (int idx = tid; idx < rows * 8; idx += 512) { int row = idx >> 3, seg = idx & 7; *(uint4*)(gp + row * 64 + seg * 8) = *(const uint4*)(s + row * LD + seg * 8); }
}
__device__ __forceinline__ void inv_perm(int x, int& s, int& g, int& j) { s = x >> 5; int rr = x & 31; g = (rr >> 2) & 3; j = 4 * (rr >> 4) + (rr & 3); }

__device__ __forceinline__ void p3_ret(const MixP& p, int c, int h, char* smem) {
  u16* sRb = (u16*)smem; u16* sKb = sRb + 64 * LD; u16* sKtT = sKb + 64 * LD; u16* sVT = sKtT + 64 * LD;
  int tid = threadIdx.x; asm volatile("" : "+v"(tid));
  const int cc = tid & 63, tg = tid >> 6, r = cc & 15, g = cc >> 4, uid = c * 8 + h;
  const float lg2 = log2f(1.f - exp2f(-(5.f + 4.f * (float)h / 7.f)));
  const float inv = exp2f(-(float)(cc & 31) * (13.287712379549449f / 32.f));
  u16 kt8[8], v8[8];
#pragma unroll
  for (int i = 0; i < 8; ++i) {
    const int tl = tg * 8 + i, t = c * 64 + tl; const u16* row = p.proj + (long)t * PC + OFF_B;
    const float q = bf2f(row[h * 64 + cc]), k = bf2f(row[512 + h * 64 + cc]);
    float sn, cs; sincosf((float)p.pos[t] * inv, &sn, &cs);
    const float qo = __shfl_xor(q, 32, 64), ko = __shfl_xor(k, 32, 64);
    const float qr = cc < 32 ? q * cs - qo * sn : q * cs + qo * sn;
    const float kr = (cc < 32 ? k * cs - ko * sn : k * cs + ko * sn) * 0.125f;
    const float e = exp2f(lg2 * (float)(tl + 1)), ei = exp2f(-lg2 * (float)(tl + 1)), et = exp2f(lg2 * (float)(63 - tl));
    sRb[tl * LD + cc] = f2bf(qr * e); sKb[tl * LD + cc] = f2bf(kr * ei); kt8[i] = f2bf(kr * et); v8[i] = row[1024 + h * 64 + cc];
  }
  *(uint4*)(sKtT + cc * LD + tg * 8) = pack8(kt8); *(uint4*)(sVT + cc * LD + tg * 8) = pack8(v8);
  lds_barrier();
  for (int tile = tg; tile < 32; tile += 8) {
    if (tile < 16) {
      const int mt = tile >> 2, nt = tile & 3; f32x4 c4 = tile_nt(sRb, sKb, mt, nt, r, g);
#pragma unroll
      for (int reg = 0; reg < 4; ++reg) { int t = 16 * mt + 4 * g + reg, i = 16 * nt + r; p.b.rt_Pak[(long)uid * 4096 + t * 64 + i] = f2bf(i <= t ? c4[reg] : 0.f); }
    } else {
      const int q = tile - 16, mt = q >> 2, nt = q & 3; f32x4 c4 = tile_nt(sVT, sKtT, mt, nt, r, g);
#pragma unroll
      for (int reg = 0; reg < 4; ++reg) { int v = 16 * mt + 4 * g + reg, k = 16 * nt + r; p.b.rt_KVT[(long)uid * 4096 + v * 64 + k] = c4[reg]; }
    }
  }
  copy_out(sRb, p.b.rt_Rb + (long)uid * 4096, 64, tid); copy_out(sVT, p.b.rt_VT + (long)uid * 4096, 64, tid);
  lds_barrier();
}

__device__ __forceinline__ void p3_gla(const MixP& p, int c, int h, char* smem) {
  u16* sRb = (u16*)smem; u16* sKb = sRb + 64 * LD; u16* sKtT = sKb + 64 * LD; u16* sVT = sKtT + 64 * LD;
  float* pre = (float*)(smem + 5 * 64 * LD * 2); float* sal = pre + 512;
  int tid = threadIdx.x; asm volatile("" : "+v"(tid));
  const int cc = tid & 63, tg = tid >> 6, r = cc & 15, g = cc >> 4, uid = c * 4 + h, hd = h * 64 + cc;
  for (int idx = tid; idx < 1024; idx += 512) { int tl = idx >> 4, j = idx & 15; sal[idx] = bf2f(p.proj[(long)(c * 64 + tl) * PC + OFF_D + 1024 + j]); }
  lds_barrier();
  float au[16];
#pragma unroll
  for (int j = 0; j < 16; ++j) au[j] = p.gla_alpha_up[j * 256 + hd];
  const float ab = p.gla_alpha_b[hd];
  float cum[8]; float run = 0.f;
#pragma unroll
  for (int i = 0; i < 8; ++i) {
    const int tl = tg * 8 + i; float x = ab;
#pragma unroll
    for (int j = 0; j < 16; ++j) x += sal[tl * 16 + j] * au[j];
    const float ls = fminf(x, 0.f) - __logf(1.f + __expf(-fabsf(x)));
    run += ls * (1.f / 16.f); cum[i] = run;
  }
  pre[tg * 64 + cc] = run;
  lds_barrier();
  float off = 0.f, tot = 0.f;
#pragma unroll
  for (int q = 0; q < 8; ++q) { float v = pre[q * 64 + cc]; tot += v; if (q < tg) off += v; }
  u16 kt8[8], v8a[8], v8b[8];
#pragma unroll
  for (int i = 0; i < 8; ++i) {
    const int tl = tg * 8 + i, t = c * 64 + tl; const u16* row = p.proj + (long)t * PC + OFF_D;
    const float cm = cum[i] + off;
    const float q = bf2f(row[hd]) * 0.125f, k = bf2f(row[256 + hd]);
    sRb[tl * LD + cc] = f2bf(q * __expf(cm)); sKb[tl * LD + cc] = f2bf(k * __expf(-cm)); kt8[i] = f2bf(k * __expf(tot - cm));
    v8a[i] = row[512 + h * 128 + cc]; v8b[i] = row[512 + h * 128 + 64 + cc];
  }
  *(uint4*)(sKtT + cc * LD + tg * 8) = pack8(kt8); *(uint4*)(sVT + cc * LD + tg * 8) = pack8(v8a); *(uint4*)(sVT + (64 + cc) * LD + tg * 8) = pack8(v8b);
  if (tg == 0) p.b.gl_gam[uid * 64 + cc] = __expf(tot);
  lds_barrier();
  for (int tile = tg; tile < 48; tile += 8) {
    if (tile < 16) {
      const int mt = tile >> 2, nt = tile & 3; f32x4 c4 = tile_nt(sRb, sKb, mt, nt, r, g);
#pragma unroll
      for (int reg = 0; reg < 4; ++reg) { int t = 16 * mt + 4 * g + reg, i = 16 * nt + r; p.b.gl_Pak[(long)uid * 4096 + t * 64 + i] = f2bf(i <= t ? c4[reg] : 0.f); }
    } else {
      const int q = tile - 16, mt = q >> 2, nt = q & 3; f32x4 c4 = tile_nt(sVT, sKtT, mt, nt, r, g);
#pragma unroll
      for (int reg = 0; reg < 4; ++reg) { int v = 16 * mt + 4 * g + reg, k = 16 * nt + r; p.b.gl_KVT[(long)uid * 8192 + v * 64 + k] = c4[reg]; }
    }
  }
  copy_out(sRb, p.b.gl_Rb + (long)uid * 4096, 64, tid); copy_out(sVT, p.b.gl_VT + (long)uid * 8192, 128, tid);
  lds_barrier();
}

__device__ __forceinline__ void p3_lru(const MixP& p, int c, int gq, char* smem) {
  u16* sx = (u16*)smem; float* sG = (float*)(smem + 9216); float* preA = sG + 8192; float* preB = preA + 512;
  int tid = threadIdx.x; asm volatile("" : "+v"(tid));
  const int cc = tid & 63, tg = tid >> 6, r = cc & 15, g = cc >> 4, ch = gq * 64 + cc, t0 = c * 64 + tg * 8;
  float xb[11];
#pragma unroll
  for (int i = 0; i < 11; ++i) { int t = t0 - 3 + i; xb[i] = t >= 0 ? bf2f(p.proj[(long)t * PC + OFF_C + ch]) : 0.f; }
  const float cw0 = p.lru.conv_w[ch], cw1 = p.lru.conv_w[512 + ch], cw2 = p.lru.conv_w[1024 + ch], cw3 = p.lru.conv_w[1536 + ch], cb = p.lru.conv_b[ch];
  float xc[8];
#pragma unroll
  for (int i = 0; i < 8; ++i) { xc[i] = cb + cw0 * xb[i] + cw1 * xb[i + 1] + cw2 * xb[i + 2] + cw3 * xb[i + 3]; sx[(tg * 8 + i) * LD + cc] = f2bf(xc[i]); }
  lds_barrier();
  {
    const u16* wt = p.lru.wt + (long)gq * 4096;
#pragma unroll 1
    for (int q = tg; q < 32; q += 8) {
      const int m = q >> 4, tile = q & 15, mt = tile >> 2, nt = tile & 3;
      f32x4 c4 = {0.f, 0.f, 0.f, 0.f};
#pragma unroll
      for (int s_ = 0; s_ < 2; ++s_) {
        const bf16x8 af = *(const bf16x8*)(sx + (16 * mt + r) * LD + 32 * s_ + 8 * g);
        const bf16x8 bfr = *(const bf16x8*)(wt + (long)m * 8 * 4096 + (16 * nt + r) * 64 + 32 * s_ + 8 * g);
        c4 = __builtin_amdgcn_mfma_f32_16x16x32_bf16(af, bfr, c4, 0, 0, 0);
      }
#pragma unroll
      for (int reg = 0; reg < 4; ++reg) sG[(m * 64 + 16 * mt + 4 * g + reg) * 64 + 16 * nt + r] = c4[reg];
    }
  }
  lds_barrier();
  float ra[8], ix[8];
  { const float ba = p.lru.b_a[ch], bx = p.lru.b_x[ch];
#pragma unroll
    for (int i = 0; i < 8; ++i) { ra[i] = ba + sG[(tg * 8 + i) * 64 + cc]; ix[i] = bx + sG[(64 + tg * 8 + i) * 64 + cc]; } }
  const float lam = p.lru.lam[ch]; const float sp = fmaxf(-lam, 0.f) + log1pf(__expf(-fabsf(lam)));
  float hl[8], ac[8]; float A = 1.f, B = 0.f;
#pragma unroll
  for (int i = 0; i < 8; ++i) {
    const float rr = sigmoidf_(ra[i]), ig = sigmoidf_(ix[i]); const float log_a = -8.f * rr * sp;
    const bool reset = p.pos[t0 + i] == 0;
    const float av = reset ? 0.f : __expf(log_a); const float mult = reset ? 1.f : sqrtf(fmaxf(1.f - av * av, 0.f));
    const float bv = mult * ig * xc[i];
    B = av * B + bv; A *= av; hl[i] = B; ac[i] = A;
  }
  preA[tg * 64 + cc] = A; preB[tg * 64 + cc] = B;
  lds_barrier();
  float Ap = 1.f, Bp = 0.f;
#pragma unroll
  for (int q = 0; q < 7; ++q) if (q < tg) { float a = preA[q * 64 + cc], b = preB[q * 64 + cc]; Bp = a * Bp + b; Ap *= a; }
#pragma unroll
  for (int i = 0; i < 8; ++i) { long o = (long)(t0 + i) * 512 + ch; p.b.lr_h[o] = hl[i] + ac[i] * Bp; p.b.lr_A[o] = ac[i] * Ap; }
  lds_barrier();
}

template <int I, int N> struct SolveDot {
  static __device__ __forceinline__ void run(const LAS float* arow, const float (&X)[64], float (&acc)[4]) {
    if constexpr (I + 4 <= N) {
      const f32x4 a = *(const LAS f32x4*)(arow + I);
      acc[0] += a[0] * X[I]; acc[1] += a[1] * X[I + 1]; acc[2] += a[2] * X[I + 2]; acc[3] += a[3] * X[I + 3];
      SolveDot<I + 4, N>::run(arow, X, acc);
    } else if constexpr (I < N) { acc[I & 3] += arow[I] * X[I]; SolveDot<I + 1, N>::run(arow, X, acc); }
  }
};
template <int T> struct SolveRow {
  static __device__ __forceinline__ void run(const LAS float* sAab, const LAS float* sRhs, int tid, float (&X)[64]) {
    if constexpr (T < 64) {
      float acc[4] = {sRhs[T * 128 + tid], 0.f, 0.f, 0.f};
      SolveDot<0, T>::run(sAab + T * 64, X, acc);
      X[T] = (acc[0] + acc[1]) + (acc[2] + acc[3]);
      asm volatile("" ::: "memory");
      SolveRow<T + 1>::run(sAab, sRhs, tid, X);
    }
  }
};
__device__ __forceinline__ void p3_rwkv_solve(const MixP& p, int uid, int tid, const float* sRhs, const float* sAab) {
  float X[64];
  const int col = tid & 63; const bool isAl = tid < 64;
  const LAS float* lA = (const LAS float*)sAab; const LAS float* lR = (const LAS float*)sRhs;
  asm volatile("" : "+v"(lA), "+v"(lR));
  SolveRow<0>::run(lA, lR, tid, X);
  if (isAl) {
    int s, g_, j; inv_perm(col, s, g_, j);
#pragma unroll
    for (int t = 0; t < 64; ++t) p.b.rw_WpF[(long)uid * 4096 + (((t >> 4) * 2 + s) * 64 + g_ * 16 + (t & 15)) * 8 + j] = f2bf(X[t]);
  } else {
    const int vs = col >> 4, r_ = col & 15;
#pragma unroll
    for (int tt = 0; tt < 4; ++tt)
#pragma unroll
      for (int g_ = 0; g_ < 4; ++g_) {
        f32x4 o = {X[16 * tt + 4 * g_], X[16 * tt + 4 * g_ + 1], X[16 * tt + 4 * g_ + 2], X[16 * tt + 4 * g_ + 3]};
        *(f32x4*)(p.b.rw_U0F + (((long)uid * 4 + vs) * 4 + tt) * 256 + (g_ * 16 + r_) * 4) = o;
      }
  }
}
__device__ __forceinline__ void p3_rwkv(const MixP& p, int c, int h, char* smem) {
  u16* sRb = (u16*)smem; u16* sKb = sRb + 64 * LD; u16* sAl = sKb + 64 * LD; u16* sBe = sAl + 64 * LD; u16* sKtT = sBe + 64 * LD; u16* sVT = sKtT + 64 * LD;
  float* pre = (float*)(smem + 55296);
  char* R2 = smem + 57344;
  constexpr int LDA_ = 168;
  u16* sAct = (u16*)R2; float* sLo = (float*)(R2 + 21504);
  float* sAab = (float*)R2; u16* sAak = (u16*)(R2 + 16384); float* sRhs = (float*)(R2 + 16384 + 9216);
  int tid = threadIdx.x; asm volatile("" : "+v"(tid));
  const int cc = tid & 63, tg = tid >> 6, r = cc & 15, g = cc >> 4, uid = c * 8 + h, hc = h * 64 + cc, t0 = c * 64 + tg * 8;
  const u16* proj = p.proj;
  {
    u16 c16[20], p16[20]; float mu20[20];
#pragma unroll
    for (int q = 0; q < 20; ++q) {
      const int idx = tid + 512 * q, tl = idx / 160, j = idx - tl * 160, t = c * 64 + tl, col = 1536 + j;
      c16[q] = proj[(long)t * PC + col]; p16[q] = t > 0 ? proj[(long)(t - 1) * PC + col] : (u16)0; mu20[q] = p.rw.mu[col];
    }
#pragma unroll
    for (int q = 0; q < 20; ++q) {
      const int idx = tid + 512 * q, tl = idx / 160, j = idx - tl * 160;
      const float cur = bf2f(c16[q]), prev = bf2f(p16[q]);
      const float z = cur + (prev - cur) * mu20[q];
      const float sg_ = sigmoidf_(j < 32 ? 2.f * z : z);
      sAct[tl * LDA_ + j] = f2bf(j < 32 ? 2.f * sg_ - 1.f : (j < 64 ? z : sg_));
    }
  }
  float zr[8], zk[8], zv[8];
  {
    float pr[9], pk[9], pv[9];
#pragma unroll
    for (int i = 0; i < 9; ++i) { int t = t0 - 1 + i; if (t >= 0) { const u16* row = proj + (long)t * PC; pr[i] = bf2f(row[hc]); pk[i] = bf2f(row[512 + hc]); pv[i] = bf2f(row[1024 + hc]); } else { pr[i] = pk[i] = pv[i] = 0.f; } }
    const float mr = p.rw.mu[hc], mk = p.rw.mu[512 + hc], mv = p.rw.mu[1024 + hc];
#pragma unroll
    for (int i = 0; i < 8; ++i) { zr[i] = pr[i + 1] + (pr[i] - pr[i + 1]) * mr; zk[i] = pk[i + 1] + (pk[i] - pk[i + 1]) * mk; zv[i] = pv[i + 1] + (pv[i] - pv[i + 1]) * mv; }
  }
  lds_barrier();
  {
    const u16* wl = p.rw.lora_w + (long)(h * 64) * 160;
#pragma unroll 1
    for (int q = tg; q < 48; q += 8) {
      const int o = q >> 4, tile = q & 15, mt = tile >> 2, nt = tile & 3, s0 = o == 0 ? 0 : (o == 1 ? 1 : 2), ns = o == 2 ? 3 : 1;
      f32x4 c4 = {0.f, 0.f, 0.f, 0.f};
#pragma unroll 1
      for (int s_ = s0; s_ < s0 + ns; ++s_) {
        const bf16x8 af = *(const bf16x8*)(sAct + (16 * mt + r) * LDA_ + 32 * s_ + 8 * g);
        const bf16x8 bfr = *(const bf16x8*)(wl + (long)(16 * nt + r) * 160 + 32 * s_ + 8 * g);
        c4 = __builtin_amdgcn_mfma_f32_16x16x32_bf16(af, bfr, c4, 0, 0, 0);
      }
#pragma unroll
      for (int reg = 0; reg < 4; ++reg) sLo[(o * 64 + 16 * mt + 4 * g + reg) * 64 + 16 * nt + r] = c4[reg];
    }
  }
  lds_barrier();
  float wv[8], av[8], gv[8];
  { const float w0 = p.rw.w0[hc], a0 = p.rw.a0[hc];
#pragma unroll
    for (int i = 0; i < 8; ++i) { wv[i] = w0 + sLo[(tg * 8 + i) * 64 + cc]; av[i] = a0 + sLo[(64 + tg * 8 + i) * 64 + cc]; gv[i] = sLo[(128 + tg * 8 + i) * 64 + cc]; } }
  lds_barrier();
  const float kkw = p.rw.k_k[hc], kaw = p.rw.k_a[hc], rkw = p.rw.r_k[hc];
  float lw[8], aa[8], kk[8], kp[8], cum[8]; float run = 0.f;
#pragma unroll
  for (int i = 0; i < 8; ++i) {
    lw[i] = -0.6065306597126334f * sigmoidf_(wv[i]); aa[i] = sigmoidf_(av[i]);
    float k0 = zk[i] * kkw; const float ss = wave_sum(k0 * k0); kk[i] = k0 / fmaxf(sqrtf(ss), 1e-12f);
    kp[i] = zk[i] * (1.f + (aa[i] - 1.f) * kaw);
    const float bs = wave_sum(zr[i] * kp[i] * rkw);
    const long o = (long)(t0 + i) * 512 + hc;
    p.b.rw_G[o] = f2bf(gv[i]); p.b.rw_BV[o] = f2bf(bs * zv[i]);
    run += lw[i]; cum[i] = run;
  }
  pre[tg * 64 + cc] = run;
  lds_barrier();
  float off = 0.f, tot = 0.f;
#pragma unroll
  for (int q = 0; q < 8; ++q) { float v = pre[q * 64 + cc]; tot += v; if (q < tg) off += v; }
  {
    u16 kt8[8], v8[8];
    const int kt = cc >> 4, r_ = cc & 15;
#pragma unroll
    for (int i = 0; i < 8; ++i) {
      const int tl = tg * 8 + i; const float cm = cum[i] + off, cx = cm - lw[i];
      const float en = __expf(-cm), et = __expf(tot - cm);
      sAl[tl * LD + cc] = f2bf(-kk[i] * __expf(cx)); sBe[tl * LD + cc] = f2bf(kk[i] * aa[i] * en);
      sKb[tl * LD + cc] = f2bf(kp[i] * en); sRb[tl * LD + cc] = f2bf(zr[i] * __expf(cm));
      kt8[i] = f2bf(kp[i] * et); v8[i] = f2bf(zv[i]);
      int s, g_, j; inv_perm(tl, s, g_, j);
      p.b.rw_BtF[(long)uid * 4096 + ((kt * 2 + s) * 64 + g_ * 16 + r_) * 8 + j] = f2bf(kk[i] * aa[i] * et);
    }
    *(uint4*)(sKtT + cc * LD + tg * 8) = pack8(kt8); *(uint4*)(sVT + cc * LD + tg * 8) = pack8(v8);
    if (tg == 0) p.b.rw_gam[uid * 64 + cc] = __expf(tot);
  }
  lds_barrier();
  for (int q = tg; q < 80; q += 8) {
    const int kind = q >> 4, tt = q & 15, mt = tt >> 2, nt = tt & 3;
    if (kind == 0) { f32x4 c4 = tile_nt(sAl, sBe, mt, nt, r, g);
#pragma unroll
      for (int reg = 0; reg < 4; ++reg) { int t = 16 * mt + 4 * g + reg, i = 16 * nt + r; sAab[t * 64 + i] = i < t ? c4[reg] : 0.f; }
    } else if (kind == 1) { f32x4 c4 = tile_nt(sAl, sKb, mt, nt, r, g);
#pragma unroll
      for (int reg = 0; reg < 4; ++reg) { int t = 16 * mt + 4 * g + reg, i = 16 * nt + r; sAak[t * LD + i] = f2bf(i < t ? c4[reg] : 0.f); }
    } else if (kind == 2) { f32x4 c4 = tile_nt(sRb, sBe, mt, nt, r, g);
#pragma unroll
      for (int reg = 0; reg < 4; ++reg) { int t = 16 * mt + 4 * g + reg, i = 16 * nt + r; p.b.rw_Pab[(long)uid * 4096 + t * 64 + i] = f2bf(i <= t ? c4[reg] : 0.f); }
    } else if (kind == 3) { f32x4 c4 = tile_nt(sRb, sKb, mt, nt, r, g);
#pragma unroll
      for (int reg = 0; reg < 4; ++reg) { int t = 16 * mt + 4 * g + reg, i = 16 * nt + r; p.b.rw_Pak[(long)uid * 4096 + t * 64 + i] = f2bf(i <= t ? c4[reg] : 0.f); }
    } else { f32x4 c4 = tile_nt(sKtT, sVT, mt, nt, r, g);
      *(f32x4*)(p.b.rw_KVF + (((long)uid * 4 + nt) * 4 + mt) * 256 + cc * 4) = c4;
    }
  }
  lds_barrier();
  for (int q = tg; q < 16; q += 8) { const int mt = q >> 2, nt = q & 3; f32x4 c4 = tile_nt(sAak, sVT, mt, nt, r, g);
#pragma unroll
    for (int reg = 0; reg < 4; ++reg) { int t = 16 * mt + 4 * g + reg, v = 16 * nt + r; sRhs[t * 128 + 64 + v] = c4[reg]; } }
  for (int idx = tid; idx < 4096; idx += 512) { int t = idx >> 6, k = idx & 63; sRhs[t * 128 + k] = bf2f(sAl[t * LD + k]); }
  copy_out(sRb, p.b.rw_Rb + (long)uid * 4096, 64, tid); copy_out(sVT, p.b.rw_VT + (long)uid * 4096, 64, tid);
  lds_barrier();
  if (tid < 128) p3_rwkv_solve(p, uid, tid, sRhs, sAab);
  else {
    const int w6 = __builtin_amdgcn_readfirstlane(tid >> 6) - 2;
    moe_tile(p.ws, p.smem, p.layer, uid * 6 + w6, tid & 63);
  }
  lds_barrier();
}

constexpr int CH_SLOT = 24832;
constexpr int CH_LA = 3, CH_NS = 4;
__device__ __forceinline__ void chain_piece(const MixP& p, int uid, int vs, int pc, char* slot, int lane) {
  if (pc < 8) __builtin_amdgcn_global_load_lds((const unsigned*)(p.b.rw_WpF + (long)uid * 4096 + pc * 512 + lane * 8), (unsigned*)(slot + pc * 1024 + lane * 16), 16, 0, 0);
  else if (pc < 16) __builtin_amdgcn_global_load_lds((const unsigned*)(p.b.rw_BtF + (long)uid * 4096 + (pc - 8) * 512 + lane * 8), (unsigned*)(slot + 8192 + (pc - 8) * 1024 + lane * 16), 16, 0, 0);
  else if (pc < 20) __builtin_amdgcn_global_load_lds((const unsigned*)(p.b.rw_U0F + ((long)uid * 4 + vs) * 1024 + (pc - 16) * 256 + lane * 4), (unsigned*)(slot + 16384 + (pc - 16) * 1024 + lane * 16), 16, 0, 0);
  else if (pc < 24) __builtin_amdgcn_global_load_lds((const unsigned*)(p.b.rw_KVF + ((long)uid * 4 + vs) * 1024 + (pc - 20) * 256 + lane * 4), (unsigned*)(slot + 20480 + (pc - 20) * 1024 + lane * 16), 16, 0, 0);
  else __builtin_amdgcn_global_load_lds((const unsigned*)(p.b.rw_gam + uid * 64 + lane), (unsigned*)(slot + 24576 + lane * 4), 4, 0, 0);
}
__device__ __forceinline__ void chain_issue(const MixP& p, int uid, int vs, char* slot, int w, int lane) {
#pragma unroll
  for (int i = 0; i < 4; ++i) { const int pc = (w - 1) + 7 * i; if (pc < 25) chain_piece(p, uid, vs, pc, slot, lane); }
}
typedef __attribute__((ext_vector_type(4))) unsigned u32x4;
__device__ __forceinline__ bf16x8 frag_of(unsigned a, unsigned b, unsigned c, unsigned d) { u32x4 v = {a, b, c, d}; return __builtin_bit_cast(bf16x8, v); }
__device__ __forceinline__ void p4_rwkv_chain(const MixP& p, int h, int vs, char* ring, int w, int lane) {
  const int r = lane & 15, g = lane >> 4, v = vs * 16 + r;
  const bool loader = w > 0; const int npc = (w >= 1 && w <= 4) ? 4 : 3;
  f32x4 ST[4];
#pragma unroll
  for (int kt = 0; kt < 4; ++kt) ST[kt] = (f32x4){0.f, 0.f, 0.f, 0.f};
  if (loader) { for (int c = 0; c < CH_LA; ++c) chain_issue(p, c * 8 + h, vs, ring + c * CH_SLOT, w, lane); }
#pragma unroll 1
  for (int c = 0; c < NCH; ++c) {
    const int uid = c * 8 + h; char* slot = ring + (c % CH_NS) * CH_SLOT;
    if (loader) {
      const int younger = (NCH - 1 - c < CH_LA - 1 ? NCH - 1 - c : CH_LA - 1);
      if (younger == 2) { if (npc == 4) asm volatile("s_waitcnt vmcnt(8)" ::: "memory"); else asm volatile("s_waitcnt vmcnt(6)" ::: "memory"); }
      else if (younger == 1) { if (npc == 4) asm volatile("s_waitcnt vmcnt(4)" ::: "memory"); else asm volatile("s_waitcnt vmcnt(3)" ::: "memory"); }
      else asm volatile("s_waitcnt vmcnt(0)" ::: "memory");
    }
    __builtin_amdgcn_s_barrier();
    if (loader) { if (c + CH_LA < NCH) chain_issue(p, (c + CH_LA) * 8 + h, vs, ring + ((c + CH_LA) % CH_NS) * CH_SLOT, w, lane); }
    else {
      unsigned ps[4][2];
#pragma unroll
      for (int kt = 0; kt < 4; ++kt) { ps[kt][0] = pack_bf16(ST[kt][0], ST[kt][1]); ps[kt][1] = pack_bf16(ST[kt][2], ST[kt][3]); }
      bf16x8 bS[2];
#pragma unroll
      for (int s = 0; s < 2; ++s) bS[s] = frag_of(ps[2 * s][0], ps[2 * s][1], ps[2 * s + 1][0], ps[2 * s + 1][1]);
#pragma unroll
      for (int kt = 0; kt < 4; ++kt) { uint2 pk; pk.x = ps[kt][0]; pk.y = ps[kt][1]; *(uint2*)(p.b.rw_S0 + (long)uid * 4096 + v * 64 + 16 * kt + 4 * g) = pk; }
      f32x4 U[4];
#pragma unroll
      for (int tt = 0; tt < 4; ++tt) {
        U[tt] = *(const f32x4*)(slot + 16384 + tt * 1024 + lane * 16);
#pragma unroll
        for (int s = 0; s < 2; ++s) { bf16x8 a = *(const bf16x8*)(slot + (tt * 2 + s) * 1024 + lane * 16); U[tt] = __builtin_amdgcn_mfma_f32_16x16x32_bf16(a, bS[s], U[tt], 0, 0, 0); }
      }
      unsigned pu[4][2];
#pragma unroll
      for (int tt = 0; tt < 4; ++tt) { pu[tt][0] = pack_bf16(U[tt][0], U[tt][1]); pu[tt][1] = pack_bf16(U[tt][2], U[tt][3]); }
      bf16x8 bU[2];
#pragma unroll
      for (int s = 0; s < 2; ++s) bU[s] = frag_of(pu[2 * s][0], pu[2 * s][1], pu[2 * s + 1][0], pu[2 * s + 1][1]);
#pragma unroll
      for (int tt = 0; tt < 4; ++tt) { uint2 pk; pk.x = pu[tt][0]; pk.y = pu[tt][1]; *(uint2*)(p.b.rw_UT + (long)uid * 4096 + v * 64 + 16 * tt + 4 * g) = pk; }
#pragma unroll
      for (int kt = 0; kt < 4; ++kt) {
        const f32x4 gm = *(const f32x4*)(slot + 24576 + (16 * kt + 4 * g) * 4); const f32x4 kv = *(const f32x4*)(slot + 20480 + kt * 1024 + lane * 16);
        f32x4 a4 = ST[kt] * gm + kv;
#pragma unroll
        for (int s = 0; s < 2; ++s) { bf16x8 a = *(const bf16x8*)(slot + 8192 + (kt * 2 + s) * 1024 + lane * 16); a4 = __builtin_amdgcn_mfma_f32_16x16x32_bf16(a, bU[s], a4, 0, 0, 0); }
        ST[kt] = a4;
      }
      asm volatile("s_waitcnt lgkmcnt(0)" ::: "memory");
    }
  }
}
__device__ __forceinline__ void p4_elem(const MixP& p, int e) {
  if (e < 32768) {
    const int h = e >> 12, vk = e & 4095; const float lg2 = log2f(1.f - exp2f(-(5.f + 4.f * (float)h / 7.f))); const float gm = exp2f(lg2 * 64.f);
    float S = 0.f;
#pragma unroll 1
    for (int c0 = 0; c0 < NCH; c0 += 16) {
      float kv[16];
#pragma unroll
      for (int i = 0; i < 16; ++i) kv[i] = p.b.rt_KVT[(long)((c0 + i) * 8 + h) * 4096 + vk];
#pragma unroll
      for (int i = 0; i < 16; ++i) { p.b.rt_S0[(long)((c0 + i) * 8 + h) * 4096 + vk] = f2bf(S); S = S * gm + kv[i]; }
    }
  } else {
    const int e2 = e - 32768, h = e2 >> 13, vk = e2 & 8191, k = vk & 63;
    float S = 0.f;
#pragma unroll 1
    for (int c0 = 0; c0 < NCH; c0 += 16) {
      float kv[16], gm[16];
#pragma unroll
      for (int i = 0; i < 16; ++i) { kv[i] = p.b.gl_KVT[(long)((c0 + i) * 4 + h) * 8192 + vk]; gm[i] = p.b.gl_gam[((c0 + i) * 4 + h) * 64 + k]; }
#pragma unroll
      for (int i = 0; i < 16; ++i) { p.b.gl_S0[(long)((c0 + i) * 4 + h) * 8192 + vk] = f2bf(S); S = S * gm[i] + kv[i]; }
    }
  }
}
__device__ __forceinline__ void p4_lru(const MixP& p, int ch) {
  float H = 0.f;
#pragma unroll 1
  for (int c0 = 0; c0 < NCH; c0 += 16) {
    float a[16], b[16];
#pragma unroll
    for (int i = 0; i < 16; ++i) { long o = (long)((c0 + i) * 64 + 63) * 512 + ch; a[i] = p.b.lr_A[o]; b[i] = p.b.lr_h[o]; }
#pragma unroll
    for (int i = 0; i < 16; ++i) { p.b.lr_Hp[(c0 + i) * 512 + ch] = H; H = a[i] * H + b[i]; }
  }
}

template <int NVT, bool DELTA, int NMT>
__device__ __forceinline__ void p5_mm(const u16* Rb, const u16* S0, const u16* Pak, const u16* VT, const u16* Pab, const u16* UT, int mt0, int r, int g, f32x4 (&acc)[NMT][4 * NVT]) {
#pragma unroll
  for (int mt = 0; mt < NMT; ++mt)
#pragma unroll
    for (int nt = 0; nt < 4 * NVT; ++nt) acc[mt][nt] = (f32x4){0.f, 0.f, 0.f, 0.f};
#pragma unroll 1
  for (int pr = 0; pr < (DELTA ? 3 : 2); ++pr) {
    const u16* A = pr == 0 ? Rb : (pr == 1 ? Pak : Pab); const u16* B = pr == 0 ? S0 : (pr == 1 ? VT : UT);
    bf16x8 af[NMT][2], bfr[4 * NVT][2];
#pragma unroll
    for (int s = 0; s < 2; ++s) {
#pragma unroll
      for (int mt = 0; mt < NMT; ++mt) af[mt][s] = *(const bf16x8*)(A + (16 * (mt0 + mt) + r) * 64 + 32 * s + 8 * g);
#pragma unroll
      for (int nt = 0; nt < 4 * NVT; ++nt) bfr[nt][s] = *(const bf16x8*)(B + (16 * nt + r) * 64 + 32 * s + 8 * g);
    }
#pragma unroll
    for (int s = 0; s < 2; ++s)
#pragma unroll
      for (int nt = 0; nt < 4 * NVT; ++nt)
#pragma unroll
        for (int mt = 0; mt < NMT; ++mt) acc[mt][nt] = __builtin_amdgcn_mfma_f32_16x16x32_bf16(bfr[nt][s], af[mt][s], acc[mt][nt], 0, 0, 0);
  }
}
__device__ __forceinline__ float red4g(float v) { v += __shfl_xor(v, 16, 64); v += __shfl_xor(v, 32, 64); return v; }
__device__ __forceinline__ f32x4 bf4(uint2 u) { return (f32x4){__uint_as_float(u.x << 16), __uint_as_float(u.x & 0xffff0000u), __uint_as_float(u.y << 16), __uint_as_float(u.y & 0xffff0000u)}; }
__device__ __forceinline__ void p5_rwkv(const MixP& p, int c, int h, int lane) {
  const int r = lane & 15, g = lane >> 4; const long uo = (long)(c * 8 + h) * 4096;
  f32x4 lg[4], lb[4];
#pragma unroll
  for (int nt = 0; nt < 4; ++nt) { lg[nt] = *(const f32x4*)(p.rw.ln_g + h * 64 + 16 * nt + 4 * g); lb[nt] = *(const f32x4*)(p.rw.ln_b + h * 64 + 16 * nt + 4 * g); }
#pragma unroll 1
  for (int mh = 0; mh < 2; ++mh) {
    f32x4 acc[2][4];
    p5_mm<1, true, 2>(p.b.rw_Rb + uo, p.b.rw_S0 + uo, p.b.rw_Pak + uo, p.b.rw_VT + uo, p.b.rw_Pab + uo, p.b.rw_UT + uo, mh * 2, r, g, acc);
#pragma unroll
    for (int mt = 0; mt < 2; ++mt) {
      const int t = c * 64 + 16 * (mh * 2 + mt) + r; const long o = (long)t * 512 + h * 64 + 4 * g;
      uint2 bv[4], gg[4];
#pragma unroll
      for (int nt = 0; nt < 4; ++nt) { bv[nt] = *(const uint2*)(p.b.rw_BV + o + 16 * nt); gg[nt] = *(const uint2*)(p.b.rw_G + o + 16 * nt); }
      float s1 = 0.f;
#pragma unroll
      for (int nt = 0; nt < 4; ++nt) s1 += acc[mt][nt][0] + acc[mt][nt][1] + acc[mt][nt][2] + acc[mt][nt][3];
      const float mean = red4g(s1) * (1.f / 64.f);
      float s2 = 0.f;
#pragma unroll
      for (int nt = 0; nt < 4; ++nt)
#pragma unroll
        for (int j = 0; j < 4; ++j) { const float d = acc[mt][nt][j] - mean; s2 += d * d; }
      const float rs = rsqrtf(red4g(s2) * (1.f / 64.f) + 64e-5f);
#pragma unroll
      for (int nt = 0; nt < 4; ++nt) {
        const f32x4 yn = (acc[mt][nt] - mean) * rs * lg[nt] + lb[nt];
        *(uint2*)(p.ycat + (long)t * DM + h * 64 + 16 * nt + 4 * g) = pack4((yn + bf4(bv[nt])) * bf4(gg[nt]));
      }
    }
  }
}
__device__ __forceinline__ void p5_ret(const MixP& p, int c, int h, int lane) {
  const int r = lane & 15, g = lane >> 4; const long uo = (long)(c * 8 + h) * 4096;
  f32x4 ng[4];
#pragma unroll
  for (int nt = 0; nt < 4; ++nt) ng[nt] = *(const f32x4*)(p.ret_norm_g + h * 64 + 16 * nt + 4 * g);
#pragma unroll 1
  for (int mh = 0; mh < 2; ++mh) {
    f32x4 acc[2][4];
    p5_mm<1, false, 2>(p.b.rt_Rb + uo, p.b.rt_S0 + uo, p.b.rt_Pak + uo, p.b.rt_VT + uo, nullptr, nullptr, mh * 2, r, g, acc);
#pragma unroll
    for (int mt = 0; mt < 2; ++mt) {
      const int t = c * 64 + 16 * (mh * 2 + mt) + r;
      uint2 gt2[4];
#pragma unroll
      for (int nt = 0; nt < 4; ++nt) gt2[nt] = *(const uint2*)(p.proj + (long)t * PC + OFF_B + 1536 + h * 64 + 16 * nt + 4 * g);
      float s2 = 0.f;
#pragma unroll
      for (int nt = 0; nt < 4; ++nt)
#pragma unroll
        for (int j = 0; j < 4; ++j) s2 += acc[mt][nt][j] * acc[mt][nt][j];
      const float rs = rsqrtf(red4g(s2) * (1.f / 64.f) + 1e-6f);
#pragma unroll
      for (int nt = 0; nt < 4; ++nt) {
        const f32x4 gt = bf4(gt2[nt]); f32x4 o;
#pragma unroll
        for (int j = 0; j < 4; ++j) o[j] = acc[mt][nt][j] * rs * ng[nt][j] * gt[j] * sigmoidf_(gt[j]);
        *(uint2*)(p.ycat + (long)t * DM + 512 + h * 64 + 16 * nt + 4 * g) = pack4(o);
      }
    }
  }
}
__device__ __forceinline__ void p5_gla(const MixP& p, int c, int h, int lane) {
  const int r = lane & 15, g = lane >> 4; const int uid = c * 4 + h;
  f32x4 ng[8];
#pragma unroll
  for (int nt = 0; nt < 8; ++nt) ng[nt] = *(const f32x4*)(p.gla_norm_g + h * 128 + 16 * nt + 4 * g);
#pragma unroll 1
  for (int mq = 0; mq < 4; ++mq) {
    f32x4 acc[1][8];
    p5_mm<2, false, 1>(p.b.gl_Rb + (long)uid * 4096, p.b.gl_S0 + (long)uid * 8192, p.b.gl_Pak + (long)uid * 4096, p.b.gl_VT + (long)uid * 8192, nullptr, nullptr, mq, r, g, acc);
    const int t = c * 64 + 16 * mq + r;
    uint2 gt2[8];
#pragma unroll
    for (int nt = 0; nt < 8; ++nt) gt2[nt] = *(const uint2*)(p.proj + (long)t * PC + OFF_D + 1040 + h * 128 + 16 * nt + 4 * g);
    float s2 = 0.f;
#pragma unroll
    for (int nt = 0; nt < 8; ++nt)
#pragma unroll
      for (int j = 0; j < 4; ++j) s2 += acc[0][nt][j] * acc[0][nt][j];
    const float rs = rsqrtf(red4g(s2) * (1.f / 128.f) + 1e-6f);
#pragma unroll
    for (int nt = 0; nt < 8; ++nt) {
      const f32x4 gt = bf4(gt2[nt]); f32x4 o;
#pragma unroll
      for (int j = 0; j < 4; ++j) o[j] = acc[0][nt][j] * rs * ng[nt][j] * gt[j] * sigmoidf_(gt[j]);
      *(uint2*)(p.ycat + (long)t * DM + 1536 + h * 128 + 16 * nt + 4 * g) = pack4(o);
    }
  }
}
__device__ __forceinline__ void p5_lru8(const MixP& p, long idx0, long stride) {
  float hv[8], av[8], hp[8]; u16 gb[8];
#pragma unroll
  for (int q = 0; q < 8; ++q) { const long idx = idx0 + q * stride; const int t = (int)(idx >> 9), ch = (int)(idx & 511), c = t >> 6;
    hv[q] = p.b.lr_h[idx]; av[q] = p.b.lr_A[idx]; hp[q] = p.b.lr_Hp[c * 512 + ch]; gb[q] = p.proj[(long)t * PC + OFF_C + 512 + ch]; }
#pragma unroll
  for (int q = 0; q < 8; ++q) { const long idx = idx0 + q * stride; const int t = (int)(idx >> 9), ch = (int)(idx & 511);
    p.ycat[(long)t * DM + 1024 + ch] = f2bf((hv[q] + av[q] * hp[q]) * gelu_tanh(bf2f(gb[q]))); }
}
__device__ __forceinline__ void phase_mix3(const MixP& p, char* smem) {
  for (int u = blockIdx.x; u < 3584; u += gridDim.x) {
    if (u < 1024) p3_rwkv(p, u >> 3, u & 7, smem);
    else if (u < 2048) p3_ret(p, (u - 1024) >> 3, (u - 1024) & 7, smem);
    else if (u < 2560) p3_gla(p, (u - 2048) >> 2, (u - 2048) & 3, smem);
    else p3_lru(p, (u - 2560) >> 3, (u - 2560) & 7, smem);
  }
}
__device__ __forceinline__ void phase_mix4(const MixP& p, char* smem) {
  int tid = threadIdx.x; asm volatile("" : "+v"(tid));
#pragma unroll 1
  for (int b = blockIdx.x; b < 256; b += gridDim.x) {
    if (b < 32) p4_rwkv_chain(p, b >> 2, b & 3, smem, __builtin_amdgcn_readfirstlane(tid >> 6), tid & 63);
    else if (b >= 64 && b < 192) p4_elem(p, (b - 64) * 512 + tid);
    else if (b == 200) p4_lru(p, tid);
    __syncthreads();
  }
}
__device__ __forceinline__ void phase_mix5(const MixP& p) {
  int tid = threadIdx.x; asm volatile("" : "+v"(tid));
  const int wave = blockIdx.x * 8 + (tid >> 6), nw = gridDim.x * 8, lane = tid & 63;
  for (int u = wave; u < 2560; u += nw) {
    if (u < 512) p5_gla(p, u >> 2, u & 3, lane);
    else if (u < 1536) p5_rwkv(p, (u - 512) >> 3, (u - 512) & 7, lane);
    else p5_ret(p, (u - 1536) >> 3, (u - 1536) & 7, lane);
  }
  { const long nthr = (long)gridDim.x * 512;
    long idx = (long)blockIdx.x * 512 + tid;
    for (; idx + 7 * nthr < (long)T_ * 512; idx += 8 * nthr) p5_lru8(p, idx, nthr);
    for (; idx < (long)T_ * 512; idx += nthr) {
      const int t = (int)(idx >> 9), ch = (int)(idx & 511), c = t >> 6;
      p.ycat[(long)t * DM + 1024 + ch] = f2bf((p.b.lr_h[idx] + p.b.lr_A[idx] * p.b.lr_Hp[c * 512 + ch]) * gelu_tanh(bf2f(p.proj[(long)t * PC + OFF_C + 512 + ch]))); } }
}

#define XB_TMO      128
#define XB_XCNT(j)  (256  + 64 * (j))
#define XB_XSUB(j)  (1280 + 64 * (j))
#define XB_XGEN(j)  (2304 + 64 * (j))
#define XB_TOP      3328
#define XB_TOPGEN   3392
#define XCD_BAR_WORDS 3456
#define XB_SPIN_CAP (1u << 18)
__device__ __forceinline__ unsigned xb_ld(unsigned* p)              { return __hip_atomic_load(p, __ATOMIC_RELAXED, __HIP_MEMORY_SCOPE_AGENT); }
__device__ __forceinline__ unsigned xb_add(unsigned* p, unsigned v) { return __hip_atomic_fetch_add(p, v, __ATOMIC_RELAXED, __HIP_MEMORY_SCOPE_AGENT); }
__device__ __forceinline__ unsigned xb_xcc_id() { return (unsigned)__builtin_amdgcn_s_getreg((3 << 11) | 20) & 0xFu; }
#define XB_SPIN(cond, bar) do { unsigned _sp = 0; while (cond) { __builtin_amdgcn_s_sleep(1); \
    if ((++_sp & 255u) == 0u) { if (xb_ld(&(bar)[XB_TMO])) break; if (_sp > XB_SPIN_CAP) { atomicAdd(&(bar)[XB_TMO], 1u); break; } } } } while (0)
struct XcdBarrier { unsigned* bar; unsigned x; volatile LAS unsigned* st; };
__device__ __forceinline__ XcdBarrier xcd_barrier_post(unsigned* bar, volatile LAS unsigned* st) {
    XcdBarrier b; b.bar = bar; b.x = xb_xcc_id(); b.st = st;
    if (threadIdx.x == 0) (void)xb_add(&bar[XB_XCNT(b.x)], 1u);
    return b;
}
__device__ __forceinline__ void xcd_barrier_complete(unsigned* bar, unsigned x, unsigned& nloc, unsigned& nx) {
    const unsigned G = gridDim.x * gridDim.y * gridDim.z;
    unsigned sum, cnt, mine, sp = 0u;
    for (;;) {
        sum = 0u; cnt = 0u; mine = 0u;
#pragma unroll
        for (unsigned j = 0; j < 16; ++j) { const unsigned c = xb_ld(&bar[XB_XCNT(j)]); sum += c; cnt += (c > 0u) ? 1u : 0u; mine = (j == x) ? c : mine; }
        if (sum == G) break;
        __builtin_amdgcn_s_sleep(1);
        if ((++sp & 255u) == 0u) { if (xb_ld(&bar[XB_TMO])) break; if (sp > XB_SPIN_CAP) { atomicAdd(&bar[XB_TMO], 1u); break; } }
    }
    nloc = mine > 0u ? mine : 1u; nx = cnt > 0u ? cnt : 1u;
}
__device__ __forceinline__ void xcd_barrier(const XcdBarrier& b) {
    asm volatile("s_waitcnt vmcnt(0)" ::: "memory");
    __syncthreads();
    if (threadIdx.x == 0) {
        unsigned* bar = b.bar;
        __builtin_amdgcn_s_waitcnt(0);
        unsigned nloc = b.st[0], nx = b.st[1];
        if (nloc == 0u) { xcd_barrier_complete(bar, b.x, nloc, nx); b.st[0] = nloc; b.st[1] = nx; }
        const unsigned old = xb_add(&bar[XB_XSUB(b.x)], 1u);
        const unsigned gen = old / nloc;
        if (old + 1u == (gen + 1u) * nloc) {
            __builtin_amdgcn_fence(__ATOMIC_RELEASE, "agent");
            asm volatile("s_waitcnt vmcnt(0)" ::: "memory");
            const unsigned og = xb_add(&bar[XB_TOP], 1u);
            const unsigned tg = og / nx;
            if (og + 1u == (tg + 1u) * nx) xb_add(&bar[XB_TOPGEN], 1u);
            else XB_SPIN(xb_ld(&bar[XB_TOPGEN]) == tg, bar);
            __builtin_amdgcn_fence(__ATOMIC_ACQUIRE, "agent");
            xb_add(&bar[XB_XGEN(b.x)], 1u);
            asm volatile("s_waitcnt vmcnt(0)" ::: "memory");
        } else {
            XB_SPIN(xb_ld(&bar[XB_XGEN(b.x)]) == gen, bar);
            __builtin_amdgcn_fence(__ATOMIC_ACQUIRE, "agent");
            asm volatile("s_waitcnt vmcnt(0)" ::: "memory");
        }
    }
    __syncthreads();
}

__device__ __forceinline__ void xcd_barrier_l(const XcdBarrier& b) {
    asm volatile("s_waitcnt vmcnt(0)" ::: "memory");
    __syncthreads();
    if (threadIdx.x == 0) {
        unsigned* bar = b.bar; unsigned x = b.x;
        { unsigned long long _z = 0; asm volatile("" : "+s"(_z), "+s"(x)); bar = (unsigned*)(unsigned __attribute__((address_space(1)))*)((unsigned long long)bar + _z); }
        __builtin_amdgcn_s_waitcnt(0);
        const unsigned nloc = b.st[0], nx = b.st[1];
        const unsigned old = xb_add(&bar[XB_XSUB(x)], 1u);
        const unsigned gen = old / nloc;
        if (old + 1u == (gen + 1u) * nloc) {
            __builtin_amdgcn_fence(__ATOMIC_RELEASE, "agent");
            asm volatile("s_waitcnt vmcnt(0)" ::: "memory");
            const unsigned og = xb_add(&bar[XB_TOP], 1u);
            const unsigned tg = og / nx;
            if (og + 1u == (tg + 1u) * nx) xb_add(&bar[XB_TOPGEN], 1u);
            else XB_SPIN(xb_ld(&bar[XB_TOPGEN]) == tg, bar);
            __builtin_amdgcn_fence(__ATOMIC_ACQUIRE, "agent");
            xb_add(&bar[XB_XGEN(x)], 1u);
            asm volatile("s_waitcnt vmcnt(0)" ::: "memory");
        } else {
            XB_SPIN(xb_ld(&bar[XB_XGEN(x)]) == gen, bar);
            __builtin_amdgcn_fence(__ATOMIC_ACQUIRE, "agent");
            asm volatile("s_waitcnt vmcnt(0)" ::: "memory");
        }
    }
    __syncthreads();
}

__device__ __forceinline__ void phase_convert(char* ws, char* smem) {
  OPAQUE_WS(ws); int tid = threadIdx.x; asm volatile("" : "+v"(tid));
  const int lane = tid & 63, G = gridDim.x * 8, b0 = blockIdx.x * 8 + __builtin_amdgcn_readfirstlane(tid >> 6);
#pragma unroll 1
  for (int j = b0; j < 2 * (32768 - CV_SOLVE); j += G) { const int l = j / (32768 - CV_SOLVE), t = CV_SOLVE + j % (32768 - CV_SOLVE); moe_tile(ws, smem, l, t, lane); }
  { u16* wt = wsp<u16>(ws, WS::LRU_W);
#pragma unroll 1
    for (int i = blockIdx.x * 512 + tid; i < NL * 2 * 8 * 4096; i += gridDim.x * 512) {
      const int l = i / (2 * 8 * 4096), r = i % (2 * 8 * 4096), m = r / (8 * 4096), g = (r / 4096) & 7, jj = (r >> 6) & 63, ii = r & 63;
      wt[i] = f2bf(in_ptr(smem, m ? 22 : 20)[(((long)l * 8 + g) * 64 + ii) * 64 + jj]);
    } }
  { u16* wl = wsp<u16>(ws, WS::LORA_W);
#pragma unroll 1
    for (int i = blockIdx.x * 512 + tid; i < NL * 512 * 160; i += gridDim.x * 512) {
      const int l = i / (512 * 160), r = i % (512 * 160), c = r / 160, j = r % 160;
      const float v = j < 32 ? in_ptr(smem, 6)[((long)l * 32 + j) * 512 + c] : (j < 64 ? in_ptr(smem, 8)[((long)l * 32 + (j - 32)) * 512 + c] : in_ptr(smem, 9)[((long)l * 96 + (j - 64)) * 512 + c]);
      wl[i] = f2bf(v);
    } }
  { u16* thi = wsp<u16>(ws, WS::RT_HI); u16* tlo = wsp<u16>(ws, WS::RT_LO);
#pragma unroll 1
    for (int i = blockIdx.x * 512 + tid; i < NL * 48 * 2048; i += gridDim.x * 512) {
      const int l = i / (48 * 2048), r = i % (48 * 2048), c = r >> 11, k = r & 2047;
      float v = 0.f;
      if (c < 36) { const float g = in_ptr(smem, 31)[(long)l * DM + k]; v = g * (c < 4 ? in_ptr(smem, 32)[((long)l * DM + k) * 4 + c] : in_ptr(smem, 34)[((long)l * DM + k) * 32 + (c - 4)]); }
      const u16 hi = f2bf(v); thi[i] = hi; tlo[i] = f2bf(v - bf2f(hi));
    } }
#pragma unroll 1
  for (int j = b0; j < 2 * 100 * 32; j += G) { const int l = j / 3200, q = j % 3200, nt = q / 32, kt = q % 32;
    transpose_tile_w(in_ptr(smem, 3) + (long)l * DM * IN_COLS, IN_COLS, NONGATE, wsp<u16>(ws, WS::WT_IN) + (long)l * PC * DM, DM, nt * 64, kt * 64, 0, 0, lane); }
#pragma unroll 1
  for (int j = b0; j < 2 * 128 * 32; j += G) { const int l = j / 4096, q = j % 4096, nt = q / 32, kt = q % 32;
    transpose_tile_w(in_ptr(smem, 3) + (long)l * DM * IN_COLS + NONGATE, IN_COLS, 8192, wsp<u16>(ws, WS::WT_IN) + (long)l * PC * DM, DM, nt * 64, kt * 64, OFF_G, 0, lane); }
#pragma unroll 1
  for (int j = b0; j < 8 * 256; j += G) { const int lk = j / 256, q = j % 256, l = lk >> 2, kb = lk & 3, nt = q / 8, kt = q % 8;
    const float* src = in_ptr(smem, kb == 0 ? 15 : kb == 1 ? 17 : kb == 2 ? 25 : 29) + (long)l * MIXW * DM;
    transpose_tile_w(src, DM, DM, wsp<u16>(ws, WS::WT_O) + (long)l * DM * DM + kb * MIXW, DM, nt * 64, kt * 64, 0, 0, lane); }
#pragma unroll 1
  for (int j = b0; j < 2 * 1024; j += G) { const int l = j / 1024, q = j % 1024, nt = q / 32, kt = q % 32;
    transpose_tile_w(in_ptr(smem, 30) + (long)l * DM * DM, DM, DM, wsp<u16>(ws, WS::WT_OUT) + (long)l * DM * DM, DM, nt * 64, kt * 64, 0, 0, lane); }
}

__device__ __forceinline__ void convert_down(char* ws, const char* smem, int l, int wave, int nwaves, int lane) {
  const float* src = in_ptr(smem, 38) + (long)l * NEXP * DEXP * DM; u16* dst = wsp<u16>(ws, WS::WDN) + (long)l * NEXP * DM * DEXP;
#pragma unroll 1
  for (int j = wave; j < 32 * 512; j += nwaves) { const int e = j / 512, q = j % 512, nt = q / 16, kt = q % 16;
    transpose_tile_w(src + (long)e * DEXP * DM, DM, DM, dst + (long)e * DM * DEXP, DEXP, nt * 64, kt * 64, 0, 0, lane); }
}
struct NormArgs {
  const float* x; float* h; const float* g; u16* xn; float* out; const float* ybuf;
  const float* wg; const float* bg; const float* we; const float* be; int* tok_e; float* tok_g;
};
template <int MODE>
__device__ __forceinline__ void norm_row(const NormArgs& a, int row, int lane) {
  float v[32];
  const float* src = (MODE == 0) ? a.x : a.h;
#pragma unroll
  for (int i = 0; i < 8; ++i) {
    f32x4 t = *(const f32x4*)(src + (long)row * DM + i * 256 + lane * 4);
    if (MODE == 1 || MODE == 2) {
      f32x4 y0 = *(const f32x4*)(a.ybuf + (long)(2 * row) * DM + i * 256 + lane * 4);
      f32x4 y1 = *(const f32x4*)(a.ybuf + (long)(2 * row + 1) * DM + i * 256 + lane * 4);
      t = t + y0 + y1;
    }
    if (MODE != 3 && MODE != 2) *(f32x4*)(a.h + (long)row * DM + i * 256 + lane * 4) = t;
    v[i * 4 + 0] = t[0]; v[i * 4 + 1] = t[1]; v[i * 4 + 2] = t[2]; v[i * 4 + 3] = t[3];
  }
  float ss = 0.f;
#pragma unroll
  for (int i = 0; i < 32; ++i) ss += v[i] * v[i];
  ss = wave_sum(ss);
  const float rs = rsqrtf(ss * (1.f / DM) + 1e-6f);
#pragma unroll
  for (int i = 0; i < 8; ++i) {
    f32x4 g = *(const f32x4*)(a.g + i * 256 + lane * 4);
#pragma unroll
    for (int j = 0; j < 4; ++j) v[i * 4 + j] = v[i * 4 + j] * rs * g[j];
    if (MODE == 2) {
      f32x4 o = {v[i * 4], v[i * 4 + 1], v[i * 4 + 2], v[i * 4 + 3]};
      *(f32x4*)(a.out + (long)row * DM + i * 256 + lane * 4) = o;
    } else {
      uint2 pk;
      pk.x = (unsigned)f2bf(v[i * 4]) | ((unsigned)f2bf(v[i * 4 + 1]) << 16);
      pk.y = (unsigned)f2bf(v[i * 4 + 2]) | ((unsigned)f2bf(v[i * 4 + 3]) << 16);
      *(uint2*)(a.xn + (long)row * DM + i * 256 + lane * 4) = pk;
    }
  }
}
template <int MODE>
__device__ __forceinline__ void phase_norm(const NormArgs& a) {
  int tid = threadIdx.x; asm volatile("" : "+v"(tid));
  const int lane = tid & 63;
  for (int row = blockIdx.x * 8 + (tid >> 6); row < T_; row += gridDim.x * 8) norm_row<MODE>(a, row, lane);
}

__device__ __forceinline__ void router_job(const NormArgs& a, const u16* __restrict__ thi, const u16* __restrict__ tlo, int job, char* smem, int tid, int* cnt, int* lst_slot, float* lst_gate) {
  const int w = __builtin_amdgcn_readfirstlane(tid >> 6), lane = tid & 63, r = lane & 15, g = lane >> 4, t0 = job * 64;
  float* part = (float*)smem;
  float* pss = part + 8 * 64 * 48;
  {
    f32x4 acc[4][3];
#pragma unroll
    for (int mt = 0; mt < 4; ++mt)
#pragma unroll
      for (int nt = 0; nt < 3; ++nt) acc[mt][nt] = (f32x4){0.f, 0.f, 0.f, 0.f};
    float ssq[4] = {0.f, 0.f, 0.f, 0.f};
    const float* hb = a.h + (long)(t0 + r) * DM + w * 256 + 8 * g;
    const u16* bh = thi + (long)r * 2048 + w * 256 + 8 * g; const u16* bl = tlo + (long)r * 2048 + w * 256 + 8 * g;
#pragma unroll 2
    for (int s_ = 0; s_ < 8; ++s_) {
      f32x4 x0[4], x1[4]; bf16x8 wh[3], wl[3];
#pragma unroll
      for (int mt = 0; mt < 4; ++mt) { x0[mt] = *(const f32x4*)(hb + (long)(16 * mt) * DM + 32 * s_); x1[mt] = *(const f32x4*)(hb + (long)(16 * mt) * DM + 32 * s_ + 4); }
#pragma unroll
      for (int nt = 0; nt < 3; ++nt) { wh[nt] = *(const bf16x8*)(bh + (long)(16 * nt) * 2048 + 32 * s_); wl[nt] = *(const bf16x8*)(bl + (long)(16 * nt) * 2048 + 32 * s_); }
#pragma unroll
      for (int mt = 0; mt < 4; ++mt) {
        const f32x4 a0 = x0[mt], a1 = x1[mt];
        ssq[mt] += a0[0] * a0[0] + a0[1] * a0[1] + a0[2] * a0[2] + a0[3] * a0[3] + a1[0] * a1[0] + a1[1] * a1[1] + a1[2] * a1[2] + a1[3] * a1[3];
        const unsigned h0 = pack_bf16(a0[0], a0[1]), h1 = pack_bf16(a0[2], a0[3]), h2 = pack_bf16(a1[0], a1[1]), h3 = pack_bf16(a1[2], a1[3]);
        const unsigned l0 = pack_bf16(a0[0] - __uint_as_float(h0 << 16), a0[1] - __uint_as_float(h0 & 0xffff0000u)), l1 = pack_bf16(a0[2] - __uint_as_float(h1 << 16), a0[3] - __uint_as_float(h1 & 0xffff0000u));
        const unsigned l2 = pack_bf16(a1[0] - __uint_as_float(h2 << 16), a1[1] - __uint_as_float(h2 & 0xffff0000u)), l3 = pack_bf16(a1[2] - __uint_as_float(h3 << 16), a1[3] - __uint_as_float(h3 & 0xffff0000u));
        const bf16x8 xh = frag_of(h0, h1, h2, h3), xl = frag_of(l0, l1, l2, l3);
#pragma unroll
        for (int nt = 0; nt < 3; ++nt) {
          acc[mt][nt] = __builtin_amdgcn_mfma_f32_16x16x32_bf16(xh, wh[nt], acc[mt][nt], 0, 0, 0);
          acc[mt][nt] = __builtin_amdgcn_mfma_f32_16x16x32_bf16(xh, wl[nt], acc[mt][nt], 0, 0, 0);
          acc[mt][nt] = __builtin_amdgcn_mfma_f32_16x16x32_bf16(xl, wh[nt], acc[mt][nt], 0, 0, 0);
        }
      }
    }
#pragma unroll
    for (int mt = 0; mt < 4; ++mt)
#pragma unroll
      for (int nt = 0; nt < 3; ++nt)
#pragma unroll
        for (int reg = 0; reg < 4; ++reg) part[(w * 64 + 16 * mt + 4 * g + reg) * 48 + 16 * nt + r] = acc[mt][nt][reg];
#pragma unroll
    for (int mt = 0; mt < 4; ++mt) { float v = ssq[mt]; v += __shfl_xor(v, 16, 64); v += __shfl_xor(v, 32, 64); if (g == 0) pss[w * 64 + 16 * mt + r] = v; }
  }
  lds_barrier();
  if (tid < 64) {
    const int tl = tid, t = t0 + tl;
    float lgt[36]; float ss = 0.f;
#pragma unroll
    for (int c = 0; c < 36; ++c) lgt[c] = 0.f;
#pragma unroll 1
    for (int q = 0; q < 8; ++q) {
#pragma unroll
      for (int c = 0; c < 36; ++c) lgt[c] += part[(q * 64 + tl) * 48 + c];
      ss += pss[q * 64 + tl];
    }
    const float rs = rsqrtf(ss * (1.f / DM) + 1e-6f);
    float lg[4];
#pragma unroll
    for (int c = 0; c < 4; ++c) lg[c] = lgt[c] * rs + a.bg[c];
    int gi = 0; float gm = lg[0];
#pragma unroll
    for (int c = 1; c < 4; ++c) if (lg[c] > gm) { gm = lg[c]; gi = c; }
    float gs = 0.f;
#pragma unroll
    for (int c = 0; c < 4; ++c) gs += __expf(lg[c] - gm);
    const float pg = 1.f / gs;
    float le[8];
#pragma unroll
    for (int j = 0; j < 8; ++j) {
      const float l0 = lgt[4 + j] * rs + a.be[j], l1 = lgt[12 + j] * rs + a.be[8 + j], l2 = lgt[20 + j] * rs + a.be[16 + j], l3 = lgt[28 + j] * rs + a.be[24 + j];
      le[j] = gi == 0 ? l0 : (gi == 1 ? l1 : (gi == 2 ? l2 : l3));
    }
    int i1 = 0; float m1 = le[0];
#pragma unroll
    for (int j = 1; j < 8; ++j) if (le[j] > m1) { m1 = le[j]; i1 = j; }
    int i2 = -1; float m2 = -3.0e38f;
#pragma unroll
    for (int j = 0; j < 8; ++j) if (j != i1 && le[j] > m2) { m2 = le[j]; i2 = j; }
    const float w1 = 1.f / (1.f + __expf(m2 - m1)), w2 = 1.f - w1;
    if (i2 < 0) i2 = (i1 + 1) & 7;
    const int e0 = gi * 8 + i1, e1 = gi * 8 + i2;
    const int p0 = atomicAdd(cnt + e0, 1) & (LCAP - 1), p1 = atomicAdd(cnt + e1, 1) & (LCAP - 1);
    lst_slot[e0 * LCAP + p0] = 2 * t; lst_gate[e0 * LCAP + p0] = pg * w1;
    lst_slot[e1 * LCAP + p1] = 2 * t + 1; lst_gate[e1 * LCAP + p1] = pg * w2;
  }
  lds_barrier();
}
__device__ __forceinline__ void phase_n3(char* ws, const NormArgs& a, char* smem, int l) {
  OPAQUE_WS(ws);
  int tid = threadIdx.x; asm volatile("" : "+v"(tid));
  int* cnt = wsp<int>(ws, WS::TILE_EXP); int* lst_slot = wsp<int>(ws, WS::LST_SLOT); float* lst_gate = wsp<float>(ws, WS::LST_GATE);
#pragma unroll 1
  for (int job = blockIdx.x; job < 256; job += gridDim.x) {
    if (job < 128) router_job(a, wsp<u16>(ws, WS::RT_HI) + (long)l * 48 * 2048, wsp<u16>(ws, WS::RT_LO) + (long)l * 48 * 2048, job, smem, tid, cnt, lst_slot, lst_gate);
    else { const int r0 = (job - 128) * 64 + (tid >> 6) * 8;
#pragma unroll 1
      for (int i = 0; i < 8; ++i) norm_row<3>(a, r0 + i, tid & 63); }
  }
}
__device__ __forceinline__ void moe_tiles(char* ws, int* tstart, int tid) {
  const int* cnt = wsp<int>(ws, WS::TILE_EXP);
  if (tid < 32) {
    int acc = 0;
#pragma unroll 1
    for (int e2 = 0; e2 < tid; ++e2) acc += (ld_i(cnt + e2) + 255) >> 8;
    const int c = ld_i(cnt + tid);
    tstart[tid] = acc; tstart[40 + tid] = c;
    if (tid == 31) tstart[32] = acc + ((c + 255) >> 8);
  }
  __syncthreads();
}

template <int MODE>
__device__ __forceinline__ void phase_gemm(char* ws, int l, u16* shm) {
  OPAQUE_WS(ws);
  if (MODE == 0) {
    const u16* Bt = wsp<u16>(ws, WS::WT_IN) + (long)l * PC * DM; const u16* xn = wsp<u16>(ws, WS::XN); u16* proj = wsp<u16>(ws, WS::PROJ);
#pragma unroll 1
    for (int u = blockIdx.x; u < ((PC / 256 + 7) / 8) * 256; u += gridDim.x) {
      int pm, pn; unit_map(u & 255, u >> 8, pm, pn);
      if (pn >= PC / 256) continue;
      EpiProj e{proj, pm * 256, pn * 256};
      gemm256(xn + (long)pm * 256 * DM, DM, Bt + (long)pn * 256 * DM, DM, DM, shm, e);
    }
  } else if (MODE == 1) {
    const u16* Bt = wsp<u16>(ws, WS::WT_O) + (long)l * DM * DM; const u16* ycat = wsp<u16>(ws, WS::YCAT);
    const u16* gates = wsp<u16>(ws, WS::PROJ) + OFF_G; u16* merged = wsp<u16>(ws, WS::MERGED);
#pragma unroll 1
    for (int u = blockIdx.x; u < 512; u += gridDim.x) {
      int pm, pn2; unit_map(u & 255, 0, pm, pn2);
      const int pn = pn2 * 2 + (u >> 8);
      gemm_merge(ycat, Bt, gates, merged, pm * 256, pn * 128, shm);
    }
  } else if (MODE == 2) {
    const u16* Bt = wsp<u16>(ws, WS::WT_OUT) + (long)l * DM * DM; const u16* merged = wsp<u16>(ws, WS::MERGED);
#pragma unroll 1
    for (int u = blockIdx.x; u < 256; u += gridDim.x) {
      int pm, pn; unit_map(u, 0, pm, pn);
      EpiResid e{wsp<float>(ws, WS::H), pm * 256, pn * 256};
      gemm256(merged + (long)pm * 256 * DM, DM, Bt + (long)pn * 256 * DM, DM, DM, shm, e);
    }
  } else if (MODE == 3) {
    int tid = threadIdx.x; asm volatile("" : "+v"(tid));
    int* tstart = (int*)((char*)shm + SHM_B); moe_tiles(ws, tstart, tid);
    const int nu = tstart[32] * 8; const u16* Bt = wsp<u16>(ws, WS::WGU) + (long)l * NEXP * 2048 * DM; const u16* xn = wsp<u16>(ws, WS::XN);
    const int* lst_slot = wsp<int>(ws, WS::LST_SLOT);
#pragma unroll 1
    for (int u = blockIdx.x; u < nu; u += gridDim.x) {
      const int rt = u >> 3, ct = u & 7; int ex = 0;
#pragma unroll 1
      while (rt >= tstart[ex + 1]) ++ex;
      const int rtl = rt - tstart[ex], nvalid = tstart[40 + ex] - rtl * 256;
      int arow[4];
#pragma unroll
      for (int i = 0; i < 2; ++i) { int r_, c_; stage_rc(tid * 16 + i * 8192, r_, c_);
#pragma unroll
        for (int hf = 0; hf < 2; ++hf) { const int r = hf * HALF + r_; arow[hf * 2 + i] = (r < nvalid ? (lst_slot[ex * LCAP + rtl * 256 + r] >> 1) : 0) * (DM * 2) + c_ * 2; } }
      EpiGateUp e{wsp<u16>(ws, WS::HMID), rt * 256, ct};
      gemm256g<true>(xn, DM, Bt + ((long)ex * 2048 + ct * 256) * DM, DM, DM, shm, e, arow);
    }
  } else {
    int tid = threadIdx.x; asm volatile("" : "+v"(tid));
    int* tstart = (int*)((char*)shm + SHM_B); moe_tiles(ws, tstart, tid);
    const int nu = tstart[32] * 8; const u16* Bt = wsp<u16>(ws, WS::WDN) + (long)l * NEXP * DM * DEXP; const u16* hmid = wsp<u16>(ws, WS::HMID);
#pragma unroll 1
    for (int u = blockIdx.x; u < nu; u += gridDim.x) {
      const int rt = u >> 3, ct = u & 7; int ex = 0;
#pragma unroll 1
      while (rt >= tstart[ex + 1]) ++ex;
      const int rtl = rt - tstart[ex], nvalid = tstart[40 + ex] - rtl * 256;
      EpiDown e{wsp<float>(ws, WS::YBUF), wsp<int>(ws, WS::LST_SLOT) + ex * LCAP + rtl * 256, wsp<float>(ws, WS::LST_GATE) + ex * LCAP + rtl * 256, nvalid, ct * 256};
      gemm256(hmid + (long)rt * 256 * DEXP, DEXP, Bt + ((long)ex * DM + ct * 256) * DEXP, DEXP, DEXP, shm, e);
    }
  }
}

__device__ __forceinline__ MixP make_mixp(char* ws, const char* smem, int l) {
  OPAQUE_WS(ws); asm volatile("" : "+s"(l));
  MixP mp;
  mp.proj = wsp<u16>(ws, WS::PROJ); mp.pos = (const int*)in_ptr(smem, 1); mp.ycat = wsp<u16>(ws, WS::YCAT); mp.ws = ws; mp.smem = smem; mp.layer = l;
  MixBuf& b = mp.b;
  b.rw_Rb = wsp<u16>(ws, WS::RW_RB); b.rw_Pab = wsp<u16>(ws, WS::RW_PAB); b.rw_Pak = wsp<u16>(ws, WS::RW_PAK); b.rw_VT = wsp<u16>(ws, WS::RW_VT); b.rw_S0 = wsp<u16>(ws, WS::RW_S0); b.rw_UT = wsp<u16>(ws, WS::RW_UT);
  b.rw_WpF = wsp<u16>(ws, WS::RW_WPF); b.rw_BtF = wsp<u16>(ws, WS::RW_BTF); b.rw_G = wsp<u16>(ws, WS::RW_G); b.rw_BV = wsp<u16>(ws, WS::RW_BV);
  b.rw_U0F = wsp<float>(ws, WS::RW_U0F); b.rw_KVF = wsp<float>(ws, WS::RW_KVF); b.rw_gam = wsp<float>(ws, WS::RW_GAM);
  b.rt_Rb = wsp<u16>(ws, WS::RT_RB); b.rt_Pak = wsp<u16>(ws, WS::RT_PAK); b.rt_VT = wsp<u16>(ws, WS::RT_VT); b.rt_S0 = wsp<u16>(ws, WS::RT_S0); b.rt_KVT = wsp<float>(ws, WS::RT_KVT);
  b.gl_Rb = wsp<u16>(ws, WS::GL_RB); b.gl_Pak = wsp<u16>(ws, WS::GL_PAK); b.gl_VT = wsp<u16>(ws, WS::GL_VT); b.gl_S0 = wsp<u16>(ws, WS::GL_S0); b.gl_KVT = wsp<float>(ws, WS::GL_KVT); b.gl_gam = wsp<float>(ws, WS::GL_GAM);
  b.lr_h = wsp<float>(ws, WS::LR_H); b.lr_A = wsp<float>(ws, WS::LR_A); b.lr_Hp = wsp<float>(ws, WS::LR_HP);
  mp.rw = RwkvP{in_ptr(smem, 4) + l * 1696, in_ptr(smem, 5) + l * 512, in_ptr(smem, 6) + l * 32 * 512, in_ptr(smem, 7) + l * 512, in_ptr(smem, 8) + l * 32 * 512, in_ptr(smem, 9) + l * 96 * 512,
                in_ptr(smem, 10) + l * 512, in_ptr(smem, 11) + l * 512, in_ptr(smem, 12) + l * 512, in_ptr(smem, 13) + l * 512, in_ptr(smem, 14) + l * 512, wsp<u16>(ws, WS::LORA_W) + (long)l * 512 * 160};
  mp.ret_norm_g = in_ptr(smem, 16) + l * 512;
  mp.lru = LruP{in_ptr(smem, 18) + l * 4 * 512, in_ptr(smem, 19) + l * 512, in_ptr(smem, 20) + l * 8 * 64 * 64, in_ptr(smem, 21) + l * 512, in_ptr(smem, 22) + l * 8 * 64 * 64, in_ptr(smem, 23) + l * 512, in_ptr(smem, 24) + l * 512, wsp<u16>(ws, WS::LRU_W) + (long)l * 2 * 8 * 4096};
  mp.gla_alpha_up = in_ptr(smem, 26) + l * 16 * 256; mp.gla_alpha_b = in_ptr(smem, 27) + l * 256; mp.gla_norm_g = in_ptr(smem, 28) + l * 512;
  return mp;
}
__device__ __forceinline__ void mix4_convert(char* ws, const char* smem, int l) {
  OPAQUE_WS(ws);
  int t_ = threadIdx.x; asm volatile("" : "+v"(t_));
  const int big = gridDim.x > 32;
  const int nb = big ? (int)gridDim.x - 32 : (int)gridDim.x;
  const int bi = big ? (int)blockIdx.x - 32 : (int)blockIdx.x;
  if (bi >= 0) convert_down(ws, smem, l, bi * 8 + __builtin_amdgcn_readfirstlane(t_ >> 6), nb * 8, t_ & 63);
}
constexpr int PH_PER_LAYER = 10, N_PHASES = 1 + NL * PH_PER_LAYER + 1;
#ifndef PROBE_MASK
#define PROBE_MASK 0
#endif
#define RUN_PH(id, code) do { const int _id = (id); if (_id >= ph0 && _id < ph1) { const int _kind = _id == 0 ? 12 : (_id == N_PHASES - 1 ? 13 : (_id - 1) % PH_PER_LAYER); \
    if ((PROBE_MASK >> _kind) & 1) { code; xcd_barrier_l(bar); } code; if (_id + 1 < ph1) xcd_barrier_l(bar); } } while (0)
__global__ __launch_bounds__(512, 2) void k_mega(MegaP p, int ph0, int ph1) {
  extern __shared__ __attribute__((aligned(16))) char smem0[];
  volatile LAS unsigned* xbw = (volatile LAS unsigned*)(smem0 + XBW_OFF);
  char* const smem = smem0 + PH_OFF;
  if (threadIdx.x == 0) {
    xbw[0] = 0u; xbw[1] = 0u; xbw[2] = 0u; xbw[3] = 0u;
    unsigned long long* tbl = (unsigned long long*)(smem0 + TBL_OFF);
#pragma unroll
    for (int i = 0; i < 40; ++i) tbl[i] = (unsigned long long)p.in[i];
  }
  __syncthreads();
  char* ws = p.ws; float* outp = p.out;
  const XcdBarrier bar = xcd_barrier_post((unsigned*)ws, xbw);
  if (ph1 - ph0 > 1) xcd_barrier(bar);
  RUN_PH(0, { phase_convert(ws, smem); NormArgs a{}; a.x = in_ptr(smem, 0); a.h = wsp<float>(ws, WS::H); a.g = in_ptr(smem, 2); a.xn = wsp<u16>(ws, WS::XN); phase_norm<0>(a); });
#pragma unroll 1
  for (int l = 0; l < NL; ++l) {
    const int pb = 1 + l * PH_PER_LAYER;
    RUN_PH(pb + 0, { if (l > 0) { NormArgs a{}; a.h = wsp<float>(ws, WS::H); a.g = in_ptr(smem, 2) + (long)l * DM; a.xn = wsp<u16>(ws, WS::XN); a.ybuf = wsp<float>(ws, WS::YBUF); phase_norm<1>(a); } });
    RUN_PH(pb + 1, phase_gemm<0>(ws, l, (u16*)smem));
    RUN_PH(pb + 2, { const MixP mp = make_mixp(ws, smem, l); phase_mix3(mp, smem); });
    RUN_PH(pb + 3, { const MixP mp = make_mixp(ws, smem, l); phase_mix4(mp, smem); mix4_convert(ws, smem, l); });
    RUN_PH(pb + 4, { const MixP mp = make_mixp(ws, smem, l); phase_mix5(mp); { int t_ = threadIdx.x; asm volatile("" : "+v"(t_)); if (blockIdx.x == 0 && t_ < 32) wsp<int>(ws, WS::TILE_EXP)[t_] = 0; } });
    RUN_PH(pb + 5, phase_gemm<1>(ws, l, (u16*)smem));
    RUN_PH(pb + 6, phase_gemm<2>(ws, l, (u16*)smem));
    RUN_PH(pb + 7, { NormArgs a{}; a.h = wsp<float>(ws, WS::H); a.g = in_ptr(smem, 31) + (long)l * DM; a.xn = wsp<u16>(ws, WS::XN); a.wg = in_ptr(smem, 32) + (long)l * DM * 4; a.bg = in_ptr(smem, 33) + l * 4;
      a.we = in_ptr(smem, 34) + (long)l * DM * 32; a.be = in_ptr(smem, 35) + l * 32; phase_n3(ws, a, smem, l); });
    RUN_PH(pb + 8, phase_gemm<3>(ws, l, (u16*)smem));
    RUN_PH(pb + 9, phase_gemm<4>(ws, l, (u16*)smem));
  }
  RUN_PH(N_PHASES - 1, { NormArgs a{}; a.h = wsp<float>(ws, WS::H); a.g = in_ptr(smem, 39); a.out = outp; a.ybuf = wsp<float>(ws, WS::YBUF); phase_norm<2>(a); });
}


extern "C" void kernel_launch(void* const* d_in, const int* in_sizes, int n_in, void* d_out, int out_size, void* d_ws, size_t ws_size, hipStream_t stream) {
  (void)in_sizes; (void)n_in; (void)out_size; (void)ws_size;
  MegaP p{};
  for (int i = 0; i < 40; ++i) p.in[i] = (const float*)d_in[i];
  p.ws = (char*)d_ws; p.out = (float*)d_out;
  static int grid = 0;
  if (!grid) {
    (void)hipFuncSetAttribute((const void*)k_mega, hipFuncAttributeMaxDynamicSharedMemorySize, LDS_BYTES);
    int dev = 0, cus = 0, per_cu = 0;
    (void)hipGetDevice(&dev);
    (void)hipDeviceGetAttribute(&cus, hipDeviceAttributeMultiprocessorCount, dev);
    (void)hipOccupancyMaxActiveBlocksPerMultiprocessor(&per_cu, (const void*)k_mega, 512, LDS_BYTES);
    grid = cus < 256 ? cus : 256;
    if (per_cu < 1) grid = 0;
  }
#ifndef MK_SPLIT
#define MK_SPLIT 0
#define PROBE_MASK 0
#endif
  if (grid > 0) {
    if (MK_SPLIT) { for (int ph = 0; ph < N_PHASES; ++ph) k_mega<<<grid, 512, LDS_BYTES, stream>>>(p, ph, ph + 1); }
    else { (void)hipMemsetAsync(d_ws, 0, XCD_BAR_WORDS * sizeof(unsigned), stream); k_mega<<<grid, 512, LDS_BYTES, stream>>>(p, 0, N_PHASES); }
  }
}
```

```cpp
#define RWKV_CHUNKED_FLAG true
#define MK_SPLIT 0
#define PROBE_MASK 0
#include <hip/hip_runtime.h>
#include <stdint.h>

#define LAS __attribute__((address_space(3)))
typedef unsigned short u16;
typedef __attribute__((ext_vector_type(8))) short bf16x8;
typedef __attribute__((ext_vector_type(4))) float f32x4;

constexpr int T_ = 8192, DM = 2048, NL = 2, MIXW = 512;
constexpr int IN_COLS = 14512, PC = 14592;
constexpr int OFF_A = 0, OFF_B = 1696, OFF_C = 3744, OFF_D = 4768, OFF_G = 6400, NONGATE = 6320;
constexpr int NEXP = 32, DEXP = 1024;
constexpr int MAXROWS = 24576, MAXRT = 96, LCAP = 8192;

typedef __attribute__((ext_vector_type(2))) float f32x2_t;
typedef __attribute__((ext_vector_type(2))) __bf16 bf16x2_t;
__device__ __forceinline__ unsigned pack_bf16(float lo, float hi) { f32x2_t v = {lo, hi}; return __builtin_bit_cast(unsigned, __builtin_convertvector(v, bf16x2_t)); }
__device__ __forceinline__ u16 f2bf(float f) { return (u16)pack_bf16(f, 0.f); }
__device__ __forceinline__ float bf2f(u16 h) { return __uint_as_float(((unsigned)h) << 16); }
__device__ __forceinline__ float sigmoidf_(float x) { return __builtin_amdgcn_rcpf(1.f + __expf(-x)); }
#define PIN8(a) asm volatile("" : "+v"(a[0]), "+v"(a[1]), "+v"(a[2]), "+v"(a[3]), "+v"(a[4]), "+v"(a[5]), "+v"(a[6]), "+v"(a[7]))
#define PIN8O(a, o) asm volatile("" : "+v"(a[o + 0]), "+v"(a[o + 1]), "+v"(a[o + 2]), "+v"(a[o + 3]), "+v"(a[o + 4]), "+v"(a[o + 5]), "+v"(a[o + 6]), "+v"(a[o + 7]))
#define PIN8x2(a, b) asm volatile("" : "+v"(a[0]), "+v"(a[1]), "+v"(a[2]), "+v"(a[3]), "+v"(a[4]), "+v"(a[5]), "+v"(a[6]), "+v"(a[7]), "+v"(b[0]), "+v"(b[1]), "+v"(b[2]), "+v"(b[3]), "+v"(b[4]), "+v"(b[5]), "+v"(b[6]), "+v"(b[7]))
__device__ __forceinline__ void lds_barrier() { asm volatile("s_waitcnt lgkmcnt(0)" ::: "memory"); __builtin_amdgcn_s_barrier(); asm volatile("" ::: "memory"); }
__device__ __forceinline__ float wave_sum(float v) {
#pragma unroll
  for (int o = 32; o > 0; o >>= 1) v += __shfl_xor(v, o, 64);
  return v;
}

constexpr int BKK = 64, HALF = 128, HT = HALF * BKK, SHM_B = 8 * HT * 2;
__device__ __forceinline__ int lds_byte(int r, int c) {
  int st = (r >> 4) * 2 + (c >> 5), rr = r & 15, cc = c & 31, ob = rr * 64 + cc * 2;
  return st * 1024 + (ob ^ (((ob >> 9) & 1) << 5));
}
__device__ __forceinline__ void stage_rc(int b, int& R, int& C) {
  int st = b / 1024, sb = b % 1024, swz = sb ^ (((sb >> 9) & 1) << 5);
  R = (st >> 1) * 16 + swz / 64; C = (st & 1) * 32 + (swz % 64) / 2;
}

template <bool GATHER, class Epi>
__device__ __forceinline__ void gemm256g(const u16* __restrict__ A, int lda, const u16* __restrict__ Bt, int ldb, int K, u16* shm, const Epi& epi, const int (&arow)[4]) {
#define SA(b, h) (shm + ((b) * 2 + (h)) * HT)
#define SB(b, h) (shm + (4 + (b) * 2 + (h)) * HT)
#define STAGE_X(TT, P, BASE, LD, br, kt) do { const u16* _g = (BASE) + (long)(br) * (LD) + (long)(kt) * BKK; \
    _Pragma("unroll") for (int _i = 0; _i < 2; ++_i) { int _b = (TT) * 16 + _i * 8192; int _r, _c; stage_rc(_b, _r, _c); \
      __builtin_amdgcn_global_load_lds((const unsigned*)(_g + (long)_r * (LD) + _c), (unsigned*)((char*)(P) + _b), 16, 0, 0); } } while (0)
#define STAGE_AG(TT, P, br, kt) do { \
    _Pragma("unroll") for (int _i = 0; _i < 2; ++_i) { int _b = (TT) * 16 + _i * 8192; \
      __builtin_amdgcn_global_load_lds((const unsigned*)((const char*)A + (unsigned)(arow[((br) / HALF) * 2 + _i] + (kt) * (BKK * 2))), (unsigned*)((char*)(P) + _b), 16, 0, 0); } } while (0)
#define STAGE_A(P, br, kt) do { if (GATHER) STAGE_AG(tid0, P, br, kt); else STAGE_X(tid0, P, A, lda, br, kt); } while (0)
#define STAGE_B(P, br, kt) STAGE_X(tid0, P, Bt, ldb, br, kt)
#define LDA(dst, b, h) _Pragma("unroll") for (int m = 0; m < 4; ++m) _Pragma("unroll") for (int k = 0; k < 2; ++k) \
    dst[m][k] = *reinterpret_cast<const bf16x8*>((char*)SA(b, h) + lds_byte(wr * 64 + m * 16 + fr, k * 32 + fq * 8))
#define LDB(dst, b, h) _Pragma("unroll") for (int n = 0; n < 2; ++n) _Pragma("unroll") for (int k = 0; k < 2; ++k) \
    dst[n][k] = *reinterpret_cast<const bf16x8*>((char*)SB(b, h) + lds_byte(wc * 32 + n * 16 + fr, k * 32 + fq * 8))
#define MMA(ai, bj, At, Bx) do { __builtin_amdgcn_s_setprio(1); \
    _Pragma("unroll") for (int m = 0; m < 4; ++m) _Pragma("unroll") for (int n = 0; n < 2; ++n) _Pragma("unroll") for (int k = 0; k < 2; ++k) \
      acc[ai][bj][m][n] = __builtin_amdgcn_mfma_f32_16x16x32_bf16(Bx[n][k], At[m][k], acc[ai][bj][m][n], 0, 0, 0); \
    __builtin_amdgcn_s_setprio(0); } while (0)
#define WAIT_V(n) asm volatile("s_waitcnt vmcnt(" #n ")" ::: "memory")
#define WAIT_L(n) asm volatile("s_waitcnt lgkmcnt(" #n ")" ::: "memory")
#define BAR __builtin_amdgcn_s_barrier()
#define SCHED __builtin_amdgcn_sched_barrier(0)
  int tid0 = threadIdx.x; asm volatile("" : "+v"(tid0));
  int wid = tid0 >> 6, lane = tid0 & 63, wr = wid >> 2, wc = wid & 3, fr = lane & 15, fq = lane >> 4;
  f32x4 acc[2][2][4][2] = {};
  bf16x8 At[4][2], B0[2][2], B1[2][2];
  const int nt = K / BKK;
  STAGE_B(SB(0, 0), 0, 0); STAGE_A(SA(0, 0), 0, 0);
  STAGE_B(SB(0, 1), HALF, 0); STAGE_A(SA(0, 1), HALF, 0);
  if (wr == 1) BAR;
  WAIT_V(4); BAR;
  STAGE_B(SB(1, 0), 0, 1); STAGE_A(SA(1, 0), 0, 1); STAGE_B(SB(1, 1), HALF, 1);
  WAIT_V(6); BAR;
  for (int t = 0; t < nt - 2; t += 2) {
    LDB(B0, 0, 0); SCHED; LDA(At, 0, 0); STAGE_A(SA(1, 1), HALF, t + 1);
    WAIT_L(8); BAR; WAIT_L(0); MMA(0, 0, At, B0); BAR; SCHED;
    LDB(B1, 0, 1); STAGE_B(SB(0, 0), 0, t + 2);
    BAR; WAIT_L(0); MMA(0, 1, At, B1); BAR;
    LDA(At, 0, 1); STAGE_A(SA(0, 0), 0, t + 2);
    BAR; WAIT_L(0); MMA(1, 0, At, B0); BAR; SCHED;
    STAGE_B(SB(0, 1), HALF, t + 2);
    WAIT_V(6); BAR; MMA(1, 1, At, B1); BAR;
    LDB(B0, 1, 0); SCHED; LDA(At, 1, 0); STAGE_A(SA(0, 1), HALF, t + 2);
    WAIT_L(8); BAR; WAIT_L(0); MMA(0, 0, At, B0); BAR; SCHED;
    LDB(B1, 1, 1); STAGE_B(SB(1, 0), 0, t + 3);
    BAR; WAIT_L(0); MMA(0, 1, At, B1); BAR;
    LDA(At, 1, 1); STAGE_A(SA(1, 0), 0, t + 3);
    BAR; WAIT_L(0); MMA(1, 0, At, B0); BAR; SCHED;
    STAGE_B(SB(1, 1), HALF, t + 3);
    WAIT_V(6); BAR; MMA(1, 1, At, B1); BAR;
  }
  int tz = threadIdx.x; asm volatile("" : "+v"(tz)); wid = tz >> 6; lane = tz & 63; wr = wid >> 2; wc = wid & 3; fr = lane & 15; fq = lane >> 4;
  { LDB(B0, 0, 0); WAIT_V(0); LDA(At, 0, 0); if (GATHER) STAGE_AG(tz, SA(1, 1), HALF, nt - 1); else STAGE_X(tz, SA(1, 1), A, lda, HALF, nt - 1);
    BAR; WAIT_L(0); MMA(0, 0, At, B0); BAR;
    LDB(B1, 0, 1); BAR; WAIT_L(0); MMA(0, 1, At, B1); BAR;
    LDA(At, 0, 1); WAIT_V(4); BAR; WAIT_L(0); MMA(1, 0, At, B0); MMA(1, 1, At, B1); BAR; }
  { LDB(B0, 1, 0); LDA(At, 1, 0); WAIT_V(2); BAR; WAIT_L(0); MMA(0, 0, At, B0); BAR;
    LDB(B1, 1, 1); WAIT_V(0); BAR; WAIT_L(0); MMA(0, 1, At, B1); BAR;
    LDA(At, 1, 1); BAR; WAIT_L(0); MMA(1, 0, At, B0); MMA(1, 1, At, B1); BAR; }
  if (wr == 0) BAR;
  epi(acc, wr, wc, fr, fq);
  __syncthreads();
#undef SA
#undef SB
}

template <class Epi>
__device__ __forceinline__ void gemm256(const u16* __restrict__ A, int lda, const u16* __restrict__ Bt, int ldb, int K, u16* shm, const Epi& epi) {
  const int dummy[4] = {0, 0, 0, 0};
  gemm256g<false>(A, lda, Bt, ldb, K, shm, epi, dummy);
}
#define UNR _Pragma("unroll")
#define EPI4 UNR for (int ai = 0; ai < 2; ++ai) UNR for (int bj = 0; bj < 2; ++bj) UNR for (int m = 0; m < 4; ++m) UNR for (int n = 0; n < 2; ++n)
#define EPI_R (ai * HALF + wr * 64 + m * 16 + fr)
#define EPI_C (bj * HALF + wc * 32 + n * 16 + fq * 4)
__device__ __forceinline__ uint2 pack4(const f32x4& v) { uint2 r; r.x = pack_bf16(v[0], v[1]); r.y = pack_bf16(v[2], v[3]); return r; }

struct EpiProj {
  u16* proj; int brow, bcol;
  __device__ __forceinline__ void operator()(const f32x4 (&acc)[2][2][4][2], int wr, int wc, int fr, int fq) const {
    u16* base = proj + (long)(brow + wr * 64 + fr) * PC + bcol + wc * 32 + fq * 4;
    if (bcol >= OFF_G) {
      EPI4 { f32x4 v = acc[ai][bj][m][n]; v[0] = sigmoidf_(v[0]); v[1] = sigmoidf_(v[1]); v[2] = sigmoidf_(v[2]); v[3] = sigmoidf_(v[3]);
             *(uint2*)(base + (long)(ai * HALF + m * 16) * PC + bj * HALF + n * 16) = pack4(v); }
    } else {
      EPI4 { *(uint2*)(base + (long)(ai * HALF + m * 16) * PC + bj * HALF + n * 16) = pack4(acc[ai][bj][m][n]); }
    }
  }
};
struct EpiResid {
  float* h; int brow, bcol;
  __device__ __forceinline__ void operator()(const f32x4 (&acc)[2][2][4][2], int wr, int wc, int fr, int fq) const {
    float* base = h + (long)(brow + wr * 64 + fr) * DM + bcol + wc * 32 + fq * 4;
    UNR for (int ai = 0; ai < 2; ++ai) UNR for (int m = 0; m < 4; ++m) {
      f32x4 o[2][2];
      UNR for (int bj = 0; bj < 2; ++bj) UNR for (int n = 0; n < 2; ++n) o[bj][n] = *(const f32x4*)(base + (long)(ai * HALF + m * 16) * DM + bj * HALF + n * 16);
      UNR for (int bj = 0; bj < 2; ++bj) UNR for (int n = 0; n < 2; ++n) *(f32x4*)(base + (long)(ai * HALF + m * 16) * DM + bj * HALF + n * 16) = o[bj][n] + acc[ai][bj][m][n];
    }
  }
};
struct EpiGateUp {
  u16* hmid; int brow, ct;
  __device__ __forceinline__ void operator()(const f32x4 (&acc)[2][2][4][2], int wr, int wc, int fr, int fq) const {
    u16* base = hmid + (long)(brow + wr * 64 + fr) * DEXP + ct * 128 + wc * 32 + fq * 4;
    UNR for (int ai = 0; ai < 2; ++ai) UNR for (int m = 0; m < 4; ++m) UNR for (int n = 0; n < 2; ++n) {
      const f32x4 g = acc[ai][0][m][n], u = acc[ai][1][m][n]; f32x4 v;
      UNR for (int j = 0; j < 4; ++j) v[j] = g[j] * sigmoidf_(g[j]) * u[j];
      *(uint2*)(base + (long)(ai * HALF + m * 16) * DEXP + n * 16) = pack4(v); }
  }
};
struct EpiDown {
  float* ybuf; const int* lslot; const float* lgate; int nvalid, bcol;
  __device__ __forceinline__ void operator()(const f32x4 (&acc)[2][2][4][2], int wr, int wc, int fr, int fq) const {
    UNR for (int ai = 0; ai < 2; ++ai) UNR for (int m = 0; m < 4; ++m) {
      const int r = ai * HALF + wr * 64 + m * 16 + fr;
      if (r < nvalid) { const int slot = lslot[r]; const float gt = lgate[r];
        float* yp = ybuf + (long)slot * DM + bcol + wc * 32 + fq * 4;
        UNR for (int bj = 0; bj < 2; ++bj) UNR for (int n = 0; n < 2; ++n) *(f32x4*)(yp + bj * HALF + n * 16) = acc[ai][bj][m][n] * gt; } }
  }
};

__device__ __forceinline__ void gemm_merge(const u16* __restrict__ A, const u16* __restrict__ Bt, const u16* __restrict__ gates, u16* __restrict__ out, int brow, int bcol, u16* shm) {
#define MA(b, h) (shm + ((b) * 3 + (h)) * HT)
#define MB(b) (shm + ((b) * 3 + 2) * HT)
#define MSTAGE(P, BASE, LD_, br, kt) do { const u16* _g = (BASE) + (long)(br) * (LD_) + (long)(kt) * BKK; \
    _Pragma("unroll") for (int _i = 0; _i < 2; ++_i) { int _b = tid0 * 16 + _i * 8192; int _r, _c; stage_rc(_b, _r, _c); \
      __builtin_amdgcn_global_load_lds((const unsigned*)(_g + (long)_r * (LD_) + _c), (unsigned*)((char*)(P) + _b), 16, 0, 0); } } while (0)
  int tid0 = threadIdx.x; asm volatile("" : "+v"(tid0));
  const int wid = tid0 >> 6, lane = tid0 & 63, wr = wid >> 2, wc = wid & 3, fr = lane & 15, fq = lane >> 4;
  f32x4 acc[2][4][2], R[2][4][2];
#pragma unroll
  for (int ai = 0; ai < 2; ++ai)
#pragma unroll
    for (int m = 0; m < 4; ++m)
#pragma unroll
      for (int n = 0; n < 2; ++n) { acc[ai][m][n] = (f32x4){0.f, 0.f, 0.f, 0.f}; R[ai][m][n] = (f32x4){0.f, 0.f, 0.f, 0.f}; }
  const u16* Ab = A + (long)brow * DM; const u16* Bb = Bt + (long)bcol * DM;
  MSTAGE(MA(0, 0), Ab, DM, 0, 0); MSTAGE(MA(0, 1), Ab, DM, HALF, 0); MSTAGE(MB(0), Bb, DM, 0, 0);
  asm volatile("s_waitcnt vmcnt(0)" ::: "memory"); __syncthreads();
#pragma unroll 1
  for (int q = 0; q < 32; ++q) {
    const int b = q & 1;
    if (q + 1 < 32) { MSTAGE(MA(b ^ 1, 0), Ab, DM, 0, q + 1); MSTAGE(MA(b ^ 1, 1), Ab, DM, HALF, q + 1); MSTAGE(MB(b ^ 1), Bb, DM, 0, q + 1); }
    bf16x8 Bf[2][2], Af[4][2];
#pragma unroll
    for (int n = 0; n < 2; ++n)
#pragma unroll
      for (int k = 0; k < 2; ++k) Bf[n][k] = *reinterpret_cast<const bf16x8*>((char*)MB(b) + lds_byte(wc * 32 + n * 16 + fr, k * 32 + fq * 8));
#pragma unroll
    for (int ai = 0; ai < 2; ++ai) {
#pragma unroll
      for (int m = 0; m < 4; ++m)
#pragma unroll
        for (int k = 0; k < 2; ++k) Af[m][k] = *reinterpret_cast<const bf16x8*>((char*)MA(b, ai) + lds_byte(wr * 64 + m * 16 + fr, k * 32 + fq * 8));
#pragma unroll
      for (int m = 0; m < 4; ++m)
#pragma unroll
        for (int n = 0; n < 2; ++n)
#pragma unroll
          for (int k = 0; k < 2; ++k) acc[ai][m][n] = __builtin_amdgcn_mfma_f32_16x16x32_bf16(Bf[n][k], Af[m][k], acc[ai][m][n], 0, 0, 0);
    }
    if ((q & 7) == 7) {
      const int kb = q >> 3;
      const u16* gp = gates + (long)(brow + wr * 64 + fr) * PC + kb * DM + bcol + wc * 32 + fq * 4;
#pragma unroll
      for (int ai = 0; ai < 2; ++ai) {
        uint2 g2[4][2];
#pragma unroll
        for (int m = 0; m < 4; ++m)
#pragma unroll
          for (int n = 0; n < 2; ++n) g2[m][n] = *(const uint2*)(gp + (long)(ai * HALF + m * 16) * PC + n * 16);
#pragma unroll
        for (int m = 0; m < 4; ++m)
#pragma unroll
          for (int n = 0; n < 2; ++n) {
            const f32x4 gv = {__uint_as_float(g2[m][n].x << 16), __uint_as_float(g2[m][n].x & 0xffff0000u), __uint_as_float(g2[m][n].y << 16), __uint_as_float(g2[m][n].y & 0xffff0000u)};
            R[ai][m][n] += gv * acc[ai][m][n]; acc[ai][m][n] = (f32x4){0.f, 0.f, 0.f, 0.f};
          }
      }
    }
    asm volatile("s_waitcnt vmcnt(0)" ::: "memory"); __syncthreads();
  }
  u16* op = out + (long)(brow + wr * 64 + fr) * DM + bcol + wc * 32 + fq * 4;
#pragma unroll
  for (int ai = 0; ai < 2; ++ai)
#pragma unroll
    for (int m = 0; m < 4; ++m)
#pragma unroll
      for (int n = 0; n < 2; ++n) *(uint2*)(op + (long)(ai * HALF + m * 16) * DM + n * 16) = pack4(R[ai][m][n]);
#undef MA
#undef MB
#undef MSTAGE
}
__device__ __forceinline__ void unit_map(int b, int round, int& pm, int& pn) {
  int xcd = b & 7, i = b >> 3, pr = xcd >> 1, pc = xcd & 1, lr = i & 7, lc = i >> 3;
  pm = pr * 8 + lr; pn = round * 8 + pc * 4 + lc;
}
constexpr int CH = 64, NCH = T_ / CH;
struct MegaP { const float* in[40]; char* ws; float* out; };
namespace WS {
constexpr size_t al(size_t x) { return (x + 255) & ~(size_t)255; }
constexpr size_t U8 = (size_t)1024 * 4096 * 2;
constexpr size_t BARW = 0;
constexpr size_t WT_IN = BARW + 65536;
constexpr size_t WT_O = WT_IN + al((size_t)NL * PC * DM * 2);
constexpr size_t WT_OUT = WT_O + al((size_t)NL * 4 * DM * MIXW * 2);
constexpr size_t WGU = WT_OUT + al((size_t)NL * DM * DM * 2);
constexpr size_t WDN = WGU + al((size_t)NL * NEXP * 2048 * DM * 2);
constexpr size_t H = WDN + al((size_t)NL * NEXP * DM * DEXP * 2);
constexpr size_t XN = H + al((size_t)T_ * DM * 4);
constexpr size_t PROJ = XN + al((size_t)T_ * DM * 2);
constexpr size_t YCAT = PROJ + al((size_t)T_ * PC * 2);
constexpr size_t MBUF = YCAT + al((size_t)T_ * DM * 2);
constexpr size_t MERGED = MBUF + al((size_t)T_ * DM * 4);
constexpr size_t TOK_E = MERGED + al((size_t)T_ * DM * 2);
constexpr size_t TOK_G = TOK_E + al((size_t)2 * T_ * 4);
constexpr size_t ROW_TOK = TOK_G + al((size_t)2 * T_ * 4);
constexpr size_t ROW_SLOT = ROW_TOK + al((size_t)MAXROWS * 4);
constexpr size_t ROW_GATE = ROW_SLOT + al((size_t)MAXROWS * 4);
constexpr size_t TILE_EXP = ROW_GATE + al((size_t)MAXROWS * 4);
constexpr size_t NRT = TILE_EXP + 1024;
constexpr size_t XG = NRT + 256;
constexpr size_t HMID = XG + al((size_t)MAXROWS * DM * 2);
constexpr size_t YBUF = HMID + al((size_t)MAXROWS * DEXP * 2);
constexpr size_t RW_RB = YBUF + al((size_t)2 * T_ * DM * 4);
constexpr size_t RW_PAB = RW_RB + U8, RW_PAK = RW_PAB + U8, RW_VT = RW_PAK + U8, RW_S0 = RW_VT + U8, RW_UT = RW_S0 + U8, RW_WPF = RW_UT + U8, RW_BTF = RW_WPF + U8;
constexpr size_t RW_G = RW_BTF + U8, RW_BV = RW_G + U8, RW_U0F = RW_BV + U8, RW_KVF = RW_U0F + 2 * U8, RW_GAM = RW_KVF + 2 * U8;
constexpr size_t RT_RB = RW_GAM + 262144, RT_PAK = RT_RB + U8, RT_VT = RT_PAK + U8, RT_S0 = RT_VT + U8, RT_KVT = RT_S0 + U8;
constexpr size_t GL_RB = RT_KVT + 2 * U8, GL_PAK = GL_RB + U8 / 2, GL_VT = GL_PAK + U8 / 2, GL_S0 = GL_VT + U8, GL_KVT = GL_S0 + U8, GL_GAM = GL_KVT + 2 * U8;
constexpr size_t LR_H = GL_GAM + 131072, LR_A = LR_H + (size_t)T_ * 512 * 4, LR_HP = LR_A + (size_t)T_ * 512 * 4;
constexpr size_t LST_SLOT = LR_HP + (size_t)NCH * 512 * 4;
constexpr size_t LST_GATE = LST_SLOT + (size_t)32 * 8192 * 4;
constexpr size_t RT_HI = LST_GATE + (size_t)32 * 8192 * 4;
constexpr size_t RT_LO = RT_HI + (size_t)NL * 48 * 2048 * 2;
constexpr size_t LORA_W = RT_LO + (size_t)NL * 48 * 2048 * 2;
constexpr size_t LRU_W = LORA_W + (size_t)NL * 512 * 160 * 2;
constexpr size_t ROT = LRU_W + (size_t)NL * 2 * 8 * 4096 * 2;
constexpr size_t END = ROT + (size_t)T_ * 32 * 8;
}
constexpr int TBL_OFF = 0, XBW_OFF = 320, PH_OFF = 512;
constexpr int PH_BYTES = 153600;
constexpr int LDS_BYTES = PH_OFF + PH_BYTES;
__device__ __forceinline__ const float* in_ptr(const char* smem, int i) {
  const unsigned long long v = *(const unsigned long long*)(smem - PH_OFF + TBL_OFF + i * 8);
  const unsigned lo = __builtin_amdgcn_readfirstlane((unsigned)v), hi = __builtin_amdgcn_readfirstlane((unsigned)(v >> 32));
  return (const float*)(const float __attribute__((address_space(1)))*)(((unsigned long long)hi << 32) | lo);
}
template <class T> __device__ __forceinline__ T* wsp(char* ws, size_t off) { return (T*)(ws + off); }
__device__ __forceinline__ int ld_i(const int* p) { return __hip_atomic_load(p, __ATOMIC_RELAXED, __HIP_MEMORY_SCOPE_AGENT); }
#define OPAQUE_WS(w) do { unsigned long long _z = 0; asm volatile("" : "+s"(_z)); (w) = (char*)(char __attribute__((address_space(1)))*)((unsigned long long)(w) + _z); } while (0)
__device__ __forceinline__ int bidx() { int b = blockIdx.x; asm volatile("" : "+s"(b)); return b; }
__device__ __forceinline__ int gdim() { int g = gridDim.x; asm volatile("" : "+s"(g)); return g; }

__device__ __forceinline__ void transpose_tile_w(const float* __restrict__ src, int sld, int nvalid, u16* __restrict__ dst, int K, int n0, int k0, int drow0, int mode, int lane) {
  const int kq = lane >> 4, n4 = lane & 15, nb = n0 + n4 * 4;
  f32x4 v[16];
  if (nb < nvalid) {
    const float* sp = src + (long)(k0 + kq * 16) * sld + nb;
#pragma unroll
    for (int i = 0; i < 16; ++i) v[i] = *(const f32x4*)(sp + (long)i * sld);
  } else {
#pragma unroll
    for (int i = 0; i < 16; ++i) v[i] = (f32x4){0.f, 0.f, 0.f, 0.f};
  }
#pragma unroll
  for (int jn = 0; jn < 4; ++jn) {
    const int n = nb + jn;
    const int row = (mode == 0) ? drow0 + n : ((n >> 7) * 256 + (mode == 2 ? 128 : 0) + (n & 127));
    u16* dp = dst + (long)row * K + k0 + kq * 16;
    uint4 lo, hi;
    lo.x = (unsigned)f2bf(v[0][jn]) | ((unsigned)f2bf(v[1][jn]) << 16); lo.y = (unsigned)f2bf(v[2][jn]) | ((unsigned)f2bf(v[3][jn]) << 16);
    lo.z = (unsigned)f2bf(v[4][jn]) | ((unsigned)f2bf(v[5][jn]) << 16); lo.w = (unsigned)f2bf(v[6][jn]) | ((unsigned)f2bf(v[7][jn]) << 16);
    hi.x = (unsigned)f2bf(v[8][jn]) | ((unsigned)f2bf(v[9][jn]) << 16); hi.y = (unsigned)f2bf(v[10][jn]) | ((unsigned)f2bf(v[11][jn]) << 16);
    hi.z = (unsigned)f2bf(v[12][jn]) | ((unsigned)f2bf(v[13][jn]) << 16); hi.w = (unsigned)f2bf(v[14][jn]) | ((unsigned)f2bf(v[15][jn]) << 16);
    *(uint4*)dp = lo; *(uint4*)(dp + 8) = hi;
  }
}
__device__ __forceinline__ void moe_tile(char* ws, const char* smem, int l, int t, int lane) {
  if (t < 32768) { const int up = t >> 14, e = (t & 16383) >> 9, q = t & 511, nt = q >> 5, kt = q & 31;
    transpose_tile_w(in_ptr(smem, up ? 37 : 36) + ((long)l * NEXP + e) * DM * DEXP, DEXP, DEXP, wsp<u16>(ws, WS::WGU) + ((long)l * NEXP + e) * 2048 * DM, DM, nt * 64, kt * 64, 0, up ? 2 : 1, lane);
  } else { const int t2 = t - 32768, e = t2 >> 9, q = t2 & 511, nt = q >> 4, kt = q & 15;
    transpose_tile_w(in_ptr(smem, 38) + ((long)l * NEXP + e) * DEXP * DM, DM, DM, wsp<u16>(ws, WS::WDN) + ((long)l * NEXP + e) * DM * DEXP, DEXP, nt * 64, kt * 64, 0, 0, lane); }
}
constexpr int CV_SOLVE = 6144;
constexpr int LD = 72;

struct RwkvP { const float *mu, *w0, *w_up, *a0, *a_up, *g_up, *k_k, *k_a, *r_k, *ln_g, *ln_b; const u16* lora_w; };
struct LruP { const float *conv_w, *conv_b, *w_a, *b_a, *w_x, *b_x, *lam; const u16* wt; };
struct MixBuf {
  u16 *rw_Rb, *rw_Pab, *rw_Pak, *rw_VT, *rw_S0, *rw_UT, *rw_WpF, *rw_BtF, *rw_G, *rw_BV; float *rw_U0F, *rw_KVF, *rw_gam;
  u16 *rt_Rb, *rt_Pak, *rt_VT, *rt_S0; float* rt_KVT;
  u16 *gl_Rb, *gl_Pak, *gl_VT, *gl_S0; float *gl_KVT, *gl_gam;
  float *lr_h, *lr_A, *lr_Hp;
};
struct MixP {
  const u16* proj; const int* pos; u16* ycat; MixBuf b; char* ws; const char* smem; int layer; const float* rot;
  RwkvP rw; const float* ret_norm_g; LruP lru; const float *gla_alpha_up, *gla_alpha_b, *gla_norm_g;
};

__device__ __forceinline__ float gelu_tanh(float x) {
  const float u = 0.7978845608028654f * (x + 0.044715f * x * x * x);
  return 0.5f * x * (1.f + tanhf(u));
}
__device__ __forceinline__ float red16(float v) {
  v += __shfl_xor(v, 1, 64); v += __shfl_xor(v, 2, 64); v += __shfl_xor(v, 4, 64); v += __shfl_xor(v, 8, 64);
  return v;
}
__device__ __forceinline__ uint4 pack8(const u16 (&a)[8]) {
  uint4 r;
  r.x = (unsigned)a[0] | ((unsigned)a[1] << 16); r.y = (unsigned)a[2] | ((unsigned)a[3] << 16);
  r.z = (unsigned)a[4] | ((unsigned)a[5] << 16); r.w = (unsigned)a[6] | ((unsigned)a[7] << 16);
  return r;
}
__device__ __forceinline__ f32x4 tile_nt(const u16* sA, const u16* sB, int mt, int nt, int r, int g) {
  f32x4 c = {0.f, 0.f, 0.f, 0.f};
#pragma unroll
  for (int s = 0; s < 2; ++s) {
    bf16x8 a = *(const bf16x8*)(sA + (16 * mt + r) * LD + 32 * s + 8 * g);
    bf16x8 b = *(const bf16x8*)(sB + (16 * nt + r) * LD + 32 * s + 8 * g);
    c = __builtin_amdgcn_mfma_f32_16x16x32_bf16(a, b, c, 0, 0, 0);
  }
  return c;
}
__device__ __forceinline__ void copy_out(const u16* s, u16* gp, int rows, int tid) {
  for (int idx = tid; idx < rows * 8; idx += 512) { int row = idx >> 3, seg = idx & 7; *(uint4*)(gp + row * 64 + seg * 8) = *(const uint4*)(s + row * LD + seg * 8); }
}
__device__ __forceinline__ void inv_perm(int x, int& s, int& g, int& j) { s = x >> 5; int rr = x & 31; g = (rr >> 2) & 3; j = 4 * (rr >> 4) + (rr & 3); }

__device__ __forceinline__ void p3_ret(const MixP& p, int c, int h, char* smem) {
  u16* sRb = (u16*)smem; u16* sKb = sRb + 64 * LD; u16* sKtT = sKb + 64 * LD; u16* sVT = sKtT + 64 * LD;
  int tid = threadIdx.x; asm volatile("" : "+v"(tid));
  const int cc = tid & 63, tg = tid >> 6, r = cc & 15, g = cc >> 4, uid = c * 8 + h;
  const float lg2 = log2f(1.f - exp2f(-(5.f + 4.f * (float)h / 7.f)));
  u16 kt8[8], v8[8], q16[8], k16[8]; f32x2_t cs2[8];
#pragma unroll
  for (int i = 0; i < 8; ++i) {
    const int t = c * 64 + tg * 8 + i; const u16* row = p.proj + (long)t * PC + OFF_B;
    q16[i] = row[h * 64 + cc]; k16[i] = row[512 + h * 64 + cc]; v8[i] = row[1024 + h * 64 + cc]; cs2[i] = *(const f32x2_t*)(p.rot + (t * 32 + (cc & 31)) * 2);
  }
      asm volatile("" ::: "memory");
#pragma unroll
  for (int i = 0; i < 8; ++i) {
    const int tl = tg * 8 + i;
    const float q = bf2f(q16[i]), k = bf2f(k16[i]), cs = cs2[i][0], sn = cs2[i][1];
    const float qo = __shfl_xor(q, 32, 64), ko = __shfl_xor(k, 32, 64);
    const float qr = cc < 32 ? q * cs - qo * sn : q * cs + qo * sn;
    const float kr = (cc < 32 ? k * cs - ko * sn : k * cs + ko * sn) * 0.125f;
    const float e = exp2f(lg2 * (float)(tl + 1)), ei = exp2f(-lg2 * (float)(tl + 1)), et = exp2f(lg2 * (float)(63 - tl));
    sRb[tl * LD + cc] = f2bf(qr * e); sKb[tl * LD + cc] = f2bf(kr * ei); kt8[i] = f2bf(kr * et);
  }
  *(uint4*)(sKtT + cc * LD + tg * 8) = pack8(kt8); *(uint4*)(sVT + cc * LD + tg * 8) = pack8(v8);
  lds_barrier();
  for (int tile = tg; tile < 32; tile += 8) {
    if (tile < 16) {
      const int mt = tile >> 2, nt = tile & 3; f32x4 c4 = tile_nt(sRb, sKb, mt, nt, r, g);
#pragma unroll
      for (int reg = 0; reg < 4; ++reg) { int t = 16 * mt + 4 * g + reg, i = 16 * nt + r; p.b.rt_Pak[(long)uid * 4096 + t * 64 + i] = f2bf(i <= t ? c4[reg] : 0.f); }
    } else {
      const int q = tile - 16, mt = q >> 2, nt = q & 3; f32x4 c4 = tile_nt(sVT, sKtT, mt, nt, r, g);
#pragma unroll
      for (int reg = 0; reg < 4; ++reg) { int v = 16 * mt + 4 * g + reg, k = 16 * nt + r; p.b.rt_KVT[(long)uid * 4096 + v * 64 + k] = c4[reg]; }
    }
  }
  copy_out(sRb, p.b.rt_Rb + (long)uid * 4096, 64, tid); copy_out(sVT, p.b.rt_VT + (long)uid * 4096, 64, tid);
  lds_barrier();
}

__device__ __forceinline__ void p3_gla(const MixP& p, int c, int h, char* smem) {
  u16* sRb = (u16*)smem; u16* sKb = sRb + 64 * LD; u16* sKtT = sKb + 64 * LD; u16* sVT = sKtT + 64 * LD;
  float* pre = (float*)(smem + 5 * 64 * LD * 2); float* sal = pre + 512;
  int tid = threadIdx.x; asm volatile("" : "+v"(tid));
  const int cc = tid & 63, tg = tid >> 6, r = cc & 15, g = cc >> 4, uid = c * 4 + h, hd = h * 64 + cc;
  for (int idx = tid; idx < 1024; idx += 512) { int tl = idx >> 4, j = idx & 15; sal[idx] = bf2f(p.proj[(long)(c * 64 + tl) * PC + OFF_D + 1024 + j]); }
  lds_barrier();
  float au[16];
#pragma unroll
  for (int j = 0; j < 16; ++j) au[j] = p.gla_alpha_up[j * 256 + hd];
  const float ab = p.gla_alpha_b[hd];
  float cum[8]; float run = 0.f;
#pragma unroll
  for (int i = 0; i < 8; ++i) {
    const int tl = tg * 8 + i; float x = ab;
#pragma unroll
    for (int j = 0; j < 16; ++j) x += sal[tl * 16 + j] * au[j];
    const float ls = fminf(x, 0.f) - __logf(1.f + __expf(-fabsf(x)));
    run += ls * (1.f / 16.f); cum[i] = run;
  }
  pre[tg * 64 + cc] = run;
  lds_barrier();
  float off = 0.f, tot = 0.f;
#pragma unroll
  for (int q = 0; q < 8; ++q) { float v = pre[q * 64 + cc]; tot += v; if (q < tg) off += v; }
  u16 kt8[8], v8a[8], v8b[8];
#pragma unroll
  for (int i = 0; i < 8; ++i) {
    const int tl = tg * 8 + i, t = c * 64 + tl; const u16* row = p.proj + (long)t * PC + OFF_D;
    const float cm = cum[i] + off;
    const float q = bf2f(row[hd]) * 0.125f, k = bf2f(row[256 + hd]);
    sRb[tl * LD + cc] = f2bf(q * __expf(cm)); sKb[tl * LD + cc] = f2bf(k * __expf(-cm)); kt8[i] = f2bf(k * __expf(tot - cm));
    v8a[i] = row[512 + h * 128 + cc]; v8b[i] = row[512 + h * 128 + 64 + cc];
  }
  *(uint4*)(sKtT + cc * LD + tg * 8) = pack8(kt8); *(uint4*)(sVT + cc * LD + tg * 8) = pack8(v8a); *(uint4*)(sVT + (64 + cc) * LD + tg * 8) = pack8(v8b);
  if (tg == 0) p.b.gl_gam[uid * 64 + cc] = __expf(tot);
  lds_barrier();
  for (int tile = tg; tile < 48; tile += 8) {
    if (tile < 16) {
      const int mt = tile >> 2, nt = tile & 3; f32x4 c4 = tile_nt(sRb, sKb, mt, nt, r, g);
#pragma unroll
      for (int reg = 0; reg < 4; ++reg) { int t = 16 * mt + 4 * g + reg, i = 16 * nt + r; p.b.gl_Pak[(long)uid * 4096 + t * 64 + i] = f2bf(i <= t ? c4[reg] : 0.f); }
    } else {
      const int q = tile - 16, mt = q >> 2, nt = q & 3; f32x4 c4 = tile_nt(sVT, sKtT, mt, nt, r, g);
#pragma unroll
      for (int reg = 0; reg < 4; ++reg) { int v = 16 * mt + 4 * g + reg, k = 16 * nt + r; p.b.gl_KVT[(long)uid * 8192 + v * 64 + k] = c4[reg]; }
    }
  }
  copy_out(sRb, p.b.gl_Rb + (long)uid * 4096, 64, tid); copy_out(sVT, p.b.gl_VT + (long)uid * 8192, 128, tid);
  lds_barrier();
}

__device__ __forceinline__ void p3_lru(const MixP& p, int c, int gq, char* smem) {
  u16* sx = (u16*)smem; float* sG = (float*)(smem + 9216); float* preA = sG + 8192; float* preB = preA + 512;
  int tid = threadIdx.x; asm volatile("" : "+v"(tid));
  const int cc = tid & 63, tg = tid >> 6, r = cc & 15, g = cc >> 4, ch = gq * 64 + cc, t0 = c * 64 + tg * 8;
  float xb[11];
  { u16 raw[11];
#pragma unroll
    for (int i = 0; i < 11; ++i) { const int t = t0 - 3 + i; raw[i] = p.proj[(long)(t >= 0 ? t : 0) * PC + OFF_C + ch]; }
      asm volatile("" ::: "memory");
#pragma unroll
    for (int i = 0; i < 11; ++i) xb[i] = bf2f(raw[i]) * (t0 - 3 + i >= 0 ? 1.f : 0.f); }
  const float cw0 = p.lru.conv_w[ch], cw1 = p.lru.conv_w[512 + ch], cw2 = p.lru.conv_w[1024 + ch], cw3 = p.lru.conv_w[1536 + ch], cb = p.lru.conv_b[ch];
  float xc[8];
#pragma unroll
  for (int i = 0; i < 8; ++i) { xc[i] = cb + cw0 * xb[i] + cw1 * xb[i + 1] + cw2 * xb[i + 2] + cw3 * xb[i + 3]; sx[(tg * 8 + i) * LD + cc] = f2bf(xc[i]); }
  lds_barrier();
  {
    const u16* wt = p.lru.wt + (long)gq * 4096;
#pragma unroll 1
    for (int q = tg; q < 32; q += 8) {
      const int m = q >> 4, tile = q & 15, mt = tile >> 2, nt = tile & 3;
      f32x4 c4 = {0.f, 0.f, 0.f, 0.f};
#pragma unroll
      for (int s_ = 0; s_ < 2; ++s_) {
        const bf16x8 af = *(const bf16x8*)(sx + (16 * mt + r) * LD + 32 * s_ + 8 * g);
        const bf16x8 bfr = *(const bf16x8*)(wt + (long)m * 8 * 4096 + (16 * nt + r) * 64 + 32 * s_ + 8 * g);
        c4 = __builtin_amdgcn_mfma_f32_16x16x32_bf16(af, bfr, c4, 0, 0, 0);
      }
#pragma unroll
      for (int reg = 0; reg < 4; ++reg) sG[(m * 64 + 16 * mt + 4 * g + reg) * 64 + 16 * nt + r] = c4[reg];
    }
  }
  lds_barrier();
  float ra[8], ix[8];
  { const float ba = p.lru.b_a[ch], bx = p.lru.b_x[ch];
#pragma unroll
    for (int i = 0; i < 8; ++i) { ra[i] = ba + sG[(tg * 8 + i) * 64 + cc]; ix[i] = bx + sG[(64 + tg * 8 + i) * 64 + cc]; } }
  const float lam = p.lru.lam[ch]; const float sp = fmaxf(-lam, 0.f) + log1pf(__expf(-fabsf(lam)));
  float hl[8], ac[8]; float A = 1.f, B = 0.f;
#pragma unroll
  for (int i = 0; i < 8; ++i) {
    const float rr = sigmoidf_(ra[i]), ig = sigmoidf_(ix[i]); const float log_a = -8.f * rr * sp;
    const bool reset = p.pos[t0 + i] == 0;
    const float av = reset ? 0.f : __expf(log_a); const float mult = reset ? 1.f : sqrtf(fmaxf(1.f - av * av, 0.f));
    const float bv = mult * ig * xc[i];
    B = av * B + bv; A *= av; hl[i] = B; ac[i] = A;
  }
  preA[tg * 64 + cc] = A; preB[tg * 64 + cc] = B;
  lds_barrier();
  float Ap = 1.f, Bp = 0.f;
#pragma unroll
  for (int q = 0; q < 7; ++q) if (q < tg) { float a = preA[q * 64 + cc], b = preB[q * 64 + cc]; Bp = a * Bp + b; Ap *= a; }
#pragma unroll
  for (int i = 0; i < 8; ++i) { long o = (long)(t0 + i) * 512 + ch; p.b.lr_h[o] = hl[i] + ac[i] * Bp; p.b.lr_A[o] = ac[i] * Ap; }
  lds_barrier();
}

template <int I, int N> struct SolveDot {
  static __device__ __forceinline__ void run(const LAS float* arow, const float (&X)[64], float (&acc)[4]) {
    if constexpr (I + 4 <= N) {
      const f32x4 a = *(const LAS f32x4*)(arow + I);
      acc[0] += a[0] * X[I]; acc[1] += a[1] * X[I + 1]; acc[2] += a[2] * X[I + 2]; acc[3] += a[3] * X[I + 3];
      SolveDot<I + 4, N>::run(arow, X, acc);
    } else if constexpr (I < N) { acc[I & 3] += arow[I] * X[I]; SolveDot<I + 1, N>::run(arow, X, acc); }
  }
};
template <int T> struct SolveRow {
  static __device__ __forceinline__ void run(const LAS float* sAab, const LAS float* sRhs, int tid, float (&X)[64]) {
    if constexpr (T < 64) {
      float acc[4] = {sRhs[T * 128 + tid], 0.f, 0.f, 0.f};
      SolveDot<0, T>::run(sAab + T * 64, X, acc);
      X[T] = (acc[0] + acc[1]) + (acc[2] + acc[3]);
      asm volatile("" ::: "memory");
      SolveRow<T + 1>::run(sAab, sRhs, tid, X);
    }
  }
};
__device__ __forceinline__ void p3_rwkv_solve(const MixP& p, int uid, int tid, const float* sRhs, const float* sAab) {
  float X[64];
  const int col = tid & 63; const bool isAl = tid < 64;
  const LAS float* lA = (const LAS float*)sAab; const LAS float* lR = (const LAS float*)sRhs;
  asm volatile("" : "+v"(lA), "+v"(lR));
  SolveRow<0>::run(lA, lR, tid, X);
  if (isAl) {
    int s, g_, j; inv_perm(col, s, g_, j);
#pragma unroll
    for (int t = 0; t < 64; ++t) p.b.rw_WpF[(long)uid * 4096 + (((t >> 4) * 2 + s) * 64 + g_ * 16 + (t & 15)) * 8 + j] = f2bf(X[t]);
  } else {
    const int vs = col >> 4, r_ = col & 15;
#pragma unroll
    for (int tt = 0; tt < 4; ++tt)
#pragma unroll
      for (int g_ = 0; g_ < 4; ++g_) {
        f32x4 o = {X[16 * tt + 4 * g_], X[16 * tt + 4 * g_ + 1], X[16 * tt + 4 * g_ + 2], X[16 * tt + 4 * g_ + 3]};
        *(f32x4*)(p.b.rw_U0F + (((long)uid * 4 + vs) * 4 + tt) * 256 + (g_ * 16 + r_) * 4) = o;
      }
  }
}
__device__ __forceinline__ void p3_rwkv(const MixP& p, int c, int h, char* smem) {
  u16* sRb = (u16*)smem; u16* sKb = sRb + 64 * LD; u16* sAl = sKb + 64 * LD; u16* sBe = sAl + 64 * LD; u16* sKtT = sBe + 64 * LD; u16* sVT = sKtT + 64 * LD;
  float* pre = (float*)(smem + 55296);
  char* R2 = smem + 57344;
  constexpr int LDA_ = 168;
  u16* sAct = (u16*)R2; float* sLo = (float*)(R2 + 21504);
  float* sAab = (float*)R2; u16* sAak = (u16*)(R2 + 16384); float* sRhs = (float*)(R2 + 16384 + 9216);
  int tid = threadIdx.x; asm volatile("" : "+v"(tid));
  const int cc = tid & 63, tg = tid >> 6, r = cc & 15, g = cc >> 4, uid = c * 8 + h, hc = h * 64 + cc, t0 = c * 64 + tg * 8;
  const u16* proj = p.proj;
  {
    u16 c16[20], p16[20]; float mu20[20];
#pragma unroll
    for (int q = 0; q < 20; ++q) {
      const int idx = tid + 512 * q, tl = idx / 160, j = idx - tl * 160, t = c * 64 + tl, col = 1536 + j;
      c16[q] = proj[(long)t * PC + col]; p16[q] = proj[(long)(t > 0 ? t - 1 : 0) * PC + col]; mu20[q] = p.rw.mu[col];
    }
      asm volatile("" ::: "memory");
#pragma unroll
    for (int q = 0; q < 20; ++q) {
      const int idx = tid + 512 * q, tl = idx / 160, j = idx - tl * 160;
      const float cur = bf2f(c16[q]), prev = bf2f(p16[q]) * ((c * 64 + tl) > 0 ? 1.f : 0.f);
      const float z = cur + (prev - cur) * mu20[q];
      const float sg_ = sigmoidf_(j < 32 ? 2.f * z : z);
      sAct[tl * LDA_ + j] = f2bf(j < 32 ? 2.f * sg_ - 1.f : (j < 64 ? z : sg_));
    }
  }
  float zr[8], zk[8], zv[8];
  {
    float pr[9], pk[9], pv[9];
#pragma unroll
    for (int i = 0; i < 9; ++i) { const int t = t0 - 1 + i; const bool ok = t >= 0; const u16* row = proj + (long)(ok ? t : 0) * PC; const u16 a_ = row[hc], b_ = row[512 + hc], c_ = row[1024 + hc];
      const float m_ = ok ? 1.f : 0.f; pr[i] = bf2f(a_) * m_; pk[i] = bf2f(b_) * m_; pv[i] = bf2f(c_) * m_; }
    const float mr = p.rw.mu[hc], mk = p.rw.mu[512 + hc], mv = p.rw.mu[1024 + hc];
#pragma unroll
    for (int i = 0; i < 8; ++i) { zr[i] = pr[i + 1] + (pr[i] - pr[i + 1]) * mr; zk[i] = pk[i + 1] + (pk[i] - pk[i + 1]) * mk; zv[i] = pv[i + 1] + (pv[i] - pv[i + 1]) * mv; }
  }
  lds_barrier();
  {
    const u16* wl = p.rw.lora_w + (long)(h * 64) * 160;
#pragma unroll 1
    for (int q = tg; q < 48; q += 8) {
      const int o = q >> 4, tile = q & 15, mt = tile >> 2, nt = tile & 3, s0 = o == 0 ? 0 : (o == 1 ? 1 : 2), ns = o == 2 ? 3 : 1;
      f32x4 c4 = {0.f, 0.f, 0.f, 0.f};
#pragma unroll 1
      for (int s_ = s0; s_ < s0 + ns; ++s_) {
        const bf16x8 af = *(const bf16x8*)(sAct + (16 * mt + r) * LDA_ + 32 * s_ + 8 * g);
        const bf16x8 bfr = *(const bf16x8*)(wl + (long)(16 * nt + r) * 160 + 32 * s_ + 8 * g);
        c4 = __builtin_amdgcn_mfma_f32_16x16x32_bf16(af, bfr, c4, 0, 0, 0);
      }
#pragma unroll
      for (int reg = 0; reg < 4; ++reg) sLo[(o * 64 + 16 * mt + 4 * g + reg) * 64 + 16 * nt + r] = c4[reg];
    }
  }
  lds_barrier();
  float wv[8], av[8], gv[8];
  { const float w0 = p.rw.w0[hc], a0 = p.rw.a0[hc];
#pragma unroll
    for (int i = 0; i < 8; ++i) { wv[i] = w0 + sLo[(tg * 8 + i) * 64 + cc]; av[i] = a0 + sLo[(64 + tg * 8 + i) * 64 + cc]; gv[i] = sLo[(128 + tg * 8 + i) * 64 + cc]; } }
  lds_barrier();
  const float kkw = p.rw.k_k[hc], kaw = p.rw.k_a[hc], rkw = p.rw.r_k[hc];
  float lw[8], aa[8], kk[8], kp[8], cum[8]; float run = 0.f;
#pragma unroll
  for (int i = 0; i < 8; ++i) {
    lw[i] = -0.6065306597126334f * sigmoidf_(wv[i]); aa[i] = sigmoidf_(av[i]);
    float k0 = zk[i] * kkw; const float ss = wave_sum(k0 * k0); kk[i] = k0 / fmaxf(sqrtf(ss), 1e-12f);
    kp[i] = zk[i] * (1.f + (aa[i] - 1.f) * kaw);
    const float bs = wave_sum(zr[i] * kp[i] * rkw);
    const long o = (long)(t0 + i) * 512 + hc;
    p.b.rw_G[o] = f2bf(gv[i]); p.b.rw_BV[o] = f2bf(bs * zv[i]);
    run += lw[i]; cum[i] = run;
  }
  pre[tg * 64 + cc] = run;
  lds_barrier();
  float off = 0.f, tot = 0.f;
#pragma unroll
  for (int q = 0; q < 8; ++q) { float v = pre[q * 64 + cc]; tot += v; if (q < tg) off += v; }
  {
    u16 kt8[8], v8[8];
    const int kt = cc >> 4, r_ = cc & 15;
#pragma unroll
    for (int i = 0; i < 8; ++i) {
      const int tl = tg * 8 + i; const float cm = cum[i] + off, cx = cm - lw[i];
      const float en = __expf(-cm), et = __expf(tot - cm);
      sAl[tl * LD + cc] = f2bf(-kk[i] * __expf(cx)); sBe[tl * LD + cc] = f2bf(kk[i] * aa[i] * en);
      sKb[tl * LD + cc] = f2bf(kp[i] * en); sRb[tl * LD + cc] = f2bf(zr[i] * __expf(cm));
      kt8[i] = f2bf(kp[i] * et); v8[i] = f2bf(zv[i]);
      int s, g_, j; inv_perm(tl, s, g_, j);
      p.b.rw_BtF[(long)uid * 4096 + ((kt * 2 + s) * 64 + g_ * 16 + r_) * 8 + j] = f2bf(kk[i] * aa[i] * et);
    }
    *(uint4*)(sKtT + cc * LD + tg * 8) = pack8(kt8); *(uint4*)(sVT + cc * LD + tg * 8) = pack8(v8);
    if (tg == 0) p.b.rw_gam[uid * 64 + cc] = __expf(tot);
  }
  lds_barrier();
  for (int q = tg; q < 80; q += 8) {
    const int kind = q >> 4, tt = q & 15, mt = tt >> 2, nt = tt & 3;
    if (kind == 0) { f32x4 c4 = tile_nt(sAl, sBe, mt, nt, r, g);
#pragma unroll
      for (int reg = 0; reg < 4; ++reg) { int t = 16 * mt + 4 * g + reg, i = 16 * nt + r; sAab[t * 64 + i] = i < t ? c4[reg] : 0.f; }
    } else if (kind == 1) { f32x4 c4 = tile_nt(sAl, sKb, mt, nt, r, g);
#pragma unroll
      for (int reg = 0; reg < 4; ++reg) { int t = 16 * mt + 4 * g + reg, i = 16 * nt + r; sAak[t * LD + i] = f2bf(i < t ? c4[reg] : 0.f); }
    } else if (kind == 2) { f32x4 c4 = tile_nt(sRb, sBe, mt, nt, r, g);
#pragma unroll
      for (int reg = 0; reg < 4; ++reg) { int t = 16 * mt + 4 * g + reg, i = 16 * nt + r; p.b.rw_Pab[(long)uid * 4096 + t * 64 + i] = f2bf(i <= t ? c4[reg] : 0.f); }
    } else if (kind == 3) { f32x4 c4 = tile_nt(sRb, sKb, mt, nt, r, g);
#pragma unroll
      for (int reg = 0; reg < 4; ++reg) { int t = 16 * mt + 4 * g + reg, i = 16 * nt + r; p.b.rw_Pak[(long)uid * 4096 + t * 64 + i] = f2bf(i <= t ? c4[reg] : 0.f); }
    } else { f32x4 c4 = tile_nt(sKtT, sVT, mt, nt, r, g);
      *(f32x4*)(p.b.rw_KVF + (((long)uid * 4 + nt) * 4 + mt) * 256 + cc * 4) = c4;
    }
  }
  lds_barrier();
  for (int q = tg; q < 16; q += 8) { const int mt = q >> 2, nt = q & 3; f32x4 c4 = tile_nt(sAak, sVT, mt, nt, r, g);
#pragma unroll
    for (int reg = 0; reg < 4; ++reg) { int t = 16 * mt + 4 * g + reg, v = 16 * nt + r; sRhs[t * 128 + 64 + v] = c4[reg]; } }
  for (int idx = tid; idx < 4096; idx += 512) { int t = idx >> 6, k = idx & 63; sRhs[t * 128 + k] = bf2f(sAl[t * LD + k]); }
  copy_out(sRb, p.b.rw_Rb + (long)uid * 4096, 64, tid); copy_out(sVT, p.b.rw_VT + (long)uid * 4096, 64, tid);
  lds_barrier();
  if (tid < 128) p3_rwkv_solve(p, uid, tid, sRhs, sAab);
  else {
    const int w6 = __builtin_amdgcn_readfirstlane(tid >> 6) - 2;
    moe_tile(p.ws, p.smem, p.layer, uid * 6 + w6, tid & 63);
  }
  lds_barrier();
}

constexpr int CH_SLOT = 24832;
constexpr int CH_LA = 3, CH_NS = 4;
__device__ __forceinline__ void chain_piece(const MixP& p, int uid, int vs, int pc, char* slot, int lane) {
  if (pc < 8) __builtin_amdgcn_global_load_lds((const unsigned*)(p.b.rw_WpF + (long)uid * 4096 + pc * 512 + lane * 8), (unsigned*)(slot + pc * 1024 + lane * 16), 16, 0, 0);
  else if (pc < 16) __builtin_amdgcn_global_load_lds((const unsigned*)(p.b.rw_BtF + (long)uid * 4096 + (pc - 8) * 512 + lane * 8), (unsigned*)(slot + 8192 + (pc - 8) * 1024 + lane * 16), 16, 0, 0);
  else if (pc < 20) __builtin_amdgcn_global_load_lds((const unsigned*)(p.b.rw_U0F + ((long)uid * 4 + vs) * 1024 + (pc - 16) * 256 + lane * 4), (unsigned*)(slot + 16384 + (pc - 16) * 1024 + lane * 16), 16, 0, 0);
  else if (pc < 24) __builtin_amdgcn_global_load_lds((const unsigned*)(p.b.rw_KVF + ((long)uid * 4 + vs) * 1024 + (pc - 20) * 256 + lane * 4), (unsigned*)(slot + 20480 + (pc - 20) * 1024 + lane * 16), 16, 0, 0);
  else __builtin_amdgcn_global_load_lds((const unsigned*)(p.b.rw_gam + uid * 64 + lane), (unsigned*)(slot + 24576 + lane * 4), 4, 0, 0);
}
__device__ __forceinline__ void chain_issue(const MixP& p, int uid, int vs, char* slot, int w, int lane) {
#pragma unroll
  for (int i = 0; i < 4; ++i) { const int pc = (w - 1) + 7 * i; if (pc < 25) chain_piece(p, uid, vs, pc, slot, lane); }
}
typedef __attribute__((ext_vector_type(4))) unsigned u32x4;
__device__ __forceinline__ bf16x8 frag_of(unsigned a, unsigned b, unsigned c, unsigned d) { u32x4 v = {a, b, c, d}; return __builtin_bit_cast(bf16x8, v); }
__device__ __forceinline__ void p4_rwkv_chain(const MixP& p, int h, int vs, char* ring, int w, int lane) {
  const int r = lane & 15, g = lane >> 4, v = vs * 16 + r;
  const bool loader = w > 0; const int npc = (w >= 1 && w <= 4) ? 4 : 3;
  f32x4 ST[4];
#pragma unroll
  for (int kt = 0; kt < 4; ++kt) ST[kt] = (f32x4){0.f, 0.f, 0.f, 0.f};
  if (loader) { for (int c = 0; c < CH_LA; ++c) chain_issue(p, c * 8 + h, vs, ring + c * CH_SLOT, w, lane); }
#pragma unroll 1
  for (int c = 0; c < NCH; ++c) {
    const int uid = c * 8 + h; char* slot = ring + (c % CH_NS) * CH_SLOT;
    if (loader) {
      const int younger = (NCH - 1 - c < CH_LA - 1 ? NCH - 1 - c : CH_LA - 1);
      if (younger == 2) { if (npc == 4) asm volatile("s_waitcnt vmcnt(8)" ::: "memory"); else asm volatile("s_waitcnt vmcnt(6)" ::: "memory"); }
      else if (younger == 1) { if (npc == 4) asm volatile("s_waitcnt vmcnt(4)" ::: "memory"); else asm volatile("s_waitcnt vmcnt(3)" ::: "memory"); }
      else asm volatile("s_waitcnt vmcnt(0)" ::: "memory");
    }
    __builtin_amdgcn_s_barrier();
    if (loader) { if (c + CH_LA < NCH) chain_issue(p, (c + CH_LA) * 8 + h, vs, ring + ((c + CH_LA) % CH_NS) * CH_SLOT, w, lane); }
    else {
      unsigned ps[4][2];
#pragma unroll
      for (int kt = 0; kt < 4; ++kt) { ps[kt][0] = pack_bf16(ST[kt][0], ST[kt][1]); ps[kt][1] = pack_bf16(ST[kt][2], ST[kt][3]); }
      bf16x8 bS[2];
#pragma unroll
      for (int s = 0; s < 2; ++s) bS[s] = frag_of(ps[2 * s][0], ps[2 * s][1], ps[2 * s + 1][0], ps[2 * s + 1][1]);
#pragma unroll
      for (int kt = 0; kt < 4; ++kt) { uint2 pk; pk.x = ps[kt][0]; pk.y = ps[kt][1]; *(uint2*)(p.b.rw_S0 + (long)uid * 4096 + v * 64 + 16 * kt + 4 * g) = pk; }
      f32x4 U[4];
#pragma unroll
      for (int tt = 0; tt < 4; ++tt) {
        U[tt] = *(const f32x4*)(slot + 16384 + tt * 1024 + lane * 16);
#pragma unroll
        for (int s = 0; s < 2; ++s) { bf16x8 a = *(const bf16x8*)(slot + (tt * 2 + s) * 1024 + lane * 16); U[tt] = __builtin_amdgcn_mfma_f32_16x16x32_bf16(a, bS[s], U[tt], 0, 0, 0); }
      }
      unsigned pu[4][2];
#pragma unroll
      for (int tt = 0; tt < 4; ++tt) { pu[tt][0] = pack_bf16(U[tt][0], U[tt][1]); pu[tt][1] = pack_bf16(U[tt][2], U[tt][3]); }
      bf16x8 bU[2];
#pragma unroll
      for (int s = 0; s < 2; ++s) bU[s] = frag_of(pu[2 * s][0], pu[2 * s][1], pu[2 * s + 1][0], pu[2 * s + 1][1]);
#pragma unroll
      for (int tt = 0; tt < 4; ++tt) { uint2 pk; pk.x = pu[tt][0]; pk.y = pu[tt][1]; *(uint2*)(p.b.rw_UT + (long)uid * 4096 + v * 64 + 16 * tt + 4 * g) = pk; }
#pragma unroll
      for (int kt = 0; kt < 4; ++kt) {
        const f32x4 gm = *(const f32x4*)(slot + 24576 + (16 * kt + 4 * g) * 4); const f32x4 kv = *(const f32x4*)(slot + 20480 + kt * 1024 + lane * 16);
        f32x4 a4 = ST[kt] * gm + kv;
#pragma unroll
        for (int s = 0; s < 2; ++s) { bf16x8 a = *(const bf16x8*)(slot + 8192 + (kt * 2 + s) * 1024 + lane * 16); a4 = __builtin_amdgcn_mfma_f32_16x16x32_bf16(a, bU[s], a4, 0, 0, 0); }
        ST[kt] = a4;
      }
      asm volatile("s_waitcnt lgkmcnt(0)" ::: "memory");
    }
  }
}
__device__ __forceinline__ void p4_elem(const MixP& p, int e) {
  if (e < 32768) {
    const int h = e >> 12, vk = e & 4095; const float lg2 = log2f(1.f - exp2f(-(5.f + 4.f * (float)h / 7.f))); const float gm = exp2f(lg2 * 64.f);
    float S = 0.f;
#pragma unroll 1
    for (int c0 = 0; c0 < NCH; c0 += 16) {
      float kv[16];
#pragma unroll
      for (int i = 0; i < 16; ++i) kv[i] = p.b.rt_KVT[(long)((c0 + i) * 8 + h) * 4096 + vk];
      PIN8O(kv, 0); PIN8O(kv, 8);
#pragma unroll
      for (int i = 0; i < 16; ++i) { p.b.rt_S0[(long)((c0 + i) * 8 + h) * 4096 + vk] = f2bf(S); S = S * gm + kv[i]; }
    }
  } else {
    const int e2 = e - 32768, h = e2 >> 13, vk = e2 & 8191, k = vk & 63;
    float S = 0.f;
#pragma unroll 1
    for (int c0 = 0; c0 < NCH; c0 += 8) {
      float kv[8], gm[8];
#pragma unroll
      for (int i = 0; i < 8; ++i) { kv[i] = p.b.gl_KVT[(long)((c0 + i) * 4 + h) * 8192 + vk]; gm[i] = p.b.gl_gam[((c0 + i) * 4 + h) * 64 + k]; }
      PIN8x2(kv, gm);
#pragma unroll
      for (int i = 0; i < 8; ++i) { p.b.gl_S0[(long)((c0 + i) * 4 + h) * 8192 + vk] = f2bf(S); S = S * gm[i] + kv[i]; }
    }
  }
}
__device__ __forceinline__ void p4_lru(const MixP& p, int ch) {
  float H = 0.f;
#pragma unroll 1
  for (int c0 = 0; c0 < NCH; c0 += 8) {
    float a[8], b[8];
#pragma unroll
    for (int i = 0; i < 8; ++i) { long o = (long)((c0 + i) * 64 + 63) * 512 + ch; a[i] = p.b.lr_A[o]; b[i] = p.b.lr_h[o]; }
    PIN8x2(a, b);
#pragma unroll
    for (int i = 0; i < 8; ++i) { p.b.lr_Hp[(c0 + i) * 512 + ch] = H; H = a[i] * H + b[i]; }
  }
}

template <int NVT, bool DELTA, int NMT>
__device__ __forceinline__ void p5_mm(const u16* Rb, const u16* S0, const u16* Pak, const u16* VT, const u16* Pab, const u16* UT, int mt0, int r, int g, f32x4 (&acc)[NMT][4 * NVT]) {
#pragma unroll
  for (int mt = 0; mt < NMT; ++mt)
#pragma unroll
    for (int nt = 0; nt < 4 * NVT; ++nt) acc[mt][nt] = (f32x4){0.f, 0.f, 0.f, 0.f};
#pragma unroll 1
  for (int pr = 0; pr < (DELTA ? 3 : 2); ++pr) {
    const u16* A = pr == 0 ? Rb : (pr == 1 ? Pak : Pab); const u16* B = pr == 0 ? S0 : (pr == 1 ? VT : UT);
    bf16x8 af[NMT][2], bfr[4 * NVT][2];
#pragma unroll
    for (int s = 0; s < 2; ++s) {
#pragma unroll
      for (int mt = 0; mt < NMT; ++mt) af[mt][s] = *(const bf16x8*)(A + (16 * (mt0 + mt) + r) * 64 + 32 * s + 8 * g);
#pragma unroll
      for (int nt = 0; nt < 4 * NVT; ++nt) bfr[nt][s] = *(const bf16x8*)(B + (16 * nt + r) * 64 + 32 * s + 8 * g);
    }
#pragma unroll
    for (int s = 0; s < 2; ++s)
#pragma unroll
      for (int nt = 0; nt < 4 * NVT; ++nt)
#pragma unroll
        for (int mt = 0; mt < NMT; ++mt) acc[mt][nt] = __builtin_amdgcn_mfma_f32_16x16x32_bf16(bfr[nt][s], af[mt][s], acc[mt][nt], 0, 0, 0);
  }
}
__device__ __forceinline__ float red4g(float v) { v += __shfl_xor(v, 16, 64); v += __shfl_xor(v, 32, 64); return v; }
__device__ __forceinline__ f32x4 bf4(uint2 u) { return (f32x4){__uint_as_float(u.x << 16), __uint_as_float(u.x & 0xffff0000u), __uint_as_float(u.y << 16), __uint_as_float(u.y & 0xffff0000u)}; }
__device__ __forceinline__ void p5_rwkv(const MixP& p, int c, int h, int lane) {
  const int r = lane & 15, g = lane >> 4; const long uo = (long)(c * 8 + h) * 4096;
  f32x4 lg[4], lb[4];
#pragma unroll
  for (int nt = 0; nt < 4; ++nt) { lg[nt] = *(const f32x4*)(p.rw.ln_g + h * 64 + 16 * nt + 4 * g); lb[nt] = *(const f32x4*)(p.rw.ln_b + h * 64 + 16 * nt + 4 * g); }
#pragma unroll 1
  for (int mh = 0; mh < 2; ++mh) {
    f32x4 acc[2][4];
    p5_mm<1, true, 2>(p.b.rw_Rb + uo, p.b.rw_S0 + uo, p.b.rw_Pak + uo, p.b.rw_VT + uo, p.b.rw_Pab + uo, p.b.rw_UT + uo, mh * 2, r, g, acc);
#pragma unroll
    for (int mt = 0; mt < 2; ++mt) {
      const int t = c * 64 + 16 * (mh * 2 + mt) + r; const long o = (long)t * 512 + h * 64 + 4 * g;
      uint2 bv[4], gg[4];
#pragma unroll
      for (int nt = 0; nt < 4; ++nt) { bv[nt] = *(const uint2*)(p.b.rw_BV + o + 16 * nt); gg[nt] = *(const uint2*)(p.b.rw_G + o + 16 * nt); }
      float s1 = 0.f;
#pragma unroll
      for (int nt = 0; nt < 4; ++nt) s1 += acc[mt][nt][0] + acc[mt][nt][1] + acc[mt][nt][2] + acc[mt][nt][3];
      const float mean = red4g(s1) * (1.f / 64.f);
      float s2 = 0.f;
#pragma unroll
      for (int nt = 0; nt < 4; ++nt)
#pragma unroll
        for (int j = 0; j < 4; ++j) { const float d = acc[mt][nt][j] - mean; s2 += d * d; }
      const float rs = rsqrtf(red4g(s2) * (1.f / 64.f) + 64e-5f);
#pragma unroll
      for (int nt = 0; nt < 4; ++nt) {
        const f32x4 yn = (acc[mt][nt] - mean) * rs * lg[nt] + lb[nt];
        *(uint2*)(p.ycat + (long)t * DM + h * 64 + 16 * nt + 4 * g) = pack4((yn + bf4(bv[nt])) * bf4(gg[nt]));
      }
    }
  }
}
__device__ __forceinline__ void p5_ret(const MixP& p, int c, int h, int lane) {
  const int r = lane & 15, g = lane >> 4; const long uo = (long)(c * 8 + h) * 4096;
  f32x4 ng[4];
#pragma unroll
  for (int nt = 0; nt < 4; ++nt) ng[nt] = *(const f32x4*)(p.ret_norm_g + h * 64 + 16 * nt + 4 * g);
#pragma unroll 1
  for (int mh = 0; mh < 2; ++mh) {
    f32x4 acc[2][4];
    p5_mm<1, false, 2>(p.b.rt_Rb + uo, p.b.rt_S0 + uo, p.b.rt_Pak + uo, p.b.rt_VT + uo, nullptr, nullptr, mh * 2, r, g, acc);
#pragma unroll
    for (int mt = 0; mt < 2; ++mt) {
      const int t = c * 64 + 16 * (mh * 2 + mt) + r;
      uint2 gt2[4];
#pragma unroll
      for (int nt = 0; nt < 4; ++nt) gt2[nt] = *(const uint2*)(p.proj + (long)t * PC + OFF_B + 1536 + h * 64 + 16 * nt + 4 * g);
      float s2 = 0.f;
#pragma unroll
      for (int nt = 0; nt < 4; ++nt)
#pragma unroll
        for (int j = 0; j < 4; ++j) s2 += acc[mt][nt][j] * acc[mt][nt][j];
      const float rs = rsqrtf(red4g(s2) * (1.f / 64.f) + 1e-6f);
#pragma unroll
      for (int nt = 0; nt < 4; ++nt) {
        const f32x4 gt = bf4(gt2[nt]); f32x4 o;
#pragma unroll
        for (int j = 0; j < 4; ++j) o[j] = acc[mt][nt][j] * rs * ng[nt][j] * gt[j] * sigmoidf_(gt[j]);
        *(uint2*)(p.ycat + (long)t * DM + 512 + h * 64 + 16 * nt + 4 * g) = pack4(o);
      }
    }
  }
}
__device__ __forceinline__ void p5_gla(const MixP& p, int c, int h, int lane) {
  const int r = lane & 15, g = lane >> 4; const int uid = c * 4 + h;
  f32x4 ng[8];
#pragma unroll
  for (int nt = 0; nt < 8; ++nt) ng[nt] = *(const f32x4*)(p.gla_norm_g + h * 128 + 16 * nt + 4 * g);
#pragma unroll 1
  for (int mq = 0; mq < 4; ++mq) {
    f32x4 acc[1][8];
    p5_mm<2, false, 1>(p.b.gl_Rb + (long)uid * 4096, p.b.gl_S0 + (long)uid * 8192, p.b.gl_Pak + (long)uid * 4096, p.b.gl_VT + (long)uid * 8192, nullptr, nullptr, mq, r, g, acc);
    const int t = c * 64 + 16 * mq + r;
    uint2 gt2[8];
#pragma unroll
    for (int nt = 0; nt < 8; ++nt) gt2[nt] = *(const uint2*)(p.proj + (long)t * PC + OFF_D + 1040 + h * 128 + 16 * nt + 4 * g);
    float s2 = 0.f;
#pragma unroll
    for (int nt = 0; nt < 8; ++nt)
#pragma unroll
      for (int j = 0; j < 4; ++j) s2 += acc[0][nt][j] * acc[0][nt][j];
    const float rs = rsqrtf(red4g(s2) * (1.f / 128.f) + 1e-6f);
#pragma unroll
    for (int nt = 0; nt < 8; ++nt) {
      const f32x4 gt = bf4(gt2[nt]); f32x4 o;
#pragma unroll
      for (int j = 0; j < 4; ++j) o[j] = acc[0][nt][j] * rs * ng[nt][j] * gt[j] * sigmoidf_(gt[j]);
      *(uint2*)(p.ycat + (long)t * DM + 1536 + h * 128 + 16 * nt + 4 * g) = pack4(o);
    }
  }
}
__device__ __forceinline__ void p5_lru8(const MixP& p, long idx0, long stride) {
  float hv[8], av[8], hp[8]; u16 gb[8];
#pragma unroll
  for (int q = 0; q < 8; ++q) { const long idx = idx0 + q * stride; const int t = (int)(idx >> 9), ch = (int)(idx & 511), c = t >> 6;
    hv[q] = p.b.lr_h[idx]; av[q] = p.b.lr_A[idx]; hp[q] = p.b.lr_Hp[c * 512 + ch]; gb[q] = p.proj[(long)t * PC + OFF_C + 512 + ch]; }
      asm volatile("" ::: "memory");
#pragma unroll
  for (int q = 0; q < 8; ++q) { const long idx = idx0 + q * stride; const int t = (int)(idx >> 9), ch = (int)(idx & 511);
    p.ycat[(long)t * DM + 1024 + ch] = f2bf((hv[q] + av[q] * hp[q]) * gelu_tanh(bf2f(gb[q]))); }
}
__device__ __forceinline__ void phase_mix3(const MixP& p, char* smem) {
  for (int u = blockIdx.x; u < 3584; u += gridDim.x) {
    if (u < 1024) p3_rwkv(p, u >> 3, u & 7, smem);
    else if (u < 2048) p3_ret(p, (u - 1024) >> 3, (u - 1024) & 7, smem);
    else if (u < 2560) p3_gla(p, (u - 2048) >> 2, (u - 2048) & 3, smem);
    else p3_lru(p, (u - 2560) >> 3, (u - 2560) & 7, smem);
  }
}
__device__ __forceinline__ void phase_mix4(const MixP& p, char* smem) {
  int tid = threadIdx.x; asm volatile("" : "+v"(tid));
#pragma unroll 1
  for (int b = blockIdx.x; b < 256; b += gridDim.x) {
    if (b < 32) p4_rwkv_chain(p, b >> 2, b & 3, smem, __builtin_amdgcn_readfirstlane(tid >> 6), tid & 63);
    else if (b >= 64 && b < 192) p4_elem(p, (b - 64) * 512 + tid);
    else if (b == 200) p4_lru(p, tid);
    __syncthreads();
  }
}
__device__ __forceinline__ void phase_mix5(const MixP& p) {
  int tid = threadIdx.x; asm volatile("" : "+v"(tid));
  const int wave = blockIdx.x * 8 + (tid >> 6), nw = gridDim.x * 8, lane = tid & 63;
  for (int u = wave; u < 2560; u += nw) {
    if (u < 512) p5_gla(p, u >> 2, u & 3, lane);
    else if (u < 1536) p5_rwkv(p, (u - 512) >> 3, (u - 512) & 7, lane);
    else p5_ret(p, (u - 1536) >> 3, (u - 1536) & 7, lane);
  }
  { const long nthr = (long)gridDim.x * 512;
    long idx = (long)blockIdx.x * 512 + tid;
    for (; idx + 7 * nthr < (long)T_ * 512; idx += 8 * nthr) p5_lru8(p, idx, nthr);
    for (; idx < (long)T_ * 512; idx += nthr) {
      const int t = (int)(idx >> 9), ch = (int)(idx & 511), c = t >> 6;
      p.ycat[(long)t * DM + 1024 + ch] = f2bf((p.b.lr_h[idx] + p.b.lr_A[idx] * p.b.lr_Hp[c * 512 + ch]) * gelu_tanh(bf2f(p.proj[(long)t * PC + OFF_C + 512 + ch]))); } }
}

#define XB_TMO      128
#define XB_XCNT(j)  (256  + 64 * (j))
#define XB_XSUB(j)  (1280 + 64 * (j))
#define XB_XGEN(j)  (2304 + 64 * (j))
#define XB_TOP      3328
#define XB_TOPGEN   3392
#define XCD_BAR_WORDS 3456
#define XB_SPIN_CAP (1u << 18)
__device__ __forceinline__ unsigned xb_ld(unsigned* p)              { return __hip_atomic_load(p, __ATOMIC_RELAXED, __HIP_MEMORY_SCOPE_AGENT); }
__device__ __forceinline__ unsigned xb_add(unsigned* p, unsigned v) { return __hip_atomic_fetch_add(p, v, __ATOMIC_RELAXED, __HIP_MEMORY_SCOPE_AGENT); }
__device__ __forceinline__ unsigned xb_xcc_id() { return (unsigned)__builtin_amdgcn_s_getreg((3 << 11) | 20) & 0xFu; }
#define XB_SPIN(cond, bar) do { unsigned _sp = 0; while (cond) { __builtin_amdgcn_s_sleep(1); \
    if ((++_sp & 255u) == 0u) { if (xb_ld(&(bar)[XB_TMO])) break; if (_sp > XB_SPIN_CAP) { atomicAdd(&(bar)[XB_TMO], 1u); break; } } } } while (0)
struct XcdBarrier { unsigned* bar; unsigned x; volatile LAS unsigned* st; };
__device__ __forceinline__ XcdBarrier xcd_barrier_post(unsigned* bar, volatile LAS unsigned* st) {
    XcdBarrier b; b.bar = bar; b.x = xb_xcc_id(); b.st = st;
    if (threadIdx.x == 0) (void)xb_add(&bar[XB_XCNT(b.x)], 1u);
    return b;
}
__device__ __forceinline__ void xcd_barrier_complete(unsigned* bar, unsigned x, unsigned& nloc, unsigned& nx) {
    const unsigned G = gridDim.x * gridDim.y * gridDim.z;
    unsigned sum, cnt, mine, sp = 0u;
    for (;;) {
        sum = 0u; cnt = 0u; mine = 0u;
#pragma unroll
        for (unsigned j = 0; j < 16; ++j) { const unsigned c = xb_ld(&bar[XB_XCNT(j)]); sum += c; cnt += (c > 0u) ? 1u : 0u; mine = (j == x) ? c : mine; }
        if (sum == G) break;
        __builtin_amdgcn_s_sleep(1);
        if ((++sp & 255u) == 0u) { if (xb_ld(&bar[XB_TMO])) break; if (sp > XB_SPIN_CAP) { atomicAdd(&bar[XB_TMO], 1u); break; } }
    }
    nloc = mine > 0u ? mine : 1u; nx = cnt > 0u ? cnt : 1u;
}
__device__ __forceinline__ void xcd_barrier(const XcdBarrier& b) {
    asm volatile("s_waitcnt vmcnt(0)" ::: "memory");
    __syncthreads();
    if (threadIdx.x == 0) {
        unsigned* bar = b.bar;
        __builtin_amdgcn_s_waitcnt(0);
        unsigned nloc = b.st[0], nx = b.st[1];
        if (nloc == 0u) { xcd_barrier_complete(bar, b.x, nloc, nx); b.st[0] = nloc; b.st[1] = nx; }
        const unsigned old = xb_add(&bar[XB_XSUB(b.x)], 1u);
        const unsigned gen = old / nloc;
        if (old + 1u == (gen + 1u) * nloc) {
            __builtin_amdgcn_fence(__ATOMIC_RELEASE, "agent");
            asm volatile("s_waitcnt vmcnt(0)" ::: "memory");
            const unsigned og = xb_add(&bar[XB_TOP], 1u);
            const unsigned tg = og / nx;
            if (og + 1u == (tg + 1u) * nx) xb_add(&bar[XB_TOPGEN], 1u);
            else XB_SPIN(xb_ld(&bar[XB_TOPGEN]) == tg, bar);
            __builtin_amdgcn_fence(__ATOMIC_ACQUIRE, "agent");
            xb_add(&bar[XB_XGEN(b.x)], 1u);
            asm volatile("s_waitcnt vmcnt(0)" ::: "memory");
        } else {
            XB_SPIN(xb_ld(&bar[XB_XGEN(b.x)]) == gen, bar);
            __builtin_amdgcn_fence(__ATOMIC_ACQUIRE, "agent");
            asm volatile("s_waitcnt vmcnt(0)" ::: "memory");
        }
    }
    __syncthreads();
}

__device__ __forceinline__ void xcd_barrier_l(const XcdBarrier& b) {
    asm volatile("s_waitcnt vmcnt(0)" ::: "memory");
    __syncthreads();
    if (threadIdx.x == 0) {
        unsigned* bar = b.bar; unsigned x = b.x;
        { unsigned long long _z = 0; asm volatile("" : "+s"(_z), "+s"(x)); bar = (unsigned*)(unsigned __attribute__((address_space(1)))*)((unsigned long long)bar + _z); }
        __builtin_amdgcn_s_waitcnt(0);
        const unsigned nloc = b.st[0], nx = b.st[1];
        const unsigned old = xb_add(&bar[XB_XSUB(x)], 1u);
        const unsigned gen = old / nloc;
        if (old + 1u == (gen + 1u) * nloc) {
            __builtin_amdgcn_fence(__ATOMIC_RELEASE, "agent");
            asm volatile("s_waitcnt vmcnt(0)" ::: "memory");
            const unsigned og = xb_add(&bar[XB_TOP], 1u);
            const unsigned tg = og / nx;
            if (og + 1u == (tg + 1u) * nx) xb_add(&bar[XB_TOPGEN], 1u);
            else XB_SPIN(xb_ld(&bar[XB_TOPGEN]) == tg, bar);
            __builtin_amdgcn_fence(__ATOMIC_ACQUIRE, "agent");
            xb_add(&bar[XB_XGEN(x)], 1u);
            asm volatile("s_waitcnt vmcnt(0)" ::: "memory");
        } else {
            XB_SPIN(xb_ld(&bar[XB_XGEN(x)]) == gen, bar);
            __builtin_amdgcn_fence(__ATOMIC_ACQUIRE, "agent");
            asm volatile("s_waitcnt vmcnt(0)" ::: "memory");
        }
    }
    __syncthreads();
}

__device__ __forceinline__ void phase_convert(char* ws, char* smem) {
  OPAQUE_WS(ws); int tid = threadIdx.x; asm volatile("" : "+v"(tid));
  const int lane = tid & 63, G = gridDim.x * 8, b0 = blockIdx.x * 8 + __builtin_amdgcn_readfirstlane(tid >> 6);
#pragma unroll 1
  for (int j = b0; j < 2 * (32768 - CV_SOLVE); j += G) { const int l = j / (32768 - CV_SOLVE), t = CV_SOLVE + j % (32768 - CV_SOLVE); moe_tile(ws, smem, l, t, lane); }
  { float* rot = wsp<float>(ws, WS::ROT); const int* pos = (const int*)in_ptr(smem, 1);
#pragma unroll 1
    for (int i = blockIdx.x * 512 + tid; i < T_ * 32; i += gridDim.x * 512) {
      const int t = i >> 5, j = i & 31; const float inv = exp2f(-(float)j * (13.287712379549449f / 32.f));
      float sn, cs; sincosf((float)pos[t] * inv, &sn, &cs); rot[2 * i] = cs; rot[2 * i + 1] = sn;
    } }
  { u16* wt = wsp<u16>(ws, WS::LRU_W);
#pragma unroll 1
    for (int i = blockIdx.x * 512 + tid; i < NL * 2 * 8 * 4096; i += gridDim.x * 512) {
      const int l = i / (2 * 8 * 4096), r = i % (2 * 8 * 4096), m = r / (8 * 4096), g = (r / 4096) & 7, jj = (r >> 6) & 63, ii = r & 63;
      wt[i] = f2bf(in_ptr(smem, m ? 22 : 20)[(((long)l * 8 + g) * 64 + ii) * 64 + jj]);
    } }
  { u16* wl = wsp<u16>(ws, WS::LORA_W);
#pragma unroll 1
    for (int i = blockIdx.x * 512 + tid; i < NL * 512 * 160; i += gridDim.x * 512) {
      const int l = i / (512 * 160), r = i % (512 * 160), c = r / 160, j = r % 160;
      const float v = j < 32 ? in_ptr(smem, 6)[((long)l * 32 + j) * 512 + c] : (j < 64 ? in_ptr(smem, 8)[((long)l * 32 + (j - 32)) * 512 + c] : in_ptr(smem, 9)[((long)l * 96 + (j - 64)) * 512 + c]);
      wl[i] = f2bf(v);
    } }
  { u16* thi = wsp<u16>(ws, WS::RT_HI); u16* tlo = wsp<u16>(ws, WS::RT_LO);
#pragma unroll 1
    for (int i = blockIdx.x * 512 + tid; i < NL * 48 * 2048; i += gridDim.x * 512) {
      const int l = i / (48 * 2048), r = i % (48 * 2048), c = r >> 11, k = r & 2047;
      float v = 0.f;
      if (c < 36) { const float g = in_ptr(smem, 31)[(long)l * DM + k]; v = g * (c < 4 ? in_ptr(smem, 32)[((long)l * DM + k) * 4 + c] : in_ptr(smem, 34)[((long)l * DM + k) * 32 + (c - 4)]); }
      const u16 hi = f2bf(v); thi[i] = hi; tlo[i] = f2bf(v - bf2f(hi));
    } }
#pragma unroll 1
  for (int j = b0; j < 2 * 100 * 32; j += G) { const int l = j / 3200, q = j % 3200, nt = q / 32, kt = q % 32;
    transpose_tile_w(in_ptr(smem, 3) + (long)l * DM * IN_COLS, IN_COLS, NONGATE, wsp<u16>(ws, WS::WT_IN) + (long)l * PC * DM, DM, nt * 64, kt * 64, 0, 0, lane); }
#pragma unroll 1
  for (int j = b0; j < 2 * 128 * 32; j += G) { const int l = j / 4096, q = j % 4096, nt = q / 32, kt = q % 32;
    transpose_tile_w(in_ptr(smem, 3) + (long)l * DM * IN_COLS + NONGATE, IN_COLS, 8192, wsp<u16>(ws, WS::WT_IN) + (long)l * PC * DM, DM, nt * 64, kt * 64, OFF_G, 0, lane); }
#pragma unroll 1
  for (int j = b0; j < 8 * 256; j += G) { const int lk = j / 256, q = j % 256, l = lk >> 2, kb = lk & 3, nt = q / 8, kt = q % 8;
    const float* src = in_ptr(smem, kb == 0 ? 15 : kb == 1 ? 17 : kb == 2 ? 25 : 29) + (long)l * MIXW * DM;
    transpose_tile_w(src, DM, DM, wsp<u16>(ws, WS::WT_O) + (long)l * DM * DM + kb * MIXW, DM, nt * 64, kt * 64, 0, 0, lane); }
#pragma unroll 1
  for (int j = b0; j < 2 * 1024; j += G) { const int l = j / 1024, q = j % 1024, nt = q / 32, kt = q % 32;
    transpose_tile_w(in_ptr(smem, 30) + (long)l * DM * DM, DM, DM, wsp<u16>(ws, WS::WT_OUT) + (long)l * DM * DM, DM, nt * 64, kt * 64, 0, 0, lane); }
}

__device__ __forceinline__ void convert_down(char* ws, const char* smem, int l, int wave, int nwaves, int lane) {
  const float* src = in_ptr(smem, 38) + (long)l * NEXP * DEXP * DM; u16* dst = wsp<u16>(ws, WS::WDN) + (long)l * NEXP * DM * DEXP;
#pragma unroll 1
  for (int j = wave; j < 32 * 512; j += nwaves) { const int e = j / 512, q = j % 512, nt = q / 16, kt = q % 16;
    transpose_tile_w(src + (long)e * DEXP * DM, DM, DM, dst + (long)e * DM * DEXP, DEXP, nt * 64, kt * 64, 0, 0, lane); }
}
struct NormArgs {
  const float* x; float* h; const float* g; u16* xn; float* out; const float* ybuf;
  const float* wg; const float* bg; const float* we; const float* be; int* tok_e; float* tok_g;
};
template <int MODE>
__device__ __forceinline__ void norm_row(const NormArgs& a, int row, int lane) {
  float v[32];
  const float* src = (MODE == 0) ? a.x : a.h;
#pragma unroll
  for (int i = 0; i < 8; ++i) {
    f32x4 t = *(const f32x4*)(src + (long)row * DM + i * 256 + lane * 4);
    if (MODE == 1 || MODE == 2) {
      f32x4 y0 = *(const f32x4*)(a.ybuf + (long)(2 * row) * DM + i * 256 + lane * 4);
      f32x4 y1 = *(const f32x4*)(a.ybuf + (long)(2 * row + 1) * DM + i * 256 + lane * 4);
      t = t + y0 + y1;
    }
    if (MODE != 3 && MODE != 2) *(f32x4*)(a.h + (long)row * DM + i * 256 + lane * 4) = t;
    v[i * 4 + 0] = t[0]; v[i * 4 + 1] = t[1]; v[i * 4 + 2] = t[2]; v[i * 4 + 3] = t[3];
  }
  float ss = 0.f;
#pragma unroll
  for (int i = 0; i < 32; ++i) ss += v[i] * v[i];
  ss = wave_sum(ss);
  const float rs = rsqrtf(ss * (1.f / DM) + 1e-6f);
#pragma unroll
  for (int i = 0; i < 8; ++i) {
    f32x4 g = *(const f32x4*)(a.g + i * 256 + lane * 4);
#pragma unroll
    for (int j = 0; j < 4; ++j) v[i * 4 + j] = v[i * 4 + j] * rs * g[j];
    if (MODE == 2) {
      f32x4 o = {v[i * 4], v[i * 4 + 1], v[i * 4 + 2], v[i * 4 + 3]};
      *(f32x4*)(a.out + (long)row * DM + i * 256 + lane * 4) = o;
    } else {
      uint2 pk;
      pk.x = (unsigned)f2bf(v[i * 4]) | ((unsigned)f2bf(v[i * 4 + 1]) << 16);
      pk.y = (unsigned)f2bf(v[i * 4 + 2]) | ((unsigned)f2bf(v[i * 4 + 3]) << 16);
      *(uint2*)(a.xn + (long)row * DM + i * 256 + lane * 4) = pk;
    }
  }
}
template <int MODE>
__device__ __forceinline__ void phase_norm(const NormArgs& a) {
  int tid = threadIdx.x; asm volatile("" : "+v"(tid));
  const int lane = tid & 63;
  for (int row = blockIdx.x * 8 + (tid >> 6); row < T_; row += gridDim.x * 8) norm_row<MODE>(a, row, lane);
}

__device__ __forceinline__ void router_job(const NormArgs& a, const u16* __restrict__ thi, const u16* __restrict__ tlo, int job, char* smem, int tid, int* cnt, int* lst_slot, float* lst_gate) {
  const int w = __builtin_amdgcn_readfirstlane(tid >> 6), lane = tid & 63, r = lane & 15, g = lane >> 4, t0 = job * 64;
  float* part = (float*)smem;
  float* pss = part + 8 * 64 * 48;
  {
    f32x4 acc[4][3];
#pragma unroll
    for (int mt = 0; mt < 4; ++mt)
#pragma unroll
      for (int nt = 0; nt < 3; ++nt) acc[mt][nt] = (f32x4){0.f, 0.f, 0.f, 0.f};
    float ssq[4] = {0.f, 0.f, 0.f, 0.f};
    const float* hb = a.h + (long)(t0 + r) * DM + w * 256 + 8 * g;
    const u16* bh = thi + (long)r * 2048 + w * 256 + 8 * g; const u16* bl = tlo + (long)r * 2048 + w * 256 + 8 * g;
#pragma unroll 2
    for (int s_ = 0; s_ < 8; ++s_) {
      f32x4 x0[4], x1[4]; bf16x8 wh[3], wl[3];
#pragma unroll
      for (int mt = 0; mt < 4; ++mt) { x0[mt] = *(const f32x4*)(hb + (long)(16 * mt) * DM + 32 * s_); x1[mt] = *(const f32x4*)(hb + (long)(16 * mt) * DM + 32 * s_ + 4); }
#pragma unroll
      for (int nt = 0; nt < 3; ++nt) { wh[nt] = *(const bf16x8*)(bh + (long)(16 * nt) * 2048 + 32 * s_); wl[nt] = *(const bf16x8*)(bl + (long)(16 * nt) * 2048 + 32 * s_); }
#pragma unroll
      for (int mt = 0; mt < 4; ++mt) {
        const f32x4 a0 = x0[mt], a1 = x1[mt];
        ssq[mt] += a0[0] * a0[0] + a0[1] * a0[1] + a0[2] * a0[2] + a0[3] * a0[3] + a1[0] * a1[0] + a1[1] * a1[1] + a1[2] * a1[2] + a1[3] * a1[3];
        const unsigned h0 = pack_bf16(a0[0], a0[1]), h1 = pack_bf16(a0[2], a0[3]), h2 = pack_bf16(a1[0], a1[1]), h3 = pack_bf16(a1[2], a1[3]);
        const unsigned l0 = pack_bf16(a0[0] - __uint_as_float(h0 << 16), a0[1] - __uint_as_float(h0 & 0xffff0000u)), l1 = pack_bf16(a0[2] - __uint_as_float(h1 << 16), a0[3] - __uint_as_float(h1 & 0xffff0000u));
        const unsigned l2 = pack_bf16(a1[0] - __uint_as_float(h2 << 16), a1[1] - __uint_as_float(h2 & 0xffff0000u)), l3 = pack_bf16(a1[2] - __uint_as_float(h3 << 16), a1[3] - __uint_as_float(h3 & 0xffff0000u));
        const bf16x8 xh = frag_of(h0, h1, h2, h3), xl = frag_of(l0, l1, l2, l3);
#pragma unroll
        for (int nt = 0; nt < 3; ++nt) {
          acc[mt][nt] = __builtin_amdgcn_mfma_f32_16x16x32_bf16(xh, wh[nt], acc[mt][nt], 0, 0, 0);
          acc[mt][nt] = __builtin_amdgcn_mfma_f32_16x16x32_bf16(xh, wl[nt], acc[mt][nt], 0, 0, 0);
          acc[mt][nt] = __builtin_amdgcn_mfma_f32_16x16x32_bf16(xl, wh[nt], acc[mt][nt], 0, 0, 0);
        }
      }
    }
#pragma unroll
    for (int mt = 0; mt < 4; ++mt)
#pragma unroll
      for (int nt = 0; nt < 3; ++nt)
#pragma unroll
        for (int reg = 0; reg < 4; ++reg) part[(w * 64 + 16 * mt + 4 * g + reg) * 48 + 16 * nt + r] = acc[mt][nt][reg];
#pragma unroll
    for (int mt = 0; mt < 4; ++mt) { float v = ssq[mt]; v += __shfl_xor(v, 16, 64); v += __shfl_xor(v, 32, 64); if (g == 0) pss[w * 64 + 16 * mt + r] = v; }
  }
  lds_barrier();
  if (tid < 64) {
    const int tl = tid, t = t0 + tl;
    float lgt[36]; float ss = 0.f;
#pragma unroll
    for (int c = 0; c < 36; ++c) lgt[c] = 0.f;
#pragma unroll 1
    for (int q = 0; q < 8; ++q) {
#pragma unroll
      for (int c = 0; c < 36; ++c) lgt[c] += part[(q * 64 + tl) * 48 + c];
      ss += pss[q * 64 + tl];
    }
    const float rs = rsqrtf(ss * (1.f / DM) + 1e-6f);
    f32x4 bgv = *(const f32x4*)a.bg, bev[8];
#pragma unroll
    for (int q = 0; q < 8; ++q) bev[q] = *(const f32x4*)(a.be + 4 * q);
    asm volatile("" :: "v"(bgv), "v"(bev[0]), "v"(bev[1]), "v"(bev[2]), "v"(bev[3]), "v"(bev[4]), "v"(bev[5]), "v"(bev[6]), "v"(bev[7]));
    float lg[4];
#pragma unroll
    for (int c = 0; c < 4; ++c) lg[c] = lgt[c] * rs + bgv[c];
    int gi = 0; float gm = lg[0];
#pragma unroll
    for (int c = 1; c < 4; ++c) if (lg[c] > gm) { gm = lg[c]; gi = c; }
    float gs = 0.f;
#pragma unroll
    for (int c = 0; c < 4; ++c) gs += __expf(lg[c] - gm);
    const float pg = 1.f / gs;
    float le[8];
#pragma unroll
    for (int j = 0; j < 8; ++j) {
      const float l0 = lgt[4 + j] * rs + bev[j >> 2][j & 3], l1 = lgt[12 + j] * rs + bev[2 + (j >> 2)][j & 3], l2 = lgt[20 + j] * rs + bev[4 + (j >> 2)][j & 3], l3 = lgt[28 + j] * rs + bev[6 + (j >> 2)][j & 3];
      le[j] = gi == 0 ? l0 : (gi == 1 ? l1 : (gi == 2 ? l2 : l3));
    }
    int i1 = 0; float m1 = le[0];
#pragma unroll
    for (int j = 1; j < 8; ++j) if (le[j] > m1) { m1 = le[j]; i1 = j; }
    int i2 = -1; float m2 = -3.0e38f;
#pragma unroll
    for (int j = 0; j < 8; ++j) if (j != i1 && le[j] > m2) { m2 = le[j]; i2 = j; }
    const float w1 = 1.f / (1.f + __expf(m2 - m1)), w2 = 1.f - w1;
    if (i2 < 0) i2 = (i1 + 1) & 7;
    const int e0 = gi * 8 + i1, e1 = gi * 8 + i2;
    const int p0 = atomicAdd(cnt + e0, 1) & (LCAP - 1), p1 = atomicAdd(cnt + e1, 1) & (LCAP - 1);
    lst_slot[e0 * LCAP + p0] = 2 * t; lst_gate[e0 * LCAP + p0] = pg * w1;
    lst_slot[e1 * LCAP + p1] = 2 * t + 1; lst_gate[e1 * LCAP + p1] = pg * w2;
  }
  lds_barrier();
}
__device__ __forceinline__ void phase_n3(char* ws, const NormArgs& a, char* smem, int l) {
  OPAQUE_WS(ws);
  int tid = threadIdx.x; asm volatile("" : "+v"(tid));
  int* cnt = wsp<int>(ws, WS::TILE_EXP); int* lst_slot = wsp<int>(ws, WS::LST_SLOT); float* lst_gate = wsp<float>(ws, WS::LST_GATE);
#pragma unroll 1
  for (int job = blockIdx.x; job < 256; job += gridDim.x) {
    if (job < 128) router_job(a, wsp<u16>(ws, WS::RT_HI) + (long)l * 48 * 2048, wsp<u16>(ws, WS::RT_LO) + (long)l * 48 * 2048, job, smem, tid, cnt, lst_slot, lst_gate);
    else { const int r0 = (job - 128) * 64 + (tid >> 6) * 8;
#pragma unroll 1
      for (int i = 0; i < 8; ++i) norm_row<3>(a, r0 + i, tid & 63); }
  }
}
__device__ __forceinline__ void moe_tiles(char* ws, int* tstart, int tid) {
  const int* cnt = wsp<int>(ws, WS::TILE_EXP);
  if (tid < 32) {
    int acc = 0;
#pragma unroll 1
    for (int e2 = 0; e2 < tid; ++e2) acc += (ld_i(cnt + e2) + 255) >> 8;
    const int c = ld_i(cnt + tid);
    tstart[tid] = acc; tstart[40 + tid] = c;
    if (tid == 31) tstart[32] = acc + ((c + 255) >> 8);
  }
  __syncthreads();
}

template <int MODE>
__device__ __forceinline__ void phase_gemm(char* ws, int l, u16* shm) {
  OPAQUE_WS(ws);
  if (MODE == 0) {
    const u16* Bt = wsp<u16>(ws, WS::WT_IN) + (long)l * PC * DM; const u16* xn = wsp<u16>(ws, WS::XN); u16* proj = wsp<u16>(ws, WS::PROJ);
#pragma unroll 1
    for (int u = blockIdx.x; u < ((PC / 256 + 7) / 8) * 256; u += gridDim.x) {
      int pm, pn; unit_map(u & 255, u >> 8, pm, pn);
      if (pn >= PC / 256) continue;
      EpiProj e{proj, pm * 256, pn * 256};
      gemm256(xn + (long)pm * 256 * DM, DM, Bt + (long)pn * 256 * DM, DM, DM, shm, e);
    }
  } else if (MODE == 1) {
    const u16* Bt = wsp<u16>(ws, WS::WT_O) + (long)l * DM * DM; const u16* ycat = wsp<u16>(ws, WS::YCAT);
    const u16* gates = wsp<u16>(ws, WS::PROJ) + OFF_G; u16* merged = wsp<u16>(ws, WS::MERGED);
#pragma unroll 1
    for (int u = blockIdx.x; u < 512; u += gridDim.x) {
      int pm, pn2; unit_map(u & 255, 0, pm, pn2);
      const int pn = pn2 * 2 + (u >> 8);
      gemm_merge(ycat, Bt, gates, merged, pm * 256, pn * 128, shm);
    }
  } else if (MODE == 2) {
    const u16* Bt = wsp<u16>(ws, WS::WT_OUT) + (long)l * DM * DM; const u16* merged = wsp<u16>(ws, WS::MERGED);
#pragma unroll 1
    for (int u = blockIdx.x; u < 256; u += gridDim.x) {
      int pm, pn; unit_map(u, 0, pm, pn);
      EpiResid e{wsp<float>(ws, WS::H), pm * 256, pn * 256};
      gemm256(merged + (long)pm * 256 * DM, DM, Bt + (long)pn * 256 * DM, DM, DM, shm, e);
    }
  } else if (MODE == 3) {
    int tid = threadIdx.x; asm volatile("" : "+v"(tid));
    int* tstart = (int*)((char*)shm + SHM_B); moe_tiles(ws, tstart, tid);
    const int nu = tstart[32] * 8; const u16* Bt = wsp<u16>(ws, WS::WGU) + (long)l * NEXP * 2048 * DM; const u16* xn = wsp<u16>(ws, WS::XN);
    const int* lst_slot = wsp<int>(ws, WS::LST_SLOT);
#pragma unroll 1
    for (int u = blockIdx.x; u < nu; u += gridDim.x) {
      const int rt = u >> 3, ct = u & 7; int ex = 0;
#pragma unroll 1
      while (rt >= tstart[ex + 1]) ++ex;
      const int rtl = rt - tstart[ex], nvalid = tstart[40 + ex] - rtl * 256;
      int arow[4];
#pragma unroll
      for (int i = 0; i < 2; ++i) { int r_, c_; stage_rc(tid * 16 + i * 8192, r_, c_);
#pragma unroll
        for (int hf = 0; hf < 2; ++hf) { const int r = hf * HALF + r_; arow[hf * 2 + i] = (r < nvalid ? (lst_slot[ex * LCAP + rtl * 256 + r] >> 1) : 0) * (DM * 2) + c_ * 2; } }
      EpiGateUp e{wsp<u16>(ws, WS::HMID), rt * 256, ct};
      gemm256g<true>(xn, DM, Bt + ((long)ex * 2048 + ct * 256) * DM, DM, DM, shm, e, arow);
    }
  } else {
    int tid = threadIdx.x; asm volatile("" : "+v"(tid));
    int* tstart = (int*)((char*)shm + SHM_B); moe_tiles(ws, tstart, tid);
    const int nu = tstart[32] * 8; const u16* Bt = wsp<u16>(ws, WS::WDN) + (long)l * NEXP * DM * DEXP; const u16* hmid = wsp<u16>(ws, WS::HMID);
#pragma unroll 1
    for (int u = blockIdx.x; u < nu; u += gridDim.x) {
      const int rt = u >> 3, ct = u & 7; int ex = 0;
#pragma unroll 1
      while (rt >= tstart[ex + 1]) ++ex;
      const int rtl = rt - tstart[ex], nvalid = tstart[40 + ex] - rtl * 256;
      EpiDown e{wsp<float>(ws, WS::YBUF), wsp<int>(ws, WS::LST_SLOT) + ex * LCAP + rtl * 256, wsp<float>(ws, WS::LST_GATE) + ex * LCAP + rtl * 256, nvalid, ct * 256};
      gemm256(hmid + (long)rt * 256 * DEXP, DEXP, Bt + ((long)ex * DM + ct * 256) * DEXP, DEXP, DEXP, shm, e);
    }
  }
}

__device__ __forceinline__ MixP make_mixp(char* ws, const char* smem, int l) {
  OPAQUE_WS(ws); asm volatile("" : "+s"(l));
  MixP mp;
  mp.proj = wsp<u16>(ws, WS::PROJ); mp.pos = (const int*)in_ptr(smem, 1); mp.ycat = wsp<u16>(ws, WS::YCAT); mp.ws = ws; mp.smem = smem; mp.layer = l; mp.rot = wsp<float>(ws, WS::ROT);
  MixBuf& b = mp.b;
  b.rw_Rb = wsp<u16>(ws, WS::RW_RB); b.rw_Pab = wsp<u16>(ws, WS::RW_PAB); b.rw_Pak = wsp<u16>(ws, WS::RW_PAK); b.rw_VT = wsp<u16>(ws, WS::RW_VT); b.rw_S0 = wsp<u16>(ws, WS::RW_S0); b.rw_UT = wsp<u16>(ws, WS::RW_UT);
  b.rw_WpF = wsp<u16>(ws, WS::RW_WPF); b.rw_BtF = wsp<u16>(ws, WS::RW_BTF); b.rw_G = wsp<u16>(ws, WS::RW_G); b.rw_BV = wsp<u16>(ws, WS::RW_BV);
  b.rw_U0F = wsp<float>(ws, WS::RW_U0F); b.rw_KVF = wsp<float>(ws, WS::RW_KVF); b.rw_gam = wsp<float>(ws, WS::RW_GAM);
  b.rt_Rb = wsp<u16>(ws, WS::RT_RB); b.rt_Pak = wsp<u16>(ws, WS::RT_PAK); b.rt_VT = wsp<u16>(ws, WS::RT_VT); b.rt_S0 = wsp<u16>(ws, WS::RT_S0); b.rt_KVT = wsp<float>(ws, WS::RT_KVT);
  b.gl_Rb = wsp<u16>(ws, WS::GL_RB); b.gl_Pak = wsp<u16>(ws, WS::GL_PAK); b.gl_VT = wsp<u16>(ws, WS::GL_VT); b.gl_S0 = wsp<u16>(ws, WS::GL_S0); b.gl_KVT = wsp<float>(ws, WS::GL_KVT); b.gl_gam = wsp<float>(ws, WS::GL_GAM);
  b.lr_h = wsp<float>(ws, WS::LR_H); b.lr_A = wsp<float>(ws, WS::LR_A); b.lr_Hp = wsp<float>(ws, WS::LR_HP);
  mp.rw = RwkvP{in_ptr(smem, 4) + l * 1696, in_ptr(smem, 5) + l * 512, in_ptr(smem, 6) + l * 32 * 512, in_ptr(smem, 7) + l * 512, in_ptr(smem, 8) + l * 32 * 512, in_ptr(smem, 9) + l * 96 * 512,
                in_ptr(smem, 10) + l * 512, in_ptr(smem, 11) + l * 512, in_ptr(smem, 12) + l * 512, in_ptr(smem, 13) + l * 512, in_ptr(smem, 14) + l * 512, wsp<u16>(ws, WS::LORA_W) + (long)l * 512 * 160};
  mp.ret_norm_g = in_ptr(smem, 16) + l * 512;
  mp.lru = LruP{in_ptr(smem, 18) + l * 4 * 512, in_ptr(smem, 19) + l * 512, in_ptr(smem, 20) + l * 8 * 64 * 64, in_ptr(smem, 21) + l * 512, in_ptr(smem, 22) + l * 8 * 64 * 64, in_ptr(smem, 23) + l * 512, in_ptr(smem, 24) + l * 512, wsp<u16>(ws, WS::LRU_W) + (long)l * 2 * 8 * 4096};
  mp.gla_alpha_up = in_ptr(smem, 26) + l * 16 * 256; mp.gla_alpha_b = in_ptr(smem, 27) + l * 256; mp.gla_norm_g = in_ptr(smem, 28) + l * 512;
  return mp;
}
__device__ __forceinline__ void mix4_convert(char* ws, const char* smem, int l) {
  OPAQUE_WS(ws);
  int t_ = threadIdx.x; asm volatile("" : "+v"(t_));
  const int big = gridDim.x > 32;
  const int nb = big ? (int)gridDim.x - 32 : (int)gridDim.x;
  const int bi = big ? (int)blockIdx.x - 32 : (int)blockIdx.x;
  if (bi >= 0) convert_down(ws, smem, l, bi * 8 + __builtin_amdgcn_readfirstlane(t_ >> 6), nb * 8, t_ & 63);
}
constexpr int PH_PER_LAYER = 10, N_PHASES = 1 + NL * PH_PER_LAYER + 1;
#ifndef PROBE_MASK
#define PROBE_MASK 0
#endif
#define RUN_PH(id, code) do { const int _id = (id); if (_id >= ph0 && _id < ph1) { const int _kind = _id == 0 ? 12 : (_id == N_PHASES - 1 ? 13 : (_id - 1) % PH_PER_LAYER); \
    if ((PROBE_MASK >> _kind) & 1) { code; xcd_barrier_l(bar); } code; if (_id + 1 < ph1) xcd_barrier_l(bar); } } while (0)
__global__ __launch_bounds__(512, 2) void k_mega(MegaP p, int ph0, int ph1) {
  extern __shared__ __attribute__((aligned(16))) char smem0[];
  volatile LAS unsigned* xbw = (volatile LAS unsigned*)(smem0 + XBW_OFF);
  char* const smem = smem0 + PH_OFF;
  if (threadIdx.x == 0) {
    xbw[0] = 0u; xbw[1] = 0u; xbw[2] = 0u; xbw[3] = 0u;
    unsigned long long* tbl = (unsigned long long*)(smem0 + TBL_OFF);
#pragma unroll
    for (int i = 0; i < 40; ++i) tbl[i] = (unsigned long long)p.in[i];
  }
  __syncthreads();
  char* ws = p.ws; float* outp = p.out;
  const XcdBarrier bar = xcd_barrier_post((unsigned*)ws, xbw);
  if (ph1 - ph0 > 1) xcd_barrier(bar);
  RUN_PH(0, { phase_convert(ws, smem); NormArgs a{}; a.x = in_ptr(smem, 0); a.h = wsp<float>(ws, WS::H); a.g = in_ptr(smem, 2); a.xn = wsp<u16>(ws, WS::XN); phase_norm<0>(a); });
#pragma unroll 1
  for (int l = 0; l < NL; ++l) {
    const int pb = 1 + l * PH_PER_LAYER;
    RUN_PH(pb + 0, { if (l > 0) { NormArgs a{}; a.h = wsp<float>(ws, WS::H); a.g = in_ptr(smem, 2) + (long)l * DM; a.xn = wsp<u16>(ws, WS::XN); a.ybuf = wsp<float>(ws, WS::YBUF); phase_norm<1>(a); } });
    RUN_PH(pb + 1, phase_gemm<0>(ws, l, (u16*)smem));
    RUN_PH(pb + 2, { const MixP mp = make_mixp(ws, smem, l); phase_mix3(mp, smem); });
    RUN_PH(pb + 3, { const MixP mp = make_mixp(ws, smem, l); phase_mix4(mp, smem); mix4_convert(ws, smem, l); });
    RUN_PH(pb + 4, { const MixP mp = make_mixp(ws, smem, l); phase_mix5(mp); { int t_ = threadIdx.x; asm volatile("" : "+v"(t_)); if (blockIdx.x == 0 && t_ < 32) wsp<int>(ws, WS::TILE_EXP)[t_] = 0; } });
    RUN_PH(pb + 5, phase_gemm<1>(ws, l, (u16*)smem));
    RUN_PH(pb + 6, phase_gemm<2>(ws, l, (u16*)smem));
    RUN_PH(pb + 7, { NormArgs a{}; a.h = wsp<float>(ws, WS::H); a.g = in_ptr(smem, 31) + (long)l * DM; a.xn = wsp<u16>(ws, WS::XN); a.wg = in_ptr(smem, 32) + (long)l * DM * 4; a.bg = in_ptr(smem, 33) + l * 4;
      a.we = in_ptr(smem, 34) + (long)l * DM * 32; a.be = in_ptr(smem, 35) + l * 32; phase_n3(ws, a, smem, l); });
    RUN_PH(pb + 8, phase_gemm<3>(ws, l, (u16*)smem));
    RUN_PH(pb + 9, phase_gemm<4>(ws, l, (u16*)smem));
  }
  RUN_PH(N_PHASES - 1, { NormArgs a{}; a.h = wsp<float>(ws, WS::H); a.g = in_ptr(smem, 39); a.out = outp; a.ybuf = wsp<float>(ws, WS::YBUF); phase_norm<2>(a); });
}


extern "C" void kernel_launch(void* const* d_in, const int* in_sizes, int n_in, void* d_out, int out_size, void* d_ws, size_t ws_size, hipStream_t stream) {
  (void)in_sizes; (void)n_in; (void)out_size; (void)ws_size;
  MegaP p{};
  for (int i = 0; i < 40; ++i) p.in[i] = (const float*)d_in[i];
  p.ws = (char*)d_ws; p.out = (float*)d_out;
  static int grid = 0;
  if (!grid) {
    (void)hipFuncSetAttribute((const void*)k_mega, hipFuncAttributeMaxDynamicSharedMemorySize, LDS_BYTES);
    int dev = 0, cus = 0, per_cu = 0;
    (void)hipGetDevice(&dev);
    (void)hipDeviceGetAttribute(&cus, hipDeviceAttributeMultiprocessorCount, dev);
    (void)hipOccupancyMaxActiveBlocksPerMultiprocessor(&per_cu, (const void*)k_mega, 512, LDS_BYTES);
    grid = cus < 256 ? cus : 256;
    if (per_cu < 1) grid = 0;
  }
#ifndef MK_SPLIT
#define MK_SPLIT 0
#define PROBE_MASK 0
#endif
  if (grid > 0) {
    if (MK_SPLIT) { for (int ph = 0; ph < N_PHASES; ++ph) k_mega<<<grid, 512, LDS_BYTES, stream>>>(p, ph, ph + 1); }
    else { (void)hipMemsetAsync(d_ws, 0, XCD_BAR_WORDS * sizeof(unsigned), stream); k_mega<<<grid, 512, LDS_BYTES, stream>>>(p, 0, N_PHASES); }
  }
}
```

```cpp
#define RWKV_CHUNKED_FLAG true
#define MK_SPLIT 0
#define PROBE_MASK 0
#include <hip/hip_runtime.h>
#include <stdint.h>

#define LAS __attribute__((address_space(3)))
typedef unsigned short u16;
typedef __attribute__((ext_vector_type(8))) short bf16x8;
typedef __attribute__((ext_vector_type(4))) float f32x4;

constexpr int T_ = 8192, DM = 2048, NL = 2, MIXW = 512;
constexpr int IN_COLS = 14512, PC = 14592;
constexpr int OFF_A = 0, OFF_B = 1696, OFF_C = 3744, OFF_D = 4768, OFF_G = 6400, NONGATE = 6320;
constexpr int NEXP = 32, DEXP = 1024;
constexpr int MAXROWS = 24576, MAXRT = 96, LCAP = 8192;

typedef __attribute__((ext_vector_type(2))) float f32x2_t;
typedef __attribute__((ext_vector_type(2))) __bf16 bf16x2_t;
__device__ __forceinline__ unsigned pack_bf16(float lo, float hi) { f32x2_t v = {lo, hi}; return __builtin_bit_cast(unsigned, __builtin_convertvector(v, bf16x2_t)); }
__device__ __forceinline__ u16 f2bf(float f) { return (u16)pack_bf16(f, 0.f); }
__device__ __forceinline__ float bf2f(u16 h) { return __uint_as_float(((unsigned)h) << 16); }
__device__ __forceinline__ float sigmoidf_(float x) { return __builtin_amdgcn_rcpf(1.f + __expf(-x)); }
#define PIN8(a) asm volatile("" : "+v"(a[0]), "+v"(a[1]), "+v"(a[2]), "+v"(a[3]), "+v"(a[4]), "+v"(a[5]), "+v"(a[6]), "+v"(a[7]))
#define PIN8O(a, o) asm volatile("" : "+v"(a[o + 0]), "+v"(a[o + 1]), "+v"(a[o + 2]), "+v"(a[o + 3]), "+v"(a[o + 4]), "+v"(a[o + 5]), "+v"(a[o + 6]), "+v"(a[o + 7]))
#define PIN8x2(a, b) asm volatile("" : "+v"(a[0]), "+v"(a[1]), "+v"(a[2]), "+v"(a[3]), "+v"(a[4]), "+v"(a[5]), "+v"(a[6]), "+v"(a[7]), "+v"(b[0]), "+v"(b[1]), "+v"(b[2]), "+v"(b[3]), "+v"(b[4]), "+v"(b[5]), "+v"(b[6]), "+v"(b[7]))
__device__ __forceinline__ void lds_barrier() { asm volatile("s_waitcnt lgkmcnt(0)" ::: "memory"); __builtin_amdgcn_s_barrier(); asm volatile("" ::: "memory"); }
__device__ __forceinline__ float wave_sum(float v) {
#pragma unroll
  for (int o = 32; o > 0; o >>= 1) v += __shfl_xor(v, o, 64);
  return v;
}

constexpr int BKK = 64, HALF = 128, HT = HALF * BKK, SHM_B = 8 * HT * 2;
__device__ __forceinline__ int lds_byte(int r, int c) {
  int st = (r >> 4) * 2 + (c >> 5), rr = r & 15, cc = c & 31, ob = rr * 64 + cc * 2;
  return st * 1024 + (ob ^ (((ob >> 9) & 1) << 5));
}
__device__ __forceinline__ void stage_rc(int b, int& R, int& C) {
  int st = b / 1024, sb = b % 1024, swz = sb ^ (((sb >> 9) & 1) << 5);
  R = (st >> 1) * 16 + swz / 64; C = (st & 1) * 32 + (swz % 64) / 2;
}

template <bool GATHER, class Epi>
__device__ __forceinline__ void gemm256g(const u16* __restrict__ A, int lda, const u16* __restrict__ Bt, int ldb, int K, u16* shm, const Epi& epi, const int (&arow)[4]) {
#define SA(b, h) (shm + ((b) * 2 + (h)) * HT)
#define SB(b, h) (shm + (4 + (b) * 2 + (h)) * HT)
#define STAGE_X(TT, P, BASE, LD, br, kt) do { const u16* _g = (BASE) + (long)(br) * (LD) + (long)(kt) * BKK; \
    _Pragma("unroll") for (int _i = 0; _i < 2; ++_i) { int _b = (TT) * 16 + _i * 8192; int _r, _c; stage_rc(_b, _r, _c); \
      __builtin_amdgcn_global_load_lds((const unsigned*)(_g + (long)_r * (LD) + _c), (unsigned*)((char*)(P) + _b), 16, 0, 0); } } while (0)
#define STAGE_AG(TT, P, br, kt) do { \
    _Pragma("unroll") for (int _i = 0; _i < 2; ++_i) { int _b = (TT) * 16 + _i * 8192; \
      __builtin_amdgcn_global_load_lds((const unsigned*)((const char*)A + (unsigned)(arow[((br) / HALF) * 2 + _i] + (kt) * (BKK * 2))), (unsigned*)((char*)(P) + _b), 16, 0, 0); } } while (0)
#define STAGE_A(P, br, kt) do { if (GATHER) STAGE_AG(tid0, P, br, kt); else STAGE_X(tid0, P, A, lda, br, kt); } while (0)
#define STAGE_B(P, br, kt) STAGE_X(tid0, P, Bt, ldb, br, kt)
#define LDA(dst, b, h) _Pragma("unroll") for (int m = 0; m < 4; ++m) _Pragma("unroll") for (int k = 0; k < 2; ++k) \
    dst[m][k] = *reinterpret_cast<const bf16x8*>((char*)SA(b, h) + lds_byte(wr * 64 + m * 16 + fr, k * 32 + fq * 8))
#define LDB(dst, b, h) _Pragma("unroll") for (int n = 0; n < 2; ++n) _Pragma("unroll") for (int k = 0; k < 2; ++k) \
    dst[n][k] = *reinterpret_cast<const bf16x8*>((char*)SB(b, h) + lds_byte(wc * 32 + n * 16 + fr, k * 32 + fq * 8))
#define MMA(ai, bj, At, Bx) do { __builtin_amdgcn_s_setprio(1); \
    _Pragma("unroll") for (int m = 0; m < 4; ++m) _Pragma("unroll") for (int n = 0; n < 2; ++n) _Pragma("unroll") for (int k = 0; k < 2; ++k) \
      acc[ai][bj][m][n] = __builtin_amdgcn_mfma_f32_16x16x32_bf16(Bx[n][k], At[m][k], acc[ai][bj][m][n], 0, 0, 0); \
    __builtin_amdgcn_s_setprio(0); } while (0)
#define WAIT_V(n) asm volatile("s_waitcnt vmcnt(" #n ")" ::: "memory")
#define WAIT_L(n) asm volatile("s_waitcnt lgkmcnt(" #n ")" ::: "memory")
#define BAR __builtin_amdgcn_s_barrier()
#define SCHED __builtin_amdgcn_sched_barrier(0)
  int tid0 = threadIdx.x; asm volatile("" : "+v"(tid0));
  int wid = tid0 >> 6, lane = tid0 & 63, wr = wid >> 2, wc = wid & 3, fr = lane & 15, fq = lane >> 4;
  f32x4 acc[2][2][4][2] = {};
  bf16x8 At[4][2], B0[2][2], B1[2][2];
  const int nt = K / BKK;
  STAGE_B(SB(0, 0), 0, 0); STAGE_A(SA(0, 0), 0, 0);
  STAGE_B(SB(0, 1), HALF, 0); STAGE_A(SA(0, 1), HALF, 0);
  if (wr == 1) BAR;
  WAIT_V(4); BAR;
  STAGE_B(SB(1, 0), 0, 1); STAGE_A(SA(1, 0), 0, 1); STAGE_B(SB(1, 1), HALF, 1);
  WAIT_V(6); BAR;
  for (int t = 0; t < nt - 2; t += 2) {
    LDB(B0, 0, 0); SCHED; LDA(At, 0, 0); STAGE_A(SA(1, 1), HALF, t + 1);
    WAIT_L(8); BAR; WAIT_L(0); MMA(0, 0, At, B0); BAR; SCHED;
    LDB(B1, 0, 1); STAGE_B(SB(0, 0), 0, t + 2);
    BAR; WAIT_L(0); MMA(0, 1, At, B1); BAR;
    LDA(At, 0, 1); STAGE_A(SA(0, 0), 0, t + 2);
    BAR; WAIT_L(0); MMA(1, 0, At, B0); BAR; SCHED;
    STAGE_B(SB(0, 1), HALF, t + 2);
    WAIT_V(6); BAR; MMA(1, 1, At, B1); BAR;
    LDB(B0, 1, 0); SCHED; LDA(At, 1, 0); STAGE_A(SA(0, 1), HALF, t + 2);
    WAIT_L(8); BAR; WAIT_L(0); MMA(0, 0, At, B0); BAR; SCHED;
    LDB(B1, 1, 1); STAGE_B(SB(1, 0), 0, t + 3);
    BAR; WAIT_L(0); MMA(0, 1, At, B1); BAR;
    LDA(At, 1, 1); STAGE_A(SA(1, 0), 0, t + 3);
    BAR; WAIT_L(0); MMA(1, 0, At, B0); BAR; SCHED;
    STAGE_B(SB(1, 1), HALF, t + 3);
    WAIT_V(6); BAR; MMA(1, 1, At, B1); BAR;
  }
  int tz = threadIdx.x; asm volatile("" : "+v"(tz)); wid = tz >> 6; lane = tz & 63; wr = wid >> 2; wc = wid & 3; fr = lane & 15; fq = lane >> 4;
  { LDB(B0, 0, 0); WAIT_V(0); LDA(At, 0, 0); if (GATHER) STAGE_AG(tz, SA(1, 1), HALF, nt - 1); else STAGE_X(tz, SA(1, 1), A, lda, HALF, nt - 1);
    BAR; WAIT_L(0); MMA(0, 0, At, B0); BAR;
    LDB(B1, 0, 1); BAR; WAIT_L(0); MMA(0, 1, At, B1); BAR;
    LDA(At, 0, 1); WAIT_V(4); BAR; WAIT_L(0); MMA(1, 0, At, B0); MMA(1, 1, At, B1); BAR; }
  { LDB(B0, 1, 0); LDA(At, 1, 0); WAIT_V(2); BAR; WAIT_L(0); MMA(0, 0, At, B0); BAR;
    LDB(B1, 1, 1); WAIT_V(0); BAR; WAIT_L(0); MMA(0, 1, At, B1); BAR;
    LDA(At, 1, 1); BAR; WAIT_L(0); MMA(1, 0, At, B0); MMA(1, 1, At, B1); BAR; }
  if (wr == 0) BAR;
  epi(acc, wr, wc, fr, fq);
  __syncthreads();
#undef SA
#undef SB
}

template <class Epi>
__device__ __forceinline__ void gemm256(const u16* __restrict__ A, int lda, const u16* __restrict__ Bt, int ldb, int K, u16* shm, const Epi& epi) {
  const int dummy[4] = {0, 0, 0, 0};
  gemm256g<false>(A, lda, Bt, ldb, K, shm, epi, dummy);
}
#define UNR _Pragma("unroll")
#define EPI4 UNR for (int ai = 0; ai < 2; ++ai) UNR for (int bj = 0; bj < 2; ++bj) UNR for (int m = 0; m < 4; ++m) UNR for (int n = 0; n < 2; ++n)
#define EPI_R (ai * HALF + wr * 64 + m * 16 + fr)
#define EPI_C (bj * HALF + wc * 32 + n * 16 + fq * 4)
__device__ __forceinline__ uint2 pack4(const f32x4& v) { uint2 r; r.x = pack_bf16(v[0], v[1]); r.y = pack_bf16(v[2], v[3]); return r; }

struct EpiProj {
  u16* proj; int brow, bcol;
  __device__ __forceinline__ void operator()(const f32x4 (&acc)[2][2][4][2], int wr, int wc, int fr, int fq) const {
    u16* base = proj + (long)(brow + wr * 64 + fr) * PC + bcol + wc * 32 + fq * 4;
    if (bcol >= OFF_G) {
      EPI4 { f32x4 v = acc[ai][bj][m][n]; v[0] = sigmoidf_(v[0]); v[1] = sigmoidf_(v[1]); v[2] = sigmoidf_(v[2]); v[3] = sigmoidf_(v[3]);
             *(uint2*)(base + (long)(ai * HALF + m * 16) * PC + bj * HALF + n * 16) = pack4(v); }
    } else {
      EPI4 { *(uint2*)(base + (long)(ai * HALF + m * 16) * PC + bj * HALF + n * 16) = pack4(acc[ai][bj][m][n]); }
    }
  }
};
struct EpiResid {
  float* h; int brow, bcol;
  __device__ __forceinline__ void operator()(const f32x4 (&acc)[2][2][4][2], int wr, int wc, int fr, int fq) const {
    float* base = h + (long)(brow + wr * 64 + fr) * DM + bcol + wc * 32 + fq * 4;
    UNR for (int ai = 0; ai < 2; ++ai) {
      f32x4 o[4][2][2];
      UNR for (int m = 0; m < 4; ++m) UNR for (int bj = 0; bj < 2; ++bj) UNR for (int n = 0; n < 2; ++n) o[m][bj][n] = *(const f32x4*)(base + (long)(ai * HALF + m * 16) * DM + bj * HALF + n * 16);
      asm volatile("" : "+v"(o[0][0][0]), "+v"(o[0][0][1]), "+v"(o[0][1][0]), "+v"(o[0][1][1]), "+v"(o[1][0][0]), "+v"(o[1][0][1]), "+v"(o[1][1][0]), "+v"(o[1][1][1]),
                        "+v"(o[2][0][0]), "+v"(o[2][0][1]), "+v"(o[2][1][0]), "+v"(o[2][1][1]), "+v"(o[3][0][0]), "+v"(o[3][0][1]), "+v"(o[3][1][0]), "+v"(o[3][1][1]));
      UNR for (int m = 0; m < 4; ++m) UNR for (int bj = 0; bj < 2; ++bj) UNR for (int n = 0; n < 2; ++n) *(f32x4*)(base + (long)(ai * HALF + m * 16) * DM + bj * HALF + n * 16) = o[m][bj][n] + acc[ai][bj][m][n];
    }
  }
};
struct EpiGateUp {
  u16* hmid; int brow, ct;
  __device__ __forceinline__ void operator()(const f32x4 (&acc)[2][2][4][2], int wr, int wc, int fr, int fq) const {
    u16* base = hmid + (long)(brow + wr * 64 + fr) * DEXP + ct * 128 + wc * 32 + fq * 4;
    UNR for (int ai = 0; ai < 2; ++ai) UNR for (int m = 0; m < 4; ++m) UNR for (int n = 0; n < 2; ++n) {
      const f32x4 g = acc[ai][0][m][n], u = acc[ai][1][m][n]; f32x4 v;
      UNR for (int j = 0; j < 4; ++j) v[j] = g[j] * sigmoidf_(g[j]) * u[j];
      *(uint2*)(base + (long)(ai * HALF + m * 16) * DEXP + n * 16) = pack4(v); }
  }
};
struct EpiDown {
  float* ybuf; const int* lslot; const float* lgate; int nvalid, bcol;
  __device__ __forceinline__ void operator()(const f32x4 (&acc)[2][2][4][2], int wr, int wc, int fr, int fq) const {
    UNR for (int ai = 0; ai < 2; ++ai) UNR for (int m = 0; m < 4; ++m) {
      const int r = ai * HALF + wr * 64 + m * 16 + fr;
      if (r < nvalid) { const int slot = lslot[r]; const float gt = lgate[r];
        float* yp = ybuf + (long)slot * DM + bcol + wc * 32 + fq * 4;
        UNR for (int bj = 0; bj < 2; ++bj) UNR for (int n = 0; n < 2; ++n) *(f32x4*)(yp + bj * HALF + n * 16) = acc[ai][bj][m][n] * gt; } }
  }
};

__device__ __forceinline__ void gemm_merge(const u16* __restrict__ A, const u16* __restrict__ Bt, const u16* __restrict__ gates, u16* __restrict__ out, int brow, int bcol, u16* shm) {
#define MA(b, h) (shm + ((b) * 3 + (h)) * HT)
#define MB(b) (shm + ((b) * 3 + 2) * HT)
#define MSTAGE(P, BASE, LD_, br, kt) do { const u16* _g = (BASE) + (long)(br) * (LD_) + (long)(kt) * BKK; \
    _Pragma("unroll") for (int _i = 0; _i < 2; ++_i) { int _b = tid0 * 16 + _i * 8192; int _r, _c; stage_rc(_b, _r, _c); \
      __builtin_amdgcn_global_load_lds((const unsigned*)(_g + (long)_r * (LD_) + _c), (unsigned*)((char*)(P) + _b), 16, 0, 0); } } while (0)
  int tid0 = threadIdx.x; asm volatile("" : "+v"(tid0));
  const int wid = tid0 >> 6, lane = tid0 & 63, wr = wid >> 2, wc = wid & 3, fr = lane & 15, fq = lane >> 4;
  f32x4 acc[2][4][2], R[2][4][2];
#pragma unroll
  for (int ai = 0; ai < 2; ++ai)
#pragma unroll
    for (int m = 0; m < 4; ++m)
#pragma unroll
      for (int n = 0; n < 2; ++n) { acc[ai][m][n] = (f32x4){0.f, 0.f, 0.f, 0.f}; R[ai][m][n] = (f32x4){0.f, 0.f, 0.f, 0.f}; }
  const u16* Ab = A + (long)brow * DM; const u16* Bb = Bt + (long)bcol * DM;
  MSTAGE(MA(0, 0), Ab, DM, 0, 0); MSTAGE(MA(0, 1), Ab, DM, HALF, 0); MSTAGE(MB(0), Bb, DM, 0, 0);
  asm volatile("s_waitcnt vmcnt(0)" ::: "memory"); __syncthreads();
#pragma unroll 1
  for (int q = 0; q < 32; ++q) {
    const int b = q & 1;
    if (q + 1 < 32) { MSTAGE(MA(b ^ 1, 0), Ab, DM, 0, q + 1); MSTAGE(MA(b ^ 1, 1), Ab, DM, HALF, q + 1); MSTAGE(MB(b ^ 1), Bb, DM, 0, q + 1); }
    bf16x8 Bf[2][2], Af[4][2];
#pragma unroll
    for (int n = 0; n < 2; ++n)
#pragma unroll
      for (int k = 0; k < 2; ++k) Bf[n][k] = *reinterpret_cast<const bf16x8*>((char*)MB(b) + lds_byte(wc * 32 + n * 16 + fr, k * 32 + fq * 8));
#pragma unroll
    for (int ai = 0; ai < 2; ++ai) {
#pragma unroll
      for (int m = 0; m < 4; ++m)
#pragma unroll
        for (int k = 0; k < 2; ++k) Af[m][k] = *reinterpret_cast<const bf16x8*>((char*)MA(b, ai) + lds_byte(wr * 64 + m * 16 + fr, k * 32 + fq * 8));
#pragma unroll
      for (int m = 0; m < 4; ++m)
#pragma unroll
        for (int n = 0; n < 2; ++n)
#pragma unroll
          for (int k = 0; k < 2; ++k) acc[ai][m][n] = __builtin_amdgcn_mfma_f32_16x16x32_bf16(Bf[n][k], Af[m][k], acc[ai][m][n], 0, 0, 0);
    }
    if ((q & 7) == 7) {
      const int kb = q >> 3;
      const u16* gp = gates + (long)(brow + wr * 64 + fr) * PC + kb * DM + bcol + wc * 32 + fq * 4;
#pragma unroll
      for (int ai = 0; ai < 2; ++ai) {
        uint2 g2[4][2];
#pragma unroll
        for (int m = 0; m < 4; ++m)
#pragma unroll
          for (int n = 0; n < 2; ++n) g2[m][n] = *(const uint2*)(gp + (long)(ai * HALF + m * 16) * PC + n * 16);
#pragma unroll
        for (int m = 0; m < 4; ++m)
#pragma unroll
          for (int n = 0; n < 2; ++n) {
            const f32x4 gv = {__uint_as_float(g2[m][n].x << 16), __uint_as_float(g2[m][n].x & 0xffff0000u), __uint_as_float(g2[m][n].y << 16), __uint_as_float(g2[m][n].y & 0xffff0000u)};
            R[ai][m][n] += gv * acc[ai][m][n]; acc[ai][m][n] = (f32x4){0.f, 0.f, 0.f, 0.f};
          }
      }
    }
    asm volatile("s_waitcnt vmcnt(0)" ::: "memory"); __syncthreads();
  }
  u16* op = out + (long)(brow + wr * 64 + fr) * DM + bcol + wc * 32 + fq * 4;
#pragma unroll
  for (int ai = 0; ai < 2; ++ai)
#pragma unroll
    for (int m = 0; m < 4; ++m)
#pragma unroll
      for (int n = 0; n < 2; ++n) *(uint2*)(op + (long)(ai * HALF + m * 16) * DM + n * 16) = pack4(R[ai][m][n]);
#undef MA
#undef MB
#undef MSTAGE
}
__device__ __forceinline__ void unit_map(int b, int round, int& pm, int& pn) {
  int xcd = b & 7, i = b >> 3, pr = xcd >> 1, pc = xcd & 1, lr = i & 7, lc = i >> 3;
  pm = pr * 8 + lr; pn = round * 8 + pc * 4 + lc;
}
constexpr int CH = 64, NCH = T_ / CH;
struct MegaP { const float* in[40]; char* ws; float* out; };
namespace WS {
constexpr size_t al(size_t x) { return (x + 255) & ~(size_t)255; }
constexpr size_t U8 = (size_t)1024 * 4096 * 2;
constexpr size_t BARW = 0;
constexpr size_t WT_IN = BARW + 65536;
constexpr size_t WT_O = WT_IN + al((size_t)NL * PC * DM * 2);
constexpr size_t WT_OUT = WT_O + al((size_t)NL * 4 * DM * MIXW * 2);
constexpr size_t WGU = WT_OUT + al((size_t)NL * DM * DM * 2);
constexpr size_t WDN = WGU + al((size_t)NL * NEXP * 2048 * DM * 2);
constexpr size_t H = WDN + al((size_t)NL * NEXP * DM * DEXP * 2);
constexpr size_t XN = H + al((size_t)T_ * DM * 4);
constexpr size_t PROJ = XN + al((size_t)T_ * DM * 2);
constexpr size_t YCAT = PROJ + al((size_t)T_ * PC * 2);
constexpr size_t MBUF = YCAT + al((size_t)T_ * DM * 2);
constexpr size_t MERGED = MBUF + al((size_t)T_ * DM * 4);
constexpr size_t TOK_E = MERGED + al((size_t)T_ * DM * 2);
constexpr size_t TOK_G = TOK_E + al((size_t)2 * T_ * 4);
constexpr size_t ROW_TOK = TOK_G + al((size_t)2 * T_ * 4);
constexpr size_t ROW_SLOT = ROW_TOK + al((size_t)MAXROWS * 4);
constexpr size_t ROW_GATE = ROW_SLOT + al((size_t)MAXROWS * 4);
constexpr size_t TILE_EXP = ROW_GATE + al((size_t)MAXROWS * 4);
constexpr size_t NRT = TILE_EXP + 1024;
constexpr size_t XG = NRT + 256;
constexpr size_t HMID = XG + al((size_t)MAXROWS * DM * 2);
constexpr size_t YBUF = HMID + al((size_t)MAXROWS * DEXP * 2);
constexpr size_t RW_RB = YBUF + al((size_t)2 * T_ * DM * 4);
constexpr size_t RW_PAB = RW_RB + U8, RW_PAK = RW_PAB + U8, RW_VT = RW_PAK + U8, RW_S0 = RW_VT + U8, RW_UT = RW_S0 + U8, RW_WPF = RW_UT + U8, RW_BTF = RW_WPF + U8;
constexpr size_t RW_G = RW_BTF + U8, RW_BV = RW_G + U8, RW_U0F = RW_BV + U8, RW_KVF = RW_U0F + 2 * U8, RW_GAM = RW_KVF + 2 * U8;
constexpr size_t RT_RB = RW_GAM + 262144, RT_PAK = RT_RB + U8, RT_VT = RT_PAK + U8, RT_S0 = RT_VT + U8, RT_KVT = RT_S0 + U8;
constexpr size_t GL_RB = RT_KVT + 2 * U8, GL_PAK = GL_RB + U8 / 2, GL_VT = GL_PAK + U8 / 2, GL_S0 = GL_VT + U8, GL_KVT = GL_S0 + U8, GL_GAM = GL_KVT + 2 * U8;
constexpr size_t LR_H = GL_GAM + 131072, LR_A = LR_H + (size_t)T_ * 512 * 4, LR_HP = LR_A + (size_t)T_ * 512 * 4;
constexpr size_t LST_SLOT = LR_HP + (size_t)NCH * 512 * 4;
constexpr size_t LST_GATE = LST_SLOT + (size_t)32 * 8192 * 4;
constexpr size_t RT_HI = LST_GATE + (size_t)32 * 8192 * 4;
constexpr size_t RT_LO = RT_HI + (size_t)NL * 48 * 2048 * 2;
constexpr size_t LORA_W = RT_LO + (size_t)NL * 48 * 2048 * 2;
constexpr size_t LRU_W = LORA_W + (size_t)NL * 512 * 160 * 2;
constexpr size_t ROT = LRU_W + (size_t)NL * 2 * 8 * 4096 * 2;
constexpr size_t END = ROT + (size_t)T_ * 32 * 8;
}
constexpr int TBL_OFF = 0, XBW_OFF = 320, PH_OFF = 512;
constexpr int PH_BYTES = 153600;
constexpr int LDS_BYTES = PH_OFF + PH_BYTES;
__device__ __forceinline__ const float* in_ptr(const char* smem, int i) {
  const unsigned long long v = *(const unsigned long long*)(smem - PH_OFF + TBL_OFF + i * 8);
  const unsigned lo = __builtin_amdgcn_readfirstlane((unsigned)v), hi = __builtin_amdgcn_readfirstlane((unsigned)(v >> 32));
  return (const float*)(const float __attribute__((address_space(1)))*)(((unsigned long long)hi << 32) | lo);
}
template <class T> __device__ __forceinline__ T* wsp(char* ws, size_t off) { return (T*)(ws + off); }
__device__ __forceinline__ int ld_i(const int* p) { return __hip_atomic_load(p, __ATOMIC_RELAXED, __HIP_MEMORY_SCOPE_AGENT); }
#define OPAQUE_WS(w) do { unsigned long long _z = 0; asm volatile("" : "+s"(_z)); (w) = (char*)(char __attribute__((address_space(1)))*)((unsigned long long)(w) + _z); } while (0)
__device__ __forceinline__ int bidx() { int b = blockIdx.x; asm volatile("" : "+s"(b)); return b; }
__device__ __forceinline__ int gdim() { int g = gridDim.x; asm volatile("" : "+s"(g)); return g; }

__device__ __forceinline__ void transpose_tile_w(const float* __restrict__ src, int sld, int nvalid, u16* __restrict__ dst, int K, int n0, int k0, int drow0, int mode, int lane) {
  const int kq = lane >> 4, n4 = lane & 15, nb = n0 + n4 * 4;
  f32x4 v[16];
  if (nb < nvalid) {
    const float* sp = src + (long)(k0 + kq * 16) * sld + nb;
#pragma unroll
    for (int i = 0; i < 16; ++i) v[i] = *(const f32x4*)(sp + (long)i * sld);
  } else {
#pragma unroll
    for (int i = 0; i < 16; ++i) v[i] = (f32x4){0.f, 0.f, 0.f, 0.f};
  }
#pragma unroll
  for (int jn = 0; jn < 4; ++jn) {
    const int n = nb + jn;
    const int row = (mode == 0) ? drow0 + n : ((n >> 7) * 256 + (mode == 2 ? 128 : 0) + (n & 127));
    u16* dp = dst + (long)row * K + k0 + kq * 16;
    uint4 lo, hi;
    lo.x = (unsigned)f2bf(v[0][jn]) | ((unsigned)f2bf(v[1][jn]) << 16); lo.y = (unsigned)f2bf(v[2][jn]) | ((unsigned)f2bf(v[3][jn]) << 16);
    lo.z = (unsigned)f2bf(v[4][jn]) | ((unsigned)f2bf(v[5][jn]) << 16); lo.w = (unsigned)f2bf(v[6][jn]) | ((unsigned)f2bf(v[7][jn]) << 16);
    hi.x = (unsigned)f2bf(v[8][jn]) | ((unsigned)f2bf(v[9][jn]) << 16); hi.y = (unsigned)f2bf(v[10][jn]) | ((unsigned)f2bf(v[11][jn]) << 16);
    hi.z = (unsigned)f2bf(v[12][jn]) | ((unsigned)f2bf(v[13][jn]) << 16); hi.w = (unsigned)f2bf(v[14][jn]) | ((unsigned)f2bf(v[15][jn]) << 16);
    *(uint4*)dp = lo; *(uint4*)(dp + 8) = hi;
  }
}
__device__ __forceinline__ void moe_tile(char* ws, const char* smem, int l, int t, int lane) {
  if (t < 32768) { const int up = t >> 14, e = (t & 16383) >> 9, q = t & 511, nt = q >> 5, kt = q & 31;
    transpose_tile_w(in_ptr(smem, up ? 37 : 36) + ((long)l * NEXP + e) * DM * DEXP, DEXP, DEXP, wsp<u16>(ws, WS::WGU) + ((long)l * NEXP + e) * 2048 * DM, DM, nt * 64, kt * 64, 0, up ? 2 : 1, lane);
  } else { const int t2 = t - 32768, e = t2 >> 9, q = t2 & 511, nt = q >> 4, kt = q & 15;
    transpose_tile_w(in_ptr(smem, 38) + ((long)l * NEXP + e) * DEXP * DM, DM, DM, wsp<u16>(ws, WS::WDN) + ((long)l * NEXP + e) * DM * DEXP, DEXP, nt * 64, kt * 64, 0, 0, lane); }
}
constexpr int CV_SOLVE = 6144;
constexpr int LD = 72;

struct RwkvP { const float *mu, *w0, *w_up, *a0, *a_up, *g_up, *k_k, *k_a, *r_k, *ln_g, *ln_b; const u16* lora_w; };
struct LruP { const float *conv_w, *conv_b, *w_a, *b_a, *w_x, *b_x, *lam; const u16* wt; };
struct MixBuf {
  u16 *rw_Rb, *rw_Pab, *rw_Pak, *rw_VT, *rw_S0, *rw_UT, *rw_WpF, *rw_BtF, *rw_G, *rw_BV; float *rw_U0F, *rw_KVF, *rw_gam;
  u16 *rt_Rb, *rt_Pak, *rt_VT, *rt_S0; float* rt_KVT;
  u16 *gl_Rb, *gl_Pak, *gl_VT, *gl_S0; float *gl_KVT, *gl_gam;
  float *lr_h, *lr_A, *lr_Hp;
};
struct MixP {
  const u16* proj; const int* pos; u16* ycat; MixBuf b; char* ws; const char* smem; int layer; const float* rot;
  RwkvP rw; const float* ret_norm_g; LruP lru; const float *gla_alpha_up, *gla_alpha_b, *gla_norm_g;
};

__device__ __forceinline__ float gelu_tanh(float x) {
  const float u = 0.7978845608028654f * (x + 0.044715f * x * x * x);
  return 0.5f * x * (1.f + tanhf(u));
}
__device__ __forceinline__ float red16(float v) {
  v += __shfl_xor(v, 1, 64); v += __shfl_xor(v, 2, 64); v += __shfl_xor(v, 4, 64); v += __shfl_xor(v, 8, 64);
  return v;
}
__device__ __forceinline__ uint4 pack8(const u16 (&a)[8]) {
  uint4 r;
  r.x = (unsigned)a[0] | ((unsigned)a[1] << 16); r.y = (unsigned)a[2] | ((unsigned)a[3] << 16);
  r.z = (unsigned)a[4] | ((unsigned)a[5] << 16); r.w = (unsigned)a[6] | ((unsigned)a[7] << 16);
  return r;
}
__device__ __forceinline__ f32x4 tile_nt(const u16* sA, const u16* sB, int mt, int nt, int r, int g) {
  f32x4 c = {0.f, 0.f, 0.f, 0.f};
#pragma unroll
  for (int s = 0; s < 2; ++s) {
    bf16x8 a = *(const bf16x8*)(sA + (16 * mt + r) * LD + 32 * s + 8 * g);
    bf16x8 b = *(const bf16x8*)(sB + (16 * nt + r) * LD + 32 * s + 8 * g);
    c = __builtin_amdgcn_mfma_f32_16x16x32_bf16(a, b, c, 0, 0, 0);
  }
  return c;
}
__device__ __forceinline__ void copy_out(const u16* s, u16* gp, int rows, int tid) {
  for (int idx = tid; idx < rows * 8; idx += 512) { int row = idx >> 3, seg = idx & 7; *(uint4*)(gp + row * 64 + seg * 8) = *(const uint4*)(s + row * LD + seg * 8); }
}
__device__ __forceinline__ void inv_perm(int x, int& s, int& g, int& j) { s = x >> 5; int rr = x & 31; g = (rr >> 2) & 3; j = 4 * (rr >> 4) + (rr & 3); }

__device__ __forceinline__ void p3_ret(const MixP& p, int c, int h, char* smem) {
  u16* sRb = (u16*)smem; u16* sKb = sRb + 64 * LD; u16* sKtT = sKb + 64 * LD; u16* sVT = sKtT + 64 * LD;
  int tid = threadIdx.x; asm volatile("" : "+v"(tid));
  const int cc = tid & 63, tg = tid >> 6, r = cc & 15, g = cc >> 4, uid = c * 8 + h;
  const float lg2 = log2f(1.f - exp2f(-(5.f + 4.f * (float)h / 7.f)));
  u16 kt8[8], v8[8], q16[8], k16[8]; f32x2_t cs2[8];
#pragma unroll
  for (int i = 0; i < 8; ++i) {
    const int t = c * 64 + tg * 8 + i; const u16* row = p.proj + (long)t * PC + OFF_B;
    q16[i] = row[h * 64 + cc]; k16[i] = row[512 + h * 64 + cc]; v8[i] = row[1024 + h * 64 + cc]; cs2[i] = *(const f32x2_t*)(p.rot + (t * 32 + (cc & 31)) * 2);
  }
      asm volatile("" ::: "memory");
#pragma unroll
  for (int i = 0; i < 8; ++i) {
    const int tl = tg * 8 + i;
    const float q = bf2f(q16[i]), k = bf2f(k16[i]), cs = cs2[i][0], sn = cs2[i][1];
    const float qo = __shfl_xor(q, 32, 64), ko = __shfl_xor(k, 32, 64);
    const float qr = cc < 32 ? q * cs - qo * sn : q * cs + qo * sn;
    const float kr = (cc < 32 ? k * cs - ko * sn : k * cs + ko * sn) * 0.125f;
    const float e = exp2f(lg2 * (float)(tl + 1)), ei = exp2f(-lg2 * (float)(tl + 1)), et = exp2f(lg2 * (float)(63 - tl));
    sRb[tl * LD + cc] = f2bf(qr * e); sKb[tl * LD + cc] = f2bf(kr * ei); kt8[i] = f2bf(kr * et);
  }
  *(uint4*)(sKtT + cc * LD + tg * 8) = pack8(kt8); *(uint4*)(sVT + cc * LD + tg * 8) = pack8(v8);
  lds_barrier();
  for (int tile = tg; tile < 32; tile += 8) {
    if (tile < 16) {
      const int mt = tile >> 2, nt = tile & 3; f32x4 c4 = tile_nt(sRb, sKb, mt, nt, r, g);
#pragma unroll
      for (int reg = 0; reg < 4; ++reg) { int t = 16 * mt + 4 * g + reg, i = 16 * nt + r; p.b.rt_Pak[(long)uid * 4096 + t * 64 + i] = f2bf(i <= t ? c4[reg] : 0.f); }
    } else {
      const int q = tile - 16, mt = q >> 2, nt = q & 3; f32x4 c4 = tile_nt(sVT, sKtT, mt, nt, r, g);
#pragma unroll
      for (int reg = 0; reg < 4; ++reg) { int v = 16 * mt + 4 * g + reg, k = 16 * nt + r; p.b.rt_KVT[(long)uid * 4096 + v * 64 + k] = c4[reg]; }
    }
  }
  copy_out(sRb, p.b.rt_Rb + (long)uid * 4096, 64, tid); copy_out(sVT, p.b.rt_VT + (long)uid * 4096, 64, tid);
  lds_barrier();
}

__device__ __forceinline__ void p3_gla(const MixP& p, int c, int h, char* smem) {
  u16* sRb = (u16*)smem; u16* sKb = sRb + 64 * LD; u16* sKtT = sKb + 64 * LD; u16* sVT = sKtT + 64 * LD;
  float* pre = (float*)(smem + 5 * 64 * LD * 2); float* sal = pre + 512;
  int tid = threadIdx.x; asm volatile("" : "+v"(tid));
  const int cc = tid & 63, tg = tid >> 6, r = cc & 15, g = cc >> 4, uid = c * 4 + h, hd = h * 64 + cc;
  for (int idx = tid; idx < 1024; idx += 512) { int tl = idx >> 4, j = idx & 15; sal[idx] = bf2f(p.proj[(long)(c * 64 + tl) * PC + OFF_D + 1024 + j]); }
  lds_barrier();
  float au[16];
#pragma unroll
  for (int j = 0; j < 16; ++j) au[j] = p.gla_alpha_up[j * 256 + hd];
  const float ab = p.gla_alpha_b[hd];
  float cum[8]; float run = 0.f;
#pragma unroll
  for (int i = 0; i < 8; ++i) {
    const int tl = tg * 8 + i; float x = ab;
#pragma unroll
    for (int j = 0; j < 16; ++j) x += sal[tl * 16 + j] * au[j];
    const float ls = fminf(x, 0.f) - __logf(1.f + __expf(-fabsf(x)));
    run += ls * (1.f / 16.f); cum[i] = run;
  }
  pre[tg * 64 + cc] = run;
  lds_barrier();
  float off = 0.f, tot = 0.f;
#pragma unroll
  for (int q = 0; q < 8; ++q) { float v = pre[q * 64 + cc]; tot += v; if (q < tg) off += v; }
  u16 kt8[8], v8a[8], v8b[8];
#pragma unroll
  for (int i = 0; i < 8; ++i) {
    const int tl = tg * 8 + i, t = c * 64 + tl; const u16* row = p.proj + (long)t * PC + OFF_D;
    const float cm = cum[i] + off;
    const float q = bf2f(row[hd]) * 0.125f, k = bf2f(row[256 + hd]);
    sRb[tl * LD + cc] = f2bf(q * __expf(cm)); sKb[tl * LD + cc] = f2bf(k * __expf(-cm)); kt8[i] = f2bf(k * __expf(tot - cm));
    v8a[i] = row[512 + h * 128 + cc]; v8b[i] = row[512 + h * 128 + 64 + cc];
  }
  *(uint4*)(sKtT + cc * LD + tg * 8) = pack8(kt8); *(uint4*)(sVT + cc * LD + tg * 8) = pack8(v8a); *(uint4*)(sVT + (64 + cc) * LD + tg * 8) = pack8(v8b);
  if (tg == 0) p.b.gl_gam[uid * 64 + cc] = __expf(tot);
  lds_barrier();
  for (int tile = tg; tile < 48; tile += 8) {
    if (tile < 16) {
      const int mt = tile >> 2, nt = tile & 3; f32x4 c4 = tile_nt(sRb, sKb, mt, nt, r, g);
#pragma unroll
      for (int reg = 0; reg < 4; ++reg) { int t = 16 * mt + 4 * g + reg, i = 16 * nt + r; p.b.gl_Pak[(long)uid * 4096 + t * 64 + i] = f2bf(i <= t ? c4[reg] : 0.f); }
    } else {
      const int q = tile - 16, mt = q >> 2, nt = q & 3; f32x4 c4 = tile_nt(sVT, sKtT, mt, nt, r, g);
#pragma unroll
      for (int reg = 0; reg < 4; ++reg) { int v = 16 * mt + 4 * g + reg, k = 16 * nt + r; p.b.gl_KVT[(long)uid * 8192 + v * 64 + k] = c4[reg]; }
    }
  }
  copy_out(sRb, p.b.gl_Rb + (long)uid * 4096, 64, tid); copy_out(sVT, p.b.gl_VT + (long)uid * 8192, 128, tid);
  lds_barrier();
}

__device__ __forceinline__ void p3_lru(const MixP& p, int c, int gq, char* smem) {
  u16* sx = (u16*)smem; float* sG = (float*)(smem + 9216); float* preA = sG + 8192; float* preB = preA + 512;
  int tid = threadIdx.x; asm volatile("" : "+v"(tid));
  const int cc = tid & 63, tg = tid >> 6, r = cc & 15, g = cc >> 4, ch = gq * 64 + cc, t0 = c * 64 + tg * 8;
  float xb[11];
  { u16 raw[11];
#pragma unroll
    for (int i = 0; i < 11; ++i) { const int t = t0 - 3 + i; raw[i] = p.proj[(long)(t >= 0 ? t : 0) * PC + OFF_C + ch]; }
      asm volatile("" ::: "memory");
#pragma unroll
    for (int i = 0; i < 11; ++i) xb[i] = bf2f(raw[i]) * (t0 - 3 + i >= 0 ? 1.f : 0.f); }
  const float cw0 = p.lru.conv_w[ch], cw1 = p.lru.conv_w[512 + ch], cw2 = p.lru.conv_w[1024 + ch], cw3 = p.lru.conv_w[1536 + ch], cb = p.lru.conv_b[ch];
  float xc[8];
#pragma unroll
  for (int i = 0; i < 8; ++i) { xc[i] = cb + cw0 * xb[i] + cw1 * xb[i + 1] + cw2 * xb[i + 2] + cw3 * xb[i + 3]; sx[(tg * 8 + i) * LD + cc] = f2bf(xc[i]); }
  lds_barrier();
  {
    const u16* wt = p.lru.wt + (long)gq * 4096;
#pragma unroll 1
    for (int q = tg; q < 32; q += 8) {
      const int m = q >> 4, tile = q & 15, mt = tile >> 2, nt = tile & 3;
      f32x4 c4 = {0.f, 0.f, 0.f, 0.f};
#pragma unroll
      for (int s_ = 0; s_ < 2; ++s_) {
        const bf16x8 af = *(const bf16x8*)(sx + (16 * mt + r) * LD + 32 * s_ + 8 * g);
        const bf16x8 bfr = *(const bf16x8*)(wt + (long)m * 8 * 4096 + (16 * nt + r) * 64 + 32 * s_ + 8 * g);
        c4 = __builtin_amdgcn_mfma_f32_16x16x32_bf16(af, bfr, c4, 0, 0, 0);
      }
#pragma unroll
      for (int reg = 0; reg < 4; ++reg) sG[(m * 64 + 16 * mt + 4 * g + reg) * 64 + 16 * nt + r] = c4[reg];
    }
  }
  lds_barrier();
  float ra[8], ix[8];
  { const float ba = p.lru.b_a[ch], bx = p.lru.b_x[ch];
#pragma unroll
    for (int i = 0; i < 8; ++i) { ra[i] = ba + sG[(tg * 8 + i) * 64 + cc]; ix[i] = bx + sG[(64 + tg * 8 + i) * 64 + cc]; } }
  const float lam = p.lru.lam[ch]; const float sp = fmaxf(-lam, 0.f) + log1pf(__expf(-fabsf(lam)));
  float hl[8], ac[8]; float A = 1.f, B = 0.f;
#pragma unroll
  for (int i = 0; i < 8; ++i) {
    const float rr = sigmoidf_(ra[i]), ig = sigmoidf_(ix[i]); const float log_a = -8.f * rr * sp;
    const bool reset = p.pos[t0 + i] == 0;
    const float av = reset ? 0.f : __expf(log_a); const float mult = reset ? 1.f : sqrtf(fmaxf(1.f - av * av, 0.f));
    const float bv = mult * ig * xc[i];
    B = av * B + bv; A *= av; hl[i] = B; ac[i] = A;
  }
  preA[tg * 64 + cc] = A; preB[tg * 64 + cc] = B;
  lds_barrier();
  float Ap = 1.f, Bp = 0.f;
#pragma unroll
  for (int q = 0; q < 7; ++q) if (q < tg) { float a = preA[q * 64 + cc], b = preB[q * 64 + cc]; Bp = a * Bp + b; Ap *= a; }
#pragma unroll
  for (int i = 0; i < 8; ++i) { long o = (long)(t0 + i) * 512 + ch; p.b.lr_h[o] = hl[i] + ac[i] * Bp; p.b.lr_A[o] = ac[i] * Ap; }
  lds_barrier();
}

template <int I, int N> struct SolveDot {
  static __device__ __forceinline__ void run(const LAS float* arow, const float (&X)[64], float (&acc)[4]) {
    if constexpr (I + 4 <= N) {
      const f32x4 a = *(const LAS f32x4*)(arow + I);
      acc[0] += a[0] * X[I]; acc[1] += a[1] * X[I + 1]; acc[2] += a[2] * X[I + 2]; acc[3] += a[3] * X[I + 3];
      SolveDot<I + 4, N>::run(arow, X, acc);
    } else if constexpr (I < N) { acc[I & 3] += arow[I] * X[I]; SolveDot<I + 1, N>::run(arow, X, acc); }
  }
};
template <int T> struct SolveRow {
  static __device__ __forceinline__ void run(const LAS float* sAab, const LAS float* sRhs, int tid, float (&X)[64]) {
    if constexpr (T < 64) {
      float acc[4] = {sRhs[T * 128 + tid], 0.f, 0.f, 0.f};
      SolveDot<0, T>::run(sAab + T * 64, X, acc);
      X[T] = (acc[0] + acc[1]) + (acc[2] + acc[3]);
      asm volatile("" ::: "memory");
      SolveRow<T + 1>::run(sAab, sRhs, tid, X);
    }
  }
};
__device__ __forceinline__ void p3_rwkv_solve(const MixP& p, int uid, int tid, const float* sRhs, const float* sAab) {
  float X[64];
  const int col = tid & 63; const bool isAl = tid < 64;
  const LAS float* lA = (const LAS float*)sAab; const LAS float* lR = (const LAS float*)sRhs;
  asm volatile("" : "+v"(lA), "+v"(lR));
  SolveRow<0>::run(lA, lR, tid, X);
  if (isAl) {
    int s, g_, j; inv_perm(col, s, g_, j);
#pragma unroll
    for (int t = 0; t < 64; ++t) p.b.rw_WpF[(long)uid * 4096 + (((t >> 4) * 2 + s) * 64 + g_ * 16 + (t & 15)) * 8 + j] = f2bf(X[t]);
  } else {
    const int vs = col >> 4, r_ = col & 15;
#pragma unroll
    for (int tt = 0; tt < 4; ++tt)
#pragma unroll
      for (int g_ = 0; g_ < 4; ++g_) {
        f32x4 o = {X[16 * tt + 4 * g_], X[16 * tt + 4 * g_ + 1], X[16 * tt + 4 * g_ + 2], X[16 * tt + 4 * g_ + 3]};
        *(f32x4*)(p.b.rw_U0F + (((long)uid * 4 + vs) * 4 + tt) * 256 + (g_ * 16 + r_) * 4) = o;
      }
  }
}
__device__ __forceinline__ void p3_rwkv(const MixP& p, int c, int h, char* smem) {
  u16* sRb = (u16*)smem; u16* sKb = sRb + 64 * LD; u16* sAl = sKb + 64 * LD; u16* sBe = sAl + 64 * LD; u16* sKtT = sBe + 64 * LD; u16* sVT = sKtT + 64 * LD;
  float* pre = (float*)(smem + 55296);
  char* R2 = smem + 57344;
  constexpr int LDA_ = 168;
  u16* sAct = (u16*)R2; float* sLo = (float*)(R2 + 21504);
  float* sAab = (float*)R2; u16* sAak = (u16*)(R2 + 16384); float* sRhs = (float*)(R2 + 16384 + 9216);
  int tid = threadIdx.x; asm volatile("" : "+v"(tid));
  const int cc = tid & 63, tg = tid >> 6, r = cc & 15, g = cc >> 4, uid = c * 8 + h, hc = h * 64 + cc, t0 = c * 64 + tg * 8;
  const u16* proj = p.proj;
  {
    u16 c16[20], p16[20]; float mu20[20];
#pragma unroll
    for (int q = 0; q < 20; ++q) {
      const int idx = tid + 512 * q, tl = idx / 160, j = idx - tl * 160, t = c * 64 + tl, col = 1536 + j;
      c16[q] = proj[(long)t * PC + col]; p16[q] = proj[(long)(t > 0 ? t - 1 : 0) * PC + col]; mu20[q] = p.rw.mu[col];
    }
      asm volatile("" ::: "memory");
#pragma unroll
    for (int q = 0; q < 20; ++q) {
      const int idx = tid + 512 * q, tl = idx / 160, j = idx - tl * 160;
      const float cur = bf2f(c16[q]), prev = bf2f(p16[q]) * ((c * 64 + tl) > 0 ? 1.f : 0.f);
      const float z = cur + (prev - cur) * mu20[q];
      const float sg_ = sigmoidf_(j < 32 ? 2.f * z : z);
      sAct[tl * LDA_ + j] = f2bf(j < 32 ? 2.f * sg_ - 1.f : (j < 64 ? z : sg_));
    }
  }
  float zr[8], zk[8], zv[8];
  {
    float pr[9], pk[9], pv[9];
#pragma unroll
    for (int i = 0; i < 9; ++i) { const int t = t0 - 1 + i; const bool ok = t >= 0; const u16* row = proj + (long)(ok ? t : 0) * PC; const u16 a_ = row[hc], b_ = row[512 + hc], c_ = row[1024 + hc];
      const float m_ = ok ? 1.f : 0.f; pr[i] = bf2f(a_) * m_; pk[i] = bf2f(b_) * m_; pv[i] = bf2f(c_) * m_; }
    const float mr = p.rw.mu[hc], mk = p.rw.mu[512 + hc], mv = p.rw.mu[1024 + hc];
#pragma unroll
    for (int i = 0; i < 8; ++i) { zr[i] = pr[i + 1] + (pr[i] - pr[i + 1]) * mr; zk[i] = pk[i + 1] + (pk[i] - pk[i + 1]) * mk; zv[i] = pv[i + 1] + (pv[i] - pv[i + 1]) * mv; }
  }
  lds_barrier();
  {
    const u16* wl = p.rw.lora_w + (long)(h * 64) * 160;
#pragma unroll 1
    for (int q = tg; q < 48; q += 8) {
      const int o = q >> 4, tile = q & 15, mt = tile >> 2, nt = tile & 3, s0 = o == 0 ? 0 : (o == 1 ? 1 : 2), ns = o == 2 ? 3 : 1;
      f32x4 c4 = {0.f, 0.f, 0.f, 0.f};
#pragma unroll 1
      for (int s_ = s0; s_ < s0 + ns; ++s_) {
        const bf16x8 af = *(const bf16x8*)(sAct + (16 * mt + r) * LDA_ + 32 * s_ + 8 * g);
        const bf16x8 bfr = *(const bf16x8*)(wl + (long)(16 * nt + r) * 160 + 32 * s_ + 8 * g);
        c4 = __builtin_amdgcn_mfma_f32_16x16x32_bf16(af, bfr, c4, 0, 0, 0);
      }
#pragma unroll
      for (int reg = 0; reg < 4; ++reg) sLo[(o * 64 + 16 * mt + 4 * g + reg) * 64 + 16 * nt + r] = c4[reg];
    }
  }
  lds_barrier();
  float wv[8], av[8], gv[8];
  { const float w0 = p.rw.w0[hc], a0 = p.rw.a0[hc];
#pragma unroll
    for (int i = 0; i < 8; ++i) { wv[i] = w0 + sLo[(tg * 8 + i) * 64 + cc]; av[i] = a0 + sLo[(64 + tg * 8 + i) * 64 + cc]; gv[i] = sLo[(128 + tg * 8 + i) * 64 + cc]; } }
  lds_barrier();
  const float kkw = p.rw.k_k[hc], kaw = p.rw.k_a[hc], rkw = p.rw.r_k[hc];
  float lw[8], aa[8], kk[8], kp[8], cum[8]; float run = 0.f;
#pragma unroll
  for (int i = 0; i < 8; ++i) {
    lw[i] = -0.6065306597126334f * sigmoidf_(wv[i]); aa[i] = sigmoidf_(av[i]);
    float k0 = zk[i] * kkw; const float ss = wave_sum(k0 * k0); kk[i] = k0 / fmaxf(sqrtf(ss), 1e-12f);
    kp[i] = zk[i] * (1.f + (aa[i] - 1.f) * kaw);
    const float bs = wave_sum(zr[i] * kp[i] * rkw);
    const long o = (long)(t0 + i) * 512 + hc;
    p.b.rw_G[o] = f2bf(gv[i]); p.b.rw_BV[o] = f2bf(bs * zv[i]);
    run += lw[i]; cum[i] = run;
  }
  pre[tg * 64 + cc] = run;
  lds_barrier();
  float off = 0.f, tot = 0.f;
#pragma unroll
  for (int q = 0; q < 8; ++q) { float v = pre[q * 64 + cc]; tot += v; if (q < tg) off += v; }
  {
    u16 kt8[8], v8[8];
    const int kt = cc >> 4, r_ = cc & 15;
#pragma unroll
    for (int i = 0; i < 8; ++i) {
      const int tl = tg * 8 + i; const float cm = cum[i] + off, cx = cm - lw[i];
      const float en = __expf(-cm), et = __expf(tot - cm);
      sAl[tl * LD + cc] = f2bf(-kk[i] * __expf(cx)); sBe[tl * LD + cc] = f2bf(kk[i] * aa[i] * en);
      sKb[tl * LD + cc] = f2bf(kp[i] * en); sRb[tl * LD + cc] = f2bf(zr[i] * __expf(cm));
      kt8[i] = f2bf(kp[i] * et); v8[i] = f2bf(zv[i]);
      int s, g_, j; inv_perm(tl, s, g_, j);
      p.b.rw_BtF[(long)uid * 4096 + ((kt * 2 + s) * 64 + g_ * 16 + r_) * 8 + j] = f2bf(kk[i] * aa[i] * et);
    }
    *(uint4*)(sKtT + cc * LD + tg * 8) = pack8(kt8); *(uint4*)(sVT + cc * LD + tg * 8) = pack8(v8);
    if (tg == 0) p.b.rw_gam[uid * 64 + cc] = __expf(tot);
  }
  lds_barrier();
  for (int q = tg; q < 80; q += 8) {
    const int kind = q >> 4, tt = q & 15, mt = tt >> 2, nt = tt & 3;
    if (kind == 0) { f32x4 c4 = tile_nt(sAl, sBe, mt, nt, r, g);
#pragma unroll
      for (int reg = 0; reg < 4; ++reg) { int t = 16 * mt + 4 * g + reg, i = 16 * nt + r; sAab[t * 64 + i] = i < t ? c4[reg] : 0.f; }
    } else if (kind == 1) { f32x4 c4 = tile_nt(sAl, sKb, mt, nt, r, g);
#pragma unroll
      for (int reg = 0; reg < 4; ++reg) { int t = 16 * mt + 4 * g + reg, i = 16 * nt + r; sAak[t * LD + i] = f2bf(i < t ? c4[reg] : 0.f); }
    } else if (kind == 2) { f32x4 c4 = tile_nt(sRb, sBe, mt, nt, r, g);
#pragma unroll
      for (int reg = 0; reg < 4; ++reg) { int t = 16 * mt + 4 * g + reg, i = 16 * nt + r; p.b.rw_Pab[(long)uid * 4096 + t * 64 + i] = f2bf(i <= t ? c4[reg] : 0.f); }
    } else if (kind == 3) { f32x4 c4 = tile_nt(sRb, sKb, mt, nt, r, g);
#pragma unroll
      for (int reg = 0; reg < 4; ++reg) { int t = 16 * mt + 4 * g + reg, i = 16 * nt + r; p.b.rw_Pak[(long)uid * 4096 + t * 64 + i] = f2bf(i <= t ? c4[reg] : 0.f); }
    } else { f32x4 c4 = tile_nt(sKtT, sVT, mt, nt, r, g);
      *(f32x4*)(p.b.rw_KVF + (((long)uid * 4 + nt) * 4 + mt) * 256 + cc * 4) = c4;
    }
  }
  lds_barrier();
  for (int q = tg; q < 16; q += 8) { const int mt = q >> 2, nt = q & 3; f32x4 c4 = tile_nt(sAak, sVT, mt, nt, r, g);
#pragma unroll
    for (int reg = 0; reg < 4; ++reg) { int t = 16 * mt + 4 * g + reg, v = 16 * nt + r; sRhs[t * 128 + 64 + v] = c4[reg]; } }
  for (int idx = tid; idx < 4096; idx += 512) { int t = idx >> 6, k = idx & 63; sRhs[t * 128 + k] = bf2f(sAl[t * LD + k]); }
  copy_out(sRb, p.b.rw_Rb + (long)uid * 4096, 64, tid); copy_out(sVT, p.b.rw_VT + (long)uid * 4096, 64, tid);
  lds_barrier();
  if (tid < 128) p3_rwkv_solve(p, uid, tid, sRhs, sAab);
  else {
    const int w6 = __builtin_amdgcn_readfirstlane(tid >> 6) - 2;
    moe_tile(p.ws, p.smem, p.layer, uid * 6 + w6, tid & 63);
  }
  lds_barrier();
}

constexpr int CH_SLOT = 24832;
constexpr int CH_LA = 3, CH_NS = 4;
__device__ __forceinline__ void chain_piece(const MixP& p, int uid, int vs, int pc, char* slot, int lane) {
  if (pc < 8) __builtin_amdgcn_global_load_lds((const unsigned*)(p.b.rw_WpF + (long)uid * 4096 + pc * 512 + lane * 8), (unsigned*)(slot + pc * 1024 + lane * 16), 16, 0, 0);
  else if (pc < 16) __builtin_amdgcn_global_load_lds((const unsigned*)(p.b.rw_BtF + (long)uid * 4096 + (pc - 8) * 512 + lane * 8), (unsigned*)(slot + 8192 + (pc - 8) * 1024 + lane * 16), 16, 0, 0);
  else if (pc < 20) __builtin_amdgcn_global_load_lds((const unsigned*)(p.b.rw_U0F + ((long)uid * 4 + vs) * 1024 + (pc - 16) * 256 + lane * 4), (unsigned*)(slot + 16384 + (pc - 16) * 1024 + lane * 16), 16, 0, 0);
  else if (pc < 24) __builtin_amdgcn_global_load_lds((const unsigned*)(p.b.rw_KVF + ((long)uid * 4 + vs) * 1024 + (pc - 20) * 256 + lane * 4), (unsigned*)(slot + 20480 + (pc - 20) * 1024 + lane * 16), 16, 0, 0);
  else __builtin_amdgcn_global_load_lds((const unsigned*)(p.b.rw_gam + uid * 64 + lane), (unsigned*)(slot + 24576 + lane * 4), 4, 0, 0);
}
__device__ __forceinline__ void chain_issue(const MixP& p, int uid, int vs, char* slot, int w, int lane) {
#pragma unroll
  for (int i = 0; i < 4; ++i) { const int pc = (w - 1) + 7 * i; if (pc < 25) chain_piece(p, uid, vs, pc, slot, lane); }
}
typedef __attribute__((ext_vector_type(4))) unsigned u32x4;
__device__ __forceinline__ bf16x8 frag_of(unsigned a, unsigned b, unsigned c, unsigned d) { u32x4 v = {a, b, c, d}; return __builtin_bit_cast(bf16x8, v); }
__device__ __forceinline__ void p4_rwkv_chain(const MixP& p, int h, int vs, char* ring, int w, int lane) {
  const int r = lane & 15, g = lane >> 4, v = vs * 16 + r;
  const bool loader = w > 0; const int npc = (w >= 1 && w <= 4) ? 4 : 3;
  f32x4 ST[4];
#pragma unroll
  for (int kt = 0; kt < 4; ++kt) ST[kt] = (f32x4){0.f, 0.f, 0.f, 0.f};
  if (loader) { for (int c = 0; c < CH_LA; ++c) chain_issue(p, c * 8 + h, vs, ring + c * CH_SLOT, w, lane); }
#pragma unroll 1
  for (int c = 0; c < NCH; ++c) {
    const int uid = c * 8 + h; char* slot = ring + (c % CH_NS) * CH_SLOT;
    if (loader) {
      const int younger = (NCH - 1 - c < CH_LA - 1 ? NCH - 1 - c : CH_LA - 1);
      if (younger == 2) { if (npc == 4) asm volatile("s_waitcnt vmcnt(8)" ::: "memory"); else asm volatile("s_waitcnt vmcnt(6)" ::: "memory"); }
      else if (younger == 1) { if (npc == 4) asm volatile("s_waitcnt vmcnt(4)" ::: "memory"); else asm volatile("s_waitcnt vmcnt(3)" ::: "memory"); }
      else asm volatile("s_waitcnt vmcnt(0)" ::: "memory");
    }
    __builtin_amdgcn_s_barrier();
    if (loader) { if (c + CH_LA < NCH) chain_issue(p, (c + CH_LA) * 8 + h, vs, ring + ((c + CH_LA) % CH_NS) * CH_SLOT, w, lane); }
    else {
      unsigned ps[4][2];
#pragma unroll
      for (int kt = 0; kt < 4; ++kt) { ps[kt][0] = pack_bf16(ST[kt][0], ST[kt][1]); ps[kt][1] = pack_bf16(ST[kt][2], ST[kt][3]); }
      bf16x8 bS[2];
#pragma unroll
      for (int s = 0; s < 2; ++s) bS[s] = frag_of(ps[2 * s][0], ps[2 * s][1], ps[2 * s + 1][0], ps[2 * s + 1][1]);
#pragma unroll
      for (int kt = 0; kt < 4; ++kt) { uint2 pk; pk.x = ps[kt][0]; pk.y = ps[kt][1]; *(uint2*)(p.b.rw_S0 + (long)uid * 4096 + v * 64 + 16 * kt + 4 * g) = pk; }
      f32x4 U[4];
#pragma unroll
      for (int tt = 0; tt < 4; ++tt) {
        U[tt] = *(const f32x4*)(slot + 16384 + tt * 1024 + lane * 16);
#pragma unroll
        for (int s = 0; s < 2; ++s) { bf16x8 a = *(const bf16x8*)(slot + (tt * 2 + s) * 1024 + lane * 16); U[tt] = __builtin_amdgcn_mfma_f32_16x16x32_bf16(a, bS[s], U[tt], 0, 0, 0); }
      }
      unsigned pu[4][2];
#pragma unroll
      for (int tt = 0; tt < 4; ++tt) { pu[tt][0] = pack_bf16(U[tt][0], U[tt][1]); pu[tt][1] = pack_bf16(U[tt][2], U[tt][3]); }
      bf16x8 bU[2];
#pragma unroll
      for (int s = 0; s < 2; ++s) bU[s] = frag_of(pu[2 * s][0], pu[2 * s][1], pu[2 * s + 1][0], pu[2 * s + 1][1]);
#pragma unroll
      for (int tt = 0; tt < 4; ++tt) { uint2 pk; pk.x = pu[tt][0]; pk.y = pu[tt][1]; *(uint2*)(p.b.rw_UT + (long)uid * 4096 + v * 64 + 16 * tt + 4 * g) = pk; }
#pragma unroll
      for (int kt = 0; kt < 4; ++kt) {
        const f32x4 gm = *(const f32x4*)(slot + 24576 + (16 * kt + 4 * g) * 4); const f32x4 kv = *(const f32x4*)(slot + 20480 + kt * 1024 + lane * 16);
        f32x4 a4 = ST[kt] * gm + kv;
#pragma unroll
        for (int s = 0; s < 2; ++s) { bf16x8 a = *(const bf16x8*)(slot + 8192 + (kt * 2 + s) * 1024 + lane * 16); a4 = __builtin_amdgcn_mfma_f32_16x16x32_bf16(a, bU[s], a4, 0, 0, 0); }
        ST[kt] = a4;
      }
      asm volatile("s_waitcnt lgkmcnt(0)" ::: "memory");
    }
  }
}
__device__ __forceinline__ void p4_elem(const MixP& p, int e) {
  if (e < 32768) {
    const int h = e >> 12, vk = e & 4095; const float lg2 = log2f(1.f - exp2f(-(5.f + 4.f * (float)h / 7.f))); const float gm = exp2f(lg2 * 64.f);
    float S = 0.f;
#pragma unroll 1
    for (int c0 = 0; c0 < NCH; c0 += 16) {
      float kv[16];
#pragma unroll
      for (int i = 0; i < 16; ++i) kv[i] = p.b.rt_KVT[(long)((c0 + i) * 8 + h) * 4096 + vk];
      PIN8O(kv, 0); PIN8O(kv, 8);
#pragma unroll
      for (int i = 0; i < 16; ++i) { p.b.rt_S0[(long)((c0 + i) * 8 + h) * 4096 + vk] = f2bf(S); S = S * gm + kv[i]; }
    }
  } else {
    const int e2 = e - 32768, h = e2 >> 13, vk = e2 & 8191, k = vk & 63;
    float S = 0.f;
#pragma unroll 1
    for (int c0 = 0; c0 < NCH; c0 += 8) {
      float kv[8], gm[8];
#pragma unroll
      for (int i = 0; i < 8; ++i) { kv[i] = p.b.gl_KVT[(long)((c0 + i) * 4 + h) * 8192 + vk]; gm[i] = p.b.gl_gam[((c0 + i) * 4 + h) * 64 + k]; }
      PIN8x2(kv, gm);
#pragma unroll
      for (int i = 0; i < 8; ++i) { p.b.gl_S0[(long)((c0 + i) * 4 + h) * 8192 + vk] = f2bf(S); S = S * gm[i] + kv[i]; }
    }
  }
}
__device__ __forceinline__ void p4_lru(const MixP& p, int ch) {
  float H = 0.f;
#pragma unroll 1
  for (int c0 = 0; c0 < NCH; c0 += 8) {
    float a[8], b[8];
#pragma unroll
    for (int i = 0; i < 8; ++i) { long o = (long)((c0 + i) * 64 + 63) * 512 + ch; a[i] = p.b.lr_A[o]; b[i] = p.b.lr_h[o]; }
    PIN8x2(a, b);
#pragma unroll
    for (int i = 0; i < 8; ++i) { p.b.lr_Hp[(c0 + i) * 512 + ch] = H; H = a[i] * H + b[i]; }
  }
}

template <int NVT, bool DELTA, int NMT>
__device__ __forceinline__ void p5_mm(const u16* Rb, const u16* S0, const u16* Pak, const u16* VT, const u16* Pab, const u16* UT, int mt0, int r, int g, f32x4 (&acc)[NMT][4 * NVT]) {
#pragma unroll
  for (int mt = 0; mt < NMT; ++mt)
#pragma unroll
    for (int nt = 0; nt < 4 * NVT; ++nt) acc[mt][nt] = (f32x4){0.f, 0.f, 0.f, 0.f};
#pragma unroll 1
  for (int pr = 0; pr < (DELTA ? 3 : 2); ++pr) {
    const u16* A = pr == 0 ? Rb : (pr == 1 ? Pak : Pab); const u16* B = pr == 0 ? S0 : (pr == 1 ? VT : UT);
    bf16x8 af[NMT][2], bfr[4 * NVT][2];
#pragma unroll
    for (int s = 0; s < 2; ++s) {
#pragma unroll
      for (int mt = 0; mt < NMT; ++mt) af[mt][s] = *(const bf16x8*)(A + (16 * (mt0 + mt) + r) * 64 + 32 * s + 8 * g);
#pragma unroll
      for (int nt = 0; nt < 4 * NVT; ++nt) bfr[nt][s] = *(const bf16x8*)(B + (16 * nt + r) * 64 + 32 * s + 8 * g);
    }
#pragma unroll
    for (int s = 0; s < 2; ++s)
#pragma unroll
      for (int nt = 0; nt < 4 * NVT; ++nt)
#pragma unroll
        for (int mt = 0; mt < NMT; ++mt) acc[mt][nt] = __builtin_amdgcn_mfma_f32_16x16x32_bf16(bfr[nt][s], af[mt][s], acc[mt][nt], 0, 0, 0);
  }
}
__device__ __forceinline__ float red4g(float v) { v += __shfl_xor(v, 16, 64); v += __shfl_xor(v, 32, 64); return v; }
__device__ __forceinline__ f32x4 bf4(uint2 u) { return (f32x4){__uint_as_float(u.x << 16), __uint_as_float(u.x & 0xffff0000u), __uint_as_float(u.y << 16), __uint_as_float(u.y & 0xffff0000u)}; }
__device__ __forceinline__ void p5_rwkv(const MixP& p, int c, int h, int lane) {
  const int r = lane & 15, g = lane >> 4; const long uo = (long)(c * 8 + h) * 4096;
  f32x4 lg[4], lb[4];
#pragma unroll
  for (int nt = 0; nt < 4; ++nt) { lg[nt] = *(const f32x4*)(p.rw.ln_g + h * 64 + 16 * nt + 4 * g); lb[nt] = *(const f32x4*)(p.rw.ln_b + h * 64 + 16 * nt + 4 * g); }
#pragma unroll 1
  for (int mh = 0; mh < 2; ++mh) {
    f32x4 acc[2][4];
    p5_mm<1, true, 2>(p.b.rw_Rb + uo, p.b.rw_S0 + uo, p.b.rw_Pak + uo, p.b.rw_VT + uo, p.b.rw_Pab + uo, p.b.rw_UT + uo, mh * 2, r, g, acc);
#pragma unroll
    for (int mt = 0; mt < 2; ++mt) {
      const int t = c * 64 + 16 * (mh * 2 + mt) + r; const long o = (long)t * 512 + h * 64 + 4 * g;
      uint2 bv[4], gg[4];
#pragma unroll
      for (int nt = 0; nt < 4; ++nt) { bv[nt] = *(const uint2*)(p.b.rw_BV + o + 16 * nt); gg[nt] = *(const uint2*)(p.b.rw_G + o + 16 * nt); }
      float s1 = 0.f;
#pragma unroll
      for (int nt = 0; nt < 4; ++nt) s1 += acc[mt][nt][0] + acc[mt][nt][1] + acc[mt][nt][2] + acc[mt][nt][3];
      const float mean = red4g(s1) * (1.f / 64.f);
      float s2 = 0.f;
#pragma unroll
      for (int nt = 0; nt < 4; ++nt)
#pragma unroll
        for (int j = 0; j < 4; ++j) { const float d = acc[mt][nt][j] - mean; s2 += d * d; }
      const float rs = rsqrtf(red4g(s2) * (1.f / 64.f) + 64e-5f);
#pragma unroll
      for (int nt = 0; nt < 4; ++nt) {
        const f32x4 yn = (acc[mt][nt] - mean) * rs * lg[nt] + lb[nt];
        *(uint2*)(p.ycat + (long)t * DM + h * 64 + 16 * nt + 4 * g) = pack4((yn + bf4(bv[nt])) * bf4(gg[nt]));
      }
    }
  }
}
__device__ __forceinline__ void p5_ret(const MixP& p, int c, int h, int lane) {
  const int r = lane & 15, g = lane >> 4; const long uo = (long)(c * 8 + h) * 4096;
  f32x4 ng[4];
#pragma unroll
  for (int nt = 0; nt < 4; ++nt) ng[nt] = *(const f32x4*)(p.ret_norm_g + h * 64 + 16 * nt + 4 * g);
#pragma unroll 1
  for (int mh = 0; mh < 2; ++mh) {
    f32x4 acc[2][4];
    p5_mm<1, false, 2>(p.b.rt_Rb + uo, p.b.rt_S0 + uo, p.b.rt_Pak + uo, p.b.rt_VT + uo, nullptr, nullptr, mh * 2, r, g, acc);
#pragma unroll
    for (int mt = 0; mt < 2; ++mt) {
      const int t = c * 64 + 16 * (mh * 2 + mt) + r;
      uint2 gt2[4];
#pragma unroll
      for (int nt = 0; nt < 4; ++nt) gt2[nt] = *(const uint2*)(p.proj + (long)t * PC + OFF_B + 1536 + h * 64 + 16 * nt + 4 * g);
      float s2 = 0.f;
#pragma unroll
      for (int nt = 0; nt < 4; ++nt)
#pragma unroll
        for (int j = 0; j < 4; ++j) s2 += acc[mt][nt][j] * acc[mt][nt][j];
      const float rs = rsqrtf(red4g(s2) * (1.f / 64.f) + 1e-6f);
#pragma unroll
      for (int nt = 0; nt < 4; ++nt) {
        const f32x4 gt = bf4(gt2[nt]); f32x4 o;
#pragma unroll
        for (int j = 0; j < 4; ++j) o[j] = acc[mt][nt][j] * rs * ng[nt][j] * gt[j] * sigmoidf_(gt[j]);
        *(uint2*)(p.ycat + (long)t * DM + 512 + h * 64 + 16 * nt + 4 * g) = pack4(o);
      }
    }
  }
}
__device__ __forceinline__ void p5_gla(const MixP& p, int c, int h, int lane) {
  const int r = lane & 15, g = lane >> 4; const int uid = c * 4 + h;
  f32x4 ng[8];
#pragma unroll
  for (int nt = 0; nt < 8; ++nt) ng[nt] = *(const f32x4*)(p.gla_norm_g + h * 128 + 16 * nt + 4 * g);
#pragma unroll 1
  for (int mq = 0; mq < 4; ++mq) {
    f32x4 acc[1][8];
    p5_mm<2, false, 1>(p.b.gl_Rb + (long)uid * 4096, p.b.gl_S0 + (long)uid * 8192, p.b.gl_Pak + (long)uid * 4096, p.b.gl_VT + (long)uid * 8192, nullptr, nullptr, mq, r, g, acc);
    const int t = c * 64 + 16 * mq + r;
    uint2 gt2[8];
#pragma unroll
    for (int nt = 0; nt < 8; ++nt) gt2[nt] = *(const uint2*)(p.proj + (long)t * PC + OFF_D + 1040 + h * 128 + 16 * nt + 4 * g);
    float s2 = 0.f;
#pragma unroll
    for (int nt = 0; nt < 8; ++nt)
#pragma unroll
      for (int j = 0; j < 4; ++j) s2 += acc[0][nt][j] * acc[0][nt][j];
    const float rs = rsqrtf(red4g(s2) * (1.f / 128.f) + 1e-6f);
#pragma unroll
    for (int nt = 0; nt < 8; ++nt) {
      const f32x4 gt = bf4(gt2[nt]); f32x4 o;
#pragma unroll
      for (int j = 0; j < 4; ++j) o[j] = acc[0][nt][j] * rs * ng[nt][j] * gt[j] * sigmoidf_(gt[j]);
      *(uint2*)(p.ycat + (long)t * DM + 1536 + h * 128 + 16 * nt + 4 * g) = pack4(o);
    }
  }
}
__device__ __forceinline__ void p5_lru8(const MixP& p, long idx0, long stride) {
  float hv[8], av[8], hp[8]; u16 gb[8];
#pragma unroll
  for (int q = 0; q < 8; ++q) { const long idx = idx0 + q * stride; const int t = (int)(idx >> 9), ch = (int)(idx & 511), c = t >> 6;
    hv[q] = p.b.lr_h[idx]; av[q] = p.b.lr_A[idx]; hp[q] = p.b.lr_Hp[c * 512 + ch]; gb[q] = p.proj[(long)t * PC + OFF_C + 512 + ch]; }
      asm volatile("" ::: "memory");
#pragma unroll
  for (int q = 0; q < 8; ++q) { const long idx = idx0 + q * stride; const int t = (int)(idx >> 9), ch = (int)(idx & 511);
    p.ycat[(long)t * DM + 1024 + ch] = f2bf((hv[q] + av[q] * hp[q]) * gelu_tanh(bf2f(gb[q]))); }
}
__device__ __forceinline__ void phase_mix3(const MixP& p, char* smem) {
  for (int u = blockIdx.x; u < 3584; u += gridDim.x) {
    if (u < 1024) p3_rwkv(p, u >> 3, u & 7, smem);
    else if (u < 2048) p3_ret(p, (u - 1024) >> 3, (u - 1024) & 7, smem);
    else if (u < 2560) p3_gla(p, (u - 2048) >> 2, (u - 2048) & 3, smem);
    else p3_lru(p, (u - 2560) >> 3, (u - 2560) & 7, smem);
  }
}
__device__ __forceinline__ void phase_mix4(const MixP& p, char* smem) {
  int tid = threadIdx.x; asm volatile("" : "+v"(tid));
#pragma unroll 1
  for (int b = blockIdx.x; b < 256; b += gridDim.x) {
    if (b < 32) p4_rwkv_chain(p, b >> 2, b & 3, smem, __builtin_amdgcn_readfirstlane(tid >> 6), tid & 63);
    else if (b >= 64 && b < 192) p4_elem(p, (b - 64) * 512 + tid);
    else if (b == 200) p4_lru(p, tid);
    __syncthreads();
  }
}
__device__ __forceinline__ void phase_mix5(const MixP& p) {
  int tid = threadIdx.x; asm volatile("" : "+v"(tid));
  const int wave = blockIdx.x * 8 + (tid >> 6), nw = gridDim.x * 8, lane = tid & 63;
  for (int u = wave; u < 2560; u += nw) {
    if (u < 512) p5_gla(p, u >> 2, u & 3, lane);
    else if (u < 1536) p5_rwkv(p, (u - 512) >> 3, (u - 512) & 7, lane);
    else p5_ret(p, (u - 1536) >> 3, (u - 1536) & 7, lane);
  }
  { const long nthr = (long)gridDim.x * 512;
    long idx = (long)blockIdx.x * 512 + tid;
    for (; idx + 7 * nthr < (long)T_ * 512; idx += 8 * nthr) p5_lru8(p, idx, nthr);
    for (; idx < (long)T_ * 512; idx += nthr) {
      const int t = (int)(idx >> 9), ch = (int)(idx & 511), c = t >> 6;
      p.ycat[(long)t * DM + 1024 + ch] = f2bf((p.b.lr_h[idx] + p.b.lr_A[idx] * p.b.lr_Hp[c * 512 + ch]) * gelu_tanh(bf2f(p.proj[(long)t * PC + OFF_C + 512 + ch]))); } }
}

#define XB_TMO      128
#define XB_XCNT(j)  (256  + 64 * (j))
#define XB_XSUB(j)  (1280 + 64 * (j))
#define XB_XGEN(j)  (2304 + 64 * (j))
#define XB_TOP      3328
#define XB_TOPGEN   3392
#define XCD_BAR_WORDS 3456
#define XB_SPIN_CAP (1u << 18)
__device__ __forceinline__ unsigned xb_ld(unsigned* p)              { return __hip_atomic_load(p, __ATOMIC_RELAXED, __HIP_MEMORY_SCOPE_AGENT); }
__device__ __forceinline__ unsigned xb_add(unsigned* p, unsigned v) { return __hip_atomic_fetch_add(p, v, __ATOMIC_RELAXED, __HIP_MEMORY_SCOPE_AGENT); }
__device__ __forceinline__ unsigned xb_xcc_id() { return (unsigned)__builtin_amdgcn_s_getreg((3 << 11) | 20) & 0xFu; }
#define XB_SPIN(cond, bar) do { unsigned _sp = 0; while (cond) { __builtin_amdgcn_s_sleep(1); \
    if ((++_sp & 255u) == 0u) { if (xb_ld(&(bar)[XB_TMO])) break; if (_sp > XB_SPIN_CAP) { atomicAdd(&(bar)[XB_TMO], 1u); break; } } } } while (0)
struct XcdBarrier { unsigned* bar; unsigned x; volatile LAS unsigned* st; };
__device__ __forceinline__ XcdBarrier xcd_barrier_post(unsigned* bar, volatile LAS unsigned* st) {
    XcdBarrier b; b.bar = bar; b.x = xb_xcc_id(); b.st = st;
    if (threadIdx.x == 0) (void)xb_add(&bar[XB_XCNT(b.x)], 1u);
    return b;
}
__device__ __forceinline__ void xcd_barrier_complete(unsigned* bar, unsigned x, unsigned& nloc, unsigned& nx) {
    const unsigned G = gridDim.x * gridDim.y * gridDim.z;
    unsigned sum, cnt, mine, sp = 0u;
    for (;;) {
        sum = 0u; cnt = 0u; mine = 0u;
#pragma unroll
        for (unsigned j = 0; j < 16; ++j) { const unsigned c = xb_ld(&bar[XB_XCNT(j)]); sum += c; cnt += (c > 0u) ? 1u : 0u; mine = (j == x) ? c : mine; }
        if (sum == G) break;
        __builtin_amdgcn_s_sleep(1);
        if ((++sp & 255u) == 0u) { if (xb_ld(&bar[XB_TMO])) break; if (sp > XB_SPIN_CAP) { atomicAdd(&bar[XB_TMO], 1u); break; } }
    }
    nloc = mine > 0u ? mine : 1u; nx = cnt > 0u ? cnt : 1u;
}
__device__ __forceinline__ void xcd_barrier(const XcdBarrier& b) {
    asm volatile("s_waitcnt vmcnt(0)" ::: "memory");
    __syncthreads();
    if (threadIdx.x == 0) {
        unsigned* bar = b.bar;
        __builtin_amdgcn_s_waitcnt(0);
        unsigned nloc = b.st[0], nx = b.st[1];
        if (nloc == 0u) { xcd_barrier_complete(bar, b.x, nloc, nx); b.st[0] = nloc; b.st[1] = nx; }
        const unsigned old = xb_add(&bar[XB_XSUB(b.x)], 1u);
        const unsigned gen = old / nloc;
        if (old + 1u == (gen + 1u) * nloc) {
            __builtin_amdgcn_fence(__ATOMIC_RELEASE, "agent");
            asm volatile("s_waitcnt vmcnt(0)" ::: "memory");
            const unsigned og = xb_add(&bar[XB_TOP], 1u);
            const unsigned tg = og / nx;
            if (og + 1u == (tg + 1u) * nx) xb_add(&bar[XB_TOPGEN], 1u);
            else XB_SPIN(xb_ld(&bar[XB_TOPGEN]) == tg, bar);
            __builtin_amdgcn_fence(__ATOMIC_ACQUIRE, "agent");
            xb_add(&bar[XB_XGEN(b.x)], 1u);
            asm volatile("s_waitcnt vmcnt(0)" ::: "memory");
        } else {
            XB_SPIN(xb_ld(&bar[XB_XGEN(b.x)]) == gen, bar);
            __builtin_amdgcn_fence(__ATOMIC_ACQUIRE, "agent");
            asm volatile("s_waitcnt vmcnt(0)" ::: "memory");
        }
    }
    __syncthreads();
}

__device__ __forceinline__ void xcd_barrier_l(const XcdBarrier& b) {
    asm volatile("s_waitcnt vmcnt(0)" ::: "memory");
    __syncthreads();
    if (threadIdx.x == 0) {
        unsigned* bar = b.bar; unsigned x = b.x;
        { unsigned long long _z = 0; asm volatile("" : "+s"(_z), "+s"(x)); bar = (unsigned*)(unsigned __attribute__((address_space(1)))*)((unsigned long long)bar + _z); }
        __builtin_amdgcn_s_waitcnt(0);
        const unsigned nloc = b.st[0], nx = b.st[1];
        const unsigned old = xb_add(&bar[XB_XSUB(x)], 1u);
        const unsigned gen = old / nloc;
        if (old + 1u == (gen + 1u) * nloc) {
            __builtin_amdgcn_fence(__ATOMIC_RELEASE, "agent");
            asm volatile("s_waitcnt vmcnt(0)" ::: "memory");
            const unsigned og = xb_add(&bar[XB_TOP], 1u);
            const unsigned tg = og / nx;
            if (og + 1u == (tg + 1u) * nx) xb_add(&bar[XB_TOPGEN], 1u);
            else XB_SPIN(xb_ld(&bar[XB_TOPGEN]) == tg, bar);
            __builtin_amdgcn_fence(__ATOMIC_ACQUIRE, "agent");
            xb_add(&bar[XB_XGEN(x)], 1u);
            asm volatile("s_waitcnt vmcnt(0)" ::: "memory");
        } else {
            XB_SPIN(xb_ld(&bar[XB_XGEN(x)]) == gen, bar);
            __builtin_amdgcn_fence(__ATOMIC_ACQUIRE, "agent");
            asm volatile("s_waitcnt vmcnt(0)" ::: "memory");
        }
    }
    __syncthreads();
}

__device__ __forceinline__ void phase_convert(char* ws, char* smem) {
  OPAQUE_WS(ws); int tid = threadIdx.x; asm volatile("" : "+v"(tid));
  const int lane = tid & 63, G = gridDim.x * 8, b0 = blockIdx.x * 8 + __builtin_amdgcn_readfirstlane(tid >> 6);
#pragma unroll 1
  for (int j = b0; j < 2 * (32768 - CV_SOLVE); j += G) { const int l = j / (32768 - CV_SOLVE), t = CV_SOLVE + j % (32768 - CV_SOLVE); moe_tile(ws, smem, l, t, lane); }
  { float* rot = wsp<float>(ws, WS::ROT); const int* pos = (const int*)in_ptr(smem, 1);
#pragma unroll 1
    for (int i = blockIdx.x * 512 + tid; i < T_ * 32; i += gridDim.x * 512) {
      const int t = i >> 5, j = i & 31; const float inv = exp2f(-(float)j * (13.287712379549449f / 32.f));
      float sn, cs; sincosf((float)pos[t] * inv, &sn, &cs); rot[2 * i] = cs; rot[2 * i + 1] = sn;
    } }
  { u16* wt = wsp<u16>(ws, WS::LRU_W);
#pragma unroll 1
    for (int i = blockIdx.x * 512 + tid; i < NL * 2 * 8 * 4096; i += gridDim.x * 512) {
      const int l = i / (2 * 8 * 4096), r = i % (2 * 8 * 4096), m = r / (8 * 4096), g = (r / 4096) & 7, jj = (r >> 6) & 63, ii = r & 63;
      wt[i] = f2bf(in_ptr(smem, m ? 22 : 20)[(((long)l * 8 + g) * 64 + ii) * 64 + jj]);
    } }
  { u16* wl = wsp<u16>(ws, WS::LORA_W);
#pragma unroll 1
    for (int i = blockIdx.x * 512 + tid; i < NL * 512 * 160; i += gridDim.x * 512) {
      const int l = i / (512 * 160), r = i % (512 * 160), c = r / 160, j = r % 160;
      const float v = j < 32 ? in_ptr(smem, 6)[((long)l * 32 + j) * 512 + c] : (j < 64 ? in_ptr(smem, 8)[((long)l * 32 + (j - 32)) * 512 + c] : in_ptr(smem, 9)[((long)l * 96 + (j - 64)) * 512 + c]);
      wl[i] = f2bf(v);
    } }
  { u16* thi = wsp<u16>(ws, WS::RT_HI); u16* tlo = wsp<u16>(ws, WS::RT_LO);
#pragma unroll 1
    for (int i = blockIdx.x * 512 + tid; i < NL * 48 * 2048; i += gridDim.x * 512) {
      const int l = i / (48 * 2048), r = i % (48 * 2048), c = r >> 11, k = r & 2047;
      float v = 0.f;
      if (c < 36) { const float g = in_ptr(smem, 31)[(long)l * DM + k]; v = g * (c < 4 ? in_ptr(smem, 32)[((long)l * DM + k) * 4 + c] : in_ptr(smem, 34)[((long)l * DM + k) * 32 + (c - 4)]); }
      const u16 hi = f2bf(v); thi[i] = hi; tlo[i] = f2bf(v - bf2f(hi));
    } }
#pragma unroll 1
  for (int j = b0; j < 2 * 100 * 32; j += G) { const int l = j / 3200, q = j % 3200, nt = q / 32, kt = q % 32;
    transpose_tile_w(in_ptr(smem, 3) + (long)l * DM * IN_COLS, IN_COLS, NONGATE, wsp<u16>(ws, WS::WT_IN) + (long)l * PC * DM, DM, nt * 64, kt * 64, 0, 0, lane); }
#pragma unroll 1
  for (int j = b0; j < 2 * 128 * 32; j += G) { const int l = j / 4096, q = j % 4096, nt = q / 32, kt = q % 32;
    transpose_tile_w(in_ptr(smem, 3) + (long)l * DM * IN_COLS + NONGATE, IN_COLS, 8192, wsp<u16>(ws, WS::WT_IN) + (long)l * PC * DM, DM, nt * 64, kt * 64, OFF_G, 0, lane); }
#pragma unroll 1
  for (int j = b0; j < 8 * 256; j += G) { const int lk = j / 256, q = j % 256, l = lk >> 2, kb = lk & 3, nt = q / 8, kt = q % 8;
    const float* src = in_ptr(smem, kb == 0 ? 15 : kb == 1 ? 17 : kb == 2 ? 25 : 29) + (long)l * MIXW * DM;
    transpose_tile_w(src, DM, DM, wsp<u16>(ws, WS::WT_O) + (long)l * DM * DM + kb * MIXW, DM, nt * 64, kt * 64, 0, 0, lane); }
#pragma unroll 1
  for (int j = b0; j < 2 * 1024; j += G) { const int l = j / 1024, q = j % 1024, nt = q / 32, kt = q % 32;
    transpose_tile_w(in_ptr(smem, 30) + (long)l * DM * DM, DM, DM, wsp<u16>(ws, WS::WT_OUT) + (long)l * DM * DM, DM, nt * 64, kt * 64, 0, 0, lane); }
}

__device__ __forceinline__ void convert_down(char* ws, const char* smem, int l, int wave, int nwaves, int lane) {
  const float* src = in_ptr(smem, 38) + (long)l * NEXP * DEXP * DM; u16* dst = wsp<u16>(ws, WS::WDN) + (long)l * NEXP * DM * DEXP;
#pragma unroll 1
  for (int j = wave; j < 32 * 512; j += nwaves) { const int e = j / 512, q = j % 512, nt = q / 16, kt = q % 16;
    transpose_tile_w(src + (long)e * DEXP * DM, DM, DM, dst + (long)e * DM * DEXP, DEXP, nt * 64, kt * 64, 0, 0, lane); }
}
struct NormArgs {
  const float* x; float* h; const float* g; u16* xn; float* out; const float* ybuf;
  const float* wg; const float* bg; const float* we; const float* be; int* tok_e; float* tok_g;
};
template <int MODE>
__device__ __forceinline__ void norm_row(const NormArgs& a, int row, int lane) {
  float v[32];
  const float* src = (MODE == 0) ? a.x : a.h;
#pragma unroll
  for (int i = 0; i < 8; ++i) {
    f32x4 t = *(const f32x4*)(src + (long)row * DM + i * 256 + lane * 4);
    if (MODE == 1 || MODE == 2) {
      f32x4 y0 = *(const f32x4*)(a.ybuf + (long)(2 * row) * DM + i * 256 + lane * 4);
      f32x4 y1 = *(const f32x4*)(a.ybuf + (long)(2 * row + 1) * DM + i * 256 + lane * 4);
      t = t + y0 + y1;
    }
    if (MODE != 3 && MODE != 2) *(f32x4*)(a.h + (long)row * DM + i * 256 + lane * 4) = t;
    v[i * 4 + 0] = t[0]; v[i * 4 + 1] = t[1]; v[i * 4 + 2] = t[2]; v[i * 4 + 3] = t[3];
  }
  float ss = 0.f;
#pragma unroll
  for (int i = 0; i < 32; ++i) ss += v[i] * v[i];
  ss = wave_sum(ss);
  const float rs = rsqrtf(ss * (1.f / DM) + 1e-6f);
  f32x4 gv8[8];
#pragma unroll
  for (int i = 0; i < 8; ++i) gv8[i] = *(const f32x4*)(a.g + i * 256 + lane * 4);
  PIN8(gv8);
#pragma unroll
  for (int i = 0; i < 8; ++i) {
    const f32x4 g = gv8[i];
#pragma unroll
    for (int j = 0; j < 4; ++j) v[i * 4 + j] = v[i * 4 + j] * rs * g[j];
    if (MODE == 2) {
      f32x4 o = {v[i * 4], v[i * 4 + 1], v[i * 4 + 2], v[i * 4 + 3]};
      *(f32x4*)(a.out + (long)row * DM + i * 256 + lane * 4) = o;
    } else {
      uint2 pk;
      pk.x = (unsigned)f2bf(v[i * 4]) | ((unsigned)f2bf(v[i * 4 + 1]) << 16);
      pk.y = (unsigned)f2bf(v[i * 4 + 2]) | ((unsigned)f2bf(v[i * 4 + 3]) << 16);
      *(uint2*)(a.xn + (long)row * DM + i * 256 + lane * 4) = pk;
    }
  }
}
template <int MODE>
__device__ __forceinline__ void phase_norm(const NormArgs& a) {
  int tid = threadIdx.x; asm volatile("" : "+v"(tid));
  const int lane = tid & 63;
  for (int row = blockIdx.x * 8 + (tid >> 6); row < T_; row += gridDim.x * 8) norm_row<MODE>(a, row, lane);
}

__device__ __forceinline__ void router_job(const NormArgs& a, const u16* __restrict__ thi, const u16* __restrict__ tlo, int job, char* smem, int tid, int* cnt, int* lst_slot, float* lst_gate) {
  const int w = __builtin_amdgcn_readfirstlane(tid >> 6), lane = tid & 63, r = lane & 15, g = lane >> 4, t0 = job * 64;
  float* part = (float*)smem;
  float* pss = part + 8 * 64 * 48;
  {
    f32x4 acc[4][3];
#pragma unroll
    for (int mt = 0; mt < 4; ++mt)
#pragma unroll
      for (int nt = 0; nt < 3; ++nt) acc[mt][nt] = (f32x4){0.f, 0.f, 0.f, 0.f};
    float ssq[4] = {0.f, 0.f, 0.f, 0.f};
    const float* hb = a.h + (long)(t0 + r) * DM + w * 256 + 8 * g;
    const u16* bh = thi + (long)r * 2048 + w * 256 + 8 * g; const u16* bl = tlo + (long)r * 2048 + w * 256 + 8 * g;
#pragma unroll 2
    for (int s_ = 0; s_ < 8; ++s_) {
      f32x4 x0[4], x1[4]; bf16x8 wh[3], wl[3];
#pragma unroll
      for (int mt = 0; mt < 4; ++mt) { x0[mt] = *(const f32x4*)(hb + (long)(16 * mt) * DM + 32 * s_); x1[mt] = *(const f32x4*)(hb + (long)(16 * mt) * DM + 32 * s_ + 4); }
#pragma unroll
      for (int nt = 0; nt < 3; ++nt) { wh[nt] = *(const bf16x8*)(bh + (long)(16 * nt) * 2048 + 32 * s_); wl[nt] = *(const bf16x8*)(bl + (long)(16 * nt) * 2048 + 32 * s_); }
#pragma unroll
      for (int mt = 0; mt < 4; ++mt) {
        const f32x4 a0 = x0[mt], a1 = x1[mt];
        ssq[mt] += a0[0] * a0[0] + a0[1] * a0[1] + a0[2] * a0[2] + a0[3] * a0[3] + a1[0] * a1[0] + a1[1] * a1[1] + a1[2] * a1[2] + a1[3] * a1[3];
        const unsigned h0 = pack_bf16(a0[0], a0[1]), h1 = pack_bf16(a0[2], a0[3]), h2 = pack_bf16(a1[0], a1[1]), h3 = pack_bf16(a1[2], a1[3]);
        const unsigned l0 = pack_bf16(a0[0] - __uint_as_float(h0 << 16), a0[1] - __uint_as_float(h0 & 0xffff0000u)), l1 = pack_bf16(a0[2] - __uint_as_float(h1 << 16), a0[3] - __uint_as_float(h1 & 0xffff0000u));
        const unsigned l2 = pack_bf16(a1[0] - __uint_as_float(h2 << 16), a1[1] - __uint_as_float(h2 & 0xffff0000u)), l3 = pack_bf16(a1[2] - __uint_as_float(h3 << 16), a1[3] - __uint_as_float(h3 & 0xffff0000u));
        const bf16x8 xh = frag_of(h0, h1, h2, h3), xl = frag_of(l0, l1, l2, l3);
#pragma unroll
        for (int nt = 0; nt < 3; ++nt) {
          acc[mt][nt] = __builtin_amdgcn_mfma_f32_16x16x32_bf16(xh, wh[nt], acc[mt][nt], 0, 0, 0);
          acc[mt][nt] = __builtin_amdgcn_mfma_f32_16x16x32_bf16(xh, wl[nt], acc[mt][nt], 0, 0, 0);
          acc[mt][nt] = __builtin_amdgcn_mfma_f32_16x16x32_bf16(xl, wh[nt], acc[mt][nt], 0, 0, 0);
        }
      }
    }
#pragma unroll
    for (int mt = 0; mt < 4; ++mt)
#pragma unroll
      for (int nt = 0; nt < 3; ++nt)
#pragma unroll
        for (int reg = 0; reg < 4; ++reg) part[(w * 64 + 16 * mt + 4 * g + reg) * 48 + 16 * nt + r] = acc[mt][nt][reg];
#pragma unroll
    for (int mt = 0; mt < 4; ++mt) { float v = ssq[mt]; v += __shfl_xor(v, 16, 64); v += __shfl_xor(v, 32, 64); if (g == 0) pss[w * 64 + 16 * mt + r] = v; }
  }
  lds_barrier();
  if (tid < 64) {
    const int tl = tid, t = t0 + tl;
    float lgt[36]; float ss = 0.f;
#pragma unroll
    for (int c = 0; c < 36; ++c) lgt[c] = 0.f;
#pragma unroll 1
    for (int q = 0; q < 8; ++q) {
#pragma unroll
      for (int c = 0; c < 36; ++c) lgt[c] += part[(q * 64 + tl) * 48 + c];
      ss += pss[q * 64 + tl];
    }
    const float rs = rsqrtf(ss * (1.f / DM) + 1e-6f);
    f32x4 bgv = *(const f32x4*)a.bg, bev[8];
#pragma unroll
    for (int q = 0; q < 8; ++q) bev[q] = *(const f32x4*)(a.be + 4 * q);
    asm volatile("" :: "v"(bgv), "v"(bev[0]), "v"(bev[1]), "v"(bev[2]), "v"(bev[3]), "v"(bev[4]), "v"(bev[5]), "v"(bev[6]), "v"(bev[7]));
    float lg[4];
#pragma unroll
    for (int c = 0; c < 4; ++c) lg[c] = lgt[c] * rs + bgv[c];
    int gi = 0; float gm = lg[0];
#pragma unroll
    for (int c = 1; c < 4; ++c) if (lg[c] > gm) { gm = lg[c]; gi = c; }
    float gs = 0.f;
#pragma unroll
    for (int c = 0; c < 4; ++c) gs += __expf(lg[c] - gm);
    const float pg = 1.f / gs;
    float le[8];
#pragma unroll
    for (int j = 0; j < 8; ++j) {
      const float l0 = lgt[4 + j] * rs + bev[j >> 2][j & 3], l1 = lgt[12 + j] * rs + bev[2 + (j >> 2)][j & 3], l2 = lgt[20 + j] * rs + bev[4 + (j >> 2)][j & 3], l3 = lgt[28 + j] * rs + bev[6 + (j >> 2)][j & 3];
      le[j] = gi == 0 ? l0 : (gi == 1 ? l1 : (gi == 2 ? l2 : l3));
    }
    int i1 = 0; float m1 = le[0];
#pragma unroll
    for (int j = 1; j < 8; ++j) if (le[j] > m1) { m1 = le[j]; i1 = j; }
    int i2 = -1; float m2 = -3.0e38f;
#pragma unroll
    for (int j = 0; j < 8; ++j) if (j != i1 && le[j] > m2) { m2 = le[j]; i2 = j; }
    const float w1 = 1.f / (1.f + __expf(m2 - m1)), w2 = 1.f - w1;
    if (i2 < 0) i2 = (i1 + 1) & 7;
    const int e0 = gi * 8 + i1, e1 = gi * 8 + i2;
    const int p0 = atomicAdd(cnt + e0, 1) & (LCAP - 1), p1 = atomicAdd(cnt + e1, 1) & (LCAP - 1);
    lst_slot[e0 * LCAP + p0] = 2 * t; lst_gate[e0 * LCAP + p0] = pg * w1;
    lst_slot[e1 * LCAP + p1] = 2 * t + 1; lst_gate[e1 * LCAP + p1] = pg * w2;
  }
  lds_barrier();
}
__device__ __forceinline__ void phase_n3(char* ws, const NormArgs& a, char* smem, int l) {
  OPAQUE_WS(ws);
  int tid = threadIdx.x; asm volatile("" : "+v"(tid));
  int* cnt = wsp<int>(ws, WS::TILE_EXP); int* lst_slot = wsp<int>(ws, WS::LST_SLOT); float* lst_gate = wsp<float>(ws, WS::LST_GATE);
#pragma unroll 1
  for (int job = blockIdx.x; job < 256; job += gridDim.x) {
    if (job < 128) router_job(a, wsp<u16>(ws, WS::RT_HI) + (long)l * 48 * 2048, wsp<u16>(ws, WS::RT_LO) + (long)l * 48 * 2048, job, smem, tid, cnt, lst_slot, lst_gate);
    else { const int r0 = (job - 128) * 64 + (tid >> 6) * 8;
#pragma unroll 1
      for (int i = 0; i < 8; ++i) norm_row<3>(a, r0 + i, tid & 63); }
  }
}
__device__ __forceinline__ void moe_tiles(char* ws, int* tstart, int tid) {
  const int* cnt = wsp<int>(ws, WS::TILE_EXP);
  if (tid < 32) {
    int acc = 0;
#pragma unroll 1
    for (int e2 = 0; e2 < tid; ++e2) acc += (ld_i(cnt + e2) + 255) >> 8;
    const int c = ld_i(cnt + tid);
    tstart[tid] = acc; tstart[40 + tid] = c;
    if (tid == 31) tstart[32] = acc + ((c + 255) >> 8);
  }
  __syncthreads();
}

template <int MODE>
__device__ __forceinline__ void phase_gemm(char* ws, int l, u16* shm) {
  OPAQUE_WS(ws);
  if (MODE == 0) {
    const u16* Bt = wsp<u16>(ws, WS::WT_IN) + (long)l * PC * DM; const u16* xn = wsp<u16>(ws, WS::XN); u16* proj = wsp<u16>(ws, WS::PROJ);
#pragma unroll 1
    for (int u = blockIdx.x; u < ((PC / 256 + 7) / 8) * 256; u += gridDim.x) {
      int pm, pn; unit_map(u & 255, u >> 8, pm, pn);
      if (pn >= PC / 256) continue;
      EpiProj e{proj, pm * 256, pn * 256};
      gemm256(xn + (long)pm * 256 * DM, DM, Bt + (long)pn * 256 * DM, DM, DM, shm, e);
    }
  } else if (MODE == 1) {
    const u16* Bt = wsp<u16>(ws, WS::WT_O) + (long)l * DM * DM; const u16* ycat = wsp<u16>(ws, WS::YCAT);
    const u16* gates = wsp<u16>(ws, WS::PROJ) + OFF_G; u16* merged = wsp<u16>(ws, WS::MERGED);
#pragma unroll 1
    for (int u = blockIdx.x; u < 512; u += gridDim.x) {
      int pm, pn2; unit_map(u & 255, 0, pm, pn2);
      const int pn = pn2 * 2 + (u >> 8);
      gemm_merge(ycat, Bt, gates, merged, pm * 256, pn * 128, shm);
    }
  } else if (MODE == 2) {
    const u16* Bt = wsp<u16>(ws, WS::WT_OUT) + (long)l * DM * DM; const u16* merged = wsp<u16>(ws, WS::MERGED);
#pragma unroll 1
    for (int u = blockIdx.x; u < 256; u += gridDim.x) {
      int pm, pn; unit_map(u, 0, pm, pn);
      EpiResid e{wsp<float>(ws, WS::H), pm * 256, pn * 256};
      gemm256(merged + (long)pm * 256 * DM, DM, Bt + (long)pn * 256 * DM, DM, DM, shm, e);
    }
  } else if (MODE == 3) {
    int tid = threadIdx.x; asm volatile("" : "+v"(tid));
    int* tstart = (int*)((char*)shm + SHM_B); moe_tiles(ws, tstart, tid);
    const int nu = tstart[32] * 8; const u16* Bt = wsp<u16>(ws, WS::WGU) + (long)l * NEXP * 2048 * DM; const u16* xn = wsp<u16>(ws, WS::XN);
    const int* lst_slot = wsp<int>(ws, WS::LST_SLOT);
#pragma unroll 1
    for (int u = blockIdx.x; u < nu; u += gridDim.x) {
      const int rt = u >> 3, ct = u & 7; int ex = 0;
#pragma unroll 1
      while (rt >= tstart[ex + 1]) ++ex;
      const int rtl = rt - tstart[ex], nvalid = tstart[40 + ex] - rtl * 256;
      int arow[4];
#pragma unroll
      for (int i = 0; i < 2; ++i) { int r_, c_; stage_rc(tid * 16 + i * 8192, r_, c_);
#pragma unroll
        for (int hf = 0; hf < 2; ++hf) { const int r = hf * HALF + r_; arow[hf * 2 + i] = (r < nvalid ? (lst_slot[ex * LCAP + rtl * 256 + r] >> 1) : 0) * (DM * 2) + c_ * 2; } }
      EpiGateUp e{wsp<u16>(ws, WS::HMID), rt * 256, ct};
      gemm256g<true>(xn, DM, Bt + ((long)ex * 2048 + ct * 256) * DM, DM, DM, shm, e, arow);
    }
  } else {
    int tid = threadIdx.x; asm volatile("" : "+v"(tid));
    int* tstart = (int*)((char*)shm + SHM_B); moe_tiles(ws, tstart, tid);
    const int nu = tstart[32] * 8; const u16* Bt = wsp<u16>(ws, WS::WDN) + (long)l * NEXP * DM * DEXP; const u16* hmid = wsp<u16>(ws, WS::HMID);
#pragma unroll 1
    for (int u = blockIdx.x; u < nu; u += gridDim.x) {
      const int rt = u >> 3, ct = u & 7; int ex = 0;
#pragma unroll 1
      while (rt >= tstart[ex + 1]) ++ex;
      const int rtl = rt - tstart[ex], nvalid = tstart[40 + ex] - rtl * 256;
      EpiDown e{wsp<float>(ws, WS::YBUF), wsp<int>(ws, WS::LST_SLOT) + ex * LCAP + rtl * 256, wsp<float>(ws, WS::LST_GATE) + ex * LCAP + rtl * 256, nvalid, ct * 256};
      gemm256(hmid + (long)rt * 256 * DEXP, DEXP, Bt + ((long)ex * DM + ct * 256) * DEXP, DEXP, DEXP, shm, e);
    }
  }
}

__device__ __forceinline__ MixP make_mixp(char* ws, const char* smem, int l) {
  OPAQUE_WS(ws); asm volatile("" : "+s"(l));
  MixP mp;
  mp.proj = wsp<u16>(ws, WS::PROJ); mp.pos = (const int*)in_ptr(smem, 1); mp.ycat = wsp<u16>(ws, WS::YCAT); mp.ws = ws; mp.smem = smem; mp.layer = l; mp.rot = wsp<float>(ws, WS::ROT);
  MixBuf& b = mp.b;
  b.rw_Rb = wsp<u16>(ws, WS::RW_RB); b.rw_Pab = wsp<u16>(ws, WS::RW_PAB); b.rw_Pak = wsp<u16>(ws, WS::RW_PAK); b.rw_VT = wsp<u16>(ws, WS::RW_VT); b.rw_S0 = wsp<u16>(ws, WS::RW_S0); b.rw_UT = wsp<u16>(ws, WS::RW_UT);
  b.rw_WpF = wsp<u16>(ws, WS::RW_WPF); b.rw_BtF = wsp<u16>(ws, WS::RW_BTF); b.rw_G = wsp<u16>(ws, WS::RW_G); b.rw_BV = wsp<u16>(ws, WS::RW_BV);
  b.rw_U0F = wsp<float>(ws, WS::RW_U0F); b.rw_KVF = wsp<float>(ws, WS::RW_KVF); b.rw_gam = wsp<float>(ws, WS::RW_GAM);
  b.rt_Rb = wsp<u16>(ws, WS::RT_RB); b.rt_Pak = wsp<u16>(ws, WS::RT_PAK); b.rt_VT = wsp<u16>(ws, WS::RT_VT); b.rt_S0 = wsp<u16>(ws, WS::RT_S0); b.rt_KVT = wsp<float>(ws, WS::RT_KVT);
  b.gl_Rb = wsp<u16>(ws, WS::GL_RB); b.gl_Pak = wsp<u16>(ws, WS::GL_PAK); b.gl_VT = wsp<u16>(ws, WS::GL_VT); b.gl_S0 = wsp<u16>(ws, WS::GL_S0); b.gl_KVT = wsp<float>(ws, WS::GL_KVT); b.gl_gam = wsp<float>(ws, WS::GL_GAM);
  b.lr_h = wsp<float>(ws, WS::LR_H); b.lr_A = wsp<float>(ws, WS::LR_A); b.lr_Hp = wsp<float>(ws, WS::LR_HP);
  mp.rw = RwkvP{in_ptr(smem, 4) + l * 1696, in_ptr(smem, 5) + l * 512, in_ptr(smem, 6) + l * 32 * 512, in_ptr(smem, 7) + l * 512, in_ptr(smem, 8) + l * 32 * 512, in_ptr(smem, 9) + l * 96 * 512,
                in_ptr(smem, 10) + l * 512, in_ptr(smem, 11) + l * 512, in_ptr(smem, 12) + l * 512, in_ptr(smem, 13) + l * 512, in_ptr(smem, 14) + l * 512, wsp<u16>(ws, WS::LORA_W) + (long)l * 512 * 160};
  mp.ret_norm_g = in_ptr(smem, 16) + l * 512;
  mp.lru = LruP{in_ptr(smem, 18) + l * 4 * 512, in_ptr(smem, 19) + l * 512, in_ptr(smem, 20) + l * 8 * 64 * 64, in_ptr(smem, 21) + l * 512, in_ptr(smem, 22) + l * 8 * 64 * 64, in_ptr(smem, 23) + l * 512, in_ptr(smem, 24) + l * 512, wsp<u16>(ws, WS::LRU_W) + (long)l * 2 * 8 * 4096};
  mp.gla_alpha_up = in_ptr(smem, 26) + l * 16 * 256; mp.gla_alpha_b = in_ptr(smem, 27) + l * 256; mp.gla_norm_g = in_ptr(smem, 28) + l * 512;
  return mp;
}
__device__ __forceinline__ void mix4_convert(char* ws, const char* smem, int l) {
  OPAQUE_WS(ws);
  int t_ = threadIdx.x; asm volatile("" : "+v"(t_));
  const int big = gridDim.x > 32;
  const int nb = big ? (int)gridDim.x - 32 : (int)gridDim.x;
  const int bi = big ? (int)blockIdx.x - 32 : (int)blockIdx.x;
  if (bi >= 0) convert_down(ws, smem, l, bi * 8 + __builtin_amdgcn_readfirstlane(t_ >> 6), nb * 8, t_ & 63);
}
constexpr int PH_PER_LAYER = 10, N_PHASES = 1 + NL * PH_PER_LAYER + 1;
#ifndef PROBE_MASK
#define PROBE_MASK 0
#endif
#define RUN_PH(id, code) do { const int _id = (id); if (_id >= ph0 && _id < ph1) { const int _kind = _id == 0 ? 12 : (_id == N_PHASES - 1 ? 13 : (_id - 1) % PH_PER_LAYER); \
    if ((PROBE_MASK >> _kind) & 1) { code; xcd_barrier_l(bar); } code; if (_id + 1 < ph1) xcd_barrier_l(bar); } } while (0)
__global__ __launch_bounds__(512, 2) void k_mega(MegaP p, int ph0, int ph1) {
  extern __shared__ __attribute__((aligned(16))) char smem0[];
  volatile LAS unsigned* xbw = (volatile LAS unsigned*)(smem0 + XBW_OFF);
  char* const smem = smem0 + PH_OFF;
  if (threadIdx.x == 0) {
    xbw[0] = 0u; xbw[1] = 0u; xbw[2] = 0u; xbw[3] = 0u;
    unsigned long long* tbl = (unsigned long long*)(smem0 + TBL_OFF);
#pragma unroll
    for (int i = 0; i < 40; ++i) tbl[i] = (unsigned long long)p.in[i];
  }
  __syncthreads();
  char* ws = p.ws; float* outp = p.out;
  const XcdBarrier bar = xcd_barrier_post((unsigned*)ws, xbw);
  if (ph1 - ph0 > 1) xcd_barrier(bar);
  RUN_PH(0, { phase_convert(ws, smem); NormArgs a{}; a.x = in_ptr(smem, 0); a.h = wsp<float>(ws, WS::H); a.g = in_ptr(smem, 2); a.xn = wsp<u16>(ws, WS::XN); phase_norm<0>(a); });
#pragma unroll 1
  for (int l = 0; l < NL; ++l) {
    const int pb = 1 + l * PH_PER_LAYER;
    RUN_PH(pb + 0, { if (l > 0) { NormArgs a{}; a.h = wsp<float>(ws, WS::H); a.g = in_ptr(smem, 2) + (long)l * DM; a.xn = wsp<u16>(ws, WS::XN); a.ybuf = wsp<float>(ws, WS::YBUF); phase_norm<1>(a); } });
    RUN_PH(pb + 1, phase_gemm<0>(ws, l, (u16*)smem));
    RUN_PH(pb + 2, { const MixP mp = make_mixp(ws, smem, l); phase_mix3(mp, smem); });
    RUN_PH(pb + 3, { const MixP mp = make_mixp(ws, smem, l); phase_mix4(mp, smem); mix4_convert(ws, smem, l); });
    RUN_PH(pb + 4, { const MixP mp = make_mixp(ws, smem, l); phase_mix5(mp); { int t_ = threadIdx.x; asm volatile("" : "+v"(t_)); if (blockIdx.x == 0 && t_ < 32) wsp<int>(ws, WS::TILE_EXP)[t_] = 0; } });
    RUN_PH(pb + 5, phase_gemm<1>(ws, l, (u16*)smem));
    RUN_PH(pb + 6, phase_gemm<2>(ws, l, (u16*)smem));
    RUN_PH(pb + 7, { NormArgs a{}; a.h = wsp<float>(ws, WS::H); a.g = in_ptr(smem, 31) + (long)l * DM; a.xn = wsp<u16>(ws, WS::XN); a.wg = in_ptr(smem, 32) + (long)l * DM * 4; a.bg = in_ptr(smem, 33) + l * 4;
      a.we = in_ptr(smem, 34) + (long)l * DM * 32; a.be = in_ptr(smem, 35) + l * 32; phase_n3(ws, a, smem, l); });
    RUN_PH(pb + 8, phase_gemm<3>(ws, l, (u16*)smem));
    RUN_PH(pb + 9, phase_gemm<4>(ws, l, (u16*)smem));
  }
  RUN_PH(N_PHASES - 1, { NormArgs a{}; a.h = wsp<float>(ws, WS::H); a.g = in_ptr(smem, 39); a.out = outp; a.ybuf = wsp<float>(ws, WS::YBUF); phase_norm<2>(a); });
}


extern "C" void kernel_launch(void* const* d_in, const int* in_sizes, int n_in, void* d_out, int out_size, void* d_ws, size_t ws_size, hipStream_t stream) {
  (void)in_sizes; (void)n_in; (void)out_size; (void)ws_size;
  MegaP p{};
  for (int i = 0; i < 40; ++i) p.in[i] = (const float*)d_in[i];
  p.ws = (char*)d_ws; p.out = (float*)d_out;
  static int grid = 0;
  if (!grid) {
    (void)hipFuncSetAttribute((const void*)k_mega, hipFuncAttributeMaxDynamicSharedMemorySize, LDS_BYTES);
    int dev = 0, cus = 0, per_cu = 0;
    (void)hipGetDevice(&dev);
    (void)hipDeviceGetAttribute(&cus, hipDeviceAttributeMultiprocessorCount, dev);
    (void)hipOccupancyMaxActiveBlocksPerMultiprocessor(&per_cu, (const void*)k_mega, 512, LDS_BYTES);
    grid = cus < 256 ? cus : 256;
    if (per_cu < 1) grid = 0;
  }
#ifndef MK_SPLIT
#define MK_SPLIT 0
#define PROBE_MASK 0
#endif
  if (grid > 0) {
    if (MK_SPLIT) { for (int ph = 0; ph < N_PHASES; ++ph) k_mega<<<grid, 512, LDS_BYTES, stream>>>(p, ph, ph + 1); }
    else { (void)hipMemsetAsync(d_ws, 0, XCD_BAR_WORDS * sizeof(unsigned), stream); k_mega<<<grid, 512, LDS_BYTES, stream>>>(p, 0, N_PHASES); }
  }
}
```

```cpp
#define RWKV_CHUNKED_FLAG true
#define MK_SPLIT 0
#define PROBE_MASK 0
#include <hip/hip_runtime.h>
#include <stdint.h>

#define LAS __attribute__((address_space(3)))
typedef unsigned short u16;
typedef __attribute__((ext_vector_type(8))) short bf16x8;
typedef __attribute__((ext_vector_type(4))) float f32x4;

constexpr int T_ = 8192, DM = 2048, NL = 2, MIXW = 512;
constexpr int IN_COLS = 14512, PC = 14592;
constexpr int OFF_A = 0, OFF_B = 1696, OFF_C = 3744, OFF_D = 4768, OFF_G = 6400, NONGATE = 6320;
constexpr int NEXP = 32, DEXP = 1024;
constexpr int MAXROWS = 24576, MAXRT = 96, LCAP = 8192;

typedef __attribute__((ext_vector_type(2))) float f32x2_t;
typedef __attribute__((ext_vector_type(2))) __bf16 bf16x2_t;
__device__ __forceinline__ unsigned pack_bf16(float lo, float hi) { f32x2_t v = {lo, hi}; return __builtin_bit_cast(unsigned, __builtin_convertvector(v, bf16x2_t)); }
__device__ __forceinline__ u16 f2bf(float f) { return (u16)pack_bf16(f, 0.f); }
__device__ __forceinline__ float bf2f(u16 h) { return __uint_as_float(((unsigned)h) << 16); }
__device__ __forceinline__ float sigmoidf_(float x) { return __builtin_amdgcn_rcpf(1.f + __expf(-x)); }
#define PIN8(a) asm volatile("" : "+v"(a[0]), "+v"(a[1]), "+v"(a[2]), "+v"(a[3]), "+v"(a[4]), "+v"(a[5]), "+v"(a[6]), "+v"(a[7]))
#define PIN8O(a, o) asm volatile("" : "+v"(a[o + 0]), "+v"(a[o + 1]), "+v"(a[o + 2]), "+v"(a[o + 3]), "+v"(a[o + 4]), "+v"(a[o + 5]), "+v"(a[o + 6]), "+v"(a[o + 7]))
#define PIN8x2(a, b) asm volatile("" : "+v"(a[0]), "+v"(a[1]), "+v"(a[2]), "+v"(a[3]), "+v"(a[4]), "+v"(a[5]), "+v"(a[6]), "+v"(a[7]), "+v"(b[0]), "+v"(b[1]), "+v"(b[2]), "+v"(b[3]), "+v"(b[4]), "+v"(b[5]), "+v"(b[6]), "+v"(b[7]))
__device__ __forceinline__ void lds_barrier() { asm volatile("s_waitcnt lgkmcnt(0)" ::: "memory"); __builtin_amdgcn_s_barrier(); asm volatile("" ::: "memory"); }
__device__ __forceinline__ float wave_sum(float v) {
#pragma unroll
  for (int o = 32; o > 0; o >>= 1) v += __shfl_xor(v, o, 64);
  return v;
}

constexpr int BKK = 64, HALF = 128, HT = HALF * BKK, SHM_B = 8 * HT * 2;
__device__ __forceinline__ int lds_byte(int r, int c) {
  int st = (r >> 4) * 2 + (c >> 5), rr = r & 15, cc = c & 31, ob = rr * 64 + cc * 2;
  return st * 1024 + (ob ^ (((ob >> 9) & 1) << 5));
}
__device__ __forceinline__ void stage_rc(int b, int& R, int& C) {
  int st = b / 1024, sb = b % 1024, swz = sb ^ (((sb >> 9) & 1) << 5);
  R = (st >> 1) * 16 + swz / 64; C = (st & 1) * 32 + (swz % 64) / 2;
}

template <bool GATHER, class Epi>
__device__ __forceinline__ void gemm256g(const u16* __restrict__ A, int lda, const u16* __restrict__ Bt, int ldb, int K, u16* shm, const Epi& epi, const int (&arow)[4]) {
#define SA(b, h) (shm + ((b) * 2 + (h)) * HT)
#define SB(b, h) (shm + (4 + (b) * 2 + (h)) * HT)
#define STAGE_X(TT, P, BASE, LD, br, kt) do { const u16* _g = (BASE) + (long)(br) * (LD) + (long)(kt) * BKK; \
    _Pragma("unroll") for (int _i = 0; _i < 2; ++_i) { int _b = (TT) * 16 + _i * 8192; int _r, _c; stage_rc(_b, _r, _c); \
      __builtin_amdgcn_global_load_lds((const unsigned*)(_g + (long)_r * (LD) + _c), (unsigned*)((char*)(P) + _b), 16, 0, 0); } } while (0)
#define STAGE_AG(TT, P, br, kt) do { \
    _Pragma("unroll") for (int _i = 0; _i < 2; ++_i) { int _b = (TT) * 16 + _i * 8192; \
      __builtin_amdgcn_global_load_lds((const unsigned*)((const char*)A + (unsigned)(arow[((br) / HALF) * 2 + _i] + (kt) * (BKK * 2))), (unsigned*)((char*)(P) + _b), 16, 0, 0); } } while (0)
#define STAGE_A(P, br, kt) do { if (GATHER) STAGE_AG(tid0, P, br, kt); else STAGE_X(tid0, P, A, lda, br, kt); } while (0)
#define STAGE_B(P, br, kt) STAGE_X(tid0, P, Bt, ldb, br, kt)
#define LDA(dst, b, h) _Pragma("unroll") for (int m = 0; m < 4; ++m) _Pragma("unroll") for (int k = 0; k < 2; ++k) \
    dst[m][k] = *reinterpret_cast<const bf16x8*>((char*)SA(b, h) + lds_byte(wr * 64 + m * 16 + fr, k * 32 + fq * 8))
#define LDB(dst, b, h) _Pragma("unroll") for (int n = 0; n < 2; ++n) _Pragma("unroll") for (int k = 0; k < 2; ++k) \
    dst[n][k] = *reinterpret_cast<const bf16x8*>((char*)SB(b, h) + lds_byte(wc * 32 + n * 16 + fr, k * 32 + fq * 8))
#define MMA(ai, bj, At, Bx) do { __builtin_amdgcn_s_setprio(1); \
    _Pragma("unroll") for (int m = 0; m < 4; ++m) _Pragma("unroll") for (int n = 0; n < 2; ++n) _Pragma("unroll") for (int k = 0; k < 2; ++k) \
      acc[ai][bj][m][n] = __builtin_amdgcn_mfma_f32_16x16x32_bf16(Bx[n][k], At[m][k], acc[ai][bj][m][n], 0, 0, 0); \
    __builtin_amdgcn_s_setprio(0); } while (0)
#define WAIT_V(n) asm volatile("s_waitcnt vmcnt(" #n ")" ::: "memory")
#define WAIT_L(n) asm volatile("s_waitcnt lgkmcnt(" #n ")" ::: "memory")
#define BAR __builtin_amdgcn_s_barrier()
#define SCHED __builtin_amdgcn_sched_barrier(0)
  int tid0 = threadIdx.x; asm volatile("" : "+v"(tid0));
  int wid = tid0 >> 6, lane = tid0 & 63, wr = wid >> 2, wc = wid & 3, fr = lane & 15, fq = lane >> 4;
  f32x4 acc[2][2][4][2] = {};
  bf16x8 At[4][2], B0[2][2], B1[2][2];
  const int nt = K / BKK;
  STAGE_B(SB(0, 0), 0, 0); STAGE_A(SA(0, 0), 0, 0);
  STAGE_B(SB(0, 1), HALF, 0); STAGE_A(SA(0, 1), HALF, 0);
  if (wr == 1) BAR;
  WAIT_V(4); BAR;
  STAGE_B(SB(1, 0), 0, 1); STAGE_A(SA(1, 0), 0, 1); STAGE_B(SB(1, 1), HALF, 1);
  WAIT_V(6); BAR;
  for (int t = 0; t < nt - 2; t += 2) {
    LDB(B0, 0, 0); SCHED; LDA(At, 0, 0); STAGE_A(SA(1, 1), HALF, t + 1);
    WAIT_L(8); BAR; WAIT_L(0); MMA(0, 0, At, B0); BAR; SCHED;
    LDB(B1, 0, 1); STAGE_B(SB(0, 0), 0, t + 2);
    BAR; WAIT_L(0); MMA(0, 1, At, B1); BAR;
    LDA(At, 0, 1); STAGE_A(SA(0, 0), 0, t + 2);
    BAR; WAIT_L(0); MMA(1, 0, At, B0); BAR; SCHED;
    STAGE_B(SB(0, 1), HALF, t + 2);
    WAIT_V(6); BAR; MMA(1, 1, At, B1); BAR;
    LDB(B0, 1, 0); SCHED; LDA(At, 1, 0); STAGE_A(SA(0, 1), HALF, t + 2);
    WAIT_L(8); BAR; WAIT_L(0); MMA(0, 0, At, B0); BAR; SCHED;
    LDB(B1, 1, 1); STAGE_B(SB(1, 0), 0, t + 3);
    BAR; WAIT_L(0); MMA(0, 1, At, B1); BAR;
    LDA(At, 1, 1); STAGE_A(SA(1, 0), 0, t + 3);
    BAR; WAIT_L(0); MMA(1, 0, At, B0); BAR; SCHED;
    STAGE_B(SB(1, 1), HALF, t + 3);
    WAIT_V(6); BAR; MMA(1, 1, At, B1); BAR;
  }
  int tz = threadIdx.x; asm volatile("" : "+v"(tz)); wid = tz >> 6; lane = tz & 63; wr = wid >> 2; wc = wid & 3; fr = lane & 15; fq = lane >> 4;
  { LDB(B0, 0, 0); WAIT_V(0); LDA(At, 0, 0); if (GATHER) STAGE_AG(tz, SA(1, 1), HALF, nt - 1); else STAGE_X(tz, SA(1, 1), A, lda, HALF, nt - 1);
    BAR; WAIT_L(0); MMA(0, 0, At, B0); BAR;
    LDB(B1, 0, 1); BAR; WAIT_L(0); MMA(0, 1, At, B1); BAR;
    LDA(At, 0, 1); WAIT_V(4); BAR; WAIT_L(0); MMA(1, 0, At, B0); MMA(1, 1, At, B1); BAR; }
  { LDB(B0, 1, 0); LDA(At, 1, 0); WAIT_V(2); BAR; WAIT_L(0); MMA(0, 0, At, B0); BAR;
    LDB(B1, 1, 1); WAIT_V(0); BAR; WAIT_L(0); MMA(0, 1, At, B1); BAR;
    LDA(At, 1, 1); BAR; WAIT_L(0); MMA(1, 0, At, B0); MMA(1, 1, At, B1); BAR; }
  if (wr == 0) BAR;
  epi(acc, wr, wc, fr, fq);
  __syncthreads();
#undef SA
#undef SB
}

template <class Epi>
__device__ __forceinline__ void gemm256(const u16* __restrict__ A, int lda, const u16* __restrict__ Bt, int ldb, int K, u16* shm, const Epi& epi) {
  const int dummy[4] = {0, 0, 0, 0};
  gemm256g<false>(A, lda, Bt, ldb, K, shm, epi, dummy);
}
#define UNR _Pragma("unroll")
#define EPI4 UNR for (int ai = 0; ai < 2; ++ai) UNR for (int bj = 0; bj < 2; ++bj) UNR for (int m = 0; m < 4; ++m) UNR for (int n = 0; n < 2; ++n)
#define EPI_R (ai * HALF + wr * 64 + m * 16 + fr)
#define EPI_C (bj * HALF + wc * 32 + n * 16 + fq * 4)
__device__ __forceinline__ uint2 pack4(const f32x4& v) { uint2 r; r.x = pack_bf16(v[0], v[1]); r.y = pack_bf16(v[2], v[3]); return r; }

struct EpiProj {
  u16* proj; int brow, bcol;
  __device__ __forceinline__ void operator()(const f32x4 (&acc)[2][2][4][2], int wr, int wc, int fr, int fq) const {
    u16* base = proj + (long)(brow + wr * 64 + fr) * PC + bcol + wc * 32 + fq * 4;
    if (bcol >= OFF_G) {
      EPI4 { f32x4 v = acc[ai][bj][m][n]; v[0] = sigmoidf_(v[0]); v[1] = sigmoidf_(v[1]); v[2] = sigmoidf_(v[2]); v[3] = sigmoidf_(v[3]);
             *(uint2*)(base + (long)(ai * HALF + m * 16) * PC + bj * HALF + n * 16) = pack4(v); }
    } else {
      EPI4 { *(uint2*)(base + (long)(ai * HALF + m * 16) * PC + bj * HALF + n * 16) = pack4(acc[ai][bj][m][n]); }
    }
  }
};
struct EpiResid {
  float* h; int brow, bcol;
  __device__ __forceinline__ void operator()(const f32x4 (&acc)[2][2][4][2], int wr, int wc, int fr, int fq) const {
    float* base = h + (long)(brow + wr * 64 + fr) * DM + bcol + wc * 32 + fq * 4;
    UNR for (int ai = 0; ai < 2; ++ai) {
      f32x4 o[4][2][2];
      UNR for (int m = 0; m < 4; ++m) UNR for (int bj = 0; bj < 2; ++bj) UNR for (int n = 0; n < 2; ++n) o[m][bj][n] = *(const f32x4*)(base + (long)(ai * HALF + m * 16) * DM + bj * HALF + n * 16);
      asm volatile("" : "+v"(o[0][0][0]), "+v"(o[0][0][1]), "+v"(o[0][1][0]), "+v"(o[0][1][1]), "+v"(o[1][0][0]), "+v"(o[1][0][1]), "+v"(o[1][1][0]), "+v"(o[1][1][1]),
                        "+v"(o[2][0][0]), "+v"(o[2][0][1]), "+v"(o[2][1][0]), "+v"(o[2][1][1]), "+v"(o[3][0][0]), "+v"(o[3][0][1]), "+v"(o[3][1][0]), "+v"(o[3][1][1]));
      UNR for (int m = 0; m < 4; ++m) UNR for (int bj = 0; bj < 2; ++bj) UNR for (int n = 0; n < 2; ++n) *(f32x4*)(base + (long)(ai * HALF + m * 16) * DM + bj * HALF + n * 16) = o[m][bj][n] + acc[ai][bj][m][n];
    }
  }
};
struct EpiGateUp {
  u16* hmid; int brow, ct;
  __device__ __forceinline__ void operator()(const f32x4 (&acc)[2][2][4][2], int wr, int wc, int fr, int fq) const {
    u16* base = hmid + (long)(brow + wr * 64 + fr) * DEXP + ct * 128 + wc * 32 + fq * 4;
    UNR for (int ai = 0; ai < 2; ++ai) UNR for (int m = 0; m < 4; ++m) UNR for (int n = 0; n < 2; ++n) {
      const f32x4 g = acc[ai][0][m][n], u = acc[ai][1][m][n]; f32x4 v;
      UNR for (int j = 0; j < 4; ++j) v[j] = g[j] * sigmoidf_(g[j]) * u[j];
      *(uint2*)(base + (long)(ai * HALF + m * 16) * DEXP + n * 16) = pack4(v); }
  }
};
struct EpiDown {
  float* ybuf; const int* lslot; const float* lgate; int nvalid, bcol;
  __device__ __forceinline__ void operator()(const f32x4 (&acc)[2][2][4][2], int wr, int wc, int fr, int fq) const {
    int slot8[8]; float gt8[8];
    UNR for (int q = 0; q < 8; ++q) { const int r = (q >> 2) * HALF + wr * 64 + (q & 3) * 16 + fr, rc = r < nvalid ? r : 0; slot8[q] = lslot[rc]; gt8[q] = lgate[rc]; }
    PIN8(slot8); PIN8(gt8);
    UNR for (int ai = 0; ai < 2; ++ai) UNR for (int m = 0; m < 4; ++m) {
      const int r = ai * HALF + wr * 64 + m * 16 + fr;
      if (r < nvalid) { const float gt = gt8[ai * 4 + m];
        float* yp = ybuf + (long)slot8[ai * 4 + m] * DM + bcol + wc * 32 + fq * 4;
        UNR for (int bj = 0; bj < 2; ++bj) UNR for (int n = 0; n < 2; ++n) *(f32x4*)(yp + bj * HALF + n * 16) = acc[ai][bj][m][n] * gt; } }
  }
};

__device__ __forceinline__ void gemm_merge(const u16* __restrict__ A, const u16* __restrict__ Bt, const u16* __restrict__ gates, u16* __restrict__ out, int brow, int bcol, u16* shm) {
#define MA(b, h) (shm + ((b) * 3 + (h)) * HT)
#define MB(b) (shm + ((b) * 3 + 2) * HT)
#define MSTAGE(P, BASE, LD_, br, kt) do { const u16* _g = (BASE) + (long)(br) * (LD_) + (long)(kt) * BKK; \
    _Pragma("unroll") for (int _i = 0; _i < 2; ++_i) { int _b = tid0 * 16 + _i * 8192; int _r, _c; stage_rc(_b, _r, _c); \
      __builtin_amdgcn_global_load_lds((const unsigned*)(_g + (long)_r * (LD_) + _c), (unsigned*)((char*)(P) + _b), 16, 0, 0); } } while (0)
  int tid0 = threadIdx.x; asm volatile("" : "+v"(tid0));
  const int wid = tid0 >> 6, lane = tid0 & 63, wr = wid >> 2, wc = wid & 3, fr = lane & 15, fq = lane >> 4;
  f32x4 acc[2][4][2], R[2][4][2];
#pragma unroll
  for (int ai = 0; ai < 2; ++ai)
#pragma unroll
    for (int m = 0; m < 4; ++m)
#pragma unroll
      for (int n = 0; n < 2; ++n) { acc[ai][m][n] = (f32x4){0.f, 0.f, 0.f, 0.f}; R[ai][m][n] = (f32x4){0.f, 0.f, 0.f, 0.f}; }
  const u16* Ab = A + (long)brow * DM; const u16* Bb = Bt + (long)bcol * DM;
  MSTAGE(MA(0, 0), Ab, DM, 0, 0); MSTAGE(MA(0, 1), Ab, DM, HALF, 0); MSTAGE(MB(0), Bb, DM, 0, 0);
  asm volatile("s_waitcnt vmcnt(0)" ::: "memory"); __syncthreads();
#pragma unroll 1
  for (int q = 0; q < 32; ++q) {
    const int b = q & 1;
    if (q + 1 < 32) { MSTAGE(MA(b ^ 1, 0), Ab, DM, 0, q + 1); MSTAGE(MA(b ^ 1, 1), Ab, DM, HALF, q + 1); MSTAGE(MB(b ^ 1), Bb, DM, 0, q + 1); }
    bf16x8 Bf[2][2], Af[4][2];
#pragma unroll
    for (int n = 0; n < 2; ++n)
#pragma unroll
      for (int k = 0; k < 2; ++k) Bf[n][k] = *reinterpret_cast<const bf16x8*>((char*)MB(b) + lds_byte(wc * 32 + n * 16 + fr, k * 32 + fq * 8));
#pragma unroll
    for (int ai = 0; ai < 2; ++ai) {
#pragma unroll
      for (int m = 0; m < 4; ++m)
#pragma unroll
        for (int k = 0; k < 2; ++k) Af[m][k] = *reinterpret_cast<const bf16x8*>((char*)MA(b, ai) + lds_byte(wr * 64 + m * 16 + fr, k * 32 + fq * 8));
#pragma unroll
      for (int m = 0; m < 4; ++m)
#pragma unroll
        for (int n = 0; n < 2; ++n)
#pragma unroll
          for (int k = 0; k < 2; ++k) acc[ai][m][n] = __builtin_amdgcn_mfma_f32_16x16x32_bf16(Bf[n][k], Af[m][k], acc[ai][m][n], 0, 0, 0);
    }
    if ((q & 7) == 7) {
      const int kb = q >> 3;
      const u16* gp = gates + (long)(brow + wr * 64 + fr) * PC + kb * DM + bcol + wc * 32 + fq * 4;
#pragma unroll
      for (int ai = 0; ai < 2; ++ai) {
        uint2 g2[4][2];
#pragma unroll
        for (int m = 0; m < 4; ++m)
#pragma unroll
          for (int n = 0; n < 2; ++n) g2[m][n] = *(const uint2*)(gp + (long)(ai * HALF + m * 16) * PC + n * 16);
#pragma unroll
        for (int m = 0; m < 4; ++m)
#pragma unroll
          for (int n = 0; n < 2; ++n) {
            const f32x4 gv = {__uint_as_float(g2[m][n].x << 16), __uint_as_float(g2[m][n].x & 0xffff0000u), __uint_as_float(g2[m][n].y << 16), __uint_as_float(g2[m][n].y & 0xffff0000u)};
            R[ai][m][n] += gv * acc[ai][m][n]; acc[ai][m][n] = (f32x4){0.f, 0.f, 0.f, 0.f};
          }
      }
    }
    asm volatile("s_waitcnt vmcnt(0)" ::: "memory"); __syncthreads();
  }
  u16* op = out + (long)(brow + wr * 64 + fr) * DM + bcol + wc * 32 + fq * 4;
#pragma unroll
  for (int ai = 0; ai < 2; ++ai)
#pragma unroll
    for (int m = 0; m < 4; ++m)
#pragma unroll
      for (int n = 0; n < 2; ++n) *(uint2*)(op + (long)(ai * HALF + m * 16) * DM + n * 16) = pack4(R[ai][m][n]);
#undef MA
#undef MB
#undef MSTAGE
}
__device__ __forceinline__ void unit_map(int b, int round, int& pm, int& pn) {
  int xcd = b & 7, i = b >> 3, pr = xcd >> 1, pc = xcd & 1, lr = i & 7, lc = i >> 3;
  pm = pr * 8 + lr; pn = round * 8 + pc * 4 + lc;
}
constexpr int CH = 64, NCH = T_ / CH;
struct MegaP { const float* in[40]; char* ws; float* out; };
namespace WS {
constexpr size_t al(size_t x) { return (x + 255) & ~(size_t)255; }
constexpr size_t U8 = (size_t)1024 * 4096 * 2;
constexpr size_t BARW = 0;
constexpr size_t WT_IN = BARW + 65536;
constexpr size_t WT_O = WT_IN + al((size_t)NL * PC * DM * 2);
constexpr size_t WT_OUT = WT_O + al((size_t)NL * 4 * DM * MIXW * 2);
constexpr size_t WGU = WT_OUT + al((size_t)NL * DM * DM * 2);
constexpr size_t WDN = WGU + al((size_t)NL * NEXP * 2048 * DM * 2);
constexpr size_t H = WDN + al((size_t)NL * NEXP * DM * DEXP * 2);
constexpr size_t XN = H + al((size_t)T_ * DM * 4);
constexpr size_t PROJ = XN + al((size_t)T_ * DM * 2);
constexpr size_t YCAT = PROJ + al((size_t)T_ * PC * 2);
constexpr size_t MBUF = YCAT + al((size_t)T_ * DM * 2);
constexpr size_t MERGED = MBUF + al((size_t)T_ * DM * 4);
constexpr size_t TOK_E = MERGED + al((size_t)T_ * DM * 2);
constexpr size_t TOK_G = TOK_E + al((size_t)2 * T_ * 4);
constexpr size_t ROW_TOK = TOK_G + al((size_t)2 * T_ * 4);
constexpr size_t ROW_SLOT = ROW_TOK + al((size_t)MAXROWS * 4);
constexpr size_t ROW_GATE = ROW_SLOT + al((size_t)MAXROWS * 4);
constexpr size_t TILE_EXP = ROW_GATE + al((size_t)MAXROWS * 4);
constexpr size_t NRT = TILE_EXP + 1024;
constexpr size_t XG = NRT + 256;
constexpr size_t HMID = XG + al((size_t)MAXROWS * DM * 2);
constexpr size_t YBUF = HMID + al((size_t)MAXROWS * DEXP * 2);
constexpr size_t RW_RB = YBUF + al((size_t)2 * T_ * DM * 4);
constexpr size_t RW_PAB = RW_RB + U8, RW_PAK = RW_PAB + U8, RW_VT = RW_PAK + U8, RW_S0 = RW_VT + U8, RW_UT = RW_S0 + U8, RW_WPF = RW_UT + U8, RW_BTF = RW_WPF + U8;
constexpr size_t RW_G = RW_BTF + U8, RW_BV = RW_G + U8, RW_U0F = RW_BV + U8, RW_KVF = RW_U0F + 2 * U8, RW_GAM = RW_KVF + 2 * U8;
constexpr size_t RT_RB = RW_GAM + 262144, RT_PAK = RT_RB + U8, RT_VT = RT_PAK + U8, RT_S0 = RT_VT + U8, RT_KVT = RT_S0 + U8;
constexpr size_t GL_RB = RT_KVT + 2 * U8, GL_PAK = GL_RB + U8 / 2, GL_VT = GL_PAK + U8 / 2, GL_S0 = GL_VT + U8, GL_KVT = GL_S0 + U8, GL_GAM = GL_KVT + 2 * U8;
constexpr size_t LR_H = GL_GAM + 131072, LR_A = LR_H + (size_t)T_ * 512 * 4, LR_HP = LR_A + (size_t)T_ * 512 * 4;
constexpr size_t LST_SLOT = LR_HP + (size_t)NCH * 512 * 4;
constexpr size_t LST_GATE = LST_SLOT + (size_t)32 * 8192 * 4;
constexpr size_t RT_HI = LST_GATE + (size_t)32 * 8192 * 4;
constexpr size_t RT_LO = RT_HI + (size_t)NL * 48 * 2048 * 2;
constexpr size_t LORA_W = RT_LO + (size_t)NL * 48 * 2048 * 2;
constexpr size_t LRU_W = LORA_W + (size_t)NL * 512 * 160 * 2;
constexpr size_t ROT = LRU_W + (size_t)NL * 2 * 8 * 4096 * 2;
constexpr size_t END = ROT + (size_t)T_ * 32 * 8;
}
constexpr int TBL_OFF = 0, XBW_OFF = 320, PH_OFF = 512;
constexpr int PH_BYTES = 153600;
constexpr int LDS_BYTES = PH_OFF + PH_BYTES;
__device__ __forceinline__ const float* in_ptr(const char* smem, int i) {
  const unsigned long long v = *(const unsigned long long*)(smem - PH_OFF + TBL_OFF + i * 8);
  const unsigned lo = __builtin_amdgcn_readfirstlane((unsigned)v), hi = __builtin_amdgcn_readfirstlane((unsigned)(v >> 32));
  return (const float*)(const float __attribute__((address_space(1)))*)(((unsigned long long)hi << 32) | lo);
}
template <class T> __device__ __forceinline__ T* wsp(char* ws, size_t off) { return (T*)(ws + off); }
__device__ __forceinline__ int ld_i(const int* p) { return __hip_atomic_load(p, __ATOMIC_RELAXED, __HIP_MEMORY_SCOPE_AGENT); }
#define OPAQUE_WS(w) do { unsigned long long _z = 0; asm volatile("" : "+s"(_z)); (w) = (char*)(char __attribute__((address_space(1)))*)((unsigned long long)(w) + _z); } while (0)
__device__ __forceinline__ int bidx() { int b = blockIdx.x; asm volatile("" : "+s"(b)); return b; }
__device__ __forceinline__ int gdim() { int g = gridDim.x; asm volatile("" : "+s"(g)); return g; }

__device__ __forceinline__ void transpose_tile_w(const float* __restrict__ src, int sld, int nvalid, u16* __restrict__ dst, int K, int n0, int k0, int drow0, int mode, int lane) {
  const int kq = lane >> 4, n4 = lane & 15, nb = n0 + n4 * 4;
  f32x4 v[16];
  if (nb < nvalid) {
    const float* sp = src + (long)(k0 + kq * 16) * sld + nb;
#pragma unroll
    for (int i = 0; i < 16; ++i) v[i] = *(const f32x4*)(sp + (long)i * sld);
  } else {
#pragma unroll
    for (int i = 0; i < 16; ++i) v[i] = (f32x4){0.f, 0.f, 0.f, 0.f};
  }
#pragma unroll
  for (int jn = 0; jn < 4; ++jn) {
    const int n = nb + jn;
    const int row = (mode == 0) ? drow0 + n : ((n >> 7) * 256 + (mode == 2 ? 128 : 0) + (n & 127));
    u16* dp = dst + (long)row * K + k0 + kq * 16;
    uint4 lo, hi;
    lo.x = (unsigned)f2bf(v[0][jn]) | ((unsigned)f2bf(v[1][jn]) << 16); lo.y = (unsigned)f2bf(v[2][jn]) | ((unsigned)f2bf(v[3][jn]) << 16);
    lo.z = (unsigned)f2bf(v[4][jn]) | ((unsigned)f2bf(v[5][jn]) << 16); lo.w = (unsigned)f2bf(v[6][jn]) | ((unsigned)f2bf(v[7][jn]) << 16);
    hi.x = (unsigned)f2bf(v[8][jn]) | ((unsigned)f2bf(v[9][jn]) << 16); hi.y = (unsigned)f2bf(v[10][jn]) | ((unsigned)f2bf(v[11][jn]) << 16);
    hi.z = (unsigned)f2bf(v[12][jn]) | ((unsigned)f2bf(v[13][jn]) << 16); hi.w = (unsigned)f2bf(v[14][jn]) | ((unsigned)f2bf(v[15][jn]) << 16);
    *(uint4*)dp = lo; *(uint4*)(dp + 8) = hi;
  }
}
__device__ __forceinline__ void moe_tile(char* ws, const char* smem, int l, int t, int lane) {
  if (t < 32768) { const int up = t >> 14, e = (t & 16383) >> 9, q = t & 511, nt = q >> 5, kt = q & 31;
    transpose_tile_w(in_ptr(smem, up ? 37 : 36) + ((long)l * NEXP + e) * DM * DEXP, DEXP, DEXP, wsp<u16>(ws, WS::WGU) + ((long)l * NEXP + e) * 2048 * DM, DM, nt * 64, kt * 64, 0, up ? 2 : 1, lane);
  } else { const int t2 = t - 32768, e = t2 >> 9, q = t2 & 511, nt = q >> 4, kt = q & 15;
    transpose_tile_w(in_ptr(smem, 38) + ((long)l * NEXP + e) * DEXP * DM, DM, DM, wsp<u16>(ws, WS::WDN) + ((long)l * NEXP + e) * DM * DEXP, DEXP, nt * 64, kt * 64, 0, 0, lane); }
}
constexpr int CV_SOLVE = 6144;
constexpr int LD = 72;

struct RwkvP { const float *mu, *w0, *w_up, *a0, *a_up, *g_up, *k_k, *k_a, *r_k, *ln_g, *ln_b; const u16* lora_w; };
struct LruP { const float *conv_w, *conv_b, *w_a, *b_a, *w_x, *b_x, *lam; const u16* wt; };
struct MixBuf {
  u16 *rw_Rb, *rw_Pab, *rw_Pak, *rw_VT, *rw_S0, *rw_UT, *rw_WpF, *rw_BtF, *rw_G, *rw_BV; float *rw_U0F, *rw_KVF, *rw_gam;
  u16 *rt_Rb, *rt_Pak, *rt_VT, *rt_S0; float* rt_KVT;
  u16 *gl_Rb, *gl_Pak, *gl_VT, *gl_S0; float *gl_KVT, *gl_gam;
  float *lr_h, *lr_A, *lr_Hp;
};
struct MixP {
  const u16* proj; const int* pos; u16* ycat; MixBuf b; char* ws; const char* smem; int layer; const float* rot;
  RwkvP rw; const float* ret_norm_g; LruP lru; const float *gla_alpha_up, *gla_alpha_b, *gla_norm_g;
};

__device__ __forceinline__ float gelu_tanh(float x) {
  const float u = 0.7978845608028654f * (x + 0.044715f * x * x * x);
  return 0.5f * x * (1.f + tanhf(u));
}
__device__ __forceinline__ float red16(float v) {
  v += __shfl_xor(v, 1, 64); v += __shfl_xor(v, 2, 64); v += __shfl_xor(v, 4, 64); v += __shfl_xor(v, 8, 64);
  return v;
}
__device__ __forceinline__ uint4 pack8(const u16 (&a)[8]) {
  uint4 r;
  r.x = (unsigned)a[0] | ((unsigned)a[1] << 16); r.y = (unsigned)a[2] | ((unsigned)a[3] << 16);
  r.z = (unsigned)a[4] | ((unsigned)a[5] << 16); r.w = (unsigned)a[6] | ((unsigned)a[7] << 16);
  return r;
}
__device__ __forceinline__ f32x4 tile_nt(const u16* sA, const u16* sB, int mt, int nt, int r, int g) {
  f32x4 c = {0.f, 0.f, 0.f, 0.f};
#pragma unroll
  for (int s = 0; s < 2; ++s) {
    bf16x8 a = *(const bf16x8*)(sA + (16 * mt + r) * LD + 32 * s + 8 * g);
    bf16x8 b = *(const bf16x8*)(sB + (16 * nt + r) * LD + 32 * s + 8 * g);
    c = __builtin_amdgcn_mfma_f32_16x16x32_bf16(a, b, c, 0, 0, 0);
  }
  return c;
}
__device__ __forceinline__ void copy_out(const u16* s, u16* gp, int rows, int tid) {
  for (int idx = tid; idx < rows * 8; idx += 512) { int row = idx >> 3, seg = idx & 7; *(uint4*)(gp + row * 64 + seg * 8) = *(const uint4*)(s + row * LD + seg * 8); }
}
__device__ __forceinline__ void inv_perm(int x, int& s, int& g, int& j) { s = x >> 5; int rr = x & 31; g = (rr >> 2) & 3; j = 4 * (rr >> 4) + (rr & 3); }

__device__ __forceinline__ void p3_ret(const MixP& p, int c, int h, char* smem) {
  u16* sRb = (u16*)smem; u16* sKb = sRb + 64 * LD; u16* sKtT = sKb + 64 * LD; u16* sVT = sKtT + 64 * LD;
  int tid = threadIdx.x; asm volatile("" : "+v"(tid));
  const int cc = tid & 63, tg = tid >> 6, r = cc & 15, g = cc >> 4, uid = c * 8 + h;
  const float lg2 = log2f(1.f - exp2f(-(5.f + 4.f * (float)h / 7.f)));
  u16 kt8[8], v8[8], q16[8], k16[8]; f32x2_t cs2[8];
#pragma unroll
  for (int i = 0; i < 8; ++i) {
    const int t = c * 64 + tg * 8 + i; const u16* row = p.proj + (long)t * PC + OFF_B;
    q16[i] = row[h * 64 + cc]; k16[i] = row[512 + h * 64 + cc]; v8[i] = row[1024 + h * 64 + cc]; cs2[i] = *(const f32x2_t*)(p.rot + (t * 32 + (cc & 31)) * 2);
  }
      asm volatile("" ::: "memory");
#pragma unroll
  for (int i = 0; i < 8; ++i) {
    const int tl = tg * 8 + i;
    const float q = bf2f(q16[i]), k = bf2f(k16[i]), cs = cs2[i][0], sn = cs2[i][1];
    const float qo = __shfl_xor(q, 32, 64), ko = __shfl_xor(k, 32, 64);
    const float qr = cc < 32 ? q * cs - qo * sn : q * cs + qo * sn;
    const float kr = (cc < 32 ? k * cs - ko * sn : k * cs + ko * sn) * 0.125f;
    const float e = exp2f(lg2 * (float)(tl + 1)), ei = exp2f(-lg2 * (float)(tl + 1)), et = exp2f(lg2 * (float)(63 - tl));
    sRb[tl * LD + cc] = f2bf(qr * e); sKb[tl * LD + cc] = f2bf(kr * ei); kt8[i] = f2bf(kr * et);
  }
  *(uint4*)(sKtT + cc * LD + tg * 8) = pack8(kt8); *(uint4*)(sVT + cc * LD + tg * 8) = pack8(v8);
  lds_barrier();
  for (int tile = tg; tile < 32; tile += 8) {
    if (tile < 16) {
      const int mt = tile >> 2, nt = tile & 3; f32x4 c4 = tile_nt(sRb, sKb, mt, nt, r, g);
#pragma unroll
      for (int reg = 0; reg < 4; ++reg) { int t = 16 * mt + 4 * g + reg, i = 16 * nt + r; p.b.rt_Pak[(long)uid * 4096 + t * 64 + i] = f2bf(i <= t ? c4[reg] : 0.f); }
    } else {
      const int q = tile - 16, mt = q >> 2, nt = q & 3; f32x4 c4 = tile_nt(sVT, sKtT, mt, nt, r, g);
#pragma unroll
      for (int reg = 0; reg < 4; ++reg) { int v = 16 * mt + 4 * g + reg, k = 16 * nt + r; p.b.rt_KVT[(long)uid * 4096 + v * 64 + k] = c4[reg]; }
    }
  }
  copy_out(sRb, p.b.rt_Rb + (long)uid * 4096, 64, tid); copy_out(sVT, p.b.rt_VT + (long)uid * 4096, 64, tid);
  lds_barrier();
}

__device__ __forceinline__ void p3_gla(const MixP& p, int c, int h, char* smem) {
  u16* sRb = (u16*)smem; u16* sKb = sRb + 64 * LD; u16* sKtT = sKb + 64 * LD; u16* sVT = sKtT + 64 * LD;
  float* pre = (float*)(smem + 5 * 64 * LD * 2); float* sal = pre + 512;
  int tid = threadIdx.x; asm volatile("" : "+v"(tid));
  const int cc = tid & 63, tg = tid >> 6, r = cc & 15, g = cc >> 4, uid = c * 4 + h, hd = h * 64 + cc;
  for (int idx = tid; idx < 1024; idx += 512) { int tl = idx >> 4, j = idx & 15; sal[idx] = bf2f(p.proj[(long)(c * 64 + tl) * PC + OFF_D + 1024 + j]); }
  lds_barrier();
  float au[16];
#pragma unroll
  for (int j = 0; j < 16; ++j) au[j] = p.gla_alpha_up[j * 256 + hd];
  const float ab = p.gla_alpha_b[hd];
  float cum[8]; float run = 0.f;
#pragma unroll
  for (int i = 0; i < 8; ++i) {
    const int tl = tg * 8 + i; float x = ab;
#pragma unroll
    for (int j = 0; j < 16; ++j) x += sal[tl * 16 + j] * au[j];
    const float ls = fminf(x, 0.f) - __logf(1.f + __expf(-fabsf(x)));
    run += ls * (1.f / 16.f); cum[i] = run;
  }
  pre[tg * 64 + cc] = run;
  lds_barrier();
  float off = 0.f, tot = 0.f;
#pragma unroll
  for (int q = 0; q < 8; ++q) { float v = pre[q * 64 + cc]; tot += v; if (q < tg) off += v; }
  u16 kt8[8], v8a[8], v8b[8];
#pragma unroll
  for (int i = 0; i < 8; ++i) {
    const int tl = tg * 8 + i, t = c * 64 + tl; const u16* row = p.proj + (long)t * PC + OFF_D;
    const float cm = cum[i] + off;
    const float q = bf2f(row[hd]) * 0.125f, k = bf2f(row[256 + hd]);
    sRb[tl * LD + cc] = f2bf(q * __expf(cm)); sKb[tl * LD + cc] = f2bf(k * __expf(-cm)); kt8[i] = f2bf(k * __expf(tot - cm));
    v8a[i] = row[512 + h * 128 + cc]; v8b[i] = row[512 + h * 128 + 64 + cc];
  }
  *(uint4*)(sKtT + cc * LD + tg * 8) = pack8(kt8); *(uint4*)(sVT + cc * LD + tg * 8) = pack8(v8a); *(uint4*)(sVT + (64 + cc) * LD + tg * 8) = pack8(v8b);
  if (tg == 0) p.b.gl_gam[uid * 64 + cc] = __expf(tot);
  lds_barrier();
  for (int tile = tg; tile < 48; tile += 8) {
    if (tile < 16) {
      const int mt = tile >> 2, nt = tile & 3; f32x4 c4 = tile_nt(sRb, sKb, mt, nt, r, g);
#pragma unroll
      for (int reg = 0; reg < 4; ++reg) { int t = 16 * mt + 4 * g + reg, i = 16 * nt + r; p.b.gl_Pak[(long)uid * 4096 + t * 64 + i] = f2bf(i <= t ? c4[reg] : 0.f); }
    } else {
      const int q = tile - 16, mt = q >> 2, nt = q & 3; f32x4 c4 = tile_nt(sVT, sKtT, mt, nt, r, g);
#pragma unroll
      for (int reg = 0; reg < 4; ++reg) { int v = 16 * mt + 4 * g + reg, k = 16 * nt + r; p.b.gl_KVT[(long)uid * 8192 + v * 64 + k] = c4[reg]; }
    }
  }
  copy_out(sRb, p.b.gl_Rb + (long)uid * 4096, 64, tid); copy_out(sVT, p.b.gl_VT + (long)uid * 8192, 128, tid);
  lds_barrier();
}

__device__ __forceinline__ void p3_lru(const MixP& p, int c, int gq, char* smem) {
  u16* sx = (u16*)smem; float* sG = (float*)(smem + 9216); float* preA = sG + 8192; float* preB = preA + 512;
  int tid = threadIdx.x; asm volatile("" : "+v"(tid));
  const int cc = tid & 63, tg = tid >> 6, r = cc & 15, g = cc >> 4, ch = gq * 64 + cc, t0 = c * 64 + tg * 8;
  float xb[11];
  { u16 raw[11];
#pragma unroll
    for (int i = 0; i < 11; ++i) { const int t = t0 - 3 + i; raw[i] = p.proj[(long)(t >= 0 ? t : 0) * PC + OFF_C + ch]; }
      asm volatile("" ::: "memory");
#pragma unroll
    for (int i = 0; i < 11; ++i) xb[i] = bf2f(raw[i]) * (t0 - 3 + i >= 0 ? 1.f : 0.f); }
  const float cw0 = p.lru.conv_w[ch], cw1 = p.lru.conv_w[512 + ch], cw2 = p.lru.conv_w[1024 + ch], cw3 = p.lru.conv_w[1536 + ch], cb = p.lru.conv_b[ch];
  float xc[8];
#pragma unroll
  for (int i = 0; i < 8; ++i) { xc[i] = cb + cw0 * xb[i] + cw1 * xb[i + 1] + cw2 * xb[i + 2] + cw3 * xb[i + 3]; sx[(tg * 8 + i) * LD + cc] = f2bf(xc[i]); }
  lds_barrier();
  {
    const u16* wt = p.lru.wt + (long)gq * 4096;
#pragma unroll 1
    for (int q = tg; q < 32; q += 8) {
      const int m = q >> 4, tile = q & 15, mt = tile >> 2, nt = tile & 3;
      f32x4 c4 = {0.f, 0.f, 0.f, 0.f};
#pragma unroll
      for (int s_ = 0; s_ < 2; ++s_) {
        const bf16x8 af = *(const bf16x8*)(sx + (16 * mt + r) * LD + 32 * s_ + 8 * g);
        const bf16x8 bfr = *(const bf16x8*)(wt + (long)m * 8 * 4096 + (16 * nt + r) * 64 + 32 * s_ + 8 * g);
        c4 = __builtin_amdgcn_mfma_f32_16x16x32_bf16(af, bfr, c4, 0, 0, 0);
      }
#pragma unroll
      for (int reg = 0; reg < 4; ++reg) sG[(m * 64 + 16 * mt + 4 * g + reg) * 64 + 16 * nt + r] = c4[reg];
    }
  }
  lds_barrier();
  float ra[8], ix[8];
  { const float ba = p.lru.b_a[ch], bx = p.lru.b_x[ch];
#pragma unroll
    for (int i = 0; i < 8; ++i) { ra[i] = ba + sG[(tg * 8 + i) * 64 + cc]; ix[i] = bx + sG[(64 + tg * 8 + i) * 64 + cc]; } }
  const float lam = p.lru.lam[ch]; const float sp = fmaxf(-lam, 0.f) + log1pf(__expf(-fabsf(lam)));
  float hl[8], ac[8]; float A = 1.f, B = 0.f;
#pragma unroll
  for (int i = 0; i < 8; ++i) {
    const float rr = sigmoidf_(ra[i]), ig = sigmoidf_(ix[i]); const float log_a = -8.f * rr * sp;
    const bool reset = p.pos[t0 + i] == 0;
    const float av = reset ? 0.f : __expf(log_a); const float mult = reset ? 1.f : sqrtf(fmaxf(1.f - av * av, 0.f));
    const float bv = mult * ig * xc[i];
    B = av * B + bv; A *= av; hl[i] = B; ac[i] = A;
  }
  preA[tg * 64 + cc] = A; preB[tg * 64 + cc] = B;
  lds_barrier();
  float Ap = 1.f, Bp = 0.f;
#pragma unroll
  for (int q = 0; q < 7; ++q) if (q < tg) { float a = preA[q * 64 + cc], b = preB[q * 64 + cc]; Bp = a * Bp + b; Ap *= a; }
#pragma unroll
  for (int i = 0; i < 8; ++i) { long o = (long)(t0 + i) * 512 + ch; p.b.lr_h[o] = hl[i] + ac[i] * Bp; p.b.lr_A[o] = ac[i] * Ap; }
  lds_barrier();
}

template <int I, int N> struct SolveDot {
  static __device__ __forceinline__ void run(const LAS float* arow, const float (&X)[64], float (&acc)[4]) {
    if constexpr (I + 4 <= N) {
      const f32x4 a = *(const LAS f32x4*)(arow + I);
      acc[0] += a[0] * X[I]; acc[1] += a[1] * X[I + 1]; acc[2] += a[2] * X[I + 2]; acc[3] += a[3] * X[I + 3];
      SolveDot<I + 4, N>::run(arow, X, acc);
    } else if constexpr (I < N) { acc[I & 3] += arow[I] * X[I]; SolveDot<I + 1, N>::run(arow, X, acc); }
  }
};
template <int T> struct SolveRow {
  static __device__ __forceinline__ void run(const LAS float* sAab, const LAS float* sRhs, int tid, float (&X)[64]) {
    if constexpr (T < 64) {
      float acc[4] = {sRhs[T * 128 + tid], 0.f, 0.f, 0.f};
      SolveDot<0, T>::run(sAab + T * 64, X, acc);
      X[T] = (acc[0] + acc[1]) + (acc[2] + acc[3]);
      asm volatile("" ::: "memory");
      SolveRow<T + 1>::run(sAab, sRhs, tid, X);
    }
  }
};
__device__ __forceinline__ void p3_rwkv_solve(const MixP& p, int uid, int tid, const float* sRhs, const float* sAab) {
  float X[64];
  const int col = tid & 63; const bool isAl = tid < 64;
  const LAS float* lA = (const LAS float*)sAab; const LAS float* lR = (const LAS float*)sRhs;
  asm volatile("" : "+v"(lA), "+v"(lR));
  SolveRow<0>::run(lA, lR, tid, X);
  if (isAl) {
    int s, g_, j; inv_perm(col, s, g_, j);
#pragma unroll
    for (int t = 0; t < 64; ++t) p.b.rw_WpF[(long)uid * 4096 + (((t >> 4) * 2 + s) * 64 + g_ * 16 + (t & 15)) * 8 + j] = f2bf(X[t]);
  } else {
    const int vs = col >> 4, r_ = col & 15;
#pragma unroll
    for (int tt = 0; tt < 4; ++tt)
#pragma unroll
      for (int g_ = 0; g_ < 4; ++g_) {
        f32x4 o = {X[16 * tt + 4 * g_], X[16 * tt + 4 * g_ + 1], X[16 * tt + 4 * g_ + 2], X[16 * tt + 4 * g_ + 3]};
        *(f32x4*)(p.b.rw_U0F + (((long)uid * 4 + vs) * 4 + tt) * 256 + (g_ * 16 + r_) * 4) = o;
      }
  }
}
__device__ __forceinline__ void p3_rwkv(const MixP& p, int c, int h, char* smem) {
  u16* sRb = (u16*)smem; u16* sKb = sRb + 64 * LD; u16* sAl = sKb + 64 * LD; u16* sBe = sAl + 64 * LD; u16* sKtT = sBe + 64 * LD; u16* sVT = sKtT + 64 * LD;
  float* pre = (float*)(smem + 55296);
  char* R2 = smem + 57344;
  constexpr int LDA_ = 168;
  u16* sAct = (u16*)R2; float* sLo = (float*)(R2 + 21504);
  float* sAab = (float*)R2; u16* sAak = (u16*)(R2 + 16384); float* sRhs = (float*)(R2 + 16384 + 9216);
  int tid = threadIdx.x; asm volatile("" : "+v"(tid));
  const int cc = tid & 63, tg = tid >> 6, r = cc & 15, g = cc >> 4, uid = c * 8 + h, hc = h * 64 + cc, t0 = c * 64 + tg * 8;
  const u16* proj = p.proj;
  {
    u16 c16[20], p16[20]; float mu20[20];
#pragma unroll
    for (int q = 0; q < 20; ++q) {
      const int idx = tid + 512 * q, tl = idx / 160, j = idx - tl * 160, t = c * 64 + tl, col = 1536 + j;
      c16[q] = proj[(long)t * PC + col]; p16[q] = proj[(long)(t > 0 ? t - 1 : 0) * PC + col]; mu20[q] = p.rw.mu[col];
    }
      asm volatile("" ::: "memory");
#pragma unroll
    for (int q = 0; q < 20; ++q) {
      const int idx = tid + 512 * q, tl = idx / 160, j = idx - tl * 160;
      const float cur = bf2f(c16[q]), prev = bf2f(p16[q]) * ((c * 64 + tl) > 0 ? 1.f : 0.f);
      const float z = cur + (prev - cur) * mu20[q];
      const float sg_ = sigmoidf_(j < 32 ? 2.f * z : z);
      sAct[tl * LDA_ + j] = f2bf(j < 32 ? 2.f * sg_ - 1.f : (j < 64 ? z : sg_));
    }
  }
  float zr[8], zk[8], zv[8];
  {
    float pr[9], pk[9], pv[9];
#pragma unroll
    for (int i = 0; i < 9; ++i) { const int t = t0 - 1 + i; const bool ok = t >= 0; const u16* row = proj + (long)(ok ? t : 0) * PC; const u16 a_ = row[hc], b_ = row[512 + hc], c_ = row[1024 + hc];
      const float m_ = ok ? 1.f : 0.f; pr[i] = bf2f(a_) * m_; pk[i] = bf2f(b_) * m_; pv[i] = bf2f(c_) * m_; }
    const float mr = p.rw.mu[hc], mk = p.rw.mu[512 + hc], mv = p.rw.mu[1024 + hc];
#pragma unroll
    for (int i = 0; i < 8; ++i) { zr[i] = pr[i + 1] + (pr[i] - pr[i + 1]) * mr; zk[i] = pk[i + 1] + (pk[i] - pk[i + 1]) * mk; zv[i] = pv[i + 1] + (pv[i] - pv[i + 1]) * mv; }
  }
  lds_barrier();
  {
    const u16* wl = p.rw.lora_w + (long)(h * 64) * 160;
#pragma unroll 1
    for (int q = tg; q < 48; q += 8) {
      const int o = q >> 4, tile = q & 15, mt = tile >> 2, nt = tile & 3, s0 = o == 0 ? 0 : (o == 1 ? 1 : 2), ns = o == 2 ? 3 : 1;
      f32x4 c4 = {0.f, 0.f, 0.f, 0.f};
#pragma unroll 1
      for (int s_ = s0; s_ < s0 + ns; ++s_) {
        const bf16x8 af = *(const bf16x8*)(sAct + (16 * mt + r) * LDA_ + 32 * s_ + 8 * g);
        const bf16x8 bfr = *(const bf16x8*)(wl + (long)(16 * nt + r) * 160 + 32 * s_ + 8 * g);
        c4 = __builtin_amdgcn_mfma_f32_16x16x32_bf16(af, bfr, c4, 0, 0, 0);
      }
#pragma unroll
      for (int reg = 0; reg < 4; ++reg) sLo[(o * 64 + 16 * mt + 4 * g + reg) * 64 + 16 * nt + r] = c4[reg];
    }
  }
  lds_barrier();
  float wv[8], av[8], gv[8];
  { const float w0 = p.rw.w0[hc], a0 = p.rw.a0[hc];
#pragma unroll
    for (int i = 0; i < 8; ++i) { wv[i] = w0 + sLo[(tg * 8 + i) * 64 + cc]; av[i] = a0 + sLo[(64 + tg * 8 + i) * 64 + cc]; gv[i] = sLo[(128 + tg * 8 + i) * 64 + cc]; } }
  lds_barrier();
  const float kkw = p.rw.k_k[hc], kaw = p.rw.k_a[hc], rkw = p.rw.r_k[hc];
  float lw[8], aa[8], kk[8], kp[8], cum[8]; float run = 0.f;
#pragma unroll
  for (int i = 0; i < 8; ++i) {
    lw[i] = -0.6065306597126334f * sigmoidf_(wv[i]); aa[i] = sigmoidf_(av[i]);
    float k0 = zk[i] * kkw; const float ss = wave_sum(k0 * k0); kk[i] = k0 / fmaxf(sqrtf(ss), 1e-12f);
    kp[i] = zk[i] * (1.f + (aa[i] - 1.f) * kaw);
    const float bs = wave_sum(zr[i] * kp[i] * rkw);
    const long o = (long)(t0 + i) * 512 + hc;
    p.b.rw_G[o] = f2bf(gv[i]); p.b.rw_BV[o] = f2bf(bs * zv[i]);
    run += lw[i]; cum[i] = run;
  }
  pre[tg * 64 + cc] = run;
  lds_barrier();
  float off = 0.f, tot = 0.f;
#pragma unroll
  for (int q = 0; q < 8; ++q) { float v = pre[q * 64 + cc]; tot += v; if (q < tg) off += v; }
  {
    u16 kt8[8], v8[8];
    const int kt = cc >> 4, r_ = cc & 15;
#pragma unroll
    for (int i = 0; i < 8; ++i) {
      const int tl = tg * 8 + i; const float cm = cum[i] + off, cx = cm - lw[i];
      const float en = __expf(-cm), et = __expf(tot - cm);
      sAl[tl * LD + cc] = f2bf(-kk[i] * __expf(cx)); sBe[tl * LD + cc] = f2bf(kk[i] * aa[i] * en);
      sKb[tl * LD + cc] = f2bf(kp[i] * en); sRb[tl * LD + cc] = f2bf(zr[i] * __expf(cm));
      kt8[i] = f2bf(kp[i] * et); v8[i] = f2bf(zv[i]);
      int s, g_, j; inv_perm(tl, s, g_, j);
      p.b.rw_BtF[(long)uid * 4096 + ((kt * 2 + s) * 64 + g_ * 16 + r_) * 8 + j] = f2bf(kk[i] * aa[i] * et);
    }
    *(uint4*)(sKtT + cc * LD + tg * 8) = pack8(kt8); *(uint4*)(sVT + cc * LD + tg * 8) = pack8(v8);
    if (tg == 0) p.b.rw_gam[uid * 64 + cc] = __expf(tot);
  }
  lds_barrier();
  for (int q = tg; q < 80; q += 8) {
    const int kind = q >> 4, tt = q & 15, mt = tt >> 2, nt = tt & 3;
    if (kind == 0) { f32x4 c4 = tile_nt(sAl, sBe, mt, nt, r, g);
#pragma unroll
      for (int reg = 0; reg < 4; ++reg) { int t = 16 * mt + 4 * g + reg, i = 16 * nt + r; sAab[t * 64 + i] = i < t ? c4[reg] : 0.f; }
    } else if (kind == 1) { f32x4 c4 = tile_nt(sAl, sKb, mt, nt, r, g);
#pragma unroll
      for (int reg = 0; reg < 4; ++reg) { int t = 16 * mt + 4 * g + reg, i = 16 * nt + r; sAak[t * LD + i] = f2bf(i < t ? c4[reg] : 0.f); }
    } else if (kind == 2) { f32x4 c4 = tile_nt(sRb, sBe, mt, nt, r, g);
#pragma unroll
      for (int reg = 0; reg < 4; ++reg) { int t = 16 * mt + 4 * g + reg, i = 16 * nt + r; p.b.rw_Pab[(long)uid * 4096 + t * 64 + i] = f2bf(i <= t ? c4[reg] : 0.f); }
    } else if (kind == 3) { f32x4 c4 = tile_nt(sRb, sKb, mt, nt, r, g);
#pragma unroll
      for (int reg = 0; reg < 4; ++reg) { int t = 16 * mt + 4 * g + reg, i = 16 * nt + r; p.b.rw_Pak[(long)uid * 4096 + t * 64 + i] = f2bf(i <= t ? c4[reg] : 0.f); }
    } else { f32x4 c4 = tile_nt(sKtT, sVT, mt, nt, r, g);
      *(f32x4*)(p.b.rw_KVF + (((long)uid * 4 + nt) * 4 + mt) * 256 + cc * 4) = c4;
    }
  }
  lds_barrier();
  for (int q = tg; q < 16; q += 8) { const int mt = q >> 2, nt = q & 3; f32x4 c4 = tile_nt(sAak, sVT, mt, nt, r, g);
#pragma unroll
    for (int reg = 0; reg < 4; ++reg) { int t = 16 * mt + 4 * g + reg, v = 16 * nt + r; sRhs[t * 128 + 64 + v] = c4[reg]; } }
  for (int idx = tid; idx < 4096; idx += 512) { int t = idx >> 6, k = idx & 63; sRhs[t * 128 + k] = bf2f(sAl[t * LD + k]); }
  copy_out(sRb, p.b.rw_Rb + (long)uid * 4096, 64, tid); copy_out(sVT, p.b.rw_VT + (long)uid * 4096, 64, tid);
  lds_barrier();
  if (tid < 128) p3_rwkv_solve(p, uid, tid, sRhs, sAab);
  else {
    const int w6 = __builtin_amdgcn_readfirstlane(tid >> 6) - 2;
    moe_tile(p.ws, p.smem, p.layer, uid * 6 + w6, tid & 63);
  }
  lds_barrier();
}

constexpr int CH_SLOT = 24832;
constexpr int CH_LA = 3, CH_NS = 4;
__device__ __forceinline__ void chain_piece(const MixP& p, int uid, int vs, int pc, char* slot, int lane) {
  if (pc < 8) __builtin_amdgcn_global_load_lds((const unsigned*)(p.b.rw_WpF + (long)uid * 4096 + pc * 512 + lane * 8), (unsigned*)(slot + pc * 1024 + lane * 16), 16, 0, 0);
  else if (pc < 16) __builtin_amdgcn_global_load_lds((const unsigned*)(p.b.rw_BtF + (long)uid * 4096 + (pc - 8) * 512 + lane * 8), (unsigned*)(slot + 8192 + (pc - 8) * 1024 + lane * 16), 16, 0, 0);
  else if (pc < 20) __builtin_amdgcn_global_load_lds((const unsigned*)(p.b.rw_U0F + ((long)uid * 4 + vs) * 1024 + (pc - 16) * 256 + lane * 4), (unsigned*)(slot + 16384 + (pc - 16) * 1024 + lane * 16), 16, 0, 0);
  else if (pc < 24) __builtin_amdgcn_global_load_lds((const unsigned*)(p.b.rw_KVF + ((long)uid * 4 + vs) * 1024 + (pc - 20) * 256 + lane * 4), (unsigned*)(slot + 20480 + (pc - 20) * 1024 + lane * 16), 16, 0, 0);
  else __builtin_amdgcn_global_load_lds((const unsigned*)(p.b.rw_gam + uid * 64 + lane), (unsigned*)(slot + 24576 + lane * 4), 4, 0, 0);
}
__device__ __forceinline__ void chain_issue(const MixP& p, int uid, int vs, char* slot, int w, int lane) {
#pragma unroll
  for (int i = 0; i < 4; ++i) { const int pc = (w - 1) + 7 * i; if (pc < 25) chain_piece(p, uid, vs, pc, slot, lane); }
}
typedef __attribute__((ext_vector_type(4))) unsigned u32x4;
__device__ __forceinline__ bf16x8 frag_of(unsigned a, unsigned b, unsigned c, unsigned d) { u32x4 v = {a, b, c, d}; return __builtin_bit_cast(bf16x8, v); }
__device__ __forceinline__ void p4_rwkv_chain(const MixP& p, int h, int vs, char* ring, int w, int lane) {
  const int r = lane & 15, g = lane >> 4, v = vs * 16 + r;
  const bool loader = w > 0; const int npc = (w >= 1 && w <= 4) ? 4 : 3;
  f32x4 ST[4];
#pragma unroll
  for (int kt = 0; kt < 4; ++kt) ST[kt] = (f32x4){0.f, 0.f, 0.f, 0.f};
  if (loader) { for (int c = 0; c < CH_LA; ++c) chain_issue(p, c * 8 + h, vs, ring + c * CH_SLOT, w, lane); }
#pragma unroll 1
  for (int c = 0; c < NCH; ++c) {
    const int uid = c * 8 + h; char* slot = ring + (c % CH_NS) * CH_SLOT;
    if (loader) {
      const int younger = (NCH - 1 - c < CH_LA - 1 ? NCH - 1 - c : CH_LA - 1);
      if (younger == 2) { if (npc == 4) asm volatile("s_waitcnt vmcnt(8)" ::: "memory"); else asm volatile("s_waitcnt vmcnt(6)" ::: "memory"); }
      else if (younger == 1) { if (npc == 4) asm volatile("s_waitcnt vmcnt(4)" ::: "memory"); else asm volatile("s_waitcnt vmcnt(3)" ::: "memory"); }
      else asm volatile("s_waitcnt vmcnt(0)" ::: "memory");
    }
    __builtin_amdgcn_s_barrier();
    if (loader) { if (c + CH_LA < NCH) chain_issue(p, (c + CH_LA) * 8 + h, vs, ring + ((c + CH_LA) % CH_NS) * CH_SLOT, w, lane); }
    else {
      unsigned ps[4][2];
#pragma unroll
      for (int kt = 0; kt < 4; ++kt) { ps[kt][0] = pack_bf16(ST[kt][0], ST[kt][1]); ps[kt][1] = pack_bf16(ST[kt][2], ST[kt][3]); }
      bf16x8 bS[2];
#pragma unroll
      for (int s = 0; s < 2; ++s) bS[s] = frag_of(ps[2 * s][0], ps[2 * s][1], ps[2 * s + 1][0], ps[2 * s + 1][1]);
#pragma unroll
      for (int kt = 0; kt < 4; ++kt) { uint2 pk; pk.x = ps[kt][0]; pk.y = ps[kt][1]; *(uint2*)(p.b.rw_S0 + (long)uid * 4096 + v * 64 + 16 * kt + 4 * g) = pk; }
      f32x4 U[4];
#pragma unroll
      for (int tt = 0; tt < 4; ++tt) {
        U[tt] = *(const f32x4*)(slot + 16384 + tt * 1024 + lane * 16);
#pragma unroll
        for (int s = 0; s < 2; ++s) { bf16x8 a = *(const bf16x8*)(slot + (tt * 2 + s) * 1024 + lane * 16); U[tt] = __builtin_amdgcn_mfma_f32_16x16x32_bf16(a, bS[s], U[tt], 0, 0, 0); }
      }
      unsigned pu[4][2];
#pragma unroll
      for (int tt = 0; tt < 4; ++tt) { pu[tt][0] = pack_bf16(U[tt][0], U[tt][1]); pu[tt][1] = pack_bf16(U[tt][2], U[tt][3]); }
      bf16x8 bU[2];
#pragma unroll
      for (int s = 0; s < 2; ++s) bU[s] = frag_of(pu[2 * s][0], pu[2 * s][1], pu[2 * s + 1][0], pu[2 * s + 1][1]);
#pragma unroll
      for (int tt = 0; tt < 4; ++tt) { uint2 pk; pk.x = pu[tt][0]; pk.y = pu[tt][1]; *(uint2*)(p.b.rw_UT + (long)uid * 4096 + v * 64 + 16 * tt + 4 * g) = pk; }
#pragma unroll
      for (int kt = 0; kt < 4; ++kt) {
        const f32x4 gm = *(const f32x4*)(slot + 24576 + (16 * kt + 4 * g) * 4); const f32x4 kv = *(const f32x4*)(slot + 20480 + kt * 1024 + lane * 16);
        f32x4 a4 = ST[kt] * gm + kv;
#pragma unroll
        for (int s = 0; s < 2; ++s) { bf16x8 a = *(const bf16x8*)(slot + 8192 + (kt * 2 + s) * 1024 + lane * 16); a4 = __builtin_amdgcn_mfma_f32_16x16x32_bf16(a, bU[s], a4, 0, 0, 0); }
        ST[kt] = a4;
      }
      asm volatile("s_waitcnt lgkmcnt(0)" ::: "memory");
    }
  }
}
__device__ __forceinline__ void p4_elem(const MixP& p, int e) {
  if (e < 32768) {
    const int h = e >> 12, vk = e & 4095; const float lg2 = log2f(1.f - exp2f(-(5.f + 4.f * (float)h / 7.f))); const float gm = exp2f(lg2 * 64.f);
    float S = 0.f;
#pragma unroll 1
    for (int c0 = 0; c0 < NCH; c0 += 16) {
      float kv[16];
#pragma unroll
      for (int i = 0; i < 16; ++i) kv[i] = p.b.rt_KVT[(long)((c0 + i) * 8 + h) * 4096 + vk];
      PIN8O(kv, 0); PIN8O(kv, 8);
#pragma unroll
      for (int i = 0; i < 16; ++i) { p.b.rt_S0[(long)((c0 + i) * 8 + h) * 4096 + vk] = f2bf(S); S = S * gm + kv[i]; }
    }
  } else {
    const int e2 = e - 32768, h = e2 >> 13, vk = e2 & 8191, k = vk & 63;
    float S = 0.f;
#pragma unroll 1
    for (int c0 = 0; c0 < NCH; c0 += 8) {
      float kv[8], gm[8];
#pragma unroll
      for (int i = 0; i < 8; ++i) { kv[i] = p.b.gl_KVT[(long)((c0 + i) * 4 + h) * 8192 + vk]; gm[i] = p.b.gl_gam[((c0 + i) * 4 + h) * 64 + k]; }
      PIN8x2(kv, gm);
#pragma unroll
      for (int i = 0; i < 8; ++i) { p.b.gl_S0[(long)((c0 + i) * 4 + h) * 8192 + vk] = f2bf(S); S = S * gm[i] + kv[i]; }
    }
  }
}
__device__ __forceinline__ void p4_lru(const MixP& p, int ch) {
  float H = 0.f;
#pragma unroll 1
  for (int c0 = 0; c0 < NCH; c0 += 8) {
    float a[8], b[8];
#pragma unroll
    for (int i = 0; i < 8; ++i) { long o = (long)((c0 + i) * 64 + 63) * 512 + ch; a[i] = p.b.lr_A[o]; b[i] = p.b.lr_h[o]; }
    PIN8x2(a, b);
#pragma unroll
    for (int i = 0; i < 8; ++i) { p.b.lr_Hp[(c0 + i) * 512 + ch] = H; H = a[i] * H + b[i]; }
  }
}

template <int NVT, bool DELTA, int NMT>
__device__ __forceinline__ void p5_mm(const u16* Rb, const u16* S0, const u16* Pak, const u16* VT, const u16* Pab, const u16* UT, int mt0, int r, int g, f32x4 (&acc)[NMT][4 * NVT]) {
#pragma unroll
  for (int mt = 0; mt < NMT; ++mt)
#pragma unroll
    for (int nt = 0; nt < 4 * NVT; ++nt) acc[mt][nt] = (f32x4){0.f, 0.f, 0.f, 0.f};
#pragma unroll 1
  for (int pr = 0; pr < (DELTA ? 3 : 2); ++pr) {
    const u16* A = pr == 0 ? Rb : (pr == 1 ? Pak : Pab); const u16* B = pr == 0 ? S0 : (pr == 1 ? VT : UT);
    bf16x8 af[NMT][2], bfr[4 * NVT][2];
#pragma unroll
    for (int s = 0; s < 2; ++s) {
#pragma unroll
      for (int mt = 0; mt < NMT; ++mt) af[mt][s] = *(const bf16x8*)(A + (16 * (mt0 + mt) + r) * 64 + 32 * s + 8 * g);
#pragma unroll
      for (int nt = 0; nt < 4 * NVT; ++nt) bfr[nt][s] = *(const bf16x8*)(B + (16 * nt + r) * 64 + 32 * s + 8 * g);
    }
#pragma unroll
    for (int s = 0; s < 2; ++s)
#pragma unroll
      for (int nt = 0; nt < 4 * NVT; ++nt)
#pragma unroll
        for (int mt = 0; mt < NMT; ++mt) acc[mt][nt] = __builtin_amdgcn_mfma_f32_16x16x32_bf16(bfr[nt][s], af[mt][s], acc[mt][nt], 0, 0, 0);
  }
}
__device__ __forceinline__ float red4g(float v) { v += __shfl_xor(v, 16, 64); v += __shfl_xor(v, 32, 64); return v; }
__device__ __forceinline__ f32x4 bf4(uint2 u) { return (f32x4){__uint_as_float(u.x << 16), __uint_as_float(u.x & 0xffff0000u), __uint_as_float(u.y << 16), __uint_as_float(u.y & 0xffff0000u)}; }
__device__ __forceinline__ void p5_rwkv(const MixP& p, int c, int h, int lane) {
  const int r = lane & 15, g = lane >> 4; const long uo = (long)(c * 8 + h) * 4096;
  f32x4 lg[4], lb[4];
#pragma unroll
  for (int nt = 0; nt < 4; ++nt) { lg[nt] = *(const f32x4*)(p.rw.ln_g + h * 64 + 16 * nt + 4 * g); lb[nt] = *(const f32x4*)(p.rw.ln_b + h * 64 + 16 * nt + 4 * g); }
#pragma unroll 1
  for (int mh = 0; mh < 2; ++mh) {
    f32x4 acc[2][4];
    p5_mm<1, true, 2>(p.b.rw_Rb + uo, p.b.rw_S0 + uo, p.b.rw_Pak + uo, p.b.rw_VT + uo, p.b.rw_Pab + uo, p.b.rw_UT + uo, mh * 2, r, g, acc);
#pragma unroll
    for (int mt = 0; mt < 2; ++mt) {
      const int t = c * 64 + 16 * (mh * 2 + mt) + r; const long o = (long)t * 512 + h * 64 + 4 * g;
      uint2 bv[4], gg[4];
#pragma unroll
      for (int nt = 0; nt < 4; ++nt) { bv[nt] = *(const uint2*)(p.b.rw_BV + o + 16 * nt); gg[nt] = *(const uint2*)(p.b.rw_G + o + 16 * nt); }
      float s1 = 0.f;
#pragma unroll
      for (int nt = 0; nt < 4; ++nt) s1 += acc[mt][nt][0] + acc[mt][nt][1] + acc[mt][nt][2] + acc[mt][nt][3];
      const float mean = red4g(s1) * (1.f / 64.f);
      float s2 = 0.f;
#pragma unroll
      for (int nt = 0; nt < 4; ++nt)
#pragma unroll
        for (int j = 0; j < 4; ++j) { const float d = acc[mt][nt][j] - mean; s2 += d * d; }
      const float rs = rsqrtf(red4g(s2) * (1.f / 64.f) + 64e-5f);
#pragma unroll
      for (int nt = 0; nt < 4; ++nt) {
        const f32x4 yn = (acc[mt][nt] - mean) * rs * lg[nt] + lb[nt];
        *(uint2*)(p.ycat + (long)t * DM + h * 64 + 16 * nt + 4 * g) = pack4((yn + bf4(bv[nt])) * bf4(gg[nt]));
      }
    }
  }
}
__device__ __forceinline__ void p5_ret(const MixP& p, int c, int h, int lane) {
  const int r = lane & 15, g = lane >> 4; const long uo = (long)(c * 8 + h) * 4096;
  f32x4 ng[4];
#pragma unroll
  for (int nt = 0; nt < 4; ++nt) ng[nt] = *(const f32x4*)(p.ret_norm_g + h * 64 + 16 * nt + 4 * g);
#pragma unroll 1
  for (int mh = 0; mh < 2; ++mh) {
    f32x4 acc[2][4];
    p5_mm<1, false, 2>(p.b.rt_Rb + uo, p.b.rt_S0 + uo, p.b.rt_Pak + uo, p.b.rt_VT + uo, nullptr, nullptr, mh * 2, r, g, acc);
#pragma unroll
    for (int mt = 0; mt < 2; ++mt) {
      const int t = c * 64 + 16 * (mh * 2 + mt) + r;
      uint2 gt2[4];
#pragma unroll
      for (int nt = 0; nt < 4; ++nt) gt2[nt] = *(const uint2*)(p.proj + (long)t * PC + OFF_B + 1536 + h * 64 + 16 * nt + 4 * g);
      float s2 = 0.f;
#pragma unroll
      for (int nt = 0; nt < 4; ++nt)
#pragma unroll
        for (int j = 0; j < 4; ++j) s2 += acc[mt][nt][j] * acc[mt][nt][j];
      const float rs = rsqrtf(red4g(s2) * (1.f / 64.f) + 1e-6f);
#pragma unroll
      for (int nt = 0; nt < 4; ++nt) {
        const f32x4 gt = bf4(gt2[nt]); f32x4 o;
#pragma unroll
        for (int j = 0; j < 4; ++j) o[j] = acc[mt][nt][j] * rs * ng[nt][j] * gt[j] * sigmoidf_(gt[j]);
        *(uint2*)(p.ycat + (long)t * DM + 512 + h * 64 + 16 * nt + 4 * g) = pack4(o);
      }
    }
  }
}
__device__ __forceinline__ void p5_gla(const MixP& p, int c, int h, int lane) {
  const int r = lane & 15, g = lane >> 4; const int uid = c * 4 + h;
  f32x4 ng[8];
#pragma unroll
  for (int nt = 0; nt < 8; ++nt) ng[nt] = *(const f32x4*)(p.gla_norm_g + h * 128 + 16 * nt + 4 * g);
#pragma unroll 1
  for (int mq = 0; mq < 4; ++mq) {
    f32x4 acc[1][8];
    p5_mm<2, false, 1>(p.b.gl_Rb + (long)uid * 4096, p.b.gl_S0 + (long)uid * 8192, p.b.gl_Pak + (long)uid * 4096, p.b.gl_VT + (long)uid * 8192, nullptr, nullptr, mq, r, g, acc);
    const int t = c * 64 + 16 * mq + r;
    uint2 gt2[8];
#pragma unroll
    for (int nt = 0; nt < 8; ++nt) gt2[nt] = *(const uint2*)(p.proj + (long)t * PC + OFF_D + 1040 + h * 128 + 16 * nt + 4 * g);
    float s2 = 0.f;
#pragma unroll
    for (int nt = 0; nt < 8; ++nt)
#pragma unroll
      for (int j = 0; j < 4; ++j) s2 += acc[0][nt][j] * acc[0][nt][j];
    const float rs = rsqrtf(red4g(s2) * (1.f / 128.f) + 1e-6f);
#pragma unroll
    for (int nt = 0; nt < 8; ++nt) {
      const f32x4 gt = bf4(gt2[nt]); f32x4 o;
#pragma unroll
      for (int j = 0; j < 4; ++j) o[j] = acc[0][nt][j] * rs * ng[nt][j] * gt[j] * sigmoidf_(gt[j]);
      *(uint2*)(p.ycat + (long)t * DM + 1536 + h * 128 + 16 * nt + 4 * g) = pack4(o);
    }
  }
}
__device__ __forceinline__ void p5_lru8(const MixP& p, long idx0, long stride) {
  float hv[8], av[8], hp[8]; u16 gb[8];
#pragma unroll
  for (int q = 0; q < 8; ++q) { const long idx = idx0 + q * stride; const int t = (int)(idx >> 9), ch = (int)(idx & 511), c = t >> 6;
    hv[q] = p.b.lr_h[idx]; av[q] = p.b.lr_A[idx]; hp[q] = p.b.lr_Hp[c * 512 + ch]; gb[q] = p.proj[(long)t * PC + OFF_C + 512 + ch]; }
      asm volatile("" ::: "memory");
#pragma unroll
  for (int q = 0; q < 8; ++q) { const long idx = idx0 + q * stride; const int t = (int)(idx >> 9), ch = (int)(idx & 511);
    p.ycat[(long)t * DM + 1024 + ch] = f2bf((hv[q] + av[q] * hp[q]) * gelu_tanh(bf2f(gb[q]))); }
}
__device__ __forceinline__ void in_proj_tail(char* ws, int l, int pm, u16* shm) {
  OPAQUE_WS(ws);
  const u16* Bt = wsp<u16>(ws, WS::WT_IN) + (long)l * PC * DM; const u16* xn = wsp<u16>(ws, WS::XN);
  EpiProj e{wsp<u16>(ws, WS::PROJ), pm * 256, 56 * 256};
  gemm256(xn + (long)pm * 256 * DM, DM, Bt + (long)56 * 256 * DM, DM, DM, shm, e);
}
__device__ __forceinline__ void phase_mix3(const MixP& p, char* smem) {
  unsigned* ctr = (unsigned*)p.ws + 3584 + p.layer * 16;
  int* slot = (int*)(smem + PH_BYTES - 16);
#pragma unroll 1
  for (;;) {
    if (threadIdx.x == 0) *slot = (int)__hip_atomic_fetch_add(ctr, 1u, __ATOMIC_RELAXED, __HIP_MEMORY_SCOPE_AGENT);
    lds_barrier();
    const int u0 = *slot;
    lds_barrier();
    if (u0 >= 32 + 3584) break;
    if (u0 < 32) { in_proj_tail(p.ws, p.layer, u0, (u16*)smem); continue; }
    const int u = u0 - 32;
    if (u < 1024) p3_rwkv(p, u >> 3, u & 7, smem);
    else if (u < 2048) p3_ret(p, (u - 1024) >> 3, (u - 1024) & 7, smem);
    else if (u < 2560) p3_gla(p, (u - 2048) >> 2, (u - 2048) & 3, smem);
    else p3_lru(p, (u - 2560) >> 3, (u - 2560) & 7, smem);
  }
}
__device__ __forceinline__ void phase_mix4(const MixP& p, char* smem) {
  int tid = threadIdx.x; asm volatile("" : "+v"(tid));
#pragma unroll 1
  for (int b = blockIdx.x; b < 256; b += gridDim.x) {
    if (b < 32) p4_rwkv_chain(p, b >> 2, b & 3, smem, __builtin_amdgcn_readfirstlane(tid >> 6), tid & 63);
    else if (b >= 64 && b < 192) p4_elem(p, (b - 64) * 512 + tid);
    else if (b == 200) p4_lru(p, tid);
    __syncthreads();
  }
}
__device__ __forceinline__ void phase_mix5(const MixP& p, char* smem) {
  int tid = threadIdx.x; asm volatile("" : "+v"(tid));
  const int lane = tid & 63;
  unsigned* ctr = (unsigned*)p.ws + 3584 + 64 + p.layer * 16;
  int* slot = (int*)(smem + PH_BYTES - 16);
  const int w = __builtin_amdgcn_readfirstlane(tid >> 6);
#pragma unroll 1
  for (;;) {
    if (tid == 0) *slot = (int)__hip_atomic_fetch_add(ctr, 8u, __ATOMIC_RELAXED, __HIP_MEMORY_SCOPE_AGENT);
    lds_barrier();
    const int u = *slot + w;
    lds_barrier();
    if (u - w >= 2560) break;
    if (u < 512) p5_gla(p, u >> 2, u & 3, lane);
    else if (u < 1536) p5_rwkv(p, (u - 512) >> 3, (u - 512) & 7, lane);
    else if (u < 2560) p5_ret(p, (u - 1536) >> 3, (u - 1536) & 7, lane);
  }
  { const long nthr = (long)gridDim.x * 512;
    long idx = (long)blockIdx.x * 512 + tid;
    for (; idx + 7 * nthr < (long)T_ * 512; idx += 8 * nthr) p5_lru8(p, idx, nthr);
    for (; idx < (long)T_ * 512; idx += nthr) {
      const int t = (int)(idx >> 9), ch = (int)(idx & 511), c = t >> 6;
      p.ycat[(long)t * DM + 1024 + ch] = f2bf((p.b.lr_h[idx] + p.b.lr_A[idx] * p.b.lr_Hp[c * 512 + ch]) * gelu_tanh(bf2f(p.proj[(long)t * PC + OFF_C + 512 + ch]))); } }
}

#define XB_TMO      128
#define XB_XCNT(j)  (256  + 64 * (j))
#define XB_XSUB(j)  (1280 + 64 * (j))
#define XB_XGEN(j)  (2304 + 64 * (j))
#define XB_TOP      3328
#define XB_TOPGEN   3392
#define XCD_BAR_WORDS 3456
#define XB_SPIN_CAP (1u << 18)
__device__ __forceinline__ unsigned xb_ld(unsigned* p)              { return __hip_atomic_load(p, __ATOMIC_RELAXED, __HIP_MEMORY_SCOPE_AGENT); }
__device__ __forceinline__ unsigned xb_add(unsigned* p, unsigned v) { return __hip_atomic_fetch_add(p, v, __ATOMIC_RELAXED, __HIP_MEMORY_SCOPE_AGENT); }
__device__ __forceinline__ unsigned xb_xcc_id() { return (unsigned)__builtin_amdgcn_s_getreg((3 << 11) | 20) & 0xFu; }
#define XB_SPIN(cond, bar) do { unsigned _sp = 0; while (cond) { __builtin_amdgcn_s_sleep(1); \
    if ((++_sp & 255u) == 0u) { if (xb_ld(&(bar)[XB_TMO])) break; if (_sp > XB_SPIN_CAP) { atomicAdd(&(bar)[XB_TMO], 1u); break; } } } } while (0)
struct XcdBarrier { unsigned* bar; unsigned x; volatile LAS unsigned* st; };
__device__ __forceinline__ XcdBarrier xcd_barrier_post(unsigned* bar, volatile LAS unsigned* st) {
    XcdBarrier b; b.bar = bar; b.x = xb_xcc_id(); b.st = st;
    if (threadIdx.x == 0) (void)xb_add(&bar[XB_XCNT(b.x)], 1u);
    return b;
}
__device__ __forceinline__ void xcd_barrier_complete(unsigned* bar, unsigned x, unsigned& nloc, unsigned& nx) {
    const unsigned G = gridDim.x * gridDim.y * gridDim.z;
    unsigned sum, cnt, mine, sp = 0u;
    for (;;) {
        sum = 0u; cnt = 0u; mine = 0u;
#pragma unroll
        for (unsigned j = 0; j < 16; ++j) { const unsigned c = xb_ld(&bar[XB_XCNT(j)]); sum += c; cnt += (c > 0u) ? 1u : 0u; mine = (j == x) ? c : mine; }
        if (sum == G) break;
        __builtin_amdgcn_s_sleep(1);
        if ((++sp & 255u) == 0u) { if (xb_ld(&bar[XB_TMO])) break; if (sp > XB_SPIN_CAP) { atomicAdd(&bar[XB_TMO], 1u); break; } }
    }
    nloc = mine > 0u ? mine : 1u; nx = cnt > 0u ? cnt : 1u;
}
__device__ __forceinline__ void xcd_barrier(const XcdBarrier& b) {
    asm volatile("s_waitcnt vmcnt(0)" ::: "memory");
    __syncthreads();
    if (threadIdx.x == 0) {
        unsigned* bar = b.bar;
        __builtin_amdgcn_s_waitcnt(0);
        unsigned nloc = b.st[0], nx = b.st[1];
        if (nloc == 0u) { xcd_barrier_complete(bar, b.x, nloc, nx); b.st[0] = nloc; b.st[1] = nx; }
        const unsigned old = xb_add(&bar[XB_XSUB(b.x)], 1u);
        const unsigned gen = old / nloc;
        if (old + 1u == (gen + 1u) * nloc) {
            __builtin_amdgcn_fence(__ATOMIC_RELEASE, "agent");
            asm volatile("s_waitcnt vmcnt(0)" ::: "memory");
            const unsigned og = xb_add(&bar[XB_TOP], 1u);
            const unsigned tg = og / nx;
            if (og + 1u == (tg + 1u) * nx) xb_add(&bar[XB_TOPGEN], 1u);
            else XB_SPIN(xb_ld(&bar[XB_TOPGEN]) == tg, bar);
            __builtin_amdgcn_fence(__ATOMIC_ACQUIRE, "agent");
            xb_add(&bar[XB_XGEN(b.x)], 1u);
            asm volatile("s_waitcnt vmcnt(0)" ::: "memory");
        } else {
            XB_SPIN(xb_ld(&bar[XB_XGEN(b.x)]) == gen, bar);
            __builtin_amdgcn_fence(__ATOMIC_ACQUIRE, "agent");
            asm volatile("s_waitcnt vmcnt(0)" ::: "memory");
        }
    }
    __syncthreads();
}

__device__ __forceinline__ void xcd_barrier_l(const XcdBarrier& b) {
    asm volatile("s_waitcnt vmcnt(0)" ::: "memory");
    __syncthreads();
    if (threadIdx.x == 0) {
        unsigned* bar = b.bar; unsigned x = b.x;
        { unsigned long long _z = 0; asm volatile("" : "+s"(_z), "+s"(x)); bar = (unsigned*)(unsigned __attribute__((address_space(1)))*)((unsigned long long)bar + _z); }
        __builtin_amdgcn_s_waitcnt(0);
        const unsigned nloc = b.st[0], nx = b.st[1];
        const unsigned old = xb_add(&bar[XB_XSUB(x)], 1u);
        const unsigned gen = old / nloc;
        if (old + 1u == (gen + 1u) * nloc) {
            __builtin_amdgcn_fence(__ATOMIC_RELEASE, "agent");
            asm volatile("s_waitcnt vmcnt(0)" ::: "memory");
            const unsigned og = xb_add(&bar[XB_TOP], 1u);
            const unsigned tg = og / nx;
            if (og + 1u == (tg + 1u) * nx) xb_add(&bar[XB_TOPGEN], 1u);
            else XB_SPIN(xb_ld(&bar[XB_TOPGEN]) == tg, bar);
            __builtin_amdgcn_fence(__ATOMIC_ACQUIRE, "agent");
            xb_add(&bar[XB_XGEN(x)], 1u);
            asm volatile("s_waitcnt vmcnt(0)" ::: "memory");
        } else {
            XB_SPIN(xb_ld(&bar[XB_XGEN(x)]) == gen, bar);
            __builtin_amdgcn_fence(__ATOMIC_ACQUIRE, "agent");
            asm volatile("s_waitcnt vmcnt(0)" ::: "memory");
        }
    }
    __syncthreads();
}

__device__ __forceinline__ void phase_convert(char* ws, char* smem) {
  OPAQUE_WS(ws); int tid = threadIdx.x; asm volatile("" : "+v"(tid));
  const int lane = tid & 63, G = gridDim.x * 8, b0 = blockIdx.x * 8 + __builtin_amdgcn_readfirstlane(tid >> 6);
#pragma unroll 1
  for (int j = b0; j < 2 * (32768 - CV_SOLVE); j += G) { const int l = j / (32768 - CV_SOLVE), t = CV_SOLVE + j % (32768 - CV_SOLVE); moe_tile(ws, smem, l, t, lane); }
  { float* rot = wsp<float>(ws, WS::ROT); const int* pos = (const int*)in_ptr(smem, 1);
#pragma unroll 1
    for (int i = blockIdx.x * 512 + tid; i < T_ * 32; i += gridDim.x * 512) {
      const int t = i >> 5, j = i & 31; const float inv = exp2f(-(float)j * (13.287712379549449f / 32.f));
      float sn, cs; sincosf((float)pos[t] * inv, &sn, &cs); rot[2 * i] = cs; rot[2 * i + 1] = sn;
    } }
  { u16* wt = wsp<u16>(ws, WS::LRU_W);
#pragma unroll 1
    for (int i = blockIdx.x * 512 + tid; i < NL * 2 * 8 * 4096; i += gridDim.x * 512) {
      const int l = i / (2 * 8 * 4096), r = i % (2 * 8 * 4096), m = r / (8 * 4096), g = (r / 4096) & 7, jj = (r >> 6) & 63, ii = r & 63;
      wt[i] = f2bf(in_ptr(smem, m ? 22 : 20)[(((long)l * 8 + g) * 64 + ii) * 64 + jj]);
    } }
  { u16* wl = wsp<u16>(ws, WS::LORA_W);
#pragma unroll 1
    for (int i = blockIdx.x * 512 + tid; i < NL * 512 * 160; i += gridDim.x * 512) {
      const int l = i / (512 * 160), r = i % (512 * 160), c = r / 160, j = r % 160;
      const float v = j < 32 ? in_ptr(smem, 6)[((long)l * 32 + j) * 512 + c] : (j < 64 ? in_ptr(smem, 8)[((long)l * 32 + (j - 32)) * 512 + c] : in_ptr(smem, 9)[((long)l * 96 + (j - 64)) * 512 + c]);
      wl[i] = f2bf(v);
    } }
  { u16* thi = wsp<u16>(ws, WS::RT_HI); u16* tlo = wsp<u16>(ws, WS::RT_LO);
#pragma unroll 1
    for (int i = blockIdx.x * 512 + tid; i < NL * 48 * 2048; i += gridDim.x * 512) {
      const int l = i / (48 * 2048), r = i % (48 * 2048), c = r >> 11, k = r & 2047;
      float v = 0.f;
      if (c < 36) { const float g = in_ptr(smem, 31)[(long)l * DM + k]; v = g * (c < 4 ? in_ptr(smem, 32)[((long)l * DM + k) * 4 + c] : in_ptr(smem, 34)[((long)l * DM + k) * 32 + (c - 4)]); }
      const u16 hi = f2bf(v); thi[i] = hi; tlo[i] = f2bf(v - bf2f(hi));
    } }
#pragma unroll 1
  for (int j = b0; j < 2 * 100 * 32; j += G) { const int l = j / 3200, q = j % 3200, nt = q / 32, kt = q % 32;
    transpose_tile_w(in_ptr(smem, 3) + (long)l * DM * IN_COLS, IN_COLS, NONGATE, wsp<u16>(ws, WS::WT_IN) + (long)l * PC * DM, DM, nt * 64, kt * 64, 0, 0, lane); }
#pragma unroll 1
  for (int j = b0; j < 2 * 128 * 32; j += G) { const int l = j / 4096, q = j % 4096, nt = q / 32, kt = q % 32;
    transpose_tile_w(in_ptr(smem, 3) + (long)l * DM * IN_COLS + NONGATE, IN_COLS, 8192, wsp<u16>(ws, WS::WT_IN) + (long)l * PC * DM, DM, nt * 64, kt * 64, OFF_G, 0, lane); }
#pragma unroll 1
  for (int j = b0; j < 8 * 256; j += G) { const int lk = j / 256, q = j % 256, l = lk >> 2, kb = lk & 3, nt = q / 8, kt = q % 8;
    const float* src = in_ptr(smem, kb == 0 ? 15 : kb == 1 ? 17 : kb == 2 ? 25 : 29) + (long)l * MIXW * DM;
    transpose_tile_w(src, DM, DM, wsp<u16>(ws, WS::WT_O) + (long)l * DM * DM + kb * MIXW, DM, nt * 64, kt * 64, 0, 0, lane); }
#pragma unroll 1
  for (int j = b0; j < 2 * 1024; j += G) { const int l = j / 1024, q = j % 1024, nt = q / 32, kt = q % 32;
    transpose_tile_w(in_ptr(smem, 30) + (long)l * DM * DM, DM, DM, wsp<u16>(ws, WS::WT_OUT) + (long)l * DM * DM, DM, nt * 64, kt * 64, 0, 0, lane); }
}

__device__ __forceinline__ void convert_down(char* ws, const char* smem, int l, int wave, int nwaves, int lane) {
  const float* src = in_ptr(smem, 38) + (long)l * NEXP * DEXP * DM; u16* dst = wsp<u16>(ws, WS::WDN) + (long)l * NEXP * DM * DEXP;
#pragma unroll 1
  for (int j = wave; j < 32 * 512; j += nwaves) { const int e = j / 512, q = j % 512, nt = q / 16, kt = q % 16;
    transpose_tile_w(src + (long)e * DEXP * DM, DM, DM, dst + (long)e * DM * DEXP, DEXP, nt * 64, kt * 64, 0, 0, lane); }
}
struct NormArgs {
  const float* x; float* h; const float* g; u16* xn; float* out; const float* ybuf;
  const float* wg; const float* bg; const float* we; const float* be; int* tok_e; float* tok_g;
};
template <int MODE>
__device__ __forceinline__ void norm_row(const NormArgs& a, int row, int lane) {
  float v[32];
  const float* src = (MODE == 0) ? a.x : a.h;
  {
    f32x4 t8[8], y08[8], y18[8];
#pragma unroll
    for (int i = 0; i < 8; ++i) {
      t8[i] = *(const f32x4*)(src + (long)row * DM + i * 256 + lane * 4);
      if (MODE == 1 || MODE == 2) { y08[i] = *(const f32x4*)(a.ybuf + (long)(2 * row) * DM + i * 256 + lane * 4); y18[i] = *(const f32x4*)(a.ybuf + (long)(2 * row + 1) * DM + i * 256 + lane * 4); }
    }
    PIN8(t8); if (MODE == 1 || MODE == 2) { PIN8(y08); PIN8(y18); }
#pragma unroll
    for (int i = 0; i < 8; ++i) {
      f32x4 t = t8[i];
      if (MODE == 1 || MODE == 2) t = t + y08[i] + y18[i];
      if (MODE != 3 && MODE != 2) *(f32x4*)(a.h + (long)row * DM + i * 256 + lane * 4) = t;
      v[i * 4 + 0] = t[0]; v[i * 4 + 1] = t[1]; v[i * 4 + 2] = t[2]; v[i * 4 + 3] = t[3];
    }
  }
  float ss = 0.f;
#pragma unroll
  for (int i = 0; i < 32; ++i) ss += v[i] * v[i];
  ss = wave_sum(ss);
  const float rs = rsqrtf(ss * (1.f / DM) + 1e-6f);
  f32x4 gv8[8];
#pragma unroll
  for (int i = 0; i < 8; ++i) gv8[i] = *(const f32x4*)(a.g + i * 256 + lane * 4);
  PIN8(gv8);
#pragma unroll
  for (int i = 0; i < 8; ++i) {
    const f32x4 g = gv8[i];
#pragma unroll
    for (int j = 0; j < 4; ++j) v[i * 4 + j] = v[i * 4 + j] * rs * g[j];
    if (MODE == 2) {
      f32x4 o = {v[i * 4], v[i * 4 + 1], v[i * 4 + 2], v[i * 4 + 3]};
      *(f32x4*)(a.out + (long)row * DM + i * 256 + lane * 4) = o;
    } else {
      uint2 pk;
      pk.x = (unsigned)f2bf(v[i * 4]) | ((unsigned)f2bf(v[i * 4 + 1]) << 16);
      pk.y = (unsigned)f2bf(v[i * 4 + 2]) | ((unsigned)f2bf(v[i * 4 + 3]) << 16);
      *(uint2*)(a.xn + (long)row * DM + i * 256 + lane * 4) = pk;
    }
  }
}
template <int MODE>
__device__ __forceinline__ void phase_norm(const NormArgs& a) {
  int tid = threadIdx.x; asm volatile("" : "+v"(tid));
  const int lane = tid & 63;
  for (int row = blockIdx.x * 8 + (tid >> 6); row < T_; row += gridDim.x * 8) norm_row<MODE>(a, row, lane);
}

__device__ __forceinline__ void router_job(const NormArgs& a, const u16* __restrict__ thi, const u16* __restrict__ tlo, int job, char* smem, int tid, int* cnt, int* lst_slot, float* lst_gate) {
  const int w = __builtin_amdgcn_readfirstlane(tid >> 6), lane = tid & 63, r = lane & 15, g = lane >> 4, t0 = job * 64;
  float* part = (float*)smem;
  float* pss = part + 8 * 64 * 48;
  {
    f32x4 acc[4][3];
#pragma unroll
    for (int mt = 0; mt < 4; ++mt)
#pragma unroll
      for (int nt = 0; nt < 3; ++nt) acc[mt][nt] = (f32x4){0.f, 0.f, 0.f, 0.f};
    float ssq[4] = {0.f, 0.f, 0.f, 0.f};
    const float* hb = a.h + (long)(t0 + r) * DM + w * 256 + 8 * g;
    const u16* bh = thi + (long)r * 2048 + w * 256 + 8 * g; const u16* bl = tlo + (long)r * 2048 + w * 256 + 8 * g;
#pragma unroll 2
    for (int s_ = 0; s_ < 8; ++s_) {
      f32x4 x0[4], x1[4]; bf16x8 wh[3], wl[3];
#pragma unroll
      for (int mt = 0; mt < 4; ++mt) { x0[mt] = *(const f32x4*)(hb + (long)(16 * mt) * DM + 32 * s_); x1[mt] = *(const f32x4*)(hb + (long)(16 * mt) * DM + 32 * s_ + 4); }
#pragma unroll
      for (int nt = 0; nt < 3; ++nt) { wh[nt] = *(const bf16x8*)(bh + (long)(16 * nt) * 2048 + 32 * s_); wl[nt] = *(const bf16x8*)(bl + (long)(16 * nt) * 2048 + 32 * s_); }
#pragma unroll
      for (int mt = 0; mt < 4; ++mt) {
        const f32x4 a0 = x0[mt], a1 = x1[mt];
        ssq[mt] += a0[0] * a0[0] + a0[1] * a0[1] + a0[2] * a0[2] + a0[3] * a0[3] + a1[0] * a1[0] + a1[1] * a1[1] + a1[2] * a1[2] + a1[3] * a1[3];
        const unsigned h0 = pack_bf16(a0[0], a0[1]), h1 = pack_bf16(a0[2], a0[3]), h2 = pack_bf16(a1[0], a1[1]), h3 = pack_bf16(a1[2], a1[3]);
        const unsigned l0 = pack_bf16(a0[0] - __uint_as_float(h0 << 16), a0[1] - __uint_as_float(h0 & 0xffff0000u)), l1 = pack_bf16(a0[2] - __uint_as_float(h1 << 16), a0[3] - __uint_as_float(h1 & 0xffff0000u));
        const unsigned l2 = pack_bf16(a1[0] - __uint_as_float(h2 << 16), a1[1] - __uint_as_float(h2 & 0xffff0000u)), l3 = pack_bf16(a1[2] - __uint_as_float(h3 << 16), a1[3] - __uint_as_float(h3 & 0xffff0000u));
        const bf16x8 xh = frag_of(h0, h1, h2, h3), xl = frag_of(l0, l1, l2, l3);
#pragma unroll
        for (int nt = 0; nt < 3; ++nt) {
          acc[mt][nt] = __builtin_amdgcn_mfma_f32_16x16x32_bf16(xh, wh[nt], acc[mt][nt], 0, 0, 0);
          acc[mt][nt] = __builtin_amdgcn_mfma_f32_16x16x32_bf16(xh, wl[nt], acc[mt][nt], 0, 0, 0);
          acc[mt][nt] = __builtin_amdgcn_mfma_f32_16x16x32_bf16(xl, wh[nt], acc[mt][nt], 0, 0, 0);
        }
      }
    }
#pragma unroll
    for (int mt = 0; mt < 4; ++mt)
#pragma unroll
      for (int nt = 0; nt < 3; ++nt)
#pragma unroll
        for (int reg = 0; reg < 4; ++reg) part[(w * 64 + 16 * mt + 4 * g + reg) * 48 + 16 * nt + r] = acc[mt][nt][reg];
#pragma unroll
    for (int mt = 0; mt < 4; ++mt) { float v = ssq[mt]; v += __shfl_xor(v, 16, 64); v += __shfl_xor(v, 32, 64); if (g == 0) pss[w * 64 + 16 * mt + r] = v; }
  }
  lds_barrier();
  if (tid < 64) {
    const int tl = tid, t = t0 + tl;
    float lgt[36]; float ss = 0.f;
#pragma unroll
    for (int c = 0; c < 36; ++c) lgt[c] = 0.f;
#pragma unroll 1
    for (int q = 0; q < 8; ++q) {
#pragma unroll
      for (int c = 0; c < 36; ++c) lgt[c] += part[(q * 64 + tl) * 48 + c];
      ss += pss[q * 64 + tl];
    }
    const float rs = rsqrtf(ss * (1.f / DM) + 1e-6f);
    f32x4 bgv = *(const f32x4*)a.bg, bev[8];
#pragma unroll
    for (int q = 0; q < 8; ++q) bev[q] = *(const f32x4*)(a.be + 4 * q);
    asm volatile("" :: "v"(bgv), "v"(bev[0]), "v"(bev[1]), "v"(bev[2]), "v"(bev[3]), "v"(bev[4]), "v"(bev[5]), "v"(bev[6]), "v"(bev[7]));
    float lg[4];
#pragma unroll
    for (int c = 0; c < 4; ++c) lg[c] = lgt[c] * rs + bgv[c];
    int gi = 0; float gm = lg[0];
#pragma unroll
    for (int c = 1; c < 4; ++c) if (lg[c] > gm) { gm = lg[c]; gi = c; }
    float gs = 0.f;
#pragma unroll
    for (int c = 0; c < 4; ++c) gs += __expf(lg[c] - gm);
    const float pg = 1.f / gs;
    float le[8];
#pragma unroll
    for (int j = 0; j < 8; ++j) {
      const float l0 = lgt[4 + j] * rs + bev[j >> 2][j & 3], l1 = lgt[12 + j] * rs + bev[2 + (j >> 2)][j & 3], l2 = lgt[20 + j] * rs + bev[4 + (j >> 2)][j & 3], l3 = lgt[28 + j] * rs + bev[6 + (j >> 2)][j & 3];
      le[j] = gi == 0 ? l0 : (gi == 1 ? l1 : (gi == 2 ? l2 : l3));
    }
    int i1 = 0; float m1 = le[0];
#pragma unroll
    for (int j = 1; j < 8; ++j) if (le[j] > m1) { m1 = le[j]; i1 = j; }
    int i2 = -1; float m2 = -3.0e38f;
#pragma unroll
    for (int j = 0; j < 8; ++j) if (j != i1 && le[j] > m2) { m2 = le[j]; i2 = j; }
    const float w1 = 1.f / (1.f + __expf(m2 - m1)), w2 = 1.f - w1;
    if (i2 < 0) i2 = (i1 + 1) & 7;
    const int e0 = gi * 8 + i1, e1 = gi * 8 + i2;
    const int p0 = atomicAdd(cnt + e0, 1) & (LCAP - 1), p1 = atomicAdd(cnt + e1, 1) & (LCAP - 1);
    lst_slot[e0 * LCAP + p0] = 2 * t; lst_gate[e0 * LCAP + p0] = pg * w1;
    lst_slot[e1 * LCAP + p1] = 2 * t + 1; lst_gate[e1 * LCAP + p1] = pg * w2;
  }
  lds_barrier();
}
__device__ __forceinline__ void phase_n3(char* ws, const NormArgs& a, char* smem, int l) {
  OPAQUE_WS(ws);
  int tid = threadIdx.x; asm volatile("" : "+v"(tid));
  int* cnt = wsp<int>(ws, WS::TILE_EXP); int* lst_slot = wsp<int>(ws, WS::LST_SLOT); float* lst_gate = wsp<float>(ws, WS::LST_GATE);
#pragma unroll 1
  for (int job = blockIdx.x; job < 256; job += gridDim.x) {
    if (job < 128) router_job(a, wsp<u16>(ws, WS::RT_HI) + (long)l * 48 * 2048, wsp<u16>(ws, WS::RT_LO) + (long)l * 48 * 2048, job, smem, tid, cnt, lst_slot, lst_gate);
    else { const int r0 = (job - 128) * 64 + (tid >> 6) * 8;
#pragma unroll 1
      for (int i = 0; i < 8; ++i) norm_row<3>(a, r0 + i, tid & 63); }
  }
}
__device__ __forceinline__ void moe_tiles(char* ws, int* tstart, int tid) {
  const int* cnt = wsp<int>(ws, WS::TILE_EXP);
  if (tid < 32) tstart[40 + tid] = ld_i(cnt + tid);
  lds_barrier();
  if (tid < 32) {
    int acc = 0;
#pragma unroll 1
    for (int e2 = 0; e2 < tid; ++e2) acc += (tstart[40 + e2] + 255) >> 8;
    tstart[tid] = acc;
    if (tid == 31) tstart[32] = acc + ((tstart[40 + 31] + 255) >> 8);
  }
  lds_barrier();
}

template <int MODE>
__device__ __forceinline__ void phase_gemm(char* ws, int l, u16* shm) {
  OPAQUE_WS(ws);
  if (MODE == 0) {
    const u16* Bt = wsp<u16>(ws, WS::WT_IN) + (long)l * PC * DM; const u16* xn = wsp<u16>(ws, WS::XN); u16* proj = wsp<u16>(ws, WS::PROJ);
    static_assert(PC / 256 == 57 && OFF_G <= 56 * 256, "the 57th column tile must hold gate columns only (it is computed during the mixer phase)");
#pragma unroll 1
    for (int u = blockIdx.x; u < 7 * 256; u += gridDim.x) {
      int pm, pn; unit_map(u & 255, u >> 8, pm, pn);
      EpiProj e{proj, pm * 256, pn * 256};
      gemm256(xn + (long)pm * 256 * DM, DM, Bt + (long)pn * 256 * DM, DM, DM, shm, e);
    }
  } else if (MODE == 1) {
    const u16* Bt = wsp<u16>(ws, WS::WT_O) + (long)l * DM * DM; const u16* ycat = wsp<u16>(ws, WS::YCAT);
    const u16* gates = wsp<u16>(ws, WS::PROJ) + OFF_G; u16* merged = wsp<u16>(ws, WS::MERGED);
#pragma unroll 1
    for (int u = blockIdx.x; u < 512; u += gridDim.x) {
      int pm, pn2; unit_map(u & 255, 0, pm, pn2);
      const int pn = pn2 * 2 + (u >> 8);
      gemm_merge(ycat, Bt, gates, merged, pm * 256, pn * 128, shm);
    }
  } else if (MODE == 2) {
    const u16* Bt = wsp<u16>(ws, WS::WT_OUT) + (long)l * DM * DM; const u16* merged = wsp<u16>(ws, WS::MERGED);
#pragma unroll 1
    for (int u = blockIdx.x; u < 256; u += gridDim.x) {
      int pm, pn; unit_map(u, 0, pm, pn);
      EpiResid e{wsp<float>(ws, WS::H), pm * 256, pn * 256};
      gemm256(merged + (long)pm * 256 * DM, DM, Bt + (long)pn * 256 * DM, DM, DM, shm, e);
    }
  } else if (MODE == 3) {
    int tid = threadIdx.x; asm volatile("" : "+v"(tid));
    int* tstart = (int*)((char*)shm + SHM_B); moe_tiles(ws, tstart, tid);
    const int nu = tstart[32] * 8; const u16* Bt = wsp<u16>(ws, WS::WGU) + (long)l * NEXP * 2048 * DM; const u16* xn = wsp<u16>(ws, WS::XN);
    const int* lst_slot = wsp<int>(ws, WS::LST_SLOT);
#pragma unroll 1
    for (int u = blockIdx.x; u < nu; u += gridDim.x) {
      const int rt = u >> 3, ct = u & 7; int ex = 0;
#pragma unroll 1
      while (rt >= tstart[ex + 1]) ++ex;
      const int rtl = rt - tstart[ex], nvalid = tstart[40 + ex] - rtl * 256;
      int arow[4];
#pragma unroll
      for (int i = 0; i < 2; ++i) { int r_, c_; stage_rc(tid * 16 + i * 8192, r_, c_);
#pragma unroll
        for (int hf = 0; hf < 2; ++hf) { const int r = hf * HALF + r_; arow[hf * 2 + i] = (r < nvalid ? (lst_slot[ex * LCAP + rtl * 256 + r] >> 1) : 0) * (DM * 2) + c_ * 2; } }
      EpiGateUp e{wsp<u16>(ws, WS::HMID), rt * 256, ct};
      gemm256g<true>(xn, DM, Bt + ((long)ex * 2048 + ct * 256) * DM, DM, DM, shm, e, arow);
    }
  } else {
    int tid = threadIdx.x; asm volatile("" : "+v"(tid));
    int* tstart = (int*)((char*)shm + SHM_B); moe_tiles(ws, tstart, tid);
    const int nu = tstart[32] * 8; const u16* Bt = wsp<u16>(ws, WS::WDN) + (long)l * NEXP * DM * DEXP; const u16* hmid = wsp<u16>(ws, WS::HMID);
#pragma unroll 1
    for (int u = blockIdx.x; u < nu; u += gridDim.x) {
      const int rt = u >> 3, ct = u & 7; int ex = 0;
#pragma unroll 1
      while (rt >= tstart[ex + 1]) ++ex;
      const int rtl = rt - tstart[ex], nvalid = tstart[40 + ex] - rtl * 256;
      EpiDown e{wsp<float>(ws, WS::YBUF), wsp<int>(ws, WS::LST_SLOT) + ex * LCAP + rtl * 256, wsp<float>(ws, WS::LST_GATE) + ex * LCAP + rtl * 256, nvalid, ct * 256};
      gemm256(hmid + (long)rt * 256 * DEXP, DEXP, Bt + ((long)ex * DM + ct * 256) * DEXP, DEXP, DEXP, shm, e);
    }
  }
}

__device__ __forceinline__ MixP make_mixp(char* ws, const char* smem, int l) {
  OPAQUE_WS(ws); asm volatile("" : "+s"(l));
  MixP mp;
  mp.proj = wsp<u16>(ws, WS::PROJ); mp.pos = (const int*)in_ptr(smem, 1); mp.ycat = wsp<u16>(ws, WS::YCAT); mp.ws = ws; mp.smem = smem; mp.layer = l; mp.rot = wsp<float>(ws, WS::ROT);
  MixBuf& b = mp.b;
  b.rw_Rb = wsp<u16>(ws, WS::RW_RB); b.rw_Pab = wsp<u16>(ws, WS::RW_PAB); b.rw_Pak = wsp<u16>(ws, WS::RW_PAK); b.rw_VT = wsp<u16>(ws, WS::RW_VT); b.rw_S0 = wsp<u16>(ws, WS::RW_S0); b.rw_UT = wsp<u16>(ws, WS::RW_UT);
  b.rw_WpF = wsp<u16>(ws, WS::RW_WPF); b.rw_BtF = wsp<u16>(ws, WS::RW_BTF); b.rw_G = wsp<u16>(ws, WS::RW_G); b.rw_BV = wsp<u16>(ws, WS::RW_BV);
  b.rw_U0F = wsp<float>(ws, WS::RW_U0F); b.rw_KVF = wsp<float>(ws, WS::RW_KVF); b.rw_gam = wsp<float>(ws, WS::RW_GAM);
  b.rt_Rb = wsp<u16>(ws, WS::RT_RB); b.rt_Pak = wsp<u16>(ws, WS::RT_PAK); b.rt_VT = wsp<u16>(ws, WS::RT_VT); b.rt_S0 = wsp<u16>(ws, WS::RT_S0); b.rt_KVT = wsp<float>(ws, WS::RT_KVT);
  b.gl_Rb = wsp<u16>(ws, WS::GL_RB); b.gl_Pak = wsp<u16>(ws, WS::GL_PAK); b.gl_VT = wsp<u16>(ws, WS::GL_VT); b.gl_S0 = wsp<u16>(ws, WS::GL_S0); b.gl_KVT = wsp<float>(ws, WS::GL_KVT); b.gl_gam = wsp<float>(ws, WS::GL_GAM);
  b.lr_h = wsp<float>(ws, WS::LR_H); b.lr_A = wsp<float>(ws, WS::LR_A); b.lr_Hp = wsp<float>(ws, WS::LR_HP);
  mp.rw = RwkvP{in_ptr(smem, 4) + l * 1696, in_ptr(smem, 5) + l * 512, in_ptr(smem, 6) + l * 32 * 512, in_ptr(smem, 7) + l * 512, in_ptr(smem, 8) + l * 32 * 512, in_ptr(smem, 9) + l * 96 * 512,
                in_ptr(smem, 10) + l * 512, in_ptr(smem, 11) + l * 512, in_ptr(smem, 12) + l * 512, in_ptr(smem, 13) + l * 512, in_ptr(smem, 14) + l * 512, wsp<u16>(ws, WS::LORA_W) + (long)l * 512 * 160};
  mp.ret_norm_g = in_ptr(smem, 16) + l * 512;
  mp.lru = LruP{in_ptr(smem, 18) + l * 4 * 512, in_ptr(smem, 19) + l * 512, in_ptr(smem, 20) + l * 8 * 64 * 64, in_ptr(smem, 21) + l * 512, in_ptr(smem, 22) + l * 8 * 64 * 64, in_ptr(smem, 23) + l * 512, in_ptr(smem, 24) + l * 512, wsp<u16>(ws, WS::LRU_W) + (long)l * 2 * 8 * 4096};
  mp.gla_alpha_up = in_ptr(smem, 26) + l * 16 * 256; mp.gla_alpha_b = in_ptr(smem, 27) + l * 256; mp.gla_norm_g = in_ptr(smem, 28) + l * 512;
  return mp;
}
__device__ __forceinline__ void mix4_convert(char* ws, const char* smem, int l) {
  OPAQUE_WS(ws);
  int t_ = threadIdx.x; asm volatile("" : "+v"(t_));
  const int big = gridDim.x > 32;
  const int nb = big ? (int)gridDim.x - 32 : (int)gridDim.x;
  const int bi = big ? (int)blockIdx.x - 32 : (int)blockIdx.x;
  if (bi >= 0) convert_down(ws, smem, l, bi * 8 + __builtin_amdgcn_readfirstlane(t_ >> 6), nb * 8, t_ & 63);
}
constexpr int PH_PER_LAYER = 10, N_PHASES = 1 + NL * PH_PER_LAYER + 1;
#ifndef PROBE_MASK
#define PROBE_MASK 0
#endif
#define RUN_PH(id, code) do { const int _id = (id); if (_id >= ph0 && _id < ph1) { const int _kind = _id == 0 ? 12 : (_id == N_PHASES - 1 ? 13 : (_id - 1) % PH_PER_LAYER); \
    if ((PROBE_MASK >> _kind) & 1) { code; xcd_barrier_l(bar); } code; if (_id + 1 < ph1) xcd_barrier_l(bar); } } while (0)
__global__ __launch_bounds__(512, 2) void k_mega(MegaP p, int ph0, int ph1) {
  extern __shared__ __attribute__((aligned(16))) char smem0[];
  volatile LAS unsigned* xbw = (volatile LAS unsigned*)(smem0 + XBW_OFF);
  char* const smem = smem0 + PH_OFF;
  if (threadIdx.x == 0) {
    xbw[0] = 0u; xbw[1] = 0u; xbw[2] = 0u; xbw[3] = 0u;
    unsigned long long* tbl = (unsigned long long*)(smem0 + TBL_OFF);
#pragma unroll
    for (int i = 0; i < 40; ++i) tbl[i] = (unsigned long long)p.in[i];
  }
  __syncthreads();
  char* ws = p.ws; float* outp = p.out;
  const XcdBarrier bar = xcd_barrier_post((unsigned*)ws, xbw);
  if (ph1 - ph0 > 1) xcd_barrier(bar);
  RUN_PH(0, { phase_convert(ws, smem); NormArgs a{}; a.x = in_ptr(smem, 0); a.h = wsp<float>(ws, WS::H); a.g = in_ptr(smem, 2); a.xn = wsp<u16>(ws, WS::XN); phase_norm<0>(a); });
#pragma unroll 1
  for (int l = 0; l < NL; ++l) {
    const int pb = 1 + l * PH_PER_LAYER;
    RUN_PH(pb + 0, { if (l > 0) { NormArgs a{}; a.h = wsp<float>(ws, WS::H); a.g = in_ptr(smem, 2) + (long)l * DM; a.xn = wsp<u16>(ws, WS::XN); a.ybuf = wsp<float>(ws, WS::YBUF); phase_norm<1>(a); } });
    RUN_PH(pb + 1, phase_gemm<0>(ws, l, (u16*)smem));
    RUN_PH(pb + 2, { const MixP mp = make_mixp(ws, smem, l); phase_mix3(mp, smem); });
    RUN_PH(pb + 3, { const MixP mp = make_mixp(ws, smem, l); phase_mix4(mp, smem); mix4_convert(ws, smem, l); });
    RUN_PH(pb + 4, { const MixP mp = make_mixp(ws, smem, l); phase_mix5(mp, smem); { int t_ = threadIdx.x; asm volatile("" : "+v"(t_)); if (blockIdx.x == 0 && t_ < 32) wsp<int>(ws, WS::TILE_EXP)[t_] = 0; } });
    RUN_PH(pb + 5, phase_gemm<1>(ws, l, (u16*)smem));
    RUN_PH(pb + 6, phase_gemm<2>(ws, l, (u16*)smem));
    RUN_PH(pb + 7, { NormArgs a{}; a.h = wsp<float>(ws, WS::H); a.g = in_ptr(smem, 31) + (long)l * DM; a.xn = wsp<u16>(ws, WS::XN); a.wg = in_ptr(smem, 32) + (long)l * DM * 4; a.bg = in_ptr(smem, 33) + l * 4;
      a.we = in_ptr(smem, 34) + (long)l * DM * 32; a.be = in_ptr(smem, 35) + l * 32; phase_n3(ws, a, smem, l); });
    RUN_PH(pb + 8, phase_gemm<3>(ws, l, (u16*)smem));
    RUN_PH(pb + 9, phase_gemm<4>(ws, l, (u16*)smem));
  }
  RUN_PH(N_PHASES - 1, { NormArgs a{}; a.h = wsp<float>(ws, WS::H); a.g = in_ptr(smem, 39); a.out = outp; a.ybuf = wsp<float>(ws, WS::YBUF); phase_norm<2>(a); });
}


extern "C" void kernel_launch(void* const* d_in, const int* in_sizes, int n_in, void* d_out, int out_size, void* d_ws, size_t ws_size, hipStream_t stream) {
  (void)in_sizes; (void)n_in; (void)out_size; (void)ws_size;
  MegaP p{};
  for (int i = 0; i < 40; ++i) p.in[i] = (const float*)d_in[i];
  p.ws = (char*)d_ws; p.out = (float*)d_out;
  static int grid = 0;
  if (!grid) {
    (void)hipFuncSetAttribute((const void*)k_mega, hipFuncAttributeMaxDynamicSharedMemorySize, LDS_BYTES);
    int dev = 0, cus = 0, per_cu = 0;
    (void)hipGetDevice(&dev);
    (void)hipDeviceGetAttribute(&cus, hipDeviceAttributeMultiprocessorCount, dev);
    (void)hipOccupancyMaxActiveBlocksPerMultiprocessor(&per_cu, (const void*)k_mega, 512, LDS_BYTES);
    grid = cus < 256 ? cus : 256;
    if (per_cu < 1) grid = 0;
  }
#ifndef MK_SPLIT
#define MK_SPLIT 0
#define PROBE_MASK 0
#endif
  if (grid > 0) {
    if (MK_SPLIT) { for (int ph = 0; ph < N_PHASES; ++ph) k_mega<<<grid, 512, LDS_BYTES, stream>>>(p, ph, ph + 1); }
    else { (void)hipMemsetAsync(d_ws, 0, 16384, stream);   k_mega<<<grid, 512, LDS_BYTES, stream>>>(p, 0, N_PHASES); }
  }
}
```
